# Optimizing an MI355X kernel written in HIP

```python
import math
import jax, jax.numpy as jnp
from jax import lax
import numpy as np


D_MODEL = 1024
BATCH = 8
SEQ = 4096
DEPTH = 2

MIX_WIDTH = D_MODEL
A_WIDTH = MIX_WIDTH // 2
B_WIDTH = MIX_WIDTH - A_WIDTH
C_WIDTH = MIX_WIDTH // 2
D_WIDTH = MIX_WIDTH - C_WIDTH
LRU_HEADS = 8
LRU_HEAD_DIM = A_WIDTH // LRU_HEADS
LRU_C = 8.0
CONV_WIDTH = 4
S5_GROUP_CH = 16
S5_GROUPS = B_WIDTH // S5_GROUP_CH
S5_STATE = 64
MLSTM_HEADS = 4
MLSTM_HEAD_DIM = C_WIDTH // MLSTM_HEADS
MLSTM_CHUNK = 64
DSW_HEADS = 4
DSW_HEAD_DIM = D_WIDTH // DSW_HEADS
DSW_CONFIGS = ((128, 1), (512, 4), (2048, 16))
DSW_BLOCK = 128
ROPE_THETA = 500000.0
ROPE_DIMS = DSW_HEAD_DIM // 4
N_EXPERTS = 32
TOP_K = 4
D_EXPERT = D_MODEL
SWIGLU_LIMIT = 7.0
SWIGLU_ALPHA = 1.702
MOE_BLOCK = 128
DEEPNORM_ALPHA = (2 * DEPTH) ** 0.25
DEEPNORM_BETA = (8 * DEPTH) ** -0.25
LN_EPS = 1e-5
N_AB = (DEPTH + 1) // 2
N_CD = DEPTH // 2
AB_IN = 2 * A_WIDTH + B_WIDTH
CD_IN = 2 * C_WIDTH + 3 * D_WIDTH

kernel_name = 'hybrid_rglru_s5_mlstm_dilated_moe'


def _layer_norm(x, g, b):
    xf = x.astype(jnp.float32)
    mu = xf.mean(-1, keepdims=True)
    var = jnp.square(xf - mu).mean(-1, keepdims=True)
    return ((xf - mu) * lax.rsqrt(var + LN_EPS) * g + b).astype(x.dtype)


def _causal_dwconv(x, w, b):
    seq = x.shape[1]
    xp = jnp.pad(x, ((0, 0), (CONV_WIDTH - 1, 0), (0, 0)))
    out = b
    for tap in range(CONV_WIDTH):
        out = out + xp[:, tap:tap + seq] * w[tap]
    return out


def _linear_combine(e1, e2):
    a1, b1 = e1
    a2, b2 = e2
    return (a1 * a2, a2 * b1 + b2)


def _complex_linear_combine(e1, e2):
    a1r, a1i, b1r, b1i = e1
    a2r, a2i, b2r, b2i = e2
    return (a2r * a1r - a2i * a1i, a2r * a1i + a2i * a1r,
            a2r * b1r - a2i * b1i + b2r, a2r * b1i + a2i * b1r + b2i)


def _rg_lru(x, gate_r_w, gate_r_b, gate_i_w, gate_i_b, lru_lambda):
    bsz, seq, width = x.shape
    xh = x.reshape(bsz, seq, LRU_HEADS, LRU_HEAD_DIM)
    r = jax.nn.sigmoid(jnp.einsum('blhi,hij->blhj', xh, gate_r_w).reshape(bsz, seq, width) + gate_r_b)
    i = jax.nn.sigmoid(jnp.einsum('blhi,hij->blhj', xh, gate_i_w).reshape(bsz, seq, width) + gate_i_b)
    log_a = -LRU_C * r.astype(jnp.float32) * jax.nn.softplus(-lru_lambda.astype(jnp.float32))
    a = jnp.exp(log_a)
    u = jnp.sqrt(-jnp.expm1(2.0 * log_a)) * (i * x).astype(jnp.float32)
    _, h = lax.associative_scan(_linear_combine, (a, u), axis=1)
    return h.astype(x.dtype)


def _s5(u, lam_re, lam_im, log_step, b_re, b_im, c_re, c_im, d_skip):
    bsz, seq, width = u.shape
    f32 = jnp.float32
    ug = u.astype(f32).reshape(bsz, seq, S5_GROUPS, S5_GROUP_CH)
    lr = jnp.minimum(lam_re.astype(f32), -1e-4)
    li = lam_im.astype(f32)
    step = jnp.exp(log_step.astype(f32))[:, None]
    mag = jnp.exp(lr * step)
    ar = mag * jnp.cos(li * step)
    ai = mag * jnp.sin(li * step)
    inv = 1.0 / (lr * lr + li * li)
    zr = ((ar - 1.0) * lr + ai * li) * inv
    zi = (ai * lr - (ar - 1.0) * li) * inv
    bbr = zr[..., None] * b_re.astype(f32) - zi[..., None] * b_im.astype(f32)
    bbi = zr[..., None] * b_im.astype(f32) + zi[..., None] * b_re.astype(f32)
    bu_r = jnp.einsum('blgh,gph->blgp', ug, bbr)
    bu_i = jnp.einsum('blgh,gph->blgp', ug, bbi)
    a_r = jnp.broadcast_to(ar, (1, seq) + ar.shape)
    a_i = jnp.broadcast_to(ai, (1, seq) + ai.shape)
    _, _, xr, xi = lax.associative_scan(_complex_linear_combine, (a_r, a_i, bu_r, bu_i), axis=1)
    y = (jnp.einsum('blgp,ghp->blgh', xr, c_re.astype(f32))
         - jnp.einsum('blgp,ghp->blgh', xi, c_im.astype(f32))
         + d_skip.astype(f32) * ug)
    return y.reshape(bsz, seq, width).astype(u.dtype)


def _rglru_s5_mixer(x, w_in, conv_w, conv_b, gate_r_w, gate_r_b, gate_i_w, gate_i_b, lru_lambda,
                    lam_re, lam_im, log_step, b_re, b_im, c_re, c_im, d_skip, glu_w, glu_b, w_out):
    proj = x @ w_in
    xa = proj[..., :A_WIDTH]
    ga = proj[..., A_WIDTH:2 * A_WIDTH]
    ub = proj[..., 2 * A_WIDTH:]
    ya = _rg_lru(_causal_dwconv(xa, conv_w, conv_b), gate_r_w, gate_r_b, gate_i_w, gate_i_b,
                 lru_lambda) * jax.nn.gelu(ga)
    s = jax.nn.gelu(_s5(ub, lam_re, lam_im, log_step, b_re, b_im, c_re, c_im, d_skip))
    yb = s * jax.nn.sigmoid(s @ glu_w + glu_b)
    return jnp.concatenate([ya, yb], axis=-1) @ w_out


def _mlstm_chunkwise(q, k, v, i_pre, f_pre):
    bsz, seq, heads, dk = q.shape
    dv = v.shape[-1]
    cs = MLSTM_CHUNK
    nc = seq // cs
    f32 = jnp.float32
    qc = q.astype(f32).reshape(bsz, nc, cs, heads, dk)
    kc = k.astype(f32).reshape(bsz, nc, cs, heads, dk)
    vc = v.astype(f32).reshape(bsz, nc, cs, heads, dv)
    log_f = jax.nn.log_sigmoid(f_pre.astype(f32)).reshape(bsz, nc, cs, heads).transpose(0, 1, 3, 2)
    log_i = i_pre.astype(f32).reshape(bsz, nc, cs, heads).transpose(0, 1, 3, 2)
    cum_f = jnp.cumsum(log_f, axis=-1)
    chunk_f = cum_f[..., -1]
    to_end = chunk_f[..., None] - cum_f + log_i
    m_chunk = to_end.max(-1)
    w_end = jnp.exp(to_end - m_chunk[..., None])
    kv_chunk = jnp.einsum('bnhc,bnchk,bnchv->bnhkv', w_end, kc, vc)
    n_chunk = jnp.einsum('bnhc,bnchk->bnhk', w_end, kc)

    def step(carry, inp):
        c_st, n_st, m_st = carry
        f_c, m_c, kv_c, nk_c = inp
        m_new = jnp.maximum(f_c + m_st, m_c)
        s_old = jnp.exp(f_c + m_st - m_new)
        s_new = jnp.exp(m_c - m_new)
        c_new = s_old[..., None, None] * c_st + s_new[..., None, None] * kv_c
        n_new = s_old[..., None] * n_st + s_new[..., None] * nk_c
        return (c_new, n_new, m_new), (c_st, n_st, m_st)

    init = (jnp.zeros((bsz, heads, dk, dv), f32), jnp.zeros((bsz, heads, dk), f32),
            jnp.full((bsz, heads), -jnp.inf, f32))
    xs = (chunk_f.transpose(1, 0, 2), m_chunk.transpose(1, 0, 2),
          kv_chunk.transpose(1, 0, 2, 3, 4), n_chunk.transpose(1, 0, 2, 3))
    _, (c_prev, n_prev, m_prev) = lax.scan(step, init, xs)
    c_prev = c_prev.transpose(1, 0, 2, 3, 4)
    n_prev = n_prev.transpose(1, 0, 2, 3)
    m_prev = m_prev.transpose(1, 0, 2)

    causal = jnp.tril(jnp.ones((cs, cs), dtype=bool))
    log_d = jnp.where(causal, cum_f[..., :, None] - cum_f[..., None, :] + log_i[..., None, :], -jnp.inf)
    log_inter = cum_f + m_prev[..., None]
    m_s = jnp.maximum(log_d.max(-1), log_inter)
    scores = jnp.einsum('bnshk,bnjhk->bnhsj', qc, kc) * jnp.exp(log_d - m_s[..., None])
    inter = jnp.exp(log_inter - m_s)
    num = (jnp.einsum('bnhsj,bnjhv->bnhsv', scores, vc)
           + inter[..., None] * jnp.einsum('bnshk,bnhkv->bnhsv', qc, c_prev))
    den = scores.sum(-1) + inter * jnp.einsum('bnshk,bnhk->bnhs', qc, n_prev)
    h = num / jnp.maximum(jnp.abs(den), jnp.exp(-m_s))[..., None]
    return h.transpose(0, 1, 3, 2, 4).reshape(bsz, seq, heads, dv)


def _partial_rope(t, positions):
    half = ROPE_DIMS // 2
    inv_freq = ROPE_THETA ** (-jnp.arange(half, dtype=jnp.float32) / half)
    ang = positions.astype(jnp.float32)[..., None] * inv_freq
    cos = jnp.cos(ang)[:, :, None, :]
    sin = jnp.sin(ang)[:, :, None, :]
    tf = t.astype(jnp.float32)
    t1, t2, rest = tf[..., :half], tf[..., half:ROPE_DIMS], tf[..., ROPE_DIMS:]
    return jnp.concatenate([t1 * cos - t2 * sin, t2 * cos + t1 * sin, rest], axis=-1).astype(t.dtype)


def _strided_band_attention(q, k, v, span, dil):
    bsz, seq, heads, dh = q.shape
    n = seq // dil
    n_pad = -(-n // DSW_BLOCK) * DSW_BLOCK
    nb = n_pad // DSW_BLOCK

    def blocks(t):
        t = t.reshape(bsz, n, dil, heads, dh).transpose(0, 2, 1, 3, 4).reshape(bsz * dil, n, heads, dh)
        t = jnp.pad(t, ((0, 0), (0, n_pad - n), (0, 0), (0, 0)))
        return t.reshape(bsz * dil, nb, DSW_BLOCK, heads, dh)

    def with_prev(t):
        prev = jnp.pad(t, ((0, 0), (1, 0), (0, 0), (0, 0), (0, 0)))[:, :-1]
        return jnp.concatenate([prev, t], axis=2)

    qb = blocks(q)
    kk = with_prev(blocks(k))
    vv = with_prev(blocks(v))
    s = jnp.einsum('znqhd,znkhd->znhqk', qb, kk).astype(jnp.float32) * dh ** -0.5
    blk = jnp.arange(nb)[:, None] * DSW_BLOCK
    qpos = blk + jnp.arange(DSW_BLOCK)[None, :]
    kpos = blk - DSW_BLOCK + jnp.arange(2 * DSW_BLOCK)[None, :]
    dist = qpos[:, :, None] - kpos[:, None, :]
    valid = (dist >= 0) & (dist <= span) & (kpos[:, None, :] >= 0)
    s = jnp.where(valid[None, :, None], s, -jnp.inf)
    m = s.max(-1, keepdims=True)
    p = jnp.exp(s - m)
    l = p.sum(-1, keepdims=True)
    o = jnp.einsum('znhqk,znkhd->znqhd', p / l, vv.astype(jnp.float32))
    lse = (m + jnp.log(l))[..., 0]
    o = o.reshape(bsz, dil, n_pad, heads, dh)[:, :, :n].transpose(0, 2, 1, 3, 4).reshape(bsz, seq, heads, dh)
    lse = lse.transpose(0, 1, 3, 2).reshape(bsz, dil, n_pad, heads)[:, :, :n]
    lse = lse.transpose(0, 2, 1, 3).reshape(bsz, seq, heads)
    return o, lse


def _dilated_window_attention(q, k, v):
    outs, lses = [], []
    for window, dil in DSW_CONFIGS:
        o, lse = _strided_band_attention(q, k, v, window // dil, dil)
        outs.append(o)
        lses.append(lse)
    wts = jax.nn.softmax(jnp.stack(lses), axis=0)
    return jnp.einsum('gblh,gblhd->blhd', wts, jnp.stack(outs))


def _mlstm_dsw_mixer(x, positions, w_in, conv_w, conv_b, w_q, w_k, w_v, w_if, b_if, w_out):
    bsz, seq, _ = x.shape
    proj = x @ w_in
    xc = proj[..., :C_WIDTH]
    o_pre = proj[..., C_WIDTH:2 * C_WIDTH]
    qkv = proj[..., 2 * C_WIDTH:].reshape(bsz, seq, 3, DSW_HEADS, DSW_HEAD_DIM)
    xconv = jax.nn.silu(_causal_dwconv(xc, conv_w, conv_b)).reshape(bsz, seq, MLSTM_HEADS, MLSTM_HEAD_DIM)
    xraw = xc.reshape(bsz, seq, MLSTM_HEADS, MLSTM_HEAD_DIM)
    q = jnp.einsum('blhi,hij->blhj', xconv, w_q)
    k = jnp.einsum('blhi,hij->blhj', xconv, w_k) * MLSTM_HEAD_DIM ** -0.5
    v = jnp.einsum('blhi,hij->blhj', xraw, w_v)
    gate_in = jnp.concatenate([q.reshape(bsz, seq, C_WIDTH), k.reshape(bsz, seq, C_WIDTH),
                               v.reshape(bsz, seq, C_WIDTH)], axis=-1)
    gates = gate_in @ w_if + b_if
    h_c = _mlstm_chunkwise(q, k, v, gates[..., :MLSTM_HEADS], gates[..., MLSTM_HEADS:]).astype(x.dtype)
    y_c = jax.nn.sigmoid(o_pre) * h_c.reshape(bsz, seq, C_WIDTH)
    qd = _partial_rope(qkv[:, :, 0], positions)
    kd = _partial_rope(qkv[:, :, 1], positions)
    y_d = _dilated_window_attention(qd, kd, qkv[:, :, 2]).astype(x.dtype).reshape(bsz, seq, D_WIDTH)
    return jnp.concatenate([y_c, y_d], axis=-1) @ w_out


def _moe_ffn(x, router_w, router_b, w_in, b_in, w_out, b_out):
    bsz, seq, d = x.shape
    xt = x.reshape(-1, d)
    t = xt.shape[0]
    logits = (xt @ router_w + router_b).astype(jnp.float32)
    top_logit, top_idx = lax.top_k(logits, TOP_K)
    gate = jax.nn.softmax(top_logit, axis=-1)
    flat_e = top_idx.reshape(-1)
    order = jnp.argsort(flat_e)
    e_sorted = flat_e[order]
    tok_sorted = order // TOP_K
    gate_sorted = gate.reshape(-1)[order]
    counts = jnp.bincount(flat_e, length=N_EXPERTS)
    blocks_per_e = (counts + MOE_BLOCK - 1) // MOE_BLOCK
    blk_end = jnp.cumsum(blocks_per_e)
    blk_start = blk_end - blocks_per_e
    row_start = jnp.cumsum(counts) - counts
    rank = jnp.arange(t * TOP_K) - row_start[e_sorted]
    dest = blk_start[e_sorted] * MOE_BLOCK + rank
    n_blocks = -(-(t * TOP_K) // MOE_BLOCK) + N_EXPERTS
    n_rows = n_blocks * MOE_BLOCK
    row_tok = jnp.full((n_rows,), t, dtype=jnp.int32).at[dest].set(tok_sorted.astype(jnp.int32))
    row_gate = jnp.zeros((n_rows,), jnp.float32).at[dest].set(gate_sorted)
    block_expert = jnp.minimum(jnp.searchsorted(blk_end, jnp.arange(n_blocks), side='right'), N_EXPERTS - 1)
    x_pad = jnp.concatenate([xt, jnp.zeros((1, d), xt.dtype)], axis=0)
    xb = x_pad[row_tok].reshape(n_blocks, MOE_BLOCK, d)

    def expert_block(args):
        xblk, e = args
        h = xblk @ w_in[e] + b_in[e]
        g = jnp.minimum(h[:, :D_EXPERT], SWIGLU_LIMIT)
        lin = jnp.clip(h[:, D_EXPERT:], -SWIGLU_LIMIT, SWIGLU_LIMIT)
        y = g * jax.nn.sigmoid(SWIGLU_ALPHA * g) * (lin + 1.0)
        return y @ w_out[e] + b_out[e]

    yb = lax.map(expert_block, (xb, block_expert)).reshape(n_rows, d)
    y = jax.ops.segment_sum(yb * row_gate[:, None].astype(yb.dtype), row_tok, num_segments=t + 1)[:t]
    return y.reshape(bsz, seq, d)


def setup_inputs(seed: int = 0) -> dict:
    key = jax.random.key(seed)
    keys = iter(jax.random.split(key, 64))
    f32 = jnp.float32

    def nrm(shape, scale):
        return jax.random.normal(next(keys), shape, f32) * scale

    x = jax.random.normal(next(keys), (BATCH, SEQ, D_MODEL), f32)
    offs = jax.random.randint(next(keys), (BATCH, 1), 0, SEQ, dtype=jnp.int32)
    positions = offs + jnp.arange(SEQ, dtype=jnp.int32)[None, :]
    ab_w_in = nrm((N_AB, D_MODEL, AB_IN), D_MODEL ** -0.5)
    ab_conv_w = nrm((N_AB, CONV_WIDTH, A_WIDTH), CONV_WIDTH ** -0.5)
    ab_conv_b = nrm((N_AB, A_WIDTH), 0.02)
    ab_gate_r_w = nrm((N_AB, LRU_HEADS, LRU_HEAD_DIM, LRU_HEAD_DIM), LRU_HEAD_DIM ** -0.5)
    ab_gate_r_b = nrm((N_AB, A_WIDTH), 0.02)
    ab_gate_i_w = nrm((N_AB, LRU_HEADS, LRU_HEAD_DIM, LRU_HEAD_DIM), LRU_HEAD_DIM ** -0.5)
    ab_gate_i_b = nrm((N_AB, A_WIDTH), 0.02)
    a_pow = jax.random.uniform(next(keys), (N_AB, A_WIDTH), f32, 0.9, 0.999)
    a_base = a_pow ** (1.0 / LRU_C)
    ab_lru_lambda = jnp.log(a_base) - jnp.log1p(-a_base)
    n_idx = jnp.arange(S5_STATE, dtype=f32)
    ab_s5_lambda_re = -0.5 + nrm((N_AB, S5_GROUPS, S5_STATE), 0.01)
    ab_s5_lambda_im = jnp.pi * n_idx + nrm((N_AB, S5_GROUPS, S5_STATE), 0.01)
    ab_s5_log_step = jax.random.uniform(next(keys), (N_AB, S5_GROUPS), f32, math.log(1e-3), math.log(1e-1))
    ab_s5_b_re = nrm((N_AB, S5_GROUPS, S5_STATE, S5_GROUP_CH), (2 * S5_GROUP_CH) ** -0.5)
    ab_s5_b_im = nrm((N_AB, S5_GROUPS, S5_STATE, S5_GROUP_CH), (2 * S5_GROUP_CH) ** -0.5)
    ab_s5_c_re = nrm((N_AB, S5_GROUPS, S5_GROUP_CH, S5_STATE), (2 * S5_STATE) ** -0.5)
    ab_s5_c_im = nrm((N_AB, S5_GROUPS, S5_GROUP_CH, S5_STATE), (2 * S5_STATE) ** -0.5)
    ab_s5_d = nrm((N_AB, S5_GROUPS, S5_GROUP_CH), 1.0)
    ab_glu_w = nrm((N_AB, B_WIDTH, B_WIDTH), B_WIDTH ** -0.5)
    ab_glu_b = nrm((N_AB, B_WIDTH), 0.02)
    ab_w_out = nrm((N_AB, MIX_WIDTH, D_MODEL), MIX_WIDTH ** -0.5 * DEEPNORM_BETA)
    cd_w_in = nrm((N_CD, D_MODEL, CD_IN), D_MODEL ** -0.5)
    cd_conv_w = nrm((N_CD, CONV_WIDTH, C_WIDTH), CONV_WIDTH ** -0.5)
    cd_conv_b = nrm((N_CD, C_WIDTH), 0.02)
    cd_w_q = nrm((N_CD, MLSTM_HEADS, MLSTM_HEAD_DIM, MLSTM_HEAD_DIM), MLSTM_HEAD_DIM ** -0.5)
    cd_w_k = nrm((N_CD, MLSTM_HEADS, MLSTM_HEAD_DIM, MLSTM_HEAD_DIM), MLSTM_HEAD_DIM ** -0.5)
    cd_w_v = nrm((N_CD, MLSTM_HEADS, MLSTM_HEAD_DIM, MLSTM_HEAD_DIM), MLSTM_HEAD_DIM ** -0.5)
    cd_w_if = nrm((N_CD, 3 * C_WIDTH, 2 * MLSTM_HEADS), 0.1 * (3 * C_WIDTH) ** -0.5)
    cd_b_if = jnp.concatenate([nrm((N_CD, MLSTM_HEADS), 0.1),
                               jnp.linspace(3.0, 6.0, MLSTM_HEADS, dtype=f32)[None, :]
                               + nrm((N_CD, MLSTM_HEADS), 0.01)], axis=-1)
    cd_w_out = nrm((N_CD, MIX_WIDTH, D_MODEL), MIX_WIDTH ** -0.5 * DEEPNORM_BETA)
    ln_mix_g = 1.0 + nrm((DEPTH, D_MODEL), 0.02)
    ln_mix_b = nrm((DEPTH, D_MODEL), 0.02)
    ln_ffn_g = 1.0 + nrm((DEPTH, D_MODEL), 0.02)
    ln_ffn_b = nrm((DEPTH, D_MODEL), 0.02)
    moe_router_w = nrm((DEPTH, D_MODEL, N_EXPERTS), D_MODEL ** -0.5)
    moe_router_b = nrm((DEPTH, N_EXPERTS), 0.01)
    moe_w_in = nrm((DEPTH, N_EXPERTS, D_MODEL, 2 * D_EXPERT), D_MODEL ** -0.5)
    moe_b_in = nrm((DEPTH, N_EXPERTS, 2 * D_EXPERT), 0.02)
    moe_w_out = nrm((DEPTH, N_EXPERTS, D_EXPERT, D_MODEL), D_EXPERT ** -0.5 * DEEPNORM_BETA)
    moe_b_out = nrm((DEPTH, N_EXPERTS, D_MODEL), 0.02)
    return {'x': x, 'positions': positions,
            'ab_w_in': ab_w_in, 'ab_conv_w': ab_conv_w, 'ab_conv_b': ab_conv_b,
            'ab_gate_r_w': ab_gate_r_w, 'ab_gate_r_b': ab_gate_r_b,
            'ab_gate_i_w': ab_gate_i_w, 'ab_gate_i_b': ab_gate_i_b, 'ab_lru_lambda': ab_lru_lambda,
            'ab_s5_lambda_re': ab_s5_lambda_re, 'ab_s5_lambda_im': ab_s5_lambda_im,
            'ab_s5_log_step': ab_s5_log_step, 'ab_s5_b_re': ab_s5_b_re, 'ab_s5_b_im': ab_s5_b_im,
            'ab_s5_c_re': ab_s5_c_re, 'ab_s5_c_im': ab_s5_c_im, 'ab_s5_d': ab_s5_d,
            'ab_glu_w': ab_glu_w, 'ab_glu_b': ab_glu_b, 'ab_w_out': ab_w_out,
            'cd_w_in': cd_w_in, 'cd_conv_w': cd_conv_w, 'cd_conv_b': cd_conv_b,
            'cd_w_q': cd_w_q, 'cd_w_k': cd_w_k, 'cd_w_v': cd_w_v,
            'cd_w_if': cd_w_if, 'cd_b_if': cd_b_if, 'cd_w_out': cd_w_out,
            'ln_mix_g': ln_mix_g, 'ln_mix_b': ln_mix_b, 'ln_ffn_g': ln_ffn_g, 'ln_ffn_b': ln_ffn_b,
            'moe_router_w': moe_router_w, 'moe_router_b': moe_router_b,
            'moe_w_in': moe_w_in, 'moe_b_in': moe_b_in, 'moe_w_out': moe_w_out, 'moe_b_out': moe_b_out}


def reference(x, positions, ab_w_in, ab_conv_w, ab_conv_b, ab_gate_r_w, ab_gate_r_b, ab_gate_i_w,
              ab_gate_i_b, ab_lru_lambda, ab_s5_lambda_re, ab_s5_lambda_im, ab_s5_log_step,
              ab_s5_b_re, ab_s5_b_im, ab_s5_c_re, ab_s5_c_im, ab_s5_d, ab_glu_w, ab_glu_b, ab_w_out,
              cd_w_in, cd_conv_w, cd_conv_b, cd_w_q, cd_w_k, cd_w_v, cd_w_if, cd_b_if, cd_w_out,
              ln_mix_g, ln_mix_b, ln_ffn_g, ln_ffn_b, moe_router_w, moe_router_b,
              moe_w_in, moe_b_in, moe_w_out, moe_b_out):
    for layer in range(DEPTH):
        j = layer // 2
        if layer % 2 == 0:
            mix = _rglru_s5_mixer(x, ab_w_in[j], ab_conv_w[j], ab_conv_b[j], ab_gate_r_w[j], ab_gate_r_b[j],
                                  ab_gate_i_w[j], ab_gate_i_b[j], ab_lru_lambda[j], ab_s5_lambda_re[j],
                                  ab_s5_lambda_im[j], ab_s5_log_step[j], ab_s5_b_re[j], ab_s5_b_im[j],
                                  ab_s5_c_re[j], ab_s5_c_im[j], ab_s5_d[j], ab_glu_w[j], ab_glu_b[j],
                                  ab_w_out[j])
        else:
            mix = _mlstm_dsw_mixer(x, positions, cd_w_in[j], cd_conv_w[j], cd_conv_b[j], cd_w_q[j],
                                   cd_w_k[j], cd_w_v[j], cd_w_if[j], cd_b_if[j], cd_w_out[j])
        x = _layer_norm(DEEPNORM_ALPHA * x + mix, ln_mix_g[layer], ln_mix_b[layer])
        ffn = _moe_ffn(x, moe_router_w[layer], moe_router_b[layer], moe_w_in[layer], moe_b_in[layer],
                       moe_w_out[layer], moe_b_out[layer])
        x = _layer_norm(DEEPNORM_ALPHA * x + ffn, ln_ffn_g[layer], ln_ffn_b[layer])
    return x
```

```cpp
#include <hip/hip_runtime.h>
#include <hip/hip_cooperative_groups.h>
#include <cstdio>
#include <cstdint>
namespace cg = cooperative_groups;

#define LAS __attribute__((address_space(3)))
typedef unsigned short bf16_t;
typedef short bf16x8 __attribute__((ext_vector_type(8)));
typedef short bf16x4 __attribute__((ext_vector_type(4)));
typedef float f32x4 __attribute__((ext_vector_type(4)));
typedef unsigned u32x4 __attribute__((ext_vector_type(4)));
typedef unsigned u32x2 __attribute__((ext_vector_type(2)));
typedef LAS unsigned char lds_t;

constexpr int T = 32768, D = 1024, SEQ = 4096;
constexpr int NTHREADS = 512;
constexpr int LDS_BYTES = 160 * 1024;
constexpr float ALPHA = 1.4142135623730951f;
constexpr float LN_EPS = 1e-5f;
constexpr int MOE_ROWS = 139264;
constexpr int S5TC = 32;
constexpr int S5K = S5TC * 16 + 128;

enum { I_X = 0, I_POS, I_AB_WIN, I_AB_CONVW, I_AB_CONVB, I_AB_GRW, I_AB_GRB, I_AB_GIW, I_AB_GIB, I_AB_LAMBDA,
       I_S5_LRE, I_S5_LIM, I_S5_STEP, I_S5_BRE, I_S5_BIM, I_S5_CRE, I_S5_CIM, I_S5_D, I_AB_GLUW, I_AB_GLUB, I_AB_WOUT,
       I_CD_WIN, I_CD_CONVW, I_CD_CONVB, I_CD_WQ, I_CD_WK, I_CD_WV, I_CD_WIF, I_CD_BIF, I_CD_WOUT,
       I_LNM_G, I_LNM_B, I_LNF_G, I_LNF_B, I_R_W, I_R_B, I_M_WIN, I_M_BIN, I_M_WOUT, I_M_BOUT, N_IN };

constexpr size_t MiB = 1ull << 20;
constexpr size_t WS_CTL = 0;
constexpr size_t WS_XB = 1 * MiB;
constexpr size_t WS_WABIN = 65 * MiB;
constexpr size_t WS_WGLU = 68 * MiB;
constexpr size_t WS_WABOUT = 69 * MiB;
constexpr size_t WS_WCDIN = 71 * MiB;
constexpr size_t WS_WCDOUT = 76 * MiB;
constexpr size_t WS_WG = 78 * MiB;
constexpr size_t WS_WQKV = 78 * MiB + 256 * 1024;
constexpr size_t WS_WC = 79 * MiB;
constexpr size_t WS_S5TM = 80 * MiB;
constexpr size_t WS_S5WST = 100 * MiB;
constexpr size_t WS_MWIN = 104 * MiB;
constexpr size_t WS_MWOUT = 232 * MiB;
constexpr size_t WS_PROJ = 296 * MiB;
constexpr size_t WS_CAT = 456 * MiB;
constexpr size_t WS_X1F = 520 * MiB;
constexpr size_t WS_ZF = 648 * MiB;
constexpr size_t WS_HACT = 776 * MiB;
constexpr size_t WS_YB = 1048 * MiB;
constexpr size_t WS_ROUTE = 1320 * MiB;
constexpr size_t WS_SCR = 1328 * MiB;
constexpr size_t WS_XC = WS_SCR;
constexpr size_t WS_AF = WS_SCR + 32 * MiB;
constexpr size_t WS_UF = WS_SCR + 96 * MiB;
constexpr size_t WS_SB = WS_SCR + 160 * MiB;
constexpr size_t WS_S5S = WS_SCR + 192 * MiB;
constexpr size_t WS_S5X = WS_SCR + 208 * MiB;
constexpr size_t WS_XCONV = WS_SCR;
constexpr size_t WS_QB = WS_SCR + 32 * MiB;
constexpr size_t WS_KB = WS_SCR + 64 * MiB;
constexpr size_t WS_VB = WS_SCR + 96 * MiB;
constexpr size_t WS_GATES = WS_SCR + 128 * MiB;
constexpr size_t WS_KVC = WS_SCR + 130 * MiB;
constexpr size_t WS_CPREV = WS_SCR + 258 * MiB;
constexpr size_t WS_MISC = WS_SCR + 322 * MiB;
constexpr size_t WS_ATTO = WS_SCR + 326 * MiB;
constexpr size_t WS_LSE = WS_SCR + 518 * MiB;
constexpr size_t WS_END = WS_SCR + 520 * MiB;

struct Params { const float* in[N_IN]; float* out; unsigned char* ws; int ph_lo, ph_hi; };

__device__ __forceinline__ float bf2f(unsigned short b) { return __uint_as_float(((unsigned)b) << 16); }
typedef __bf16 bf16v2_t __attribute__((ext_vector_type(2)));
typedef float f32x2 __attribute__((ext_vector_type(2)));
__device__ __forceinline__ unsigned pk_bf16(float lo, float hi) { const f32x2 v = {lo, hi}; return __builtin_bit_cast(unsigned, __builtin_convertvector(v, bf16v2_t)); }
__device__ __forceinline__ float wave_sum(float v) {
#pragma unroll
    for (int o = 1; o < 64; o <<= 1) v += __shfl_xor(v, o);
    return v;
}
__device__ __forceinline__ float wave_max(float v) {
#pragma unroll
    for (int o = 1; o < 64; o <<= 1) v = fmaxf(v, __shfl_xor(v, o));
    return v;
}
__device__ __forceinline__ float fsigmoid(float x) { return __builtin_amdgcn_rcpf(1.0f + __builtin_amdgcn_exp2f(-1.4426950408889634f * x)); }
__device__ __forceinline__ float fexp(float x) { return __builtin_amdgcn_exp2f(1.4426950408889634f * x); }
__device__ __forceinline__ float flog(float x) { return 0.6931471805599453f * __builtin_amdgcn_logf(x); }
__device__ __forceinline__ void fsincos(float x, float& sn, float& cs) {
    const float n = rintf(x * 0.15915494309189535f);
    float r = fmaf(-n, 6.28125f, x); r = fmaf(-n, 0.0019353071795864769f, r);
    const float rev = r * 0.15915494309189535f;
    sn = __builtin_amdgcn_sinf(rev); cs = __builtin_amdgcn_cosf(rev);
}
__device__ __forceinline__ float gelu_tanh(float x) { return x * fsigmoid(1.5957691216057308f * (x + 0.044715f * x * x * x)); }
__device__ __forceinline__ float logsigmoidf(float x) { return fminf(x, 0.f) - log1pf(expf(-fabsf(x))); }
__device__ __forceinline__ void unpack8(u32x4 v, float (&f)[8]) {
    f[0] = __uint_as_float(v.x << 16); f[1] = __uint_as_float(v.x & 0xffff0000u);
    f[2] = __uint_as_float(v.y << 16); f[3] = __uint_as_float(v.y & 0xffff0000u);
    f[4] = __uint_as_float(v.z << 16); f[5] = __uint_as_float(v.z & 0xffff0000u);
    f[6] = __uint_as_float(v.w << 16); f[7] = __uint_as_float(v.w & 0xffff0000u);
}
__device__ __forceinline__ u32x4 pack8(const float (&f)[8]) { u32x4 o; o.x = pk_bf16(f[0], f[1]); o.y = pk_bf16(f[2], f[3]); o.z = pk_bf16(f[4], f[5]); o.w = pk_bf16(f[6], f[7]); return o; }
__device__ __forceinline__ bf16x4 tr_read(lds_t* p) { return __builtin_amdgcn_ds_read_tr16_b64_v4i16((LAS bf16x4*)p); }
__device__ __forceinline__ bf16x8 cat44(bf16x4 a, bf16x4 b) { bf16x8 r = {a[0], a[1], a[2], a[3], b[0], b[1], b[2], b[3]}; return r; }
#define MFMA16(a, b, c) __builtin_amdgcn_mfma_f32_16x16x32_bf16((a), (b), (c), 0, 0, 0)

constexpr int E1_PITCH = 144;
constexpr int E1_A = 256 * E1_PITCH;
constexpr int E1_B = 128 * E1_PITCH;
constexpr int E1_BUF = E1_A + E1_B;

template <bool TRANS, class AL, class BL, class EP>
__device__ __forceinline__ void e1_tile(lds_t* lds, int nk, AL aload, BL bload, EP epi) {
    const int tid = threadIdx.x, lane = tid & 63, wave = tid >> 6, wr = wave >> 1, wc = wave & 1, fr = lane & 15, fq = lane >> 4;
    const int prow = tid >> 3, pc = tid & 7;
    f32x4 acc[4][4];
#pragma unroll
    for (int m = 0; m < 4; ++m)
#pragma unroll
        for (int n = 0; n < 4; ++n) acc[m][n] = (f32x4){0.f, 0.f, 0.f, 0.f};
    u32x4 ra[4], rb[2];
#pragma unroll
    for (int i = 0; i < 4; ++i) ra[i] = aload(i, prow + 64 * i, pc);
#pragma unroll
    for (int i = 0; i < 2; ++i) rb[i] = bload(i, prow + 64 * i, pc);
#pragma unroll
    for (int i = 0; i < 4; ++i) *(LAS u32x4*)(lds + (prow + 64 * i) * E1_PITCH + pc * 16) = ra[i];
#pragma unroll
    for (int i = 0; i < 2; ++i) *(LAS u32x4*)(lds + E1_A + (prow + 64 * i) * E1_PITCH + pc * 16) = rb[i];
    __syncthreads();
    for (int t = 0; t < nk; ++t) {
        const bool more = (t + 1 < nk);
        if (more) {
#pragma unroll
            for (int i = 0; i < 4; ++i) ra[i] = aload(i, prow + 64 * i, (t + 1) * 8 + pc);
#pragma unroll
            for (int i = 0; i < 2; ++i) rb[i] = bload(i, prow + 64 * i, (t + 1) * 8 + pc);
        }
        lds_t* Ab = lds + (t & 1) * E1_BUF + (wr * 64 + fr) * E1_PITCH + fq * 16;
        lds_t* Bb = lds + (t & 1) * E1_BUF + E1_A + (wc * 64 + fr) * E1_PITCH + fq * 16;
#pragma unroll
        for (int kk = 0; kk < 2; ++kk) {
            bf16x8 af[4], bfr[4];
#pragma unroll
            for (int m = 0; m < 4; ++m) af[m] = *(LAS bf16x8*)(Ab + m * 16 * E1_PITCH + kk * 64);
#pragma unroll
            for (int n = 0; n < 4; ++n) bfr[n] = *(LAS bf16x8*)(Bb + n * 16 * E1_PITCH + kk * 64);
#pragma unroll
            for (int m = 0; m < 4; ++m)
#pragma unroll
                for (int n = 0; n < 4; ++n) acc[m][n] = TRANS ? MFMA16(bfr[n], af[m], acc[m][n]) : MFMA16(af[m], bfr[n], acc[m][n]);
        }
        if (more) {
            lds_t* nb = lds + ((t + 1) & 1) * E1_BUF;
#pragma unroll
            for (int i = 0; i < 4; ++i) *(LAS u32x4*)(nb + (prow + 64 * i) * E1_PITCH + pc * 16) = ra[i];
#pragma unroll
            for (int i = 0; i < 2; ++i) *(LAS u32x4*)(nb + E1_A + (prow + 64 * i) * E1_PITCH + pc * 16) = rb[i];
        }
        __syncthreads();
    }
    epi(acc, wr, wc, fr, fq);
}

template <class RM>
__device__ __forceinline__ void transpose_item(const float* __restrict__ W, int N, bf16_t* __restrict__ WT, int ldwt, int k0, int n0, RM rowmap, LAS float* scr, int lane) {
#pragma unroll 16
    for (int i = 0; i < 64; ++i) scr[i * 65 + lane] = W[(size_t)(k0 + i) * N + n0 + lane];
    __builtin_amdgcn_wave_barrier();
    const int c = lane & 7;
#pragma unroll
    for (int j = 0; j < 8; ++j) {
        const int n = (lane >> 3) + 8 * j;
        const LAS float* s = scr + (8 * c) * 65 + n;
        u32x4 o; o.x = pk_bf16(s[0], s[65]); o.y = pk_bf16(s[2 * 65], s[3 * 65]); o.z = pk_bf16(s[4 * 65], s[5 * 65]); o.w = pk_bf16(s[6 * 65], s[7 * 65]);
        *(u32x4*)(WT + (size_t)rowmap(n0 + n) * ldwt + k0 + 8 * c) = o;
    }
    __builtin_amdgcn_wave_barrier();
}
struct RmId { __device__ __forceinline__ int operator()(int n) const { return n; } };
struct RmMoeIn { __device__ __forceinline__ int operator()(int n) const { const int half = n >> 10, j = n & 1023; return (j >> 5) * 64 + half * 32 + (j & 31); } };
struct RmGate { int gate; __device__ __forceinline__ int operator()(int j) const { return (j >> 5) * 64 + gate * 32 + (j & 31); } };

template <class RM>
__device__ __forceinline__ void transpose_matrix(const float* W, int K, int N, bf16_t* WT, int ldwt, RM rm, LAS float* scr, int gw, int NGW, int lane) {
    const int nkb = K / 64, nnb = N / 64;
    for (int it = gw; it < nkb * nnb; it += NGW) transpose_item(W, N, WT, ldwt, (it / nnb) * 64, (it % nnb) * 64, rm, scr, lane);
}

__device__ __forceinline__ void convert_moe_weights(const Params& P, int layer, lds_t* lds) {
    const int lane = threadIdx.x & 63, wave = threadIdx.x >> 6, gw = blockIdx.x * 8 + wave, NGW = gridDim.x * 8;
    LAS float* scr = (LAS float*)(lds + wave * 16640);
    const float* win = P.in[I_M_WIN] + (size_t)layer * 32 * 1024 * 2048;
    bf16_t* dwin = (bf16_t*)(P.ws + WS_MWIN);
    for (int it = gw; it < 32 * 16 * 32; it += NGW) {
        const int e = it >> 9, r = it & 511, kb = r >> 5, nb = r & 31;
        transpose_item(win + (size_t)e * 1024 * 2048, 2048, dwin + (size_t)e * 2048 * 1024, 1024, kb * 64, nb * 64, RmMoeIn(), scr, lane);
    }
    const float* wout = P.in[I_M_WOUT] + (size_t)layer * 32 * 1024 * 1024;
    bf16_t* dwout = (bf16_t*)(P.ws + WS_MWOUT);
    for (int it = gw; it < 32 * 16 * 16; it += NGW) {
        const int e = it >> 8, r = it & 255, kb = r >> 4, nb = r & 15;
        transpose_item(wout + (size_t)e * 1024 * 1024, 1024, dwout + (size_t)e * 1024 * 1024, 1024, kb * 64, nb * 64, RmId(), scr, lane);
    }
}

__device__ __forceinline__ void s5_precompute(const Params& P, int g, lds_t* lds) {
    const int tid = threadIdx.x;
    LAS float* Bbr = (LAS float*)lds;
    LAS float* Bbi = Bbr + 1024;
    LAS float* Cr = Bbi + 1024;
    LAS float* Ci = Cr + 1024;
    LAS float* ApR = Ci + 1024;
    LAS float* ApI = ApR + 33 * 64;
    LAS float* KJ = ApI + 33 * 64;
    const float* lre = P.in[I_S5_LRE] + g * 64; const float* lim = P.in[I_S5_LIM] + g * 64;
    const float step = expf(P.in[I_S5_STEP][g]);
    for (int idx = tid; idx < 1024; idx += NTHREADS) {
        const int p = idx >> 4;
        const float lr = fminf(lre[p], -1e-4f), li = lim[p];
        const float mag = expf(lr * step); float sn, cs; sincosf(li * step, &sn, &cs);
        const float ar = mag * cs, ai = mag * sn, inv = 1.0f / (lr * lr + li * li);
        const float zr = ((ar - 1.0f) * lr + ai * li) * inv, zi = (ai * lr - (ar - 1.0f) * li) * inv;
        const float br = P.in[I_S5_BRE][g * 1024 + idx], bi = P.in[I_S5_BIM][g * 1024 + idx];
        Bbr[idx] = zr * br - zi * bi; Bbi[idx] = zr * bi + zi * br;
        Cr[idx] = P.in[I_S5_CRE][g * 1024 + idx]; Ci[idx] = P.in[I_S5_CIM][g * 1024 + idx];
    }
    for (int idx = tid; idx < 33 * 64; idx += NTHREADS) {
        const int j = idx >> 6, p = idx & 63;
        const float lr = fminf(lre[p], -1e-4f), li = lim[p];
        const float mag = expf((float)j * lr * step); float sn, cs; sincosf((float)j * li * step, &sn, &cs);
        ApR[idx] = mag * cs; ApI[idx] = mag * sn;
    }
    __syncthreads();
    for (int idx = tid; idx < 8192; idx += NTHREADS) {
        const int j = idx >> 8, h = (idx >> 4) & 15, h2 = idx & 15;
        float s = 0.f;
        for (int p = 0; p < 64; ++p) {
            const float cr = Cr[h * 64 + p], ci = Ci[h * 64 + p], ar = ApR[j * 64 + p], ai = ApI[j * 64 + p];
            const float er = cr * ar - ci * ai, ei = cr * ai + ci * ar;
            s += er * Bbr[p * 16 + h2] - ei * Bbi[p * 16 + h2];
        }
        if (j == 0 && h == h2) s += P.in[I_S5_D][g * 16 + h];
        KJ[idx] = s;
    }
    __syncthreads();
    bf16_t* Tm = (bf16_t*)(P.ws + WS_S5TM) + (size_t)g * 512 * S5K;
    for (int pi = tid; pi < 512 * (S5K / 8); pi += NTHREADS) {
        const int row = pi / (S5K / 8), c8 = (pi % (S5K / 8)) * 8, t = row >> 4, h = row & 15;
        float v[8];
#pragma unroll
        for (int e = 0; e < 8; ++e) {
            const int col = c8 + e;
            if (col < 512) { const int s = col >> 4, h2 = col & 15; v[e] = (s <= t) ? KJ[((t - s) * 16 + h) * 16 + h2] : 0.f; }
            else { const int p = (col - 512) & 63, im = (col - 512) >> 6;
                const float cr = Cr[h * 64 + p], ci = Ci[h * 64 + p], ar = ApR[(t + 1) * 64 + p], ai = ApI[(t + 1) * 64 + p];
                v[e] = im ? -(cr * ai + ci * ar) : (cr * ar - ci * ai); }
        }
        *(u32x4*)(Tm + (size_t)row * S5K + c8) = pack8(v);
    }
    bf16_t* Wst = (bf16_t*)(P.ws + WS_S5WST) + (size_t)g * 128 * 512;
    for (int pi = tid; pi < 128 * 64; pi += NTHREADS) {
        const int row = pi >> 6, c8 = (pi & 63) * 8, p = row & 63, im = row >> 6;
        float v[8];
#pragma unroll
        for (int e = 0; e < 8; ++e) {
            const int col = c8 + e, s = col >> 4, h2 = col & 15;
            const float ar = ApR[(S5TC - 1 - s) * 64 + p], ai = ApI[(S5TC - 1 - s) * 64 + p], br = Bbr[p * 16 + h2], bi = Bbi[p * 16 + h2];
            v[e] = im ? (ar * bi + ai * br) : (ar * br - ai * bi);
        }
        *(u32x4*)(Wst + (size_t)row * 512 + c8) = pack8(v);
    }
    __syncthreads();
}

__device__ __forceinline__ void phase0(const Params& P, lds_t* lds) {
    const int tid = threadIdx.x, lane = tid & 63, wave = tid >> 6, gw = blockIdx.x * 8 + wave, NGW = gridDim.x * 8;
    const size_t gtid = (size_t)blockIdx.x * NTHREADS + tid, GT = (size_t)gridDim.x * NTHREADS;
    unsigned char* ws = P.ws;
    if (blockIdx.x == 0 && tid < 128) ((int*)(ws + WS_CTL))[tid] = 0;
    for (int g = blockIdx.x; g < 32; g += gridDim.x) s5_precompute(P, g, lds);
    {
        const f32x4* x4 = (const f32x4*)P.in[I_X]; u32x4* xb = (u32x4*)(ws + WS_XB);
        for (size_t i = gtid; i < (size_t)T * D / 8; i += GT) { const f32x4 a = x4[2 * i], b = x4[2 * i + 1]; u32x4 o; o.x = pk_bf16(a.x, a.y); o.y = pk_bf16(a.z, a.w); o.z = pk_bf16(b.x, b.y); o.w = pk_bf16(b.z, b.w); xb[i] = o; }
    }
    {
        float* Wc = (float*)(ws + WS_WC);
        for (size_t idx = gtid; idx < 8192; idx += GT) {
            const int which = (int)(idx >> 12), i = (int)((idx >> 3) & 511), gg = (int)(idx & 7), h = i >> 7, ii = i & 127;
            const float* wif = P.in[I_CD_WIF];
            float s = 0.f;
            if (which == 0) {
                const float* wq = P.in[I_CD_WQ] + (size_t)(h * 128 + ii) * 128; const float* wk = P.in[I_CD_WK] + (size_t)(h * 128 + ii) * 128;
                float s2 = 0.f;
                for (int j = 0; j < 128; ++j) { s += wq[j] * wif[(h * 128 + j) * 8 + gg]; s2 += wk[j] * wif[(512 + h * 128 + j) * 8 + gg]; }
                s += s2 * 0.08838834764831845f;
            } else {
                const float* wv = P.in[I_CD_WV] + (size_t)(h * 128 + ii) * 128;
                for (int j = 0; j < 128; ++j) s += wv[j] * wif[(1024 + h * 128 + j) * 8 + gg];
            }
            Wc[idx] = s;
        }
    }
    LAS float* scr = (LAS float*)(lds + wave * 16640);
    transpose_matrix(P.in[I_AB_WIN], 1024, 1536, (bf16_t*)(ws + WS_WABIN), 1024, RmId(), scr, gw, NGW, lane);
    transpose_matrix(P.in[I_AB_GLUW], 512, 512, (bf16_t*)(ws + WS_WGLU), 512, RmId(), scr, gw, NGW, lane);
    transpose_matrix(P.in[I_AB_WOUT], 1024, 1024, (bf16_t*)(ws + WS_WABOUT), 1024, RmId(), scr, gw, NGW, lane);
    transpose_matrix(P.in[I_CD_WIN], 1024, 2560, (bf16_t*)(ws + WS_WCDIN), 1024, RmId(), scr, gw, NGW, lane);
    transpose_matrix(P.in[I_CD_WOUT], 1024, 1024, (bf16_t*)(ws + WS_WCDOUT), 1024, RmId(), scr, gw, NGW, lane);
    for (int it = gw; it < 16; it += NGW) {
        const int gate = it >> 3, h = it & 7;
        transpose_item(P.in[gate ? I_AB_GIW : I_AB_GRW] + h * 4096, 64, (bf16_t*)(ws + WS_WG) + h * 8192, 64, 0, 0, RmGate{gate}, scr, lane);
    }
    for (int it = gw; it < 48; it += NGW) {
        const int which = it >> 4, h = (it >> 2) & 3, kb = (it >> 1) & 1, nb = it & 1;
        transpose_item(P.in[I_CD_WQ + which] + h * 16384, 128, (bf16_t*)(ws + WS_WQKV) + (which * 4 + h) * 16384, 128, kb * 64, nb * 64, RmId(), scr, lane);
    }
    convert_moe_weights(P, 0, lds);
}

__device__ __forceinline__ void store_bf16x4(bf16_t* p, f32x4 v) { u32x2 o; o.x = pk_bf16(v[0], v[1]); o.y = pk_bf16(v[2], v[3]); *(u32x2*)p = o; }

__device__ __forceinline__ void ph_inproj(const Params& P, lds_t* lds, const bf16_t* Wt, int N, const int* pos) {
    const bf16_t* xb = (const bf16_t*)(P.ws + WS_XB); bf16_t* proj = (bf16_t*)(P.ws + WS_PROJ);
    const int nct = N / 128;
    for (int tile = blockIdx.x; tile < 128 * nct; tile += gridDim.x) {
        const int rt = tile / nct, ct = tile % nct;
        e1_tile<true>(lds, 16,
            [=](int, int r, int kp) { return *(const u32x4*)(xb + (size_t)(rt * 256 + r) * 1024 + kp * 8); },
            [=](int, int n, int kp) { return *(const u32x4*)(Wt + (size_t)(ct * 128 + n) * 1024 + kp * 8); },
            [=](f32x4 (&acc)[4][4], int wr, int wc, int fr, int fq) {
                if (pos != nullptr && ct >= 8 && ct < 16 && wc == 0) {
                    float invf[4];
#pragma unroll
                    for (int c = 0; c < 4; ++c) invf[c] = exp2f(-(float)(fq * 4 + c) * (18.931568569324174f / 16.0f));
#pragma unroll
                    for (int m = 0; m < 4; ++m) {
                        const float pf = (float)pos[rt * 256 + wr * 64 + m * 16 + fr];
#pragma unroll
                        for (int c = 0; c < 4; ++c) {
                            float sn, cs; fsincos(pf * invf[c], sn, cs);
                            const float a = acc[m][0][c], b = acc[m][1][c];
                            acc[m][0][c] = a * cs - b * sn; acc[m][1][c] = b * cs + a * sn;
                        }
                    }
                }
                const float sc = (pos != nullptr && ct >= 8 && ct < 12) ? 0.08838834764831845f : 1.0f;
#pragma unroll
                for (int m = 0; m < 4; ++m)
#pragma unroll
                    for (int n = 0; n < 4; ++n)
                        store_bf16x4(proj + (size_t)(rt * 256 + wr * 64 + m * 16 + fr) * N + ct * 128 + wc * 64 + n * 16 + fq * 4, acc[m][n] * sc);
            });
    }
}

__device__ __forceinline__ void ph_conv0(const Params& P) {
    const bf16_t* proj = (const bf16_t*)(P.ws + WS_PROJ); bf16_t* xc = (bf16_t*)(P.ws + WS_XC);
    const int c8 = (threadIdx.x & 63) * 8;
    float w[4][8], bias[8];
#pragma unroll
    for (int e = 0; e < 8; ++e) { bias[e] = P.in[I_AB_CONVB][c8 + e];
#pragma unroll
        for (int k = 0; k < 4; ++k) w[k][e] = P.in[I_AB_CONVW][k * 512 + c8 + e]; }
    const size_t gtid = (size_t)blockIdx.x * NTHREADS + threadIdx.x, GT = (size_t)gridDim.x * NTHREADS;
    for (size_t i = gtid; i < (size_t)T * 64; i += GT) {
        const int tok = (int)(i >> 6), p = tok & (SEQ - 1);
        float a[8];
#pragma unroll
        for (int e = 0; e < 8; ++e) a[e] = bias[e];
#pragma unroll
        for (int k = 0; k < 4; ++k) {
            if (p - 3 + k >= 0) {
                float xv[8]; unpack8(*(const u32x4*)(proj + (size_t)(tok - 3 + k) * 1536 + c8), xv);
#pragma unroll
                for (int e = 0; e < 8; ++e) a[e] += w[k][e] * xv[e];
            }
        }
        *(u32x4*)(xc + (size_t)tok * 512 + c8) = pack8(a);
    }
}

__device__ __forceinline__ void ph_gates0(const Params& P, lds_t* lds) {
    const bf16_t* xc = (const bf16_t*)(P.ws + WS_XC); const bf16_t* Wg = (const bf16_t*)(P.ws + WS_WG);
    float* af = (float*)(P.ws + WS_AF); float* uf = (float*)(P.ws + WS_UF);
    const float* br = P.in[I_AB_GRB]; const float* bi = P.in[I_AB_GIB]; const float* lam = P.in[I_AB_LAMBDA];
    for (int tile = blockIdx.x; tile < 1024; tile += gridDim.x) {
        const int h = tile & 7, rt = tile >> 3;
        e1_tile<true>(lds, 1,
            [=](int, int r, int kp) { return *(const u32x4*)(xc + (size_t)(rt * 256 + r) * 512 + h * 64 + kp * 8); },
            [=](int, int n, int kp) { return *(const u32x4*)(Wg + (size_t)h * 8192 + n * 64 + kp * 8); },
            [=](f32x4 (&acc)[4][4], int wr, int wc, int fr, int fq) {
#pragma unroll
                for (int n = 0; n < 2; ++n) {
                    const int ch = h * 64 + wc * 32 + n * 16 + fq * 4;
                    float sp[4], brv[4], biv[4];
#pragma unroll
                    for (int c = 0; c < 4; ++c) { const float l = -lam[ch + c]; sp[c] = fmaxf(l, 0.f) + flog(1.0f + fexp(-fabsf(l))); brv[c] = br[ch + c]; biv[c] = bi[ch + c]; }
#pragma unroll
                    for (int m = 0; m < 4; ++m) {
                        const size_t row = (size_t)(rt * 256 + wr * 64 + m * 16 + fr);
                        const u32x2 xr = *(const u32x2*)(xc + row * 512 + ch);
                        const float xv[4] = {__uint_as_float(xr.x << 16), __uint_as_float(xr.x & 0xffff0000u), __uint_as_float(xr.y << 16), __uint_as_float(xr.y & 0xffff0000u)};
                        f32x4 a4, u4;
#pragma unroll
                        for (int c = 0; c < 4; ++c) {
                            const float r = fsigmoid(acc[m][n][c] + brv[c]), ig = fsigmoid(acc[m][n + 2][c] + biv[c]);
                            const float la = -8.0f * r * sp[c], x2 = 2.0f * la;
                            const float om = (x2 > -0.01f) ? -x2 * (1.0f + 0.5f * x2 * (1.0f + x2 * (1.0f / 3.0f))) : 1.0f - fexp(x2);
                            a4[c] = fexp(la); u4[c] = sqrtf(om) * ig * xv[c];
                        }
                        *(f32x4*)(af + row * 512 + ch) = a4; *(f32x4*)(uf + row * 512 + ch) = u4;
                    }
                }
            });
    }
}

__device__ __forceinline__ void ph_lru_scan(const Params& P, lds_t* lds) {
    const float* af = (const float*)(P.ws + WS_AF); const float* uf = (const float*)(P.ws + WS_UF);
    const bf16_t* proj = (const bf16_t*)(P.ws + WS_PROJ); bf16_t* cat = (bf16_t*)(P.ws + WS_CAT);
    LAS float* lA = (LAS float*)lds; LAS float* lH = lA + 512;
    const int tid = threadIdx.x, seg = tid >> 4, c = tid & 15;
    for (int item = blockIdx.x; item < 256; item += gridDim.x) {
        const int b = item >> 5, ch = (item & 31) * 16 + c;
        const size_t base = (size_t)b * SEQ + seg * 128;
        float A = 1.f, H = 0.f;
#pragma unroll 8
        for (int i = 0; i < 128; ++i) { const float a = af[(base + i) * 512 + ch], u = uf[(base + i) * 512 + ch]; H = a * H + u; A *= a; }
        lA[tid] = A; lH[tid] = H;
        __syncthreads();
        float carry = 0.f;
        for (int s = 0; s < seg; ++s) carry = lA[s * 16 + c] * carry + lH[s * 16 + c];
        H = carry;
#pragma unroll 8
        for (int i = 0; i < 128; ++i) {
            const float a = af[(base + i) * 512 + ch], u = uf[(base + i) * 512 + ch]; H = a * H + u;
            const float ga = bf2f(proj[(base + i) * 1536 + 512 + ch]);
            cat[(base + i) * 1024 + ch] = (bf16_t)(pk_bf16(H * gelu_tanh(ga), 0.f) & 0xffffu);
        }
        __syncthreads();
    }
}

__device__ __forceinline__ void ph_s5_state(const Params& P, lds_t* lds) {
    const bf16_t* proj = (const bf16_t*)(P.ws + WS_PROJ); const bf16_t* Wst = (const bf16_t*)(P.ws + WS_S5WST); float* S = (float*)(P.ws + WS_S5S);
    for (int tile = blockIdx.x; tile < 128; tile += gridDim.x) {
        const int g = tile & 31, rt = tile >> 5;
        e1_tile<true>(lds, 8,
            [=](int, int r, int kp) { return *(const u32x4*)(proj + (size_t)((rt * 256 + r) * 32 + (kp >> 1)) * 1536 + 1024 + g * 16 + (kp & 1) * 8); },
            [=](int, int n, int kp) { return *(const u32x4*)(Wst + (size_t)g * 65536 + n * 512 + kp * 8); },
            [=](f32x4 (&acc)[4][4], int wr, int wc, int fr, int fq) {
#pragma unroll
                for (int m = 0; m < 4; ++m)
#pragma unroll
                    for (int n = 0; n < 4; ++n) *(f32x4*)(S + ((size_t)(rt * 256 + wr * 64 + m * 16 + fr) * 32 + g) * 128 + wc * 64 + n * 16 + fq * 4) = acc[m][n];
            });
    }
}

__device__ __forceinline__ void ph_s5_carry(const Params& P) {
    const float* S = (const float*)(P.ws + WS_S5S); bf16_t* X = (bf16_t*)(P.ws + WS_S5X);
    if (threadIdx.x >= 64) return;
    const int p = threadIdx.x;
    for (int it = blockIdx.x; it < 256; it += gridDim.x) {
        const int b = it >> 5, g = it & 31;
        const float lr = fminf(P.in[I_S5_LRE][g * 64 + p], -1e-4f), li = P.in[I_S5_LIM][g * 64 + p], step = expf(P.in[I_S5_STEP][g]);
        const float mag = expf((float)S5TC * lr * step); float sn, cs; sincosf((float)S5TC * li * step, &sn, &cs);
        const float cr = mag * cs, ci = mag * sn;
        float xr = 0.f, xi = 0.f;
#pragma unroll 8
        for (int c = 0; c < 128; ++c) {
            const size_t o = ((size_t)(b * 128 + c) * 32 + g) * 128;
            X[o + p] = (bf16_t)(pk_bf16(xr, 0.f) & 0xffffu); X[o + 64 + p] = (bf16_t)(pk_bf16(xi, 0.f) & 0xffffu);
            const float sr = S[o + p], si = S[o + 64 + p];
            const float nr = cr * xr - ci * xi + sr, ni = cr * xi + ci * xr + si;
            xr = nr; xi = ni;
        }
    }
}

__device__ __forceinline__ void ph_s5_out(const Params& P, lds_t* lds) {
    const bf16_t* proj = (const bf16_t*)(P.ws + WS_PROJ); const bf16_t* Tm = (const bf16_t*)(P.ws + WS_S5TM); const bf16_t* X = (const bf16_t*)(P.ws + WS_S5X);
    bf16_t* sb = (bf16_t*)(P.ws + WS_SB);
    for (int tile = blockIdx.x; tile < 512; tile += gridDim.x) {
        const int ct = tile & 3, g = (tile >> 2) & 31, rt = tile >> 7;
        e1_tile<true>(lds, S5K / 64,
            [=](int, int r, int kp) {
                if (kp < 64) return *(const u32x4*)(proj + (size_t)((rt * 256 + r) * 32 + (kp >> 1)) * 1536 + 1024 + g * 16 + (kp & 1) * 8);
                return *(const u32x4*)(X + ((size_t)(rt * 256 + r) * 32 + g) * 128 + (kp - 64) * 8); },
            [=](int, int n, int kp) { return *(const u32x4*)(Tm + (size_t)g * 512 * S5K + (size_t)(ct * 128 + n) * S5K + kp * 8); },
            [=](f32x4 (&acc)[4][4], int wr, int wc, int fr, int fq) {
#pragma unroll
                for (int m = 0; m < 4; ++m)
#pragma unroll
                    for (int n = 0; n < 4; ++n) {
                        const int col = ct * 128 + wc * 64 + n * 16 + fq * 4, t = col >> 4, h0 = col & 15;
                        const size_t tok = (size_t)(rt * 256 + wr * 64 + m * 16 + fr) * 32 + t;
                        f32x4 y = acc[m][n];
#pragma unroll
                        for (int c = 0; c < 4; ++c) y[c] = gelu_tanh(y[c]);
                        store_bf16x4(sb + tok * 512 + g * 16 + h0, y);
                    }
            });
    }
}

__device__ __forceinline__ void ph_glu(const Params& P, lds_t* lds) {
    const bf16_t* sb = (const bf16_t*)(P.ws + WS_SB); const bf16_t* Wt = (const bf16_t*)(P.ws + WS_WGLU); bf16_t* cat = (bf16_t*)(P.ws + WS_CAT);
    const float* gb = P.in[I_AB_GLUB];
    for (int tile = blockIdx.x; tile < 512; tile += gridDim.x) {
        const int rt = tile >> 2, ct = tile & 3;
        e1_tile<true>(lds, 8,
            [=](int, int r, int kp) { return *(const u32x4*)(sb + (size_t)(rt * 256 + r) * 512 + kp * 8); },
            [=](int, int n, int kp) { return *(const u32x4*)(Wt + (size_t)(ct * 128 + n) * 512 + kp * 8); },
            [=](f32x4 (&acc)[4][4], int wr, int wc, int fr, int fq) {
#pragma unroll
                for (int n = 0; n < 4; ++n) {
                    const int col = ct * 128 + wc * 64 + n * 16 + fq * 4;
                    const f32x4 bv = *(const f32x4*)(gb + col);
#pragma unroll
                    for (int m = 0; m < 4; ++m) {
                        const size_t row = (size_t)(rt * 256 + wr * 64 + m * 16 + fr);
                        const u32x2 sr = *(const u32x2*)(sb + row * 512 + col);
                        const float sv[4] = {__uint_as_float(sr.x << 16), __uint_as_float(sr.x & 0xffff0000u), __uint_as_float(sr.y << 16), __uint_as_float(sr.y & 0xffff0000u)};
                        f32x4 y;
#pragma unroll
                        for (int c = 0; c < 4; ++c) y[c] = sv[c] * fsigmoid(acc[m][n][c] + bv[c]);
                        store_bf16x4(cat + row * 1024 + 512 + col, y);
                    }
                }
            });
    }
}

__device__ __forceinline__ void ph_outproj(const Params& P, lds_t* lds, const bf16_t* Wt, const float* xres) {
    const bf16_t* cat = (const bf16_t*)(P.ws + WS_CAT); float* zf = (float*)(P.ws + WS_ZF);
    for (int tile = blockIdx.x; tile < 1024; tile += gridDim.x) {
        const int rt = tile >> 3, ct = tile & 7;
        e1_tile<true>(lds, 16,
            [=](int, int r, int kp) { return *(const u32x4*)(cat + (size_t)(rt * 256 + r) * 1024 + kp * 8); },
            [=](int, int n, int kp) { return *(const u32x4*)(Wt + (size_t)(ct * 128 + n) * 1024 + kp * 8); },
            [=](f32x4 (&acc)[4][4], int wr, int wc, int fr, int fq) {
#pragma unroll
                for (int m = 0; m < 4; ++m)
#pragma unroll
                    for (int n = 0; n < 4; ++n) {
                        const size_t o = (size_t)(rt * 256 + wr * 64 + m * 16 + fr) * 1024 + ct * 128 + wc * 64 + n * 16 + fq * 4;
                        *(f32x4*)(zf + o) = *(const f32x4*)(xres + o) * ALPHA + acc[m][n];
                    }
            });
    }
}

__device__ __forceinline__ void ph_ln_router(const Params& P, lds_t* lds, int layer) {
    const float* zf = (const float*)(P.ws + WS_ZF); float* x1f = (float*)(P.ws + WS_X1F); bf16_t* xb = (bf16_t*)(P.ws + WS_XB);
    const float* lg = P.in[I_LNM_G] + layer * 1024; const float* lb = P.in[I_LNM_B] + layer * 1024;
    const float* rw = P.in[I_R_W] + (size_t)layer * 1024 * 32; const float* rbias = P.in[I_R_B] + layer * 32;
    int* gcount = (int*)(P.ws + WS_CTL) + 64 * layer;
    int* pair_e = (int*)(P.ws + WS_ROUTE); int* pair_rank = pair_e + T * 4; float* pair_gate = (float*)(pair_rank + T * 4);
    LAS float* Wr = (LAS float*)lds;
    LAS int* hist = (LAS int*)(lds + 135168); LAS int* basev = hist + 32;
    LAS int* pinfo = basev + 32;
    const int tid = threadIdx.x, lane = tid & 63, wave = tid >> 6;
    for (int i = tid; i < 32768; i += NTHREADS) Wr[(i >> 5) * 33 + (i & 31)] = rw[i];
    float g[16], bb[16];
#pragma unroll
    for (int i = 0; i < 16; ++i) { g[i] = lg[lane + 64 * i]; bb[i] = lb[lane + 64 * i]; }
    const float myrb = rbias[lane & 31];
    __syncthreads();
    for (int it = blockIdx.x; it < 512; it += gridDim.x) {
        if (tid < 32) hist[tid] = 0;
        __syncthreads();
        for (int rr = 0; rr < 8; ++rr) {
            const int rl = wave * 8 + rr; const size_t row = (size_t)it * 64 + rl;
            float y[16]; float s = 0.f;
#pragma unroll
            for (int i = 0; i < 16; ++i) { y[i] = zf[row * 1024 + lane + 64 * i]; s += y[i]; }
            const float mean = wave_sum(s) * (1.0f / 1024.0f); float s2 = 0.f;
#pragma unroll
            for (int i = 0; i < 16; ++i) { y[i] -= mean; s2 += y[i] * y[i]; }
            const float rstd = rsqrtf(wave_sum(s2) * (1.0f / 1024.0f) + LN_EPS);
#pragma unroll
            for (int i = 0; i < 16; ++i) { y[i] = y[i] * rstd * g[i] + bb[i]; x1f[row * 1024 + lane + 64 * i] = y[i]; xb[row * 1024 + lane + 64 * i] = (bf16_t)(pk_bf16(y[i], 0.f) & 0xffffu); }
            float v[32];
#pragma unroll
            for (int e = 0; e < 32; ++e) v[e] = 0.f;
#pragma unroll
            for (int i = 0; i < 16; ++i) {
                const LAS float* wrow = Wr + (lane + 64 * i) * 33;
#pragma unroll
                for (int e = 0; e < 32; ++e) v[e] += y[i] * wrow[e];
            }
#pragma unroll
            for (int e = 0; e < 32; ++e) v[e] += __shfl_xor(v[e], 32);
#define TR_STEP(OFF, CNT) _Pragma("unroll") for (int e = 0; e < CNT; ++e) { const bool up = (lane & OFF) != 0; const float send = up ? v[e] : v[e + CNT]; const float keep = up ? v[e + CNT] : v[e]; v[e] = keep + __shfl_xor(send, OFF); }
            TR_STEP(16, 16) TR_STEP(8, 8) TR_STEP(4, 4) TR_STEP(2, 2) TR_STEP(1, 1)
#undef TR_STEP
            float val = v[0] + myrb; const int my = lane & 31;
            float topv[4]; int topi[4];
#pragma unroll
            for (int k = 0; k < 4; ++k) {
                float bv = val; int bi = my;
#pragma unroll
                for (int off = 16; off >= 1; off >>= 1) { const float ov = __shfl_xor(bv, off); const int oi = __shfl_xor(bi, off); if (ov > bv || (ov == bv && oi < bi)) { bv = ov; bi = oi; } }
                topv[k] = bv; topi[k] = bi; if (my == bi) val = -INFINITY;
            }
            if (lane == 0) {
                const float e1 = expf(topv[1] - topv[0]), e2 = expf(topv[2] - topv[0]), e3 = expf(topv[3] - topv[0]);
                const float inv = 1.0f / (1.0f + e1 + e2 + e3);
                const float gt[4] = {inv, e1 * inv, e2 * inv, e3 * inv};
#pragma unroll
                for (int k = 0; k < 4; ++k) { const int lr = __hip_atomic_fetch_add(&hist[topi[k]], 1, __ATOMIC_RELAXED, __HIP_MEMORY_SCOPE_WORKGROUP); pinfo[(rl * 4 + k) * 3 + 0] = topi[k]; pinfo[(rl * 4 + k) * 3 + 1] = lr; pinfo[(rl * 4 + k) * 3 + 2] = __float_as_int(gt[k]); }
            }
        }
        __syncthreads();
        if (tid < 32) { const int c = hist[tid]; basev[tid] = c ? atomicAdd(gcount + tid, c) : 0; }
        __syncthreads();
        if (tid < 256) {
            const int e = pinfo[tid * 3 + 0]; const size_t pi = (size_t)it * 256 + tid;
            pair_e[pi] = e; pair_rank[pi] = basev[e] + pinfo[tid * 3 + 1]; pair_gate[pi] = __int_as_float(pinfo[tid * 3 + 2]);
        }
        __syncthreads();
    }
}

__device__ __forceinline__ void moe_pstart(const Params& P, lds_t* lds, int layer) {
    LAS int* ps = (LAS int*)(lds + 120 * 1024);
    const int* gcount = (const int*)(P.ws + WS_CTL) + 64 * layer;
    if (threadIdx.x == 0) { int a = 0; for (int e = 0; e < 32; ++e) { const int c = gcount[e]; ps[e] = a; ps[40 + e] = c; a += ((c + 255) >> 8) << 8; } ps[32] = a; }
    __syncthreads();
}

__device__ __forceinline__ void ph_route_scatter(const Params& P, lds_t* lds, int layer) {
    moe_pstart(P, lds, layer);
    LAS int* ps = (LAS int*)(lds + 120 * 1024);
    const int* pair_e = (const int*)(P.ws + WS_ROUTE); const int* pair_rank = pair_e + T * 4; const float* pair_gate = (const float*)(pair_rank + T * 4);
    int* dest = (int*)(pair_gate + T * 4); int* row_tok = dest + T * 4; float* row_gate = (float*)(row_tok + MOE_ROWS);
    const size_t gtid = (size_t)blockIdx.x * NTHREADS + threadIdx.x, GT = (size_t)gridDim.x * NTHREADS;
    for (size_t i = gtid; i < (size_t)T * 4; i += GT) {
        const int e = pair_e[i], pos = ps[e] + pair_rank[i];
        row_tok[pos] = (int)(i >> 2); row_gate[pos] = pair_gate[i]; dest[i] = pos;
    }
    for (size_t i = gtid; i < 32 * 256; i += GT) {
        const int e = (int)(i >> 8), pos = ps[e] + ps[40 + e] + (int)(i & 255);
        if (pos < ps[e + 1]) { row_tok[pos] = 0; row_gate[pos] = 0.f; }
    }
}

__device__ __forceinline__ void ph_moe_up(const Params& P, lds_t* lds, int layer) {
    moe_pstart(P, lds, layer);
    LAS int* ps = (LAS int*)(lds + 120 * 1024);
    const bf16_t* xb = (const bf16_t*)(P.ws + WS_XB); const bf16_t* W = (const bf16_t*)(P.ws + WS_MWIN); bf16_t* hact = (bf16_t*)(P.ws + WS_HACT);
    const int* row_tok = (const int*)(P.ws + WS_ROUTE) + 4 * T * 4;
    const float* b_in = P.in[I_M_BIN] + (size_t)layer * 32 * 2048;
    const int nunits = (ps[32] >> 8) * 16;
    for (int unit = blockIdx.x; unit < nunits; unit += gridDim.x) {
        const int rb = unit >> 4, ct = unit & 15;
        int e = 0; while (ps[e + 1] <= rb * 256) ++e;
        int tok[4];
#pragma unroll
        for (int i = 0; i < 4; ++i) tok[i] = row_tok[rb * 256 + (threadIdx.x >> 3) + 64 * i];
        const bf16_t* We = W + (size_t)e * 2048 * 1024; const float* be = b_in + e * 2048;
        e1_tile<true>(lds, 16,
            [=](int i, int, int kp) { return *(const u32x4*)(xb + (size_t)tok[i] * 1024 + kp * 8); },
            [=](int, int n, int kp) { return *(const u32x4*)(We + (size_t)(ct * 128 + n) * 1024 + kp * 8); },
            [=](f32x4 (&acc)[4][4], int wr, int wc, int fr, int fq) {
#pragma unroll
                for (int n = 0; n < 2; ++n) {
                    const int j = ct * 64 + wc * 32 + n * 16 + fq * 4;
                    const f32x4 bg = *(const f32x4*)(be + j), bl = *(const f32x4*)(be + 1024 + j);
#pragma unroll
                    for (int m = 0; m < 4; ++m) {
                        f32x4 y;
#pragma unroll
                        for (int c = 0; c < 4; ++c) {
                            const float gv = fminf(acc[m][n][c] + bg[c], 7.0f), lv = fminf(fmaxf(acc[m][n + 2][c] + bl[c], -7.0f), 7.0f);
                            y[c] = gv * fsigmoid(1.702f * gv) * (lv + 1.0f);
                        }
                        store_bf16x4(hact + (size_t)(rb * 256 + wr * 64 + m * 16 + fr) * 1024 + j, y);
                    }
                }
            });
    }
}

__device__ __forceinline__ void ph_moe_down(const Params& P, lds_t* lds, int layer) {
    moe_pstart(P, lds, layer);
    LAS int* ps = (LAS int*)(lds + 120 * 1024);
    const bf16_t* hact = (const bf16_t*)(P.ws + WS_HACT); const bf16_t* W = (const bf16_t*)(P.ws + WS_MWOUT); bf16_t* yb = (bf16_t*)(P.ws + WS_YB);
    const float* row_gate = (const float*)((const int*)(P.ws + WS_ROUTE) + 4 * T * 4 + MOE_ROWS);
    const float* b_out = P.in[I_M_BOUT] + (size_t)layer * 32 * 1024;
    const int nunits = (ps[32] >> 8) * 8;
    for (int unit = blockIdx.x; unit < nunits; unit += gridDim.x) {
        const int rb = unit >> 3, ct = unit & 7;
        int e = 0; while (ps[e + 1] <= rb * 256) ++e;
        const bf16_t* We = W + (size_t)e * 1024 * 1024; const float* be = b_out + e * 1024;
        e1_tile<true>(lds, 16,
            [=](int, int r, int kp) { return *(const u32x4*)(hact + (size_t)(rb * 256 + r) * 1024 + kp * 8); },
            [=](int, int n, int kp) { return *(const u32x4*)(We + (size_t)(ct * 128 + n) * 1024 + kp * 8); },
            [=](f32x4 (&acc)[4][4], int wr, int wc, int fr, int fq) {
#pragma unroll
                for (int m = 0; m < 4; ++m) {
                    const int row = rb * 256 + wr * 64 + m * 16 + fr; const float gt = row_gate[row];
#pragma unroll
                    for (int n = 0; n < 4; ++n) {
                        const int col = ct * 128 + wc * 64 + n * 16 + fq * 4;
                        store_bf16x4(yb + (size_t)row * 1024 + col, (acc[m][n] + *(const f32x4*)(be + col)) * gt);
                    }
                }
            });
    }
}

__device__ __forceinline__ void ph_combine_ln(const Params& P, int layer, float* outf, bool write_bf) {
    float* x1f = (float*)(P.ws + WS_X1F); const bf16_t* yb = (const bf16_t*)(P.ws + WS_YB); bf16_t* xb = (bf16_t*)(P.ws + WS_XB);
    const int* dest = (const int*)(P.ws + WS_ROUTE) + 3 * T * 4;
    const float* lg = P.in[I_LNF_G] + layer * 1024; const float* lb = P.in[I_LNF_B] + layer * 1024;
    const int lane = threadIdx.x & 63, gw = blockIdx.x * 8 + (threadIdx.x >> 6), NGW = gridDim.x * 8;
    for (int row = gw; row < T; row += NGW) {
        int d[4];
#pragma unroll
        for (int k = 0; k < 4; ++k) d[k] = dest[row * 4 + k];
        f32x4 v[4]; float s = 0.f;
#pragma unroll
        for (int j = 0; j < 4; ++j) {
            v[j] = *(const f32x4*)(x1f + (size_t)row * 1024 + j * 256 + lane * 4) * ALPHA;
#pragma unroll
            for (int k = 0; k < 4; ++k) {
                const u32x2 r = *(const u32x2*)(yb + (size_t)d[k] * 1024 + j * 256 + lane * 4);
                v[j][0] += __uint_as_float(r.x << 16); v[j][1] += __uint_as_float(r.x & 0xffff0000u); v[j][2] += __uint_as_float(r.y << 16); v[j][3] += __uint_as_float(r.y & 0xffff0000u);
            }
            s += (v[j][0] + v[j][1]) + (v[j][2] + v[j][3]);
        }
        const float mean = wave_sum(s) * (1.0f / 1024.0f); float s2 = 0.f;
#pragma unroll
        for (int j = 0; j < 4; ++j) { v[j] = v[j] - mean; s2 += (v[j][0] * v[j][0] + v[j][1] * v[j][1]) + (v[j][2] * v[j][2] + v[j][3] * v[j][3]); }
        const float rstd = rsqrtf(wave_sum(s2) * (1.0f / 1024.0f) + LN_EPS);
#pragma unroll
        for (int j = 0; j < 4; ++j) {
            const f32x4 o = v[j] * rstd * *(const f32x4*)(lg + j * 256 + lane * 4) + *(const f32x4*)(lb + j * 256 + lane * 4);
            *(f32x4*)(outf + (size_t)row * 1024 + j * 256 + lane * 4) = o;
            if (write_bf) store_bf16x4(xb + (size_t)row * 1024 + j * 256 + lane * 4, o);
        }
    }
}

__device__ __forceinline__ void ph_conv1(const Params& P, lds_t* lds) {
    const bf16_t* proj = (const bf16_t*)(P.ws + WS_PROJ); bf16_t* xconv = (bf16_t*)(P.ws + WS_XCONV); float* gates = (float*)(P.ws + WS_GATES);
    LAS float* Wc = (LAS float*)lds;
    const float* Wcg = (const float*)(P.ws + WS_WC);
    for (int i = threadIdx.x; i < 8192; i += NTHREADS) Wc[i] = Wcg[i];
    __syncthreads();
    const int lane = threadIdx.x & 63, gw = blockIdx.x * 8 + (threadIdx.x >> 6), NGW = gridDim.x * 8, c8 = lane * 8;
    float w[4][8], bias[8];
#pragma unroll
    for (int e = 0; e < 8; ++e) { bias[e] = P.in[I_CD_CONVB][c8 + e];
#pragma unroll
        for (int k = 0; k < 4; ++k) w[k][e] = P.in[I_CD_CONVW][k * 512 + c8 + e]; }
    const float bif = P.in[I_CD_BIF][lane & 7];
    for (int tok = gw; tok < T; tok += NGW) {
        const int p = tok & (SEQ - 1);
        float a[8], xraw[8];
#pragma unroll
        for (int e = 0; e < 8; ++e) { a[e] = bias[e]; xraw[e] = 0.f; }
#pragma unroll
        for (int k = 0; k < 4; ++k) {
            if (p - 3 + k >= 0) {
                float xv[8]; unpack8(*(const u32x4*)(proj + (size_t)(tok - 3 + k) * 2560 + c8), xv);
#pragma unroll
                for (int e = 0; e < 8; ++e) { a[e] += w[k][e] * xv[e]; if (k == 3) xraw[e] = xv[e]; }
            }
        }
#pragma unroll
        for (int e = 0; e < 8; ++e) a[e] = a[e] * fsigmoid(a[e]);
        const u32x4 packed = pack8(a);
        *(u32x4*)(xconv + (size_t)tok * 512 + c8) = packed;
        float ar[8]; unpack8(packed, ar);
        float gs[8];
#pragma unroll
        for (int gg = 0; gg < 8; ++gg) gs[gg] = 0.f;
#pragma unroll
        for (int e = 0; e < 8; ++e) {
            const f32x4 w1a = *(LAS f32x4*)(Wc + (c8 + e) * 8), w1b = *(LAS f32x4*)(Wc + (c8 + e) * 8 + 4);
            const f32x4 w2a = *(LAS f32x4*)(Wc + 4096 + (c8 + e) * 8), w2b = *(LAS f32x4*)(Wc + 4096 + (c8 + e) * 8 + 4);
#pragma unroll
            for (int gg = 0; gg < 4; ++gg) { gs[gg] += ar[e] * w1a[gg] + xraw[e] * w2a[gg]; gs[gg + 4] += ar[e] * w1b[gg] + xraw[e] * w2b[gg]; }
        }
        float mine = 0.f;
#pragma unroll
        for (int gg = 0; gg < 8; ++gg) { const float tsum = wave_sum(gs[gg]); if ((lane & 7) == gg) mine = tsum; }
        if (lane < 8) gates[(size_t)tok * 8 + lane] = mine + bif;
    }
}

__device__ __forceinline__ void ph_qkv(const Params& P, lds_t* lds) {
    const bf16_t* xconv = (const bf16_t*)(P.ws + WS_XCONV); const bf16_t* proj = (const bf16_t*)(P.ws + WS_PROJ); const bf16_t* Wt = (const bf16_t*)(P.ws + WS_WQKV);
    for (int tile = blockIdx.x; tile < 1536; tile += gridDim.x) {
        const int which = tile % 3, rt = (tile / 3) & 127, h = tile / 384;
        const bf16_t* A = which < 2 ? xconv : proj; const int lda = which < 2 ? 512 : 2560;
        bf16_t* out = (bf16_t*)(P.ws + (which == 0 ? WS_QB : (which == 1 ? WS_KB : WS_VB)));
        const float sc = which == 1 ? 0.08838834764831845f : 1.0f;
        const bf16_t* Wh = Wt + (size_t)(which * 4 + h) * 16384;
        e1_tile<true>(lds, 2,
            [=](int, int r, int kp) { return *(const u32x4*)(A + (size_t)(rt * 256 + r) * lda + h * 128 + kp * 8); },
            [=](int, int n, int kp) { return *(const u32x4*)(Wh + n * 128 + kp * 8); },
            [=](f32x4 (&acc)[4][4], int wr, int wc, int fr, int fq) {
#pragma unroll
                for (int m = 0; m < 4; ++m)
#pragma unroll
                    for (int n = 0; n < 4; ++n)
                        store_bf16x4(out + (size_t)(rt * 256 + wr * 64 + m * 16 + fr) * 512 + h * 128 + wc * 64 + n * 16 + fq * 4, acc[m][n] * sc);
            });
    }
}

constexpr int TP = 272;
__device__ __forceinline__ void stage_tile(lds_t* dst, const bf16_t* src, size_t src_ld, int nrows) {
    for (int p = threadIdx.x; p < nrows * 16; p += NTHREADS) { const int row = p >> 4, pc = p & 15; *(LAS u32x4*)(dst + row * TP + pc * 16) = *(const u32x4*)(src + (size_t)row * src_ld + pc * 8); }
}

__device__ __forceinline__ void ph_m1(const Params& P, lds_t* lds) {
    const bf16_t* kb = (const bf16_t*)(P.ws + WS_KB); const bf16_t* vb = (const bf16_t*)(P.ws + WS_VB); const float* gates = (const float*)(P.ws + WS_GATES);
    float* kvc = (float*)(P.ws + WS_KVC); float* nchunk = (float*)(P.ws + WS_MISC); float* scal = nchunk + 2 * 2048 * 128;
    lds_t* Kt = lds; lds_t* Vt = lds + 64 * TP; LAS float* wv = (LAS float*)(lds + 128 * TP);
    const int tid = threadIdx.x, lane = tid & 63, w = tid >> 6, fr = lane & 15, fq = lane >> 4, q = (lane & 15) >> 2, p4 = lane & 3;
    for (int item = blockIdx.x; item < 2048; item += gridDim.x) {
        const int bh = item >> 6, n = item & 63, b = bh >> 2, h = bh & 3; const size_t tok0 = (size_t)b * SEQ + n * 64;
        stage_tile(Kt, kb + tok0 * 512 + h * 128, 512, 64);
        stage_tile(Vt, vb + tok0 * 512 + h * 128, 512, 64);
        if (w == 0) {
            const float f = gates[(tok0 + lane) * 8 + 4 + h], ig = gates[(tok0 + lane) * 8 + h];
            float cum = logsigmoidf(f);
#pragma unroll
            for (int off = 1; off < 64; off <<= 1) { const float t = __shfl_up(cum, off); if (lane >= off) cum += t; }
            const float cf = __shfl(cum, 63), te = cf - cum + ig, m = wave_max(te);
            wv[lane] = expf(te - m);
            if (lane == 0) { scal[item] = cf; scal[2048 + item] = m; }
        }
        __syncthreads();
        bf16x8 af[2]; float nsum = 0.f;
#pragma unroll
        for (int ks = 0; ks < 2; ++ks) {
            unsigned pk[4];
#pragma unroll
            for (int t = 0; t < 2; ++t) {
                const int s0 = 32 * ks + 8 * fq + 4 * t;
                const bf16x4 r = tr_read(Kt + (s0 + q) * TP + (16 * w + 4 * p4) * 2);
                const f32x4 ww = *(LAS f32x4*)(wv + s0);
                float x[4];
#pragma unroll
                for (int e = 0; e < 4; ++e) { x[e] = bf2f((unsigned short)r[e]) * ww[e]; nsum += x[e]; }
                pk[2 * t] = pk_bf16(x[0], x[1]); pk[2 * t + 1] = pk_bf16(x[2], x[3]);
            }
            u32x4 u = {pk[0], pk[1], pk[2], pk[3]}; af[ks] = __builtin_bit_cast(bf16x8, u);
        }
        nsum += __shfl_xor(nsum, 16); nsum += __shfl_xor(nsum, 32);
        if (fq == 0) nchunk[(size_t)item * 128 + 16 * w + fr] = nsum;
#pragma unroll
        for (int c = 0; c < 8; ++c) {
            f32x4 acc = {0.f, 0.f, 0.f, 0.f};
#pragma unroll
            for (int ks = 0; ks < 2; ++ks) {
                const int s0 = 32 * ks + 8 * fq;
                const bf16x8 bfv = cat44(tr_read(Vt + (s0 + q) * TP + (16 * c + 4 * p4) * 2), tr_read(Vt + (s0 + 4 + q) * TP + (16 * c + 4 * p4) * 2));
                acc = MFMA16(af[ks], bfv, acc);
            }
            *(f32x4*)(kvc + ((size_t)item * 128 + c * 16 + fr) * 128 + 16 * w + fq * 4) = acc;
        }
        __syncthreads();
    }
}

__device__ __forceinline__ void ph_m2(const Params& P) {
    const float* kvc = (const float*)(P.ws + WS_KVC); bf16_t* cprev = (bf16_t*)(P.ws + WS_CPREV);
    float* nchunk = (float*)(P.ws + WS_MISC); float* nprev = nchunk + 2048 * 128; float* scal = nchunk + 2 * 2048 * 128;
    const int tid = threadIdx.x;
    for (int it = blockIdx.x; it < 1024; it += gridDim.x) {
        const int bh = it >> 5, sl = it & 31, idx = sl * 512 + tid;
        float C = 0.f, nv = 0.f, m = -INFINITY;
#pragma unroll 4
        for (int n = 0; n < 64; ++n) {
            const int item = bh * 64 + n;
            cprev[(size_t)item * 16384 + idx] = (bf16_t)(pk_bf16(C, 0.f) & 0xffffu);
            if (sl == 0 && tid < 128) nprev[(size_t)item * 128 + tid] = nv;
            if (sl == 0 && tid == 0) scal[4096 + item] = m;
            const float kv = kvc[(size_t)item * 16384 + idx];
            const float fc = scal[item], mc = scal[2048 + item];
            const float mn = fmaxf(fc + m, mc), so = expf(fc + m - mn), sn = expf(mc - mn);
            C = so * C + sn * kv;
            if (sl == 0 && tid < 128) nv = so * nv + sn * nchunk[(size_t)item * 128 + tid];
            m = mn;
        }
    }
}

__device__ __forceinline__ void ph_m3(const Params& P, lds_t* lds) {
    const bf16_t* qb = (const bf16_t*)(P.ws + WS_QB); const bf16_t* kb = (const bf16_t*)(P.ws + WS_KB); const bf16_t* vb = (const bf16_t*)(P.ws + WS_VB);
    const bf16_t* cprev = (const bf16_t*)(P.ws + WS_CPREV); const float* gates = (const float*)(P.ws + WS_GATES);
    const float* nprev = (const float*)(P.ws + WS_MISC) + 2048 * 128; const float* scal = (const float*)(P.ws + WS_MISC) + 2 * 2048 * 128;
    const bf16_t* proj = (const bf16_t*)(P.ws + WS_PROJ); bf16_t* cat = (bf16_t*)(P.ws + WS_CAT);
    lds_t* Qt = lds; lds_t* Kt = lds + 64 * TP; lds_t* Vt = lds + 128 * TP; lds_t* Ct = lds + 192 * TP;
    LAS float* cumf = (LAS float*)(lds + 320 * TP); LAS float* gv = cumf + 64; LAS float* msv = gv + 64; LAS float* npv = msv + 64; LAS float* ex = npv + 128;
    const int tid = threadIdx.x, lane = tid & 63, w = tid >> 6, fr = lane & 15, fq = lane >> 4, q = (lane & 15) >> 2, p4 = lane & 3;
    const int rt = w & 3, vh = w >> 2;
    for (int item = blockIdx.x; item < 2048; item += gridDim.x) {
        const int bh = item >> 6, n = item & 63, b = bh >> 2, h = bh & 3; const size_t tok0 = (size_t)b * SEQ + n * 64;
        stage_tile(Qt, qb + tok0 * 512 + h * 128, 512, 64);
        stage_tile(Kt, kb + tok0 * 512 + h * 128, 512, 64);
        stage_tile(Vt, vb + tok0 * 512 + h * 128, 512, 64);
        stage_tile(Ct, cprev + (size_t)item * 16384, 128, 128);
        if (tid < 128) npv[tid] = nprev[(size_t)item * 128 + tid];
        const float mp = scal[4096 + item];
        if (w == 0) {
            const float f = gates[(tok0 + lane) * 8 + 4 + h], ig = gates[(tok0 + lane) * 8 + h];
            float cum = logsigmoidf(f);
#pragma unroll
            for (int off = 1; off < 64; off <<= 1) { const float t = __shfl_up(cum, off); if (lane >= off) cum += t; }
            const float gg = ig - cum; float pm = gg;
#pragma unroll
            for (int off = 1; off < 64; off <<= 1) { const float t = __shfl_up(pm, off); if (lane >= off) pm = fmaxf(pm, t); }
            cumf[lane] = cum; gv[lane] = gg; msv[lane] = cum + fmaxf(pm, mp);
        }
        __syncthreads();
        bf16x8 qf[4];
#pragma unroll
        for (int ks = 0; ks < 4; ++ks) qf[ks] = *(LAS bf16x8*)(Qt + (rt * 16 + fr) * TP + ks * 64 + fq * 16);
        const int s = rt * 16 + fr; const float cs = cumf[s], mss = msv[s];
        float sp[4][4]; float rowsum = 0.f;
#pragma unroll
        for (int jt = 0; jt < 4; ++jt) {
            f32x4 st = {0.f, 0.f, 0.f, 0.f};
            if (jt <= rt) {
#pragma unroll
                for (int ks = 0; ks < 4; ++ks) st = MFMA16(*(LAS bf16x8*)(Kt + (jt * 16 + fr) * TP + ks * 64 + fq * 16), qf[ks], st);
            }
            const f32x4 g4 = *(LAS f32x4*)(gv + jt * 16 + fq * 4);
#pragma unroll
            for (int r = 0; r < 4; ++r) { const int j = jt * 16 + fq * 4 + r; const float wgt = (j <= s) ? fexp(cs + g4[r] - mss) : 0.f; sp[jt][r] = st[r] * wgt; rowsum += sp[jt][r]; }
        }
        rowsum += __shfl_xor(rowsum, 16); rowsum += __shfl_xor(rowsum, 32);
        float qn = 0.f;
#pragma unroll
        for (int ks = 0; ks < 4; ++ks) {
            const f32x4 n0 = *(LAS f32x4*)(npv + ks * 32 + fq * 8), n1 = *(LAS f32x4*)(npv + ks * 32 + fq * 8 + 4);
#pragma unroll
            for (int e = 0; e < 4; ++e) { qn += bf2f((unsigned short)qf[ks][e]) * n0[e]; qn += bf2f((unsigned short)qf[ks][4 + e]) * n1[e]; }
        }
        qn += __shfl_xor(qn, 16); qn += __shfl_xor(qn, 32);
        const float inter = expf(cs + mp - mss), den = rowsum + inter * qn, inv = 1.0f / fmaxf(fabsf(den), expf(-mss));
        if (fq == 0) { ex[w * 32 + fr] = inv; ex[w * 32 + 16 + fr] = inter; }
        __builtin_amdgcn_wave_barrier();
        const f32x4 inv4 = *(LAS f32x4*)(ex + w * 32 + fq * 4), int4 = *(LAS f32x4*)(ex + w * 32 + 16 + fq * 4);
        bf16x8 pa[2];
#pragma unroll
        for (int kk = 0; kk < 2; ++kk) { u32x4 u = {pk_bf16(sp[2 * kk][0], sp[2 * kk][1]), pk_bf16(sp[2 * kk][2], sp[2 * kk][3]), pk_bf16(sp[2 * kk + 1][0], sp[2 * kk + 1][1]), pk_bf16(sp[2 * kk + 1][2], sp[2 * kk + 1][3])}; pa[kk] = __builtin_bit_cast(bf16x8, u); }
#pragma unroll
        for (int c = 0; c < 4; ++c) {
            const int vcol = vh * 64 + c * 16;
            f32x4 acc = {0.f, 0.f, 0.f, 0.f};
#pragma unroll
            for (int ks = 0; ks < 4; ++ks) acc = MFMA16(qf[ks], *(LAS bf16x8*)(Ct + (vcol + fr) * TP + ks * 64 + fq * 16), acc);
#pragma unroll
            for (int r = 0; r < 4; ++r) acc[r] *= int4[r];
#pragma unroll
            for (int kk = 0; kk < 2; ++kk) {
                const bf16x8 vbf = cat44(tr_read(Vt + (32 * kk + 4 * fq + q) * TP + (vcol + 4 * p4) * 2), tr_read(Vt + (32 * kk + 16 + 4 * fq + q) * TP + (vcol + 4 * p4) * 2));
                acc = MFMA16(pa[kk], vbf, acc);
            }
#pragma unroll
            for (int r = 0; r < 4; ++r) {
                const size_t tok = tok0 + rt * 16 + fq * 4 + r; const int col = h * 128 + vcol + fr;
                const float op = bf2f(proj[tok * 2560 + 512 + col]);
                cat[tok * 1024 + col] = (bf16_t)(pk_bf16(fsigmoid(op) * acc[r] * inv4[r], 0.f) & 0xffffu);
            }
        }
        __syncthreads();
    }
}

__device__ __forceinline__ void ph_attn(const Params& P, lds_t* lds) {
    const bf16_t* proj = (const bf16_t*)(P.ws + WS_PROJ); float* atto = (float*)(P.ws + WS_ATTO); float* lse = (float*)(P.ws + WS_LSE);
    lds_t* Kt = lds; lds_t* Vt = lds + 256 * TP; LAS float* ex = (LAS float*)(lds + 512 * TP);
    const int tid = threadIdx.x, lane = tid & 63, w = tid >> 6, fr = lane & 15, fq = lane >> 4, q = (lane & 15) >> 2, p4 = lane & 3;
    for (int item = blockIdx.x; item < 3072; item += gridDim.x) {
        const int g = item >> 10, rem = item & 1023, h = rem & 3, x = rem >> 2, b = x >> 5, y = x & 31;
        const int dsh = 2 * g, dil = 1 << dsh, nbsh = 5 - dsh, r = y >> nbsh, nb = y & ((1 << nbsh) - 1);
        const size_t tokb = (size_t)b * SEQ + r;
        for (int p = tid; p < 256 * 16; p += NTHREADS) {
            const int kr = p >> 4, pc = p & 15; const int i = nb * 128 + kr - 128;
            u32x4 kv = {0u, 0u, 0u, 0u}, vv = {0u, 0u, 0u, 0u};
            if (i >= 0) { const bf16_t* src = proj + (tokb + (size_t)i * dil) * 2560 + h * 128 + pc * 8; kv = *(const u32x4*)(src + 1536); vv = *(const u32x4*)(src + 2048); }
            *(LAS u32x4*)(Kt + kr * TP + pc * 16) = kv; *(LAS u32x4*)(Vt + kr * TP + pc * 16) = vv;
        }
        const int qi = w * 16 + fr;
        const size_t tokq = tokb + (size_t)(nb * 128 + qi) * dil;
        bf16x8 qf[4];
#pragma unroll
        for (int ks = 0; ks < 4; ++ks) qf[ks] = __builtin_bit_cast(bf16x8, *(const u32x4*)(proj + tokq * 2560 + 1024 + h * 128 + ks * 32 + fq * 8));
        __syncthreads();
        float pv[9][4]; float mx = -INFINITY;
#pragma unroll
        for (int jj = 0; jj < 9; ++jj) {
            f32x4 st = {0.f, 0.f, 0.f, 0.f};
#pragma unroll
            for (int ks = 0; ks < 4; ++ks) st = MFMA16(*(LAS bf16x8*)(Kt + ((w + jj) * 16 + fr) * TP + ks * 64 + fq * 16), qf[ks], st);
#pragma unroll
            for (int rr = 0; rr < 4; ++rr) {
                const int kj = (w + jj) * 16 + fq * 4 + rr;
                const bool valid = (kj >= qi) && (kj <= qi + 128) && (nb > 0 || kj >= 128);
                pv[jj][rr] = valid ? st[rr] : -INFINITY; mx = fmaxf(mx, pv[jj][rr]);
            }
        }
        mx = fmaxf(mx, __shfl_xor(mx, 16)); mx = fmaxf(mx, __shfl_xor(mx, 32));
        float l = 0.f;
#pragma unroll
        for (int jj = 0; jj < 9; ++jj)
#pragma unroll
            for (int rr = 0; rr < 4; ++rr) { pv[jj][rr] = fexp(pv[jj][rr] - mx); l += pv[jj][rr]; }
        l += __shfl_xor(l, 16); l += __shfl_xor(l, 32);
        if (fq == 0) { ex[w * 16 + fr] = 1.0f / l; lse[((size_t)g * T + tokq) * 4 + h] = mx + logf(l); }
        __builtin_amdgcn_wave_barrier();
        const f32x4 inv4 = *(LAS f32x4*)(ex + w * 16 + fq * 4);
        f32x4 acc[8];
#pragma unroll
        for (int c = 0; c < 8; ++c) acc[c] = (f32x4){0.f, 0.f, 0.f, 0.f};
#pragma unroll
        for (int kk = 0; kk < 5; ++kk) {
            const int ja = 2 * kk, jb = (2 * kk + 1 < 9) ? 2 * kk + 1 : 2 * kk;
            u32x4 u; u.x = pk_bf16(pv[ja][0], pv[ja][1]); u.y = pk_bf16(pv[ja][2], pv[ja][3]);
            if (2 * kk + 1 < 9) { u.z = pk_bf16(pv[jb][0], pv[jb][1]); u.w = pk_bf16(pv[jb][2], pv[jb][3]); } else { u.z = 0u; u.w = 0u; }
            const bf16x8 pa = __builtin_bit_cast(bf16x8, u);
#pragma unroll
            for (int c = 0; c < 8; ++c) {
                const bf16x8 vbf = cat44(tr_read(Vt + ((w + ja) * 16 + 4 * fq + q) * TP + (c * 16 + 4 * p4) * 2), tr_read(Vt + ((w + jb) * 16 + 4 * fq + q) * TP + (c * 16 + 4 * p4) * 2));
                acc[c] = MFMA16(pa, vbf, acc[c]);
            }
        }
#pragma unroll
        for (int rr = 0; rr < 4; ++rr) {
            const size_t tq = tokb + (size_t)(nb * 128 + w * 16 + fq * 4 + rr) * dil;
#pragma unroll
            for (int c = 0; c < 8; ++c) atto[((size_t)g * T + tq) * 512 + h * 128 + c * 16 + fr] = acc[c][rr] * inv4[rr];
        }
        __syncthreads();
    }
}

__device__ __forceinline__ void ph_attn_combine(const Params& P) {
    const float* atto = (const float*)(P.ws + WS_ATTO); const float* lse = (const float*)(P.ws + WS_LSE); bf16_t* cat = (bf16_t*)(P.ws + WS_CAT);
    const size_t gtid = (size_t)blockIdx.x * NTHREADS + threadIdx.x, GT = (size_t)gridDim.x * NTHREADS;
    for (size_t i = gtid; i < (size_t)T * 128; i += GT) {
        const size_t tok = i >> 7; const int c4 = (int)(i & 127) * 4, h = c4 >> 7;
        const float l0 = lse[tok * 4 + h], l1 = lse[((size_t)T + tok) * 4 + h], l2 = lse[((size_t)2 * T + tok) * 4 + h];
        const float mx = fmaxf(l0, fmaxf(l1, l2)), e0 = expf(l0 - mx), e1 = expf(l1 - mx), e2 = expf(l2 - mx), inv = 1.0f / (e0 + e1 + e2);
        const f32x4 o = (*(const f32x4*)(atto + tok * 512 + c4) * e0 + *(const f32x4*)(atto + ((size_t)T + tok) * 512 + c4) * e1 + *(const f32x4*)(atto + ((size_t)2 * T + tok) * 512 + c4) * e2) * inv;
        store_bf16x4(cat + tok * 1024 + 512 + c4, o);
    }
}

constexpr int NPHASES = 33;
__device__ __forceinline__ void grid_barrier(cg::grid_group& grid) {
    asm volatile("s_waitcnt vmcnt(0)" ::: "memory");
    grid.sync();
    __builtin_amdgcn_fence(__ATOMIC_ACQUIRE, "agent");
    asm volatile("s_waitcnt vmcnt(0)" ::: "memory");
}
typedef __attribute__((address_space(4))) const Params* KP4;
__device__ __forceinline__ const Params& phase_params() { KP4 kp = (KP4)__builtin_amdgcn_kernarg_segment_ptr(); asm volatile("" : "+s"(kp)); return *(const Params*)kp; }
__global__ void __launch_bounds__(NTHREADS) fwd_megakernel(Params Pk) {
    extern __shared__ __attribute__((aligned(16))) unsigned char lds_raw[];
    lds_t* lds = (lds_t*)lds_raw;
    cg::grid_group grid = cg::this_grid();
    const int ph_lo = Pk.ph_lo, ph_hi = Pk.ph_hi;
#ifdef ONLY_PHASE
#define PHASE(k, ...) if constexpr ((k) == ONLY_PHASE) { const Params& P = phase_params(); unsigned char* ws = P.ws; (void)ws; __VA_ARGS__; grid_barrier(grid); }
#else
#ifndef PHASE_MASK
#define PHASE_MASK 0xffffffffu
#endif
#define PHASE(k, ...) if (((PHASE_MASK >> (k)) & 1u) && ph_lo <= (k) && (k) < ph_hi) { const Params& P = phase_params(); unsigned char* ws = P.ws; (void)ws; __VA_ARGS__; if ((k) + 1 < ph_hi) grid_barrier(grid); }
#endif
    PHASE(0, phase0(P, lds))
    PHASE(1, ph_inproj(P, lds, (const bf16_t*)(ws + WS_WABIN), 1536, nullptr))
    PHASE(2, ph_conv0(P); ph_s5_state(P, lds))
    PHASE(3, ph_gates0(P, lds); ph_s5_carry(P))
    PHASE(4, ph_lru_scan(P, lds); ph_s5_out(P, lds))
    PHASE(5, ph_glu(P, lds))
    PHASE(6, ph_outproj(P, lds, (const bf16_t*)(ws + WS_WABOUT), P.in[I_X]))
    PHASE(7, ph_ln_router(P, lds, 0))
    PHASE(8, ph_route_scatter(P, lds, 0))
    PHASE(9, ph_moe_up(P, lds, 0))
    PHASE(10, ph_moe_down(P, lds, 0))
    PHASE(11, ph_combine_ln(P, 0, (float*)(ws + WS_X1F), true))
    PHASE(12, ph_inproj(P, lds, (const bf16_t*)(ws + WS_WCDIN), 2560, (const int*)P.in[I_POS]); convert_moe_weights(P, 1, lds))
    PHASE(13, ph_conv1(P, lds))
    PHASE(14, ph_qkv(P, lds))
    PHASE(15, ph_m1(P, lds))
    PHASE(16, ph_m2(P); ph_attn(P, lds))
    PHASE(17, ph_m3(P, lds); ph_attn_combine(P))
    PHASE(18, ph_outproj(P, lds, (const bf16_t*)(ws + WS_WCDOUT), (const float*)(ws + WS_X1F)))
    PHASE(19, ph_ln_router(P, lds, 1))
    PHASE(20, ph_route_scatter(P, lds, 1))
    PHASE(21, ph_moe_up(P, lds, 1))
    PHASE(22, ph_moe_down(P, lds, 1))
    PHASE(23, ph_combine_ln(P, 1, P.out, false))
#undef PHASE
}

#ifndef MULTI_LAUNCH
#define MULTI_LAUNCH 0
#endif
extern "C" void kernel_launch(void* const* d_in, const int* in_sizes, int n_in, void* d_out, int out_size, void* d_ws, size_t ws_size, hipStream_t stream) {
    static int grid_blocks = 0;
    if (grid_blocks == 0) {
        if (n_in != N_IN || out_size != T * D || ws_size < WS_END) { fprintf(stderr, "kernel_launch: unexpected shapes (n_in %d out %d ws %zu need %zu)\n", n_in, out_size, ws_size, (size_t)WS_END); grid_blocks = -1; return; }
        int dev = 0, cus = 0, per_cu = 0;
        (void)hipGetDevice(&dev);
        (void)hipDeviceGetAttribute(&cus, hipDeviceAttributeMultiprocessorCount, dev);
        if (hipFuncSetAttribute((const void*)fwd_megakernel, hipFuncAttributeMaxDynamicSharedMemorySize, LDS_BYTES) != hipSuccess) { fprintf(stderr, "kernel_launch: hipFuncSetAttribute failed\n"); grid_blocks = -1; return; }
        (void)hipOccupancyMaxActiveBlocksPerMultiprocessor(&per_cu, (const void*)fwd_megakernel, NTHREADS, LDS_BYTES);
        if (per_cu < 1) { fprintf(stderr, "kernel_launch: occupancy query returned %d\n", per_cu); grid_blocks = -1; return; }
        grid_blocks = cus * per_cu;
    }
    if (grid_blocks < 0) return;
    Params p{};
    for (int i = 0; i < N_IN; ++i) p.in[i] = (const float*)d_in[i];
    p.out = (float*)d_out; p.ws = (unsigned char*)d_ws;
#if MULTI_LAUNCH
    for (int k = 0; k < 24; ++k) { p.ph_lo = k; p.ph_hi = k + 1; hipLaunchKernelGGL(fwd_megakernel, dim3(grid_blocks), dim3(NTHREADS), LDS_BYTES, stream, p); }
#else
    p.ph_lo = 0; p.ph_hi = 24;
    void* args[] = {&p};
    hipError_t e = hipLaunchCooperativeKernel((const void*)fwd_megakernel, dim3(grid_blocks), dim3(NTHREADS), args, LDS_BYTES, stream);
    if (e != hipSuccess) fprintf(stderr, "cooperative launch failed: %s (grid %d)\n", hipGetErrorString(e), grid_blocks);
#endif
}
```

```cpp
#include <hip/hip_runtime.h>
#include <hip/hip_cooperative_groups.h>
#include <cstdio>
#include <cstdint>
namespace cg = cooperative_groups;

#define LAS __attribute__((address_space(3)))
typedef unsigned short bf16_t;
typedef short bf16x8 __attribute__((ext_vector_type(8)));
typedef short bf16x4 __attribute__((ext_vector_type(4)));
typedef float f32x4 __attribute__((ext_vector_type(4)));
typedef unsigned u32x4 __attribute__((ext_vector_type(4)));
typedef unsigned u32x2 __attribute__((ext_vector_type(2)));
typedef LAS unsigned char lds_t;

constexpr int T = 32768, D = 1024, SEQ = 4096;
constexpr int NTHREADS = 512;
constexpr int LDS_BYTES = 160 * 1024;
constexpr float ALPHA = 1.4142135623730951f;
constexpr float LN_EPS = 1e-5f;
constexpr int MOE_ROWS = 139264;
constexpr int S5TC = 32;
constexpr int S5K = S5TC * 16 + 128;

enum { I_X = 0, I_POS, I_AB_WIN, I_AB_CONVW, I_AB_CONVB, I_AB_GRW, I_AB_GRB, I_AB_GIW, I_AB_GIB, I_AB_LAMBDA,
       I_S5_LRE, I_S5_LIM, I_S5_STEP, I_S5_BRE, I_S5_BIM, I_S5_CRE, I_S5_CIM, I_S5_D, I_AB_GLUW, I_AB_GLUB, I_AB_WOUT,
       I_CD_WIN, I_CD_CONVW, I_CD_CONVB, I_CD_WQ, I_CD_WK, I_CD_WV, I_CD_WIF, I_CD_BIF, I_CD_WOUT,
       I_LNM_G, I_LNM_B, I_LNF_G, I_LNF_B, I_R_W, I_R_B, I_M_WIN, I_M_BIN, I_M_WOUT, I_M_BOUT, N_IN };

constexpr size_t MiB = 1ull << 20;
constexpr size_t WS_CTL = 0;
constexpr size_t WS_XB = 1 * MiB;
constexpr size_t WS_WABIN = 65 * MiB;
constexpr size_t WS_WGLU = 68 * MiB;
constexpr size_t WS_WABOUT = 69 * MiB;
constexpr size_t WS_WCDIN = 71 * MiB;
constexpr size_t WS_WCDOUT = 76 * MiB;
constexpr size_t WS_WG = 78 * MiB;
constexpr size_t WS_WQKV = 78 * MiB + 256 * 1024;
constexpr size_t WS_WC = 79 * MiB;
constexpr size_t WS_S5TM = 80 * MiB;
constexpr size_t WS_S5WST = 100 * MiB;
constexpr size_t WS_MWIN = 104 * MiB;
constexpr size_t WS_MWOUT = 232 * MiB;
constexpr size_t WS_PROJ = 296 * MiB;
constexpr size_t WS_CAT = 456 * MiB;
constexpr size_t WS_X1F = 520 * MiB;
constexpr size_t WS_ZF = 648 * MiB;
constexpr size_t WS_HACT = 776 * MiB;
constexpr size_t WS_YB = 1048 * MiB;
constexpr size_t WS_ROUTE = 1320 * MiB;
constexpr size_t WS_SCR = 1328 * MiB;
constexpr size_t WS_XC = WS_SCR;
constexpr size_t WS_AF = WS_SCR + 32 * MiB;
constexpr size_t WS_UF = WS_SCR + 96 * MiB;
constexpr size_t WS_SB = WS_SCR + 160 * MiB;
constexpr size_t WS_S5S = WS_SCR + 192 * MiB;
constexpr size_t WS_S5X = WS_SCR + 208 * MiB;
constexpr size_t WS_XCONV = WS_SCR;
constexpr size_t WS_QB = WS_SCR + 32 * MiB;
constexpr size_t WS_KB = WS_SCR + 64 * MiB;
constexpr size_t WS_VB = WS_SCR + 96 * MiB;
constexpr size_t WS_GATES = WS_SCR + 128 * MiB;
constexpr size_t WS_KVC = WS_SCR + 130 * MiB;
constexpr size_t WS_CPREV = WS_SCR + 258 * MiB;
constexpr size_t WS_MISC = WS_SCR + 322 * MiB;
constexpr size_t WS_ATTO = WS_SCR + 326 * MiB;
constexpr size_t WS_LSE = WS_SCR + 518 * MiB;
constexpr size_t WS_END = WS_SCR + 520 * MiB;

struct Params { const float* in[N_IN]; float* out; unsigned char* ws; int ph_lo, ph_hi; };

__device__ __forceinline__ float bf2f(unsigned short b) { return __uint_as_float(((unsigned)b) << 16); }
typedef __bf16 bf16v2_t __attribute__((ext_vector_type(2)));
typedef float f32x2 __attribute__((ext_vector_type(2)));
__device__ __forceinline__ unsigned pk_bf16(float lo, float hi) { const f32x2 v = {lo, hi}; return __builtin_bit_cast(unsigned, __builtin_convertvector(v, bf16v2_t)); }
__device__ __forceinline__ float wave_sum(float v) {
#pragma unroll
    for (int o = 1; o < 64; o <<= 1) v += __shfl_xor(v, o);
    return v;
}
__device__ __forceinline__ float wave_max(float v) {
#pragma unroll
    for (int o = 1; o < 64; o <<= 1) v = fmaxf(v, __shfl_xor(v, o));
    return v;
}
__device__ __forceinline__ float fsigmoid(float x) { return __builtin_amdgcn_rcpf(1.0f + __builtin_amdgcn_exp2f(-1.4426950408889634f * x)); }
__device__ __forceinline__ float fexp(float x) { return __builtin_amdgcn_exp2f(1.4426950408889634f * x); }
__device__ __forceinline__ float flog(float x) { return 0.6931471805599453f * __builtin_amdgcn_logf(x); }
__device__ __forceinline__ void fsincos(float x, float& sn, float& cs) {
    const float n = rintf(x * 0.15915494309189535f);
    float r = fmaf(-n, 6.28125f, x); r = fmaf(-n, 0.0019353071795864769f, r);
    const float rev = r * 0.15915494309189535f;
    sn = __builtin_amdgcn_sinf(rev); cs = __builtin_amdgcn_cosf(rev);
}
__device__ __forceinline__ float gelu_tanh(float x) { return x * fsigmoid(1.5957691216057308f * (x + 0.044715f * x * x * x)); }
__device__ __forceinline__ float logsigmoidf(float x) { return fminf(x, 0.f) - log1pf(expf(-fabsf(x))); }
__device__ __forceinline__ void unpack8(u32x4 v, float (&f)[8]) {
    f[0] = __uint_as_float(v.x << 16); f[1] = __uint_as_float(v.x & 0xffff0000u);
    f[2] = __uint_as_float(v.y << 16); f[3] = __uint_as_float(v.y & 0xffff0000u);
    f[4] = __uint_as_float(v.z << 16); f[5] = __uint_as_float(v.z & 0xffff0000u);
    f[6] = __uint_as_float(v.w << 16); f[7] = __uint_as_float(v.w & 0xffff0000u);
}
__device__ __forceinline__ u32x4 pack8(const float (&f)[8]) { u32x4 o; o.x = pk_bf16(f[0], f[1]); o.y = pk_bf16(f[2], f[3]); o.z = pk_bf16(f[4], f[5]); o.w = pk_bf16(f[6], f[7]); return o; }
__device__ __forceinline__ bf16x4 tr_read(lds_t* p) { return __builtin_amdgcn_ds_read_tr16_b64_v4i16((LAS bf16x4*)p); }
__device__ __forceinline__ bf16x8 cat44(bf16x4 a, bf16x4 b) { bf16x8 r = {a[0], a[1], a[2], a[3], b[0], b[1], b[2], b[3]}; return r; }
#define MFMA16(a, b, c) __builtin_amdgcn_mfma_f32_16x16x32_bf16((a), (b), (c), 0, 0, 0)

constexpr int E1_PITCH = 144;
constexpr int E1_A = 256 * E1_PITCH;
constexpr int E1_B = 128 * E1_PITCH;
constexpr int E1_BUF = E1_A + E1_B;

template <bool TRANS, class AL, class BL, class EP>
__device__ __forceinline__ void e1_tile(lds_t* lds, int nk, AL aload, BL bload, EP epi) {
    const int tid = threadIdx.x, lane = tid & 63, wave = tid >> 6, wr = wave >> 1, wc = wave & 1, fr = lane & 15, fq = lane >> 4;
    const int prow = tid >> 3, pc = tid & 7;
    f32x4 acc[4][4];
#pragma unroll
    for (int m = 0; m < 4; ++m)
#pragma unroll
        for (int n = 0; n < 4; ++n) acc[m][n] = (f32x4){0.f, 0.f, 0.f, 0.f};
    u32x4 ra[4], rb[2];
#pragma unroll
    for (int i = 0; i < 4; ++i) ra[i] = aload(i, prow + 64 * i, pc);
#pragma unroll
    for (int i = 0; i < 2; ++i) rb[i] = bload(i, prow + 64 * i, pc);
#pragma unroll
    for (int i = 0; i < 4; ++i) *(LAS u32x4*)(lds + (prow + 64 * i) * E1_PITCH + pc * 16) = ra[i];
#pragma unroll
    for (int i = 0; i < 2; ++i) *(LAS u32x4*)(lds + E1_A + (prow + 64 * i) * E1_PITCH + pc * 16) = rb[i];
    __syncthreads();
    for (int t = 0; t < nk; ++t) {
        const bool more = (t + 1 < nk);
        if (more) {
#pragma unroll
            for (int i = 0; i < 4; ++i) ra[i] = aload(i, prow + 64 * i, (t + 1) * 8 + pc);
#pragma unroll
            for (int i = 0; i < 2; ++i) rb[i] = bload(i, prow + 64 * i, (t + 1) * 8 + pc);
        }
        lds_t* Ab = lds + (t & 1) * E1_BUF + (wr * 64 + fr) * E1_PITCH + fq * 16;
        lds_t* Bb = lds + (t & 1) * E1_BUF + E1_A + (wc * 64 + fr) * E1_PITCH + fq * 16;
#pragma unroll
        for (int kk = 0; kk < 2; ++kk) {
            bf16x8 af[4], bfr[4];
#pragma unroll
            for (int m = 0; m < 4; ++m) af[m] = *(LAS bf16x8*)(Ab + m * 16 * E1_PITCH + kk * 64);
#pragma unroll
            for (int n = 0; n < 4; ++n) bfr[n] = *(LAS bf16x8*)(Bb + n * 16 * E1_PITCH + kk * 64);
#pragma unroll
            for (int m = 0; m < 4; ++m)
#pragma unroll
                for (int n = 0; n < 4; ++n) acc[m][n] = TRANS ? MFMA16(bfr[n], af[m], acc[m][n]) : MFMA16(af[m], bfr[n], acc[m][n]);
        }
        if (more) {
            lds_t* nb = lds + ((t + 1) & 1) * E1_BUF;
#pragma unroll
            for (int i = 0; i < 4; ++i) *(LAS u32x4*)(nb + (prow + 64 * i) * E1_PITCH + pc * 16) = ra[i];
#pragma unroll
            for (int i = 0; i < 2; ++i) *(LAS u32x4*)(nb + E1_A + (prow + 64 * i) * E1_PITCH + pc * 16) = rb[i];
        }
        __syncthreads();
    }
    epi(acc, wr, wc, fr, fq);
}


namespace g2 {
constexpr int HTB = 16384;
__device__ __forceinline__ int lds_byte(int r, int c) { const int st = (r >> 4) * 2 + (c >> 5), rr = r & 15, cc = c & 31, ob = rr * 64 + cc * 2; return st * 1024 + (ob ^ (((ob >> 9) & 1) << 5)); }
__device__ __forceinline__ void stage_rc(int b, int& R, int& C) { const int st = b / 1024, sb = b % 1024, swz = sb ^ (((sb >> 9) & 1) << 5); R = (st >> 1) * 16 + swz / 64; C = (st & 1) * 32 + (swz % 64) / 2; }
struct Unit { int pm, pn; };
__device__ __forceinline__ bool static_next(int i, int G, int c, int nM, int nN, Unit& u) {
    const int nwg = nM * nN; const long L = (long)i * G + c; if (L >= nwg) return false;
    int wgid = (int)L; { const int q = nwg / 8, r = nwg % 8, xcd = wgid % 8, off = wgid / 8; wgid = (xcd < r ? xcd * (q + 1) : r * (q + 1) + (xcd - r) * q) + off; }
    const int nig = 8 * nN, gid = wgid / nig, fm = gid * 8, gsz = (nM - fm) < 8 ? (nM - fm) : 8;
    u.pm = fm + ((wgid % nig) % gsz); u.pn = (wgid % nig) / gsz; return true;
}
template <class Sched, class Epi>
__device__ __forceinline__ void gemm_phase(lds_t* lds, const char* Abase, int K, unsigned ldb_bytes, const Sched& S, const Epi& E) {
    const int tid = threadIdx.x, wid = __builtin_amdgcn_readfirstlane(tid >> 6), lane = tid & 63, wr = wid >> 2, wc = wid & 3, fr = lane & 15, fq = lane >> 4;
    const int nt = K / 64;
    int Rs[2], Cs[2]; unsigned voffB[2];
#pragma unroll
    for (int i = 0; i < 2; ++i) { stage_rc(tid * 16 + i * 8192, Rs[i], Cs[i]); voffB[i] = (unsigned)Rs[i] * ldb_bytes + (unsigned)Cs[i] * 2u; }
    const size_t hstepB = (size_t)128 * ldb_bytes;
    const unsigned ldsw = (unsigned)wid * 1024u;
    const int aoff = lds_byte(wr * 64 + fr, fq * 8), boff = lds_byte(wc * 32 + fr, fq * 8);
#define G2_SA(b, h) (((b) * 2 + (h)) * g2::HTB)
#define G2_SB(b, h) ((4 + (b) * 2 + (h)) * g2::HTB)
#define G2_STAGE_A(bufoff, offs, kb) do { _Pragma("unroll") for (int _i = 0; _i < 2; ++_i) \
        __builtin_amdgcn_global_load_lds((const unsigned*)((Abase + (kb)) + (offs)[_i]), (LAS unsigned*)(lds + (bufoff) + ldsw + _i * 8192), 16, 0, 0); } while (0)
#define G2_STAGE_B(bufoff, gbase) do { _Pragma("unroll") for (int _i = 0; _i < 2; ++_i) \
        __builtin_amdgcn_global_load_lds((const unsigned*)((const char*)(gbase) + voffB[_i]), (LAS unsigned*)(lds + (bufoff) + ldsw + _i * 8192), 16, 0, 0); } while (0)
#define G2_LDA(dst, b, h) do { _Pragma("unroll") for (int m = 0; m < 4; ++m) _Pragma("unroll") for (int k = 0; k < 2; ++k) dst[m][k] = *(const LAS bf16x8*)(lds + G2_SA(b, h) + aoff + m * 2048 + k * 1024); } while (0)
#define G2_LDB(dst, b, h) do { _Pragma("unroll") for (int n = 0; n < 2; ++n) _Pragma("unroll") for (int k = 0; k < 2; ++k) dst[n][k] = *(const LAS bf16x8*)(lds + G2_SB(b, h) + boff + n * 2048 + k * 1024); } while (0)
#define G2_MMA(ai, bj, At, Bt) do { __builtin_amdgcn_s_setprio(1); _Pragma("unroll") for (int m = 0; m < 4; ++m) _Pragma("unroll") for (int n = 0; n < 2; ++n) _Pragma("unroll") for (int k = 0; k < 2; ++k) \
        acc[ai][bj][m][n] = __builtin_amdgcn_mfma_f32_16x16x32_bf16(Bt[n][k], At[m][k], acc[ai][bj][m][n], 0, 0, 0); __builtin_amdgcn_s_setprio(0); } while (0)
#define G2_WAIT_V(n) asm volatile("s_waitcnt vmcnt(" #n ")" ::: "memory")
#define G2_WAIT_L(n) asm volatile("s_waitcnt lgkmcnt(" #n ")" ::: "memory")
#define G2_BAR __builtin_amdgcn_s_barrier()
#define G2_SCHED __builtin_amdgcn_sched_barrier(0)
    Unit cur, nxt; int ui = 0;
    if (!S.next(0, cur)) return;
    f32x4 acc[2][2][4][2];
#pragma unroll
    for (int a = 0; a < 2; ++a)
#pragma unroll
        for (int b = 0; b < 2; ++b)
#pragma unroll
            for (int m = 0; m < 4; ++m)
#pragma unroll
                for (int n = 0; n < 2; ++n) acc[a][b][m][n] = (f32x4){0.f, 0.f, 0.f, 0.f};
    bf16x8 At[4][2], B0[2][2], B1[2][2];
    unsigned aoC[2][2], aoN[2][2];
    S.a_off(cur, Rs, Cs, aoC);
    const char* cB = S.b_base(cur);
    G2_STAGE_B(G2_SB(0, 0), cB); G2_STAGE_B(G2_SB(0, 1), cB + hstepB); G2_STAGE_A(G2_SA(0, 0), aoC[0], 0); G2_STAGE_A(G2_SA(0, 1), aoC[1], 0);
    if (wr == 1) G2_BAR;
    G2_WAIT_V(2); G2_BAR;
    G2_STAGE_B(G2_SB(1, 0), cB + 128); G2_STAGE_A(G2_SA(1, 0), aoC[0], 128); G2_STAGE_B(G2_SB(1, 1), cB + hstepB + 128);
    G2_WAIT_V(6); G2_BAR;
    for (;;) {
        const bool has_next = S.next(ui + 1, nxt);
        const char* nB = cB;
#pragma unroll
        for (int h = 0; h < 2; ++h)
#pragma unroll
            for (int i = 0; i < 2; ++i) aoN[h][i] = aoC[h][i];
        if (has_next) { S.a_off(nxt, Rs, Cs, aoN); nB = S.b_base(nxt); }
        for (int t = 0; t < nt; t += 2) {
            const bool last = (t == nt - 2);
            const unsigned k1 = (unsigned)(t + 1) * 128u, k2 = last ? 0u : (unsigned)(t + 2) * 128u, k3 = k2 + 128u;
            unsigned a2o[2][2];
#pragma unroll
            for (int h = 0; h < 2; ++h)
#pragma unroll
                for (int i = 0; i < 2; ++i) a2o[h][i] = last ? aoN[h][i] : aoC[h][i];
            const char* b2 = last ? nB : cB + (size_t)(t + 2) * 128; const char* b3 = b2 + 128;
            G2_LDB(B0, 0, 0); G2_LDB(B1, 0, 1); G2_SCHED; G2_LDA(At, 0, 0); G2_STAGE_A(G2_SA(1, 1), aoC[1], k1);
            G2_WAIT_V(8); G2_WAIT_L(0); G2_BAR; G2_MMA(0, 0, At, B0); G2_MMA(0, 1, At, B1); G2_BAR; G2_SCHED;
            G2_LDA(At, 0, 1); G2_STAGE_B(G2_SB(0, 0), b2); G2_STAGE_B(G2_SB(0, 1), b2 + hstepB); G2_STAGE_A(G2_SA(0, 0), a2o[0], k2);
            G2_WAIT_V(8); G2_WAIT_L(0); G2_BAR; G2_MMA(1, 0, At, B0); G2_MMA(1, 1, At, B1); G2_BAR; G2_SCHED;
            G2_LDB(B0, 1, 0); G2_LDB(B1, 1, 1); G2_SCHED; G2_LDA(At, 1, 0); G2_STAGE_A(G2_SA(0, 1), a2o[1], k2);
            G2_WAIT_V(8); G2_WAIT_L(0); G2_BAR; G2_MMA(0, 0, At, B0); G2_MMA(0, 1, At, B1); G2_BAR; G2_SCHED;
            G2_LDA(At, 1, 1); G2_STAGE_B(G2_SB(1, 0), b3); G2_STAGE_B(G2_SB(1, 1), b3 + hstepB); G2_STAGE_A(G2_SA(1, 0), a2o[0], k3);
            G2_WAIT_V(8); G2_WAIT_L(0); G2_BAR; G2_MMA(1, 0, At, B0); G2_MMA(1, 1, At, B1); G2_BAR; G2_SCHED;
        }
        if (wr == 0) G2_BAR;
        E(acc, cur, wr, wc, fr, fq);
        if (!has_next) break;
#pragma unroll
        for (int a = 0; a < 2; ++a)
#pragma unroll
            for (int b = 0; b < 2; ++b)
#pragma unroll
                for (int m = 0; m < 4; ++m)
#pragma unroll
                    for (int n = 0; n < 2; ++n) acc[a][b][m][n] = (f32x4){0.f, 0.f, 0.f, 0.f};
        cur = nxt; cB = nB; ++ui;
#pragma unroll
        for (int h = 0; h < 2; ++h)
#pragma unroll
            for (int i = 0; i < 2; ++i) aoC[h][i] = aoN[h][i];
        if (wr == 1) G2_BAR;
    }
    G2_WAIT_V(0);
    G2_BAR;
#undef G2_SA
#undef G2_SB
#undef G2_STAGE_A
#undef G2_STAGE_B
#undef G2_LDA
#undef G2_LDB
#undef G2_MMA
#undef G2_WAIT_V
#undef G2_WAIT_L
#undef G2_BAR
#undef G2_SCHED
}
struct DenseSched {
    int G, c, nM, nN, K; const char* Bt;
    __device__ __forceinline__ bool next(int i, Unit& u) const { return static_next(i, G, c, nM, nN, u); }
    __device__ __forceinline__ void a_off(const Unit& u, const int (&Rs)[2], const int (&Cs)[2], unsigned (&ao)[2][2]) const {
#pragma unroll
        for (int h = 0; h < 2; ++h)
#pragma unroll
            for (int i = 0; i < 2; ++i) ao[h][i] = ((unsigned)(u.pm * 256 + h * 128 + Rs[i]) * (unsigned)K + (unsigned)Cs[i]) * 2u;
    }
    __device__ __forceinline__ const char* b_base(const Unit& u) const { return Bt + (size_t)u.pn * 256 * K * 2; }
};
}

template <class RM>
__device__ __forceinline__ void transpose_item(const float* __restrict__ W, int N, bf16_t* __restrict__ WT, int ldwt, int k0, int n0, RM rowmap, LAS float* scr, int lane) {
#pragma unroll 16
    for (int i = 0; i < 64; ++i) scr[i * 65 + lane] = W[(size_t)(k0 + i) * N + n0 + lane];
    __builtin_amdgcn_wave_barrier();
    const int c = lane & 7;
#pragma unroll
    for (int j = 0; j < 8; ++j) {
        const int n = (lane >> 3) + 8 * j;
        const LAS float* s = scr + (8 * c) * 65 + n;
        u32x4 o; o.x = pk_bf16(s[0], s[65]); o.y = pk_bf16(s[2 * 65], s[3 * 65]); o.z = pk_bf16(s[4 * 65], s[5 * 65]); o.w = pk_bf16(s[6 * 65], s[7 * 65]);
        *(u32x4*)(WT + (size_t)rowmap(n0 + n) * ldwt + k0 + 8 * c) = o;
    }
    __builtin_amdgcn_wave_barrier();
}
struct RmId { __device__ __forceinline__ int operator()(int n) const { return n; } };
struct RmMoeIn { __device__ __forceinline__ int operator()(int n) const { const int half = n >> 10, j = n & 1023; return (j >> 7) * 256 + half * 128 + (j & 127); } };
struct RmGate { int gate; __device__ __forceinline__ int operator()(int j) const { return (j >> 5) * 64 + gate * 32 + (j & 31); } };

template <class RM>
__device__ __forceinline__ void transpose_matrix(const float* W, int K, int N, bf16_t* WT, int ldwt, RM rm, LAS float* scr, int gw, int NGW, int lane) {
    const int nkb = K / 64, nnb = N / 64;
    for (int it = gw; it < nkb * nnb; it += NGW) transpose_item(W, N, WT, ldwt, (it / nnb) * 64, (it % nnb) * 64, rm, scr, lane);
}

__device__ __forceinline__ void convert_moe_weights(const Params& P, int layer, lds_t* lds) {
    const int lane = threadIdx.x & 63, wave = threadIdx.x >> 6, gw = blockIdx.x * 8 + wave, NGW = gridDim.x * 8;
    LAS float* scr = (LAS float*)(lds + wave * 16640);
    const float* win = P.in[I_M_WIN] + (size_t)layer * 32 * 1024 * 2048;
    bf16_t* dwin = (bf16_t*)(P.ws + WS_MWIN);
    for (int it = gw; it < 32 * 16 * 32; it += NGW) {
        const int e = it >> 9, r = it & 511, kb = r >> 5, nb = r & 31;
        transpose_item(win + (size_t)e * 1024 * 2048, 2048, dwin + (size_t)e * 2048 * 1024, 1024, kb * 64, nb * 64, RmMoeIn(), scr, lane);
    }
    const float* wout = P.in[I_M_WOUT] + (size_t)layer * 32 * 1024 * 1024;
    bf16_t* dwout = (bf16_t*)(P.ws + WS_MWOUT);
    for (int it = gw; it < 32 * 16 * 16; it += NGW) {
        const int e = it >> 8, r = it & 255, kb = r >> 4, nb = r & 15;
        transpose_item(wout + (size_t)e * 1024 * 1024, 1024, dwout + (size_t)e * 1024 * 1024, 1024, kb * 64, nb * 64, RmId(), scr, lane);
    }
}

__device__ __forceinline__ void s5_precompute(const Params& P, int g, lds_t* lds) {
    const int tid = threadIdx.x;
    LAS float* Bbr = (LAS float*)lds;
    LAS float* Bbi = Bbr + 1024;
    LAS float* Cr = Bbi + 1024;
    LAS float* Ci = Cr + 1024;
    LAS float* ApR = Ci + 1024;
    LAS float* ApI = ApR + 33 * 64;
    LAS float* KJ = ApI + 33 * 64;
    const float* lre = P.in[I_S5_LRE] + g * 64; const float* lim = P.in[I_S5_LIM] + g * 64;
    const float step = expf(P.in[I_S5_STEP][g]);
    for (int idx = tid; idx < 1024; idx += NTHREADS) {
        const int p = idx >> 4;
        const float lr = fminf(lre[p], -1e-4f), li = lim[p];
        const float mag = expf(lr * step); float sn, cs; sincosf(li * step, &sn, &cs);
        const float ar = mag * cs, ai = mag * sn, inv = 1.0f / (lr * lr + li * li);
        const float zr = ((ar - 1.0f) * lr + ai * li) * inv, zi = (ai * lr - (ar - 1.0f) * li) * inv;
        const float br = P.in[I_S5_BRE][g * 1024 + idx], bi = P.in[I_S5_BIM][g * 1024 + idx];
        Bbr[idx] = zr * br - zi * bi; Bbi[idx] = zr * bi + zi * br;
        Cr[idx] = P.in[I_S5_CRE][g * 1024 + idx]; Ci[idx] = P.in[I_S5_CIM][g * 1024 + idx];
    }
    for (int idx = tid; idx < 33 * 64; idx += NTHREADS) {
        const int j = idx >> 6, p = idx & 63;
        const float lr = fminf(lre[p], -1e-4f), li = lim[p];
        const float mag = expf((float)j * lr * step); float sn, cs; sincosf((float)j * li * step, &sn, &cs);
        ApR[idx] = mag * cs; ApI[idx] = mag * sn;
    }
    __syncthreads();
    for (int idx = tid; idx < 8192; idx += NTHREADS) {
        const int j = idx >> 8, h = (idx >> 4) & 15, h2 = idx & 15;
        float s = 0.f;
        for (int p = 0; p < 64; ++p) {
            const float cr = Cr[h * 64 + p], ci = Ci[h * 64 + p], ar = ApR[j * 64 + p], ai = ApI[j * 64 + p];
            const float er = cr * ar - ci * ai, ei = cr * ai + ci * ar;
            s += er * Bbr[p * 16 + h2] - ei * Bbi[p * 16 + h2];
        }
        if (j == 0 && h == h2) s += P.in[I_S5_D][g * 16 + h];
        KJ[idx] = s;
    }
    __syncthreads();
    bf16_t* Tm = (bf16_t*)(P.ws + WS_S5TM) + (size_t)g * 512 * S5K;
    for (int pi = tid; pi < 512 * (S5K / 8); pi += NTHREADS) {
        const int row = pi / (S5K / 8), c8 = (pi % (S5K / 8)) * 8, t = row >> 4, h = row & 15;
        float v[8];
#pragma unroll
        for (int e = 0; e < 8; ++e) {
            const int col = c8 + e;
            if (col < 512) { const int s = col >> 4, h2 = col & 15; v[e] = (s <= t) ? KJ[((t - s) * 16 + h) * 16 + h2] : 0.f; }
            else { const int p = (col - 512) & 63, im = (col - 512) >> 6;
                const float cr = Cr[h * 64 + p], ci = Ci[h * 64 + p], ar = ApR[(t + 1) * 64 + p], ai = ApI[(t + 1) * 64 + p];
                v[e] = im ? -(cr * ai + ci * ar) : (cr * ar - ci * ai); }
        }
        *(u32x4*)(Tm + (size_t)row * S5K + c8) = pack8(v);
    }
    bf16_t* Wst = (bf16_t*)(P.ws + WS_S5WST) + (size_t)g * 128 * 512;
    for (int pi = tid; pi < 128 * 64; pi += NTHREADS) {
        const int row = pi >> 6, c8 = (pi & 63) * 8, p = row & 63, im = row >> 6;
        float v[8];
#pragma unroll
        for (int e = 0; e < 8; ++e) {
            const int col = c8 + e, s = col >> 4, h2 = col & 15;
            const float ar = ApR[(S5TC - 1 - s) * 64 + p], ai = ApI[(S5TC - 1 - s) * 64 + p], br = Bbr[p * 16 + h2], bi = Bbi[p * 16 + h2];
            v[e] = im ? (ar * bi + ai * br) : (ar * br - ai * bi);
        }
        *(u32x4*)(Wst + (size_t)row * 512 + c8) = pack8(v);
    }
    __syncthreads();
}

__device__ __forceinline__ void phase0(const Params& P, lds_t* lds) {
    const int tid = threadIdx.x, lane = tid & 63, wave = tid >> 6, gw = blockIdx.x * 8 + wave, NGW = gridDim.x * 8;
    const size_t gtid = (size_t)blockIdx.x * NTHREADS + tid, GT = (size_t)gridDim.x * NTHREADS;
    unsigned char* ws = P.ws;
    if (blockIdx.x == 0 && tid < 128) ((int*)(ws + WS_CTL))[tid] = 0;
    for (int g = blockIdx.x; g < 32; g += gridDim.x) s5_precompute(P, g, lds);
    {
        const f32x4* x4 = (const f32x4*)P.in[I_X]; u32x4* xb = (u32x4*)(ws + WS_XB);
        for (size_t i = gtid; i < (size_t)T * D / 8; i += GT) { const f32x4 a = x4[2 * i], b = x4[2 * i + 1]; u32x4 o; o.x = pk_bf16(a.x, a.y); o.y = pk_bf16(a.z, a.w); o.z = pk_bf16(b.x, b.y); o.w = pk_bf16(b.z, b.w); xb[i] = o; }
    }
    {
        float* Wc = (float*)(ws + WS_WC);
        for (size_t idx = gtid; idx < 8192; idx += GT) {
            const int which = (int)(idx >> 12), i = (int)((idx >> 3) & 511), gg = (int)(idx & 7), h = i >> 7, ii = i & 127;
            const float* wif = P.in[I_CD_WIF];
            float s = 0.f;
            if (which == 0) {
                const float* wq = P.in[I_CD_WQ] + (size_t)(h * 128 + ii) * 128; const float* wk = P.in[I_CD_WK] + (size_t)(h * 128 + ii) * 128;
                float s2 = 0.f;
                for (int j = 0; j < 128; ++j) { s += wq[j] * wif[(h * 128 + j) * 8 + gg]; s2 += wk[j] * wif[(512 + h * 128 + j) * 8 + gg]; }
                s += s2 * 0.08838834764831845f;
            } else {
                const float* wv = P.in[I_CD_WV] + (size_t)(h * 128 + ii) * 128;
                for (int j = 0; j < 128; ++j) s += wv[j] * wif[(1024 + h * 128 + j) * 8 + gg];
            }
            Wc[idx] = s;
        }
    }
    LAS float* scr = (LAS float*)(lds + wave * 16640);
    transpose_matrix(P.in[I_AB_WIN], 1024, 1536, (bf16_t*)(ws + WS_WABIN), 1024, RmId(), scr, gw, NGW, lane);
    transpose_matrix(P.in[I_AB_GLUW], 512, 512, (bf16_t*)(ws + WS_WGLU), 512, RmId(), scr, gw, NGW, lane);
    transpose_matrix(P.in[I_AB_WOUT], 1024, 1024, (bf16_t*)(ws + WS_WABOUT), 1024, RmId(), scr, gw, NGW, lane);
    transpose_matrix(P.in[I_CD_WIN], 1024, 2560, (bf16_t*)(ws + WS_WCDIN), 1024, RmId(), scr, gw, NGW, lane);
    transpose_matrix(P.in[I_CD_WOUT], 1024, 1024, (bf16_t*)(ws + WS_WCDOUT), 1024, RmId(), scr, gw, NGW, lane);
    for (int it = gw; it < 16; it += NGW) {
        const int gate = it >> 3, h = it & 7;
        transpose_item(P.in[gate ? I_AB_GIW : I_AB_GRW] + h * 4096, 64, (bf16_t*)(ws + WS_WG) + h * 8192, 64, 0, 0, RmGate{gate}, scr, lane);
    }
    for (int it = gw; it < 48; it += NGW) {
        const int which = it >> 4, h = (it >> 2) & 3, kb = (it >> 1) & 1, nb = it & 1;
        transpose_item(P.in[I_CD_WQ + which] + h * 16384, 128, (bf16_t*)(ws + WS_WQKV) + (which * 4 + h) * 16384, 128, kb * 64, nb * 64, RmId(), scr, lane);
    }
    convert_moe_weights(P, 0, lds);
}

__device__ __forceinline__ void store_bf16x4(bf16_t* p, f32x4 v) { u32x2 o; o.x = pk_bf16(v[0], v[1]); o.y = pk_bf16(v[2], v[3]); *(u32x2*)p = o; }

__device__ __forceinline__ void ph_inproj(const Params& P, lds_t* lds, const bf16_t* Wt, int N, const int* pos) {
    const bf16_t* xb = (const bf16_t*)(P.ws + WS_XB); bf16_t* proj = (bf16_t*)(P.ws + WS_PROJ);
    const int nct = N / 128;
    for (int tile = blockIdx.x; tile < 128 * nct; tile += gridDim.x) {
        const int rt = tile / nct, ct = tile % nct;
        e1_tile<true>(lds, 16,
            [=](int, int r, int kp) { return *(const u32x4*)(xb + (size_t)(rt * 256 + r) * 1024 + kp * 8); },
            [=](int, int n, int kp) { return *(const u32x4*)(Wt + (size_t)(ct * 128 + n) * 1024 + kp * 8); },
            [=](f32x4 (&acc)[4][4], int wr, int wc, int fr, int fq) {
                if (pos != nullptr && ct >= 8 && ct < 16 && wc == 0) {
                    float invf[4];
#pragma unroll
                    for (int c = 0; c < 4; ++c) invf[c] = exp2f(-(float)(fq * 4 + c) * (18.931568569324174f / 16.0f));
#pragma unroll
                    for (int m = 0; m < 4; ++m) {
                        const float pf = (float)pos[rt * 256 + wr * 64 + m * 16 + fr];
#pragma unroll
                        for (int c = 0; c < 4; ++c) {
                            float sn, cs; fsincos(pf * invf[c], sn, cs);
                            const float a = acc[m][0][c], b = acc[m][1][c];
                            acc[m][0][c] = a * cs - b * sn; acc[m][1][c] = b * cs + a * sn;
                        }
                    }
                }
                const float sc = (pos != nullptr && ct >= 8 && ct < 12) ? 0.08838834764831845f : 1.0f;
#pragma unroll
                for (int m = 0; m < 4; ++m)
#pragma unroll
                    for (int n = 0; n < 4; ++n)
                        store_bf16x4(proj + (size_t)(rt * 256 + wr * 64 + m * 16 + fr) * N + ct * 128 + wc * 64 + n * 16 + fq * 4, acc[m][n] * sc);
            });
    }
}

__device__ __forceinline__ void ph_conv0(const Params& P) {
    const bf16_t* proj = (const bf16_t*)(P.ws + WS_PROJ); bf16_t* xc = (bf16_t*)(P.ws + WS_XC);
    const int c8 = (threadIdx.x & 63) * 8;
    float w[4][8], bias[8];
#pragma unroll
    for (int e = 0; e < 8; ++e) { bias[e] = P.in[I_AB_CONVB][c8 + e];
#pragma unroll
        for (int k = 0; k < 4; ++k) w[k][e] = P.in[I_AB_CONVW][k * 512 + c8 + e]; }
    const size_t gtid = (size_t)blockIdx.x * NTHREADS + threadIdx.x, GT = (size_t)gridDim.x * NTHREADS;
    for (size_t i = gtid; i < (size_t)T * 64; i += GT) {
        const int tok = (int)(i >> 6), p = tok & (SEQ - 1);
        float a[8];
#pragma unroll
        for (int e = 0; e < 8; ++e) a[e] = bias[e];
#pragma unroll
        for (int k = 0; k < 4; ++k) {
            if (p - 3 + k >= 0) {
                float xv[8]; unpack8(*(const u32x4*)(proj + (size_t)(tok - 3 + k) * 1536 + c8), xv);
#pragma unroll
                for (int e = 0; e < 8; ++e) a[e] += w[k][e] * xv[e];
            }
        }
        *(u32x4*)(xc + (size_t)tok * 512 + c8) = pack8(a);
    }
}

__device__ __forceinline__ void ph_gates0(const Params& P, lds_t* lds) {
    const bf16_t* xc = (const bf16_t*)(P.ws + WS_XC); const bf16_t* Wg = (const bf16_t*)(P.ws + WS_WG);
    float* af = (float*)(P.ws + WS_AF); float* uf = (float*)(P.ws + WS_UF);
    const float* br = P.in[I_AB_GRB]; const float* bi = P.in[I_AB_GIB]; const float* lam = P.in[I_AB_LAMBDA];
    for (int tile = blockIdx.x; tile < 1024; tile += gridDim.x) {
        const int h = tile & 7, rt = tile >> 3;
        e1_tile<true>(lds, 1,
            [=](int, int r, int kp) { return *(const u32x4*)(xc + (size_t)(rt * 256 + r) * 512 + h * 64 + kp * 8); },
            [=](int, int n, int kp) { return *(const u32x4*)(Wg + (size_t)h * 8192 + n * 64 + kp * 8); },
            [=](f32x4 (&acc)[4][4], int wr, int wc, int fr, int fq) {
#pragma unroll
                for (int n = 0; n < 2; ++n) {
                    const int ch = h * 64 + wc * 32 + n * 16 + fq * 4;
                    float sp[4], brv[4], biv[4];
#pragma unroll
                    for (int c = 0; c < 4; ++c) { const float l = -lam[ch + c]; sp[c] = fmaxf(l, 0.f) + flog(1.0f + fexp(-fabsf(l))); brv[c] = br[ch + c]; biv[c] = bi[ch + c]; }
#pragma unroll
                    for (int m = 0; m < 4; ++m) {
                        const size_t row = (size_t)(rt * 256 + wr * 64 + m * 16 + fr);
                        const u32x2 xr = *(const u32x2*)(xc + row * 512 + ch);
                        const float xv[4] = {__uint_as_float(xr.x << 16), __uint_as_float(xr.x & 0xffff0000u), __uint_as_float(xr.y << 16), __uint_as_float(xr.y & 0xffff0000u)};
                        f32x4 a4, u4;
#pragma unroll
                        for (int c = 0; c < 4; ++c) {
                            const float r = fsigmoid(acc[m][n][c] + brv[c]), ig = fsigmoid(acc[m][n + 2][c] + biv[c]);
                            const float la = -8.0f * r * sp[c], x2 = 2.0f * la;
                            const float om = (x2 > -0.01f) ? -x2 * (1.0f + 0.5f * x2 * (1.0f + x2 * (1.0f / 3.0f))) : 1.0f - fexp(x2);
                            a4[c] = fexp(la); u4[c] = sqrtf(om) * ig * xv[c];
                        }
                        *(f32x4*)(af + row * 512 + ch) = a4; *(f32x4*)(uf + row * 512 + ch) = u4;
                    }
                }
            });
    }
}

__device__ __forceinline__ void ph_lru_scan(const Params& P, lds_t* lds) {
    const float* af = (const float*)(P.ws + WS_AF); const float* uf = (const float*)(P.ws + WS_UF);
    const bf16_t* proj = (const bf16_t*)(P.ws + WS_PROJ); bf16_t* cat = (bf16_t*)(P.ws + WS_CAT);
    LAS float* lA = (LAS float*)lds; LAS float* lH = lA + 512;
    const int tid = threadIdx.x, seg = tid >> 4, c = tid & 15;
    for (int item = blockIdx.x; item < 256; item += gridDim.x) {
        const int b = item >> 5, ch = (item & 31) * 16 + c;
        const size_t base = (size_t)b * SEQ + seg * 128;
        float A = 1.f, H = 0.f;
#pragma unroll 8
        for (int i = 0; i < 128; ++i) { const float a = af[(base + i) * 512 + ch], u = uf[(base + i) * 512 + ch]; H = a * H + u; A *= a; }
        lA[tid] = A; lH[tid] = H;
        __syncthreads();
        float carry = 0.f;
        for (int s = 0; s < seg; ++s) carry = lA[s * 16 + c] * carry + lH[s * 16 + c];
        H = carry;
#pragma unroll 8
        for (int i = 0; i < 128; ++i) {
            const float a = af[(base + i) * 512 + ch], u = uf[(base + i) * 512 + ch]; H = a * H + u;
            const float ga = bf2f(proj[(base + i) * 1536 + 512 + ch]);
            cat[(base + i) * 1024 + ch] = (bf16_t)(pk_bf16(H * gelu_tanh(ga), 0.f) & 0xffffu);
        }
        __syncthreads();
    }
}

__device__ __forceinline__ void ph_s5_state(const Params& P, lds_t* lds) {
    const bf16_t* proj = (const bf16_t*)(P.ws + WS_PROJ); const bf16_t* Wst = (const bf16_t*)(P.ws + WS_S5WST); float* S = (float*)(P.ws + WS_S5S);
    for (int tile = blockIdx.x; tile < 128; tile += gridDim.x) {
        const int g = tile & 31, rt = tile >> 5;
        e1_tile<true>(lds, 8,
            [=](int, int r, int kp) { return *(const u32x4*)(proj + (size_t)((rt * 256 + r) * 32 + (kp >> 1)) * 1536 + 1024 + g * 16 + (kp & 1) * 8); },
            [=](int, int n, int kp) { return *(const u32x4*)(Wst + (size_t)g * 65536 + n * 512 + kp * 8); },
            [=](f32x4 (&acc)[4][4], int wr, int wc, int fr, int fq) {
#pragma unroll
                for (int m = 0; m < 4; ++m)
#pragma unroll
                    for (int n = 0; n < 4; ++n) *(f32x4*)(S + ((size_t)(rt * 256 + wr * 64 + m * 16 + fr) * 32 + g) * 128 + wc * 64 + n * 16 + fq * 4) = acc[m][n];
            });
    }
}

__device__ __forceinline__ void ph_s5_carry(const Params& P) {
    const float* S = (const float*)(P.ws + WS_S5S); bf16_t* X = (bf16_t*)(P.ws + WS_S5X);
    if (threadIdx.x >= 64) return;
    const int p = threadIdx.x;
    for (int it = blockIdx.x; it < 256; it += gridDim.x) {
        const int b = it >> 5, g = it & 31;
        const float lr = fminf(P.in[I_S5_LRE][g * 64 + p], -1e-4f), li = P.in[I_S5_LIM][g * 64 + p], step = expf(P.in[I_S5_STEP][g]);
        const float mag = expf((float)S5TC * lr * step); float sn, cs; sincosf((float)S5TC * li * step, &sn, &cs);
        const float cr = mag * cs, ci = mag * sn;
        float xr = 0.f, xi = 0.f;
#pragma unroll 8
        for (int c = 0; c < 128; ++c) {
            const size_t o = ((size_t)(b * 128 + c) * 32 + g) * 128;
            X[o + p] = (bf16_t)(pk_bf16(xr, 0.f) & 0xffffu); X[o + 64 + p] = (bf16_t)(pk_bf16(xi, 0.f) & 0xffffu);
            const float sr = S[o + p], si = S[o + 64 + p];
            const float nr = cr * xr - ci * xi + sr, ni = cr * xi + ci * xr + si;
            xr = nr; xi = ni;
        }
    }
}

__device__ __forceinline__ void ph_s5_out(const Params& P, lds_t* lds) {
    const bf16_t* proj = (const bf16_t*)(P.ws + WS_PROJ); const bf16_t* Tm = (const bf16_t*)(P.ws + WS_S5TM); const bf16_t* X = (const bf16_t*)(P.ws + WS_S5X);
    bf16_t* sb = (bf16_t*)(P.ws + WS_SB);
    for (int tile = blockIdx.x; tile < 512; tile += gridDim.x) {
        const int ct = tile & 3, g = (tile >> 2) & 31, rt = tile >> 7;
        e1_tile<true>(lds, S5K / 64,
            [=](int, int r, int kp) {
                if (kp < 64) return *(const u32x4*)(proj + (size_t)((rt * 256 + r) * 32 + (kp >> 1)) * 1536 + 1024 + g * 16 + (kp & 1) * 8);
                return *(const u32x4*)(X + ((size_t)(rt * 256 + r) * 32 + g) * 128 + (kp - 64) * 8); },
            [=](int, int n, int kp) { return *(const u32x4*)(Tm + (size_t)g * 512 * S5K + (size_t)(ct * 128 + n) * S5K + kp * 8); },
            [=](f32x4 (&acc)[4][4], int wr, int wc, int fr, int fq) {
#pragma unroll
                for (int m = 0; m < 4; ++m)
#pragma unroll
                    for (int n = 0; n < 4; ++n) {
                        const int col = ct * 128 + wc * 64 + n * 16 + fq * 4, t = col >> 4, h0 = col & 15;
                        const size_t tok = (size_t)(rt * 256 + wr * 64 + m * 16 + fr) * 32 + t;
                        f32x4 y = acc[m][n];
#pragma unroll
                        for (int c = 0; c < 4; ++c) y[c] = gelu_tanh(y[c]);
                        store_bf16x4(sb + tok * 512 + g * 16 + h0, y);
                    }
            });
    }
}

__device__ __forceinline__ void ph_glu(const Params& P, lds_t* lds) {
    const bf16_t* sb = (const bf16_t*)(P.ws + WS_SB); const bf16_t* Wt = (const bf16_t*)(P.ws + WS_WGLU); bf16_t* cat = (bf16_t*)(P.ws + WS_CAT);
    const float* gb = P.in[I_AB_GLUB];
    for (int tile = blockIdx.x; tile < 512; tile += gridDim.x) {
        const int rt = tile >> 2, ct = tile & 3;
        e1_tile<true>(lds, 8,
            [=](int, int r, int kp) { return *(const u32x4*)(sb + (size_t)(rt * 256 + r) * 512 + kp * 8); },
            [=](int, int n, int kp) { return *(const u32x4*)(Wt + (size_t)(ct * 128 + n) * 512 + kp * 8); },
            [=](f32x4 (&acc)[4][4], int wr, int wc, int fr, int fq) {
#pragma unroll
                for (int n = 0; n < 4; ++n) {
                    const int col = ct * 128 + wc * 64 + n * 16 + fq * 4;
                    const f32x4 bv = *(const f32x4*)(gb + col);
#pragma unroll
                    for (int m = 0; m < 4; ++m) {
                        const size_t row = (size_t)(rt * 256 + wr * 64 + m * 16 + fr);
                        const u32x2 sr = *(const u32x2*)(sb + row * 512 + col);
                        const float sv[4] = {__uint_as_float(sr.x << 16), __uint_as_float(sr.x & 0xffff0000u), __uint_as_float(sr.y << 16), __uint_as_float(sr.y & 0xffff0000u)};
                        f32x4 y;
#pragma unroll
                        for (int c = 0; c < 4; ++c) y[c] = sv[c] * fsigmoid(acc[m][n][c] + bv[c]);
                        store_bf16x4(cat + row * 1024 + 512 + col, y);
                    }
                }
            });
    }
}

__device__ __forceinline__ void ph_outproj(const Params& P, lds_t* lds, const bf16_t* Wt, const float* xres) {
    const bf16_t* cat = (const bf16_t*)(P.ws + WS_CAT); float* zf = (float*)(P.ws + WS_ZF);
    for (int tile = blockIdx.x; tile < 1024; tile += gridDim.x) {
        const int rt = tile >> 3, ct = tile & 7;
        e1_tile<true>(lds, 16,
            [=](int, int r, int kp) { return *(const u32x4*)(cat + (size_t)(rt * 256 + r) * 1024 + kp * 8); },
            [=](int, int n, int kp) { return *(const u32x4*)(Wt + (size_t)(ct * 128 + n) * 1024 + kp * 8); },
            [=](f32x4 (&acc)[4][4], int wr, int wc, int fr, int fq) {
#pragma unroll
                for (int m = 0; m < 4; ++m)
#pragma unroll
                    for (int n = 0; n < 4; ++n) {
                        const size_t o = (size_t)(rt * 256 + wr * 64 + m * 16 + fr) * 1024 + ct * 128 + wc * 64 + n * 16 + fq * 4;
                        *(f32x4*)(zf + o) = *(const f32x4*)(xres + o) * ALPHA + acc[m][n];
                    }
            });
    }
}

__device__ __forceinline__ void ph_ln_router(const Params& P, lds_t* lds, int layer) {
    const float* zf = (const float*)(P.ws + WS_ZF); float* x1f = (float*)(P.ws + WS_X1F); bf16_t* xb = (bf16_t*)(P.ws + WS_XB);
    const float* lg = P.in[I_LNM_G] + layer * 1024; const float* lb = P.in[I_LNM_B] + layer * 1024;
    const float* rw = P.in[I_R_W] + (size_t)layer * 1024 * 32; const float* rbias = P.in[I_R_B] + layer * 32;
    int* gcount = (int*)(P.ws + WS_CTL) + 64 * layer;
    int* pair_e = (int*)(P.ws + WS_ROUTE); int* pair_rank = pair_e + T * 4; float* pair_gate = (float*)(pair_rank + T * 4);
    LAS float* Wr = (LAS float*)lds;
    LAS int* hist = (LAS int*)(lds + 135168); LAS int* basev = hist + 32;
    LAS int* pinfo = basev + 32;
    const int tid = threadIdx.x, lane = tid & 63, wave = tid >> 6;
    for (int i = tid; i < 32768; i += NTHREADS) Wr[(i >> 5) * 33 + (i & 31)] = rw[i];
    float g[16], bb[16];
#pragma unroll
    for (int i = 0; i < 16; ++i) { g[i] = lg[lane + 64 * i]; bb[i] = lb[lane + 64 * i]; }
    const float myrb = rbias[lane & 31];
    __syncthreads();
    for (int it = blockIdx.x; it < 512; it += gridDim.x) {
        if (tid < 32) hist[tid] = 0;
        __syncthreads();
        for (int rr = 0; rr < 8; ++rr) {
            const int rl = wave * 8 + rr; const size_t row = (size_t)it * 64 + rl;
            float y[16]; float s = 0.f;
#pragma unroll
            for (int i = 0; i < 16; ++i) { y[i] = zf[row * 1024 + lane + 64 * i]; s += y[i]; }
            const float mean = wave_sum(s) * (1.0f / 1024.0f); float s2 = 0.f;
#pragma unroll
            for (int i = 0; i < 16; ++i) { y[i] -= mean; s2 += y[i] * y[i]; }
            const float rstd = rsqrtf(wave_sum(s2) * (1.0f / 1024.0f) + LN_EPS);
#pragma unroll
            for (int i = 0; i < 16; ++i) { y[i] = y[i] * rstd * g[i] + bb[i]; x1f[row * 1024 + lane + 64 * i] = y[i]; xb[row * 1024 + lane + 64 * i] = (bf16_t)(pk_bf16(y[i], 0.f) & 0xffffu); }
            float v[32];
#pragma unroll
            for (int e = 0; e < 32; ++e) v[e] = 0.f;
#pragma unroll
            for (int i = 0; i < 16; ++i) {
                const LAS float* wrow = Wr + (lane + 64 * i) * 33;
#pragma unroll
                for (int e = 0; e < 32; ++e) v[e] += y[i] * wrow[e];
            }
#pragma unroll
            for (int e = 0; e < 32; ++e) v[e] += __shfl_xor(v[e], 32);
#define TR_STEP(OFF, CNT) _Pragma("unroll") for (int e = 0; e < CNT; ++e) { const bool up = (lane & OFF) != 0; const float send = up ? v[e] : v[e + CNT]; const float keep = up ? v[e + CNT] : v[e]; v[e] = keep + __shfl_xor(send, OFF); }
            TR_STEP(16, 16) TR_STEP(8, 8) TR_STEP(4, 4) TR_STEP(2, 2) TR_STEP(1, 1)
#undef TR_STEP
            float val = v[0] + myrb; const int my = lane & 31;
            float topv[4]; int topi[4];
#pragma unroll
            for (int k = 0; k < 4; ++k) {
                float bv = val; int bi = my;
#pragma unroll
                for (int off = 16; off >= 1; off >>= 1) { const float ov = __shfl_xor(bv, off); const int oi = __shfl_xor(bi, off); if (ov > bv || (ov == bv && oi < bi)) { bv = ov; bi = oi; } }
                topv[k] = bv; topi[k] = bi; if (my == bi) val = -INFINITY;
            }
            if (lane == 0) {
                const float e1 = expf(topv[1] - topv[0]), e2 = expf(topv[2] - topv[0]), e3 = expf(topv[3] - topv[0]);
                const float inv = 1.0f / (1.0f + e1 + e2 + e3);
                const float gt[4] = {inv, e1 * inv, e2 * inv, e3 * inv};
#pragma unroll
                for (int k = 0; k < 4; ++k) { const int lr = __hip_atomic_fetch_add(&hist[topi[k]], 1, __ATOMIC_RELAXED, __HIP_MEMORY_SCOPE_WORKGROUP); pinfo[(rl * 4 + k) * 3 + 0] = topi[k]; pinfo[(rl * 4 + k) * 3 + 1] = lr; pinfo[(rl * 4 + k) * 3 + 2] = __float_as_int(gt[k]); }
            }
        }
        __syncthreads();
        if (tid < 32) { const int c = hist[tid]; basev[tid] = c ? atomicAdd(gcount + tid, c) : 0; }
        __syncthreads();
        if (tid < 256) {
            const int e = pinfo[tid * 3 + 0]; const size_t pi = (size_t)it * 256 + tid;
            pair_e[pi] = e; pair_rank[pi] = basev[e] + pinfo[tid * 3 + 1]; pair_gate[pi] = __int_as_float(pinfo[tid * 3 + 2]);
        }
        __syncthreads();
    }
}

__device__ __forceinline__ void moe_pstart(const Params& P, lds_t* lds, int layer) {
    LAS int* ps = (LAS int*)(lds + 140 * 1024);
    const int* gcount = (const int*)(P.ws + WS_CTL) + 64 * layer;
    if (threadIdx.x == 0) { int a = 0; for (int e = 0; e < 32; ++e) { const int c = gcount[e]; ps[e] = a; ps[40 + e] = c; a += ((c + 255) >> 8) << 8; } ps[32] = a; }
    __syncthreads();
}

__device__ __forceinline__ void ph_route_scatter(const Params& P, lds_t* lds, int layer) {
    moe_pstart(P, lds, layer);
    LAS int* ps = (LAS int*)(lds + 140 * 1024);
    const int* pair_e = (const int*)(P.ws + WS_ROUTE); const int* pair_rank = pair_e + T * 4; const float* pair_gate = (const float*)(pair_rank + T * 4);
    int* dest = (int*)(pair_gate + T * 4); int* row_tok = dest + T * 4; float* row_gate = (float*)(row_tok + MOE_ROWS);
    const size_t gtid = (size_t)blockIdx.x * NTHREADS + threadIdx.x, GT = (size_t)gridDim.x * NTHREADS;
    for (size_t i = gtid; i < (size_t)T * 4; i += GT) {
        const int e = pair_e[i], pos = ps[e] + pair_rank[i];
        row_tok[pos] = (int)(i >> 2); row_gate[pos] = pair_gate[i]; dest[i] = pos;
    }
    for (size_t i = gtid; i < 32 * 256; i += GT) {
        const int e = (int)(i >> 8), pos = ps[e] + ps[40 + e] + (int)(i & 255);
        if (pos < ps[e + 1]) { row_tok[pos] = 0; row_gate[pos] = 0.f; }
    }
}

__device__ __forceinline__ void ph_moe_up(const Params& P, lds_t* lds, int layer) {
    moe_pstart(P, lds, layer);
    LAS int* ps = (LAS int*)(lds + 140 * 1024);
    const bf16_t* xb = (const bf16_t*)(P.ws + WS_XB); const bf16_t* W = (const bf16_t*)(P.ws + WS_MWIN); bf16_t* hact = (bf16_t*)(P.ws + WS_HACT);
    const int* row_tok = (const int*)(P.ws + WS_ROUTE) + 4 * T * 4;
    const float* b_in = P.in[I_M_BIN] + (size_t)layer * 32 * 2048;
    const int nunits = (ps[32] >> 8) * 16;
    for (int unit = blockIdx.x; unit < nunits; unit += gridDim.x) {
        const int rb = unit >> 4, ct = unit & 15;
        int e = 0; while (ps[e + 1] <= rb * 256) ++e;
        int tok[4];
#pragma unroll
        for (int i = 0; i < 4; ++i) tok[i] = row_tok[rb * 256 + (threadIdx.x >> 3) + 64 * i];
        const bf16_t* We = W + (size_t)e * 2048 * 1024; const float* be = b_in + e * 2048;
        e1_tile<true>(lds, 16,
            [=](int i, int, int kp) { return *(const u32x4*)(xb + (size_t)tok[i] * 1024 + kp * 8); },
            [=](int, int n, int kp) { return *(const u32x4*)(We + (size_t)(ct * 128 + n) * 1024 + kp * 8); },
            [=](f32x4 (&acc)[4][4], int wr, int wc, int fr, int fq) {
#pragma unroll
                for (int n = 0; n < 2; ++n) {
                    const int j = ct * 64 + wc * 32 + n * 16 + fq * 4;
                    const f32x4 bg = *(const f32x4*)(be + j), bl = *(const f32x4*)(be + 1024 + j);
#pragma unroll
                    for (int m = 0; m < 4; ++m) {
                        f32x4 y;
#pragma unroll
                        for (int c = 0; c < 4; ++c) {
                            const float gv = fminf(acc[m][n][c] + bg[c], 7.0f), lv = fminf(fmaxf(acc[m][n + 2][c] + bl[c], -7.0f), 7.0f);
                            y[c] = gv * fsigmoid(1.702f * gv) * (lv + 1.0f);
                        }
                        store_bf16x4(hact + (size_t)(rb * 256 + wr * 64 + m * 16 + fr) * 1024 + j, y);
                    }
                }
            });
    }
}

__device__ __forceinline__ void ph_moe_down(const Params& P, lds_t* lds, int layer) {
    moe_pstart(P, lds, layer);
    LAS int* ps = (LAS int*)(lds + 140 * 1024);
    const bf16_t* hact = (const bf16_t*)(P.ws + WS_HACT); const bf16_t* W = (const bf16_t*)(P.ws + WS_MWOUT); bf16_t* yb = (bf16_t*)(P.ws + WS_YB);
    const float* row_gate = (const float*)((const int*)(P.ws + WS_ROUTE) + 4 * T * 4 + MOE_ROWS);
    const float* b_out = P.in[I_M_BOUT] + (size_t)layer * 32 * 1024;
    const int nunits = (ps[32] >> 8) * 8;
    for (int unit = blockIdx.x; unit < nunits; unit += gridDim.x) {
        const int rb = unit >> 3, ct = unit & 7;
        int e = 0; while (ps[e + 1] <= rb * 256) ++e;
        const bf16_t* We = W + (size_t)e * 1024 * 1024; const float* be = b_out + e * 1024;
        e1_tile<true>(lds, 16,
            [=](int, int r, int kp) { return *(const u32x4*)(hact + (size_t)(rb * 256 + r) * 1024 + kp * 8); },
            [=](int, int n, int kp) { return *(const u32x4*)(We + (size_t)(ct * 128 + n) * 1024 + kp * 8); },
            [=](f32x4 (&acc)[4][4], int wr, int wc, int fr, int fq) {
#pragma unroll
                for (int m = 0; m < 4; ++m) {
                    const int row = rb * 256 + wr * 64 + m * 16 + fr; const float gt = row_gate[row];
#pragma unroll
                    for (int n = 0; n < 4; ++n) {
                        const int col = ct * 128 + wc * 64 + n * 16 + fq * 4;
                        store_bf16x4(yb + (size_t)row * 1024 + col, (acc[m][n] + *(const f32x4*)(be + col)) * gt);
                    }
                }
            });
    }
}

struct EpiInproj {
    bf16_t* proj; int N; const int* pos;
    __device__ __forceinline__ void operator()(f32x4 (&acc)[2][2][4][2], const g2::Unit& u, int wr, int wc, int fr, int fq) const {
#pragma unroll
        for (int bj = 0; bj < 2; ++bj) {
            const int ct = 2 * u.pn + bj;
            if (pos != nullptr && ct >= 8 && ct < 16 && wc == 0) {
                float invf[4];
#pragma unroll
                for (int c = 0; c < 4; ++c) invf[c] = exp2f(-(float)(fq * 4 + c) * (18.931568569324174f / 16.0f));
#pragma unroll
                for (int ai = 0; ai < 2; ++ai)
#pragma unroll
                    for (int m = 0; m < 4; ++m) {
                        const float pf = (float)pos[u.pm * 256 + ai * 128 + wr * 64 + m * 16 + fr];
#pragma unroll
                        for (int c = 0; c < 4; ++c) {
                            float sn, cs; fsincos(pf * invf[c], sn, cs);
                            const float a = acc[ai][bj][m][0][c], b = acc[ai][bj][m][1][c];
                            acc[ai][bj][m][0][c] = a * cs - b * sn; acc[ai][bj][m][1][c] = b * cs + a * sn;
                        }
                    }
            }
            const float sc = (pos != nullptr && ct >= 8 && ct < 12) ? 0.08838834764831845f : 1.0f;
#pragma unroll
            for (int ai = 0; ai < 2; ++ai)
#pragma unroll
                for (int m = 0; m < 4; ++m)
#pragma unroll
                    for (int n = 0; n < 2; ++n)
                        store_bf16x4(proj + (size_t)(u.pm * 256 + ai * 128 + wr * 64 + m * 16 + fr) * N + ct * 128 + wc * 32 + n * 16 + fq * 4, acc[ai][bj][m][n] * sc);
        }
    }
};
__device__ __forceinline__ void ph_inproj2(const Params& P, lds_t* lds, const bf16_t* Wt, int N, const int* pos) {
    g2::DenseSched S{(int)gridDim.x, (int)blockIdx.x, T / 256, N / 256, 1024, (const char*)Wt};
    EpiInproj E{(bf16_t*)(P.ws + WS_PROJ), N, pos};
    g2::gemm_phase(lds, (const char*)(P.ws + WS_XB), 1024, 2048u, S, E);
}
struct EpiOutproj {
    float* zf; const float* xres;
    __device__ __forceinline__ void operator()(f32x4 (&acc)[2][2][4][2], const g2::Unit& u, int wr, int wc, int fr, int fq) const {
#pragma unroll
        for (int ai = 0; ai < 2; ++ai)
#pragma unroll
            for (int m = 0; m < 4; ++m)
#pragma unroll
                for (int bj = 0; bj < 2; ++bj)
#pragma unroll
                    for (int n = 0; n < 2; ++n) {
                        const size_t o = (size_t)(u.pm * 256 + ai * 128 + wr * 64 + m * 16 + fr) * 1024 + u.pn * 256 + bj * 128 + wc * 32 + n * 16 + fq * 4;
                        *(f32x4*)(zf + o) = *(const f32x4*)(xres + o) * ALPHA + acc[ai][bj][m][n];
                    }
    }
};
__device__ __forceinline__ void ph_outproj2(const Params& P, lds_t* lds, const bf16_t* Wt, const float* xres) {
    g2::DenseSched S{(int)gridDim.x, (int)blockIdx.x, T / 256, 4, 1024, (const char*)Wt};
    EpiOutproj E{(float*)(P.ws + WS_ZF), xres};
    g2::gemm_phase(lds, (const char*)(P.ws + WS_CAT), 1024, 2048u, S, E);
}
struct MoeSched {
    int G, c, nM, nN; const char* W; size_t wstride; const int* row_tok; LAS int* ps;
    __device__ __forceinline__ bool next(int i, g2::Unit& u) const { return g2::static_next(i, G, c, nM, nN, u); }
    __device__ __forceinline__ int expert(int pm) const { int e = 0; while (ps[e + 1] <= pm * 256) ++e; return e; }
    __device__ __forceinline__ void a_off(const g2::Unit& u, const int (&Rs)[2], const int (&Cs)[2], unsigned (&ao)[2][2]) const {
#pragma unroll
        for (int h = 0; h < 2; ++h)
#pragma unroll
            for (int i = 0; i < 2; ++i) {
                const int r = u.pm * 256 + h * 128 + Rs[i];
                const unsigned row = row_tok ? (unsigned)row_tok[r] : (unsigned)r;
                ao[h][i] = (row * 1024u + (unsigned)Cs[i]) * 2u;
            }
    }
    __device__ __forceinline__ const char* b_base(const g2::Unit& u) const { return W + (size_t)expert(u.pm) * wstride + (size_t)u.pn * 256 * 2048; }
};
struct EpiMoeUp {
    bf16_t* hact; const float* b_in; LAS int* ps;
    __device__ __forceinline__ void operator()(f32x4 (&acc)[2][2][4][2], const g2::Unit& u, int wr, int wc, int fr, int fq) const {
        int e = 0; while (ps[e + 1] <= u.pm * 256) ++e;
        const float* be = b_in + e * 2048;
#pragma unroll
        for (int n = 0; n < 2; ++n) {
            const int j = u.pn * 128 + wc * 32 + n * 16 + fq * 4;
            const f32x4 bg = *(const f32x4*)(be + j), bl = *(const f32x4*)(be + 1024 + j);
#pragma unroll
            for (int ai = 0; ai < 2; ++ai)
#pragma unroll
                for (int m = 0; m < 4; ++m) {
                    f32x4 y;
#pragma unroll
                    for (int c = 0; c < 4; ++c) {
                        const float gv = fminf(acc[ai][0][m][n][c] + bg[c], 7.0f), lv = fminf(fmaxf(acc[ai][1][m][n][c] + bl[c], -7.0f), 7.0f);
                        y[c] = gv * fsigmoid(1.702f * gv) * (lv + 1.0f);
                    }
                    store_bf16x4(hact + (size_t)(u.pm * 256 + ai * 128 + wr * 64 + m * 16 + fr) * 1024 + j, y);
                }
        }
    }
};
__device__ __forceinline__ void ph_moe_up2(const Params& P, lds_t* lds, int layer) {
    moe_pstart(P, lds, layer);
    LAS int* ps = (LAS int*)(lds + 140 * 1024);
    const int* row_tok = (const int*)(P.ws + WS_ROUTE) + 4 * T * 4;
    MoeSched S{(int)gridDim.x, (int)blockIdx.x, ps[32] >> 8, 8, (const char*)(P.ws + WS_MWIN), (size_t)2048 * 1024 * 2, row_tok, ps};
    EpiMoeUp E{(bf16_t*)(P.ws + WS_HACT), P.in[I_M_BIN] + (size_t)layer * 32 * 2048, ps};
    g2::gemm_phase(lds, (const char*)(P.ws + WS_XB), 1024, 2048u, S, E);
}
struct EpiMoeDown {
    bf16_t* yb; const float* b_out; const float* row_gate; LAS int* ps;
    __device__ __forceinline__ void operator()(f32x4 (&acc)[2][2][4][2], const g2::Unit& u, int wr, int wc, int fr, int fq) const {
        int e = 0; while (ps[e + 1] <= u.pm * 256) ++e;
        const float* be = b_out + e * 1024;
#pragma unroll
        for (int ai = 0; ai < 2; ++ai)
#pragma unroll
            for (int m = 0; m < 4; ++m) {
                const int row = u.pm * 256 + ai * 128 + wr * 64 + m * 16 + fr; const float gt = row_gate[row];
#pragma unroll
                for (int bj = 0; bj < 2; ++bj)
#pragma unroll
                    for (int n = 0; n < 2; ++n) {
                        const int col = u.pn * 256 + bj * 128 + wc * 32 + n * 16 + fq * 4;
                        store_bf16x4(yb + (size_t)row * 1024 + col, (acc[ai][bj][m][n] + *(const f32x4*)(be + col)) * gt);
                    }
            }
    }
};
__device__ __forceinline__ void ph_moe_down2(const Params& P, lds_t* lds, int layer) {
    moe_pstart(P, lds, layer);
    LAS int* ps = (LAS int*)(lds + 140 * 1024);
    const float* row_gate = (const float*)((const int*)(P.ws + WS_ROUTE) + 4 * T * 4 + MOE_ROWS);
    MoeSched S{(int)gridDim.x, (int)blockIdx.x, ps[32] >> 8, 4, (const char*)(P.ws + WS_MWOUT), (size_t)1024 * 1024 * 2, nullptr, ps};
    EpiMoeDown E{(bf16_t*)(P.ws + WS_YB), P.in[I_M_BOUT] + (size_t)layer * 32 * 1024, row_gate, ps};
    g2::gemm_phase(lds, (const char*)(P.ws + WS_HACT), 1024, 2048u, S, E);
}

__device__ __forceinline__ void ph_combine_ln(const Params& P, int layer, float* outf, bool write_bf) {
    float* x1f = (float*)(P.ws + WS_X1F); const bf16_t* yb = (const bf16_t*)(P.ws + WS_YB); bf16_t* xb = (bf16_t*)(P.ws + WS_XB);
    const int* dest = (const int*)(P.ws + WS_ROUTE) + 3 * T * 4;
    const float* lg = P.in[I_LNF_G] + layer * 1024; const float* lb = P.in[I_LNF_B] + layer * 1024;
    const int lane = threadIdx.x & 63, gw = blockIdx.x * 8 + (threadIdx.x >> 6), NGW = gridDim.x * 8;
    for (int row = gw; row < T; row += NGW) {
        int d[4];
#pragma unroll
        for (int k = 0; k < 4; ++k) d[k] = dest[row * 4 + k];
        f32x4 v[4]; float s = 0.f;
#pragma unroll
        for (int j = 0; j < 4; ++j) {
            v[j] = *(const f32x4*)(x1f + (size_t)row * 1024 + j * 256 + lane * 4) * ALPHA;
#pragma unroll
            for (int k = 0; k < 4; ++k) {
                const u32x2 r = *(const u32x2*)(yb + (size_t)d[k] * 1024 + j * 256 + lane * 4);
                v[j][0] += __uint_as_float(r.x << 16); v[j][1] += __uint_as_float(r.x & 0xffff0000u); v[j][2] += __uint_as_float(r.y << 16); v[j][3] += __uint_as_float(r.y & 0xffff0000u);
            }
            s += (v[j][0] + v[j][1]) + (v[j][2] + v[j][3]);
        }
        const float mean = wave_sum(s) * (1.0f / 1024.0f); float s2 = 0.f;
#pragma unroll
        for (int j = 0; j < 4; ++j) { v[j] = v[j] - mean; s2 += (v[j][0] * v[j][0] + v[j][1] * v[j][1]) + (v[j][2] * v[j][2] + v[j][3] * v[j][3]); }
        const float rstd = rsqrtf(wave_sum(s2) * (1.0f / 1024.0f) + LN_EPS);
#pragma unroll
        for (int j = 0; j < 4; ++j) {
            const f32x4 o = v[j] * rstd * *(const f32x4*)(lg + j * 256 + lane * 4) + *(const f32x4*)(lb + j * 256 + lane * 4);
            *(f32x4*)(outf + (size_t)row * 1024 + j * 256 + lane * 4) = o;
            if (write_bf) store_bf16x4(xb + (size_t)row * 1024 + j * 256 + lane * 4, o);
        }
    }
}

__device__ __forceinline__ void ph_conv1(const Params& P, lds_t* lds) {
    const bf16_t* proj = (const bf16_t*)(P.ws + WS_PROJ); bf16_t* xconv = (bf16_t*)(P.ws + WS_XCONV); float* gates = (float*)(P.ws + WS_GATES);
    LAS float* Wc = (LAS float*)lds;
    const float* Wcg = (const float*)(P.ws + WS_WC);
    for (int i = threadIdx.x; i < 8192; i += NTHREADS) Wc[i] = Wcg[i];
    __syncthreads();
    const int lane = threadIdx.x & 63, gw = blockIdx.x * 8 + (threadIdx.x >> 6), NGW = gridDim.x * 8, c8 = lane * 8;
    float w[4][8], bias[8];
#pragma unroll
    for (int e = 0; e < 8; ++e) { bias[e] = P.in[I_CD_CONVB][c8 + e];
#pragma unroll
        for (int k = 0; k < 4; ++k) w[k][e] = P.in[I_CD_CONVW][k * 512 + c8 + e]; }
    const float bif = P.in[I_CD_BIF][lane & 7];
    for (int tok = gw; tok < T; tok += NGW) {
        const int p = tok & (SEQ - 1);
        float a[8], xraw[8];
#pragma unroll
        for (int e = 0; e < 8; ++e) { a[e] = bias[e]; xraw[e] = 0.f; }
#pragma unroll
        for (int k = 0; k < 4; ++k) {
            if (p - 3 + k >= 0) {
                float xv[8]; unpack8(*(const u32x4*)(proj + (size_t)(tok - 3 + k) * 2560 + c8), xv);
#pragma unroll
                for (int e = 0; e < 8; ++e) { a[e] += w[k][e] * xv[e]; if (k == 3) xraw[e] = xv[e]; }
            }
        }
#pragma unroll
        for (int e = 0; e < 8; ++e) a[e] = a[e] * fsigmoid(a[e]);
        const u32x4 packed = pack8(a);
        *(u32x4*)(xconv + (size_t)tok * 512 + c8) = packed;
        float ar[8]; unpack8(packed, ar);
        float gs[8];
#pragma unroll
        for (int gg = 0; gg < 8; ++gg) gs[gg] = 0.f;
#pragma unroll
        for (int e = 0; e < 8; ++e) {
            const f32x4 w1a = *(LAS f32x4*)(Wc + (c8 + e) * 8), w1b = *(LAS f32x4*)(Wc + (c8 + e) * 8 + 4);
            const f32x4 w2a = *(LAS f32x4*)(Wc + 4096 + (c8 + e) * 8), w2b = *(LAS f32x4*)(Wc + 4096 + (c8 + e) * 8 + 4);
#pragma unroll
            for (int gg = 0; gg < 4; ++gg) { gs[gg] += ar[e] * w1a[gg] + xraw[e] * w2a[gg]; gs[gg + 4] += ar[e] * w1b[gg] + xraw[e] * w2b[gg]; }
        }
        float mine = 0.f;
#pragma unroll
        for (int gg = 0; gg < 8; ++gg) { const float tsum = wave_sum(gs[gg]); if ((lane & 7) == gg) mine = tsum; }
        if (lane < 8) gates[(size_t)tok * 8 + lane] = mine + bif;
    }
}

__device__ __forceinline__ void ph_qkv(const Params& P, lds_t* lds) {
    const bf16_t* xconv = (const bf16_t*)(P.ws + WS_XCONV); const bf16_t* proj = (const bf16_t*)(P.ws + WS_PROJ); const bf16_t* Wt = (const bf16_t*)(P.ws + WS_WQKV);
    for (int tile = blockIdx.x; tile < 1536; tile += gridDim.x) {
        const int which = tile % 3, rt = (tile / 3) & 127, h = tile / 384;
        const bf16_t* A = which < 2 ? xconv : proj; const int lda = which < 2 ? 512 : 2560;
        bf16_t* out = (bf16_t*)(P.ws + (which == 0 ? WS_QB : (which == 1 ? WS_KB : WS_VB)));
        const float sc = which == 1 ? 0.08838834764831845f : 1.0f;
        const bf16_t* Wh = Wt + (size_t)(which * 4 + h) * 16384;
        e1_tile<true>(lds, 2,
            [=](int, int r, int kp) { return *(const u32x4*)(A + (size_t)(rt * 256 + r) * lda + h * 128 + kp * 8); },
            [=](int, int n, int kp) { return *(const u32x4*)(Wh + n * 128 + kp * 8); },
            [=](f32x4 (&acc)[4][4], int wr, int wc, int fr, int fq) {
#pragma unroll
                for (int m = 0; m < 4; ++m)
#pragma unroll
                    for (int n = 0; n < 4; ++n)
                        store_bf16x4(out + (size_t)(rt * 256 + wr * 64 + m * 16 + fr) * 512 + h * 128 + wc * 64 + n * 16 + fq * 4, acc[m][n] * sc);
            });
    }
}

constexpr int TP = 272;
__device__ __forceinline__ void stage_tile(lds_t* dst, const bf16_t* src, size_t src_ld, int nrows) {
    for (int p = threadIdx.x; p < nrows * 16; p += NTHREADS) { const int row = p >> 4, pc = p & 15; *(LAS u32x4*)(dst + row * TP + pc * 16) = *(const u32x4*)(src + (size_t)row * src_ld + pc * 8); }
}

__device__ __forceinline__ void ph_m1(const Params& P, lds_t* lds) {
    const bf16_t* kb = (const bf16_t*)(P.ws + WS_KB); const bf16_t* vb = (const bf16_t*)(P.ws + WS_VB); const float* gates = (const float*)(P.ws + WS_GATES);
    float* kvc = (float*)(P.ws + WS_KVC); float* nchunk = (float*)(P.ws + WS_MISC); float* scal = nchunk + 2 * 2048 * 128;
    lds_t* Kt = lds; lds_t* Vt = lds + 64 * TP; LAS float* wv = (LAS float*)(lds + 128 * TP);
    const int tid = threadIdx.x, lane = tid & 63, w = tid >> 6, fr = lane & 15, fq = lane >> 4, q = (lane & 15) >> 2, p4 = lane & 3;
    for (int item = blockIdx.x; item < 2048; item += gridDim.x) {
        const int bh = item >> 6, n = item & 63, b = bh >> 2, h = bh & 3; const size_t tok0 = (size_t)b * SEQ + n * 64;
        stage_tile(Kt, kb + tok0 * 512 + h * 128, 512, 64);
        stage_tile(Vt, vb + tok0 * 512 + h * 128, 512, 64);
        if (w == 0) {
            const float f = gates[(tok0 + lane) * 8 + 4 + h], ig = gates[(tok0 + lane) * 8 + h];
            float cum = logsigmoidf(f);
#pragma unroll
            for (int off = 1; off < 64; off <<= 1) { const float t = __shfl_up(cum, off); if (lane >= off) cum += t; }
            const float cf = __shfl(cum, 63), te = cf - cum + ig, m = wave_max(te);
            wv[lane] = expf(te - m);
            if (lane == 0) { scal[item] = cf; scal[2048 + item] = m; }
        }
        __syncthreads();
        bf16x8 af[2]; float nsum = 0.f;
#pragma unroll
        for (int ks = 0; ks < 2; ++ks) {
            unsigned pk[4];
#pragma unroll
            for (int t = 0; t < 2; ++t) {
                const int s0 = 32 * ks + 8 * fq + 4 * t;
                const bf16x4 r = tr_read(Kt + (s0 + q) * TP + (16 * w + 4 * p4) * 2);
                const f32x4 ww = *(LAS f32x4*)(wv + s0);
                float x[4];
#pragma unroll
                for (int e = 0; e < 4; ++e) { x[e] = bf2f((unsigned short)r[e]) * ww[e]; nsum += x[e]; }
                pk[2 * t] = pk_bf16(x[0], x[1]); pk[2 * t + 1] = pk_bf16(x[2], x[3]);
            }
            u32x4 u = {pk[0], pk[1], pk[2], pk[3]}; af[ks] = __builtin_bit_cast(bf16x8, u);
        }
        nsum += __shfl_xor(nsum, 16); nsum += __shfl_xor(nsum, 32);
        if (fq == 0) nchunk[(size_t)item * 128 + 16 * w + fr] = nsum;
#pragma unroll
        for (int c = 0; c < 8; ++c) {
            f32x4 acc = {0.f, 0.f, 0.f, 0.f};
#pragma unroll
            for (int ks = 0; ks < 2; ++ks) {
                const int s0 = 32 * ks + 8 * fq;
                const bf16x8 bfv = cat44(tr_read(Vt + (s0 + q) * TP + (16 * c + 4 * p4) * 2), tr_read(Vt + (s0 + 4 + q) * TP + (16 * c + 4 * p4) * 2));
                acc = MFMA16(af[ks], bfv, acc);
            }
            *(f32x4*)(kvc + ((size_t)item * 128 + c * 16 + fr) * 128 + 16 * w + fq * 4) = acc;
        }
        __syncthreads();
    }
}

__device__ __forceinline__ void ph_m2(const Params& P) {
    const float* kvc = (const float*)(P.ws + WS_KVC); bf16_t* cprev = (bf16_t*)(P.ws + WS_CPREV);
    float* nchunk = (float*)(P.ws + WS_MISC); float* nprev = nchunk + 2048 * 128; float* scal = nchunk + 2 * 2048 * 128;
    const int tid = threadIdx.x;
    for (int it = blockIdx.x; it < 1024; it += gridDim.x) {
        const int bh = it >> 5, sl = it & 31, idx = sl * 512 + tid;
        float C = 0.f, nv = 0.f, m = -INFINITY;
#pragma unroll 4
        for (int n = 0; n < 64; ++n) {
            const int item = bh * 64 + n;
            cprev[(size_t)item * 16384 + idx] = (bf16_t)(pk_bf16(C, 0.f) & 0xffffu);
            if (sl == 0 && tid < 128) nprev[(size_t)item * 128 + tid] = nv;
            if (sl == 0 && tid == 0) scal[4096 + item] = m;
            const float kv = kvc[(size_t)item * 16384 + idx];
            const float fc = scal[item], mc = scal[2048 + item];
            const float mn = fmaxf(fc + m, mc), so = expf(fc + m - mn), sn = expf(mc - mn);
            C = so * C + sn * kv;
            if (sl == 0 && tid < 128) nv = so * nv + sn * nchunk[(size_t)item * 128 + tid];
            m = mn;
        }
    }
}

__device__ __forceinline__ void ph_m3(const Params& P, lds_t* lds) {
    const bf16_t* qb = (const bf16_t*)(P.ws + WS_QB); const bf16_t* kb = (const bf16_t*)(P.ws + WS_KB); const bf16_t* vb = (const bf16_t*)(P.ws + WS_VB);
    const bf16_t* cprev = (const bf16_t*)(P.ws + WS_CPREV); const float* gates = (const float*)(P.ws + WS_GATES);
    const float* nprev = (const float*)(P.ws + WS_MISC) + 2048 * 128; const float* scal = (const float*)(P.ws + WS_MISC) + 2 * 2048 * 128;
    const bf16_t* proj = (const bf16_t*)(P.ws + WS_PROJ); bf16_t* cat = (bf16_t*)(P.ws + WS_CAT);
    lds_t* Qt = lds; lds_t* Kt = lds + 64 * TP; lds_t* Vt = lds + 128 * TP; lds_t* Ct = lds + 192 * TP;
    LAS float* cumf = (LAS float*)(lds + 320 * TP); LAS float* gv = cumf + 64; LAS float* msv = gv + 64; LAS float* npv = msv + 64; LAS float* ex = npv + 128;
    const int tid = threadIdx.x, lane = tid & 63, w = tid >> 6, fr = lane & 15, fq = lane >> 4, q = (lane & 15) >> 2, p4 = lane & 3;
    const int rt = w & 3, vh = w >> 2;
    for (int item = blockIdx.x; item < 2048; item += gridDim.x) {
        const int bh = item >> 6, n = item & 63, b = bh >> 2, h = bh & 3; const size_t tok0 = (size_t)b * SEQ + n * 64;
        stage_tile(Qt, qb + tok0 * 512 + h * 128, 512, 64);
        stage_tile(Kt, kb + tok0 * 512 + h * 128, 512, 64);
        stage_tile(Vt, vb + tok0 * 512 + h * 128, 512, 64);
        stage_tile(Ct, cprev + (size_t)item * 16384, 128, 128);
        if (tid < 128) npv[tid] = nprev[(size_t)item * 128 + tid];
        const float mp = scal[4096 + item];
        if (w == 0) {
            const float f = gates[(tok0 + lane) * 8 + 4 + h], ig = gates[(tok0 + lane) * 8 + h];
            float cum = logsigmoidf(f);
#pragma unroll
            for (int off = 1; off < 64; off <<= 1) { const float t = __shfl_up(cum, off); if (lane >= off) cum += t; }
            const float gg = ig - cum; float pm = gg;
#pragma unroll
            for (int off = 1; off < 64; off <<= 1) { const float t = __shfl_up(pm, off); if (lane >= off) pm = fmaxf(pm, t); }
            cumf[lane] = cum; gv[lane] = gg; msv[lane] = cum + fmaxf(pm, mp);
        }
        __syncthreads();
        bf16x8 qf[4];
#pragma unroll
        for (int ks = 0; ks < 4; ++ks) qf[ks] = *(LAS bf16x8*)(Qt + (rt * 16 + fr) * TP + ks * 64 + fq * 16);
        const int s = rt * 16 + fr; const float cs = cumf[s], mss = msv[s];
        float sp[4][4]; float rowsum = 0.f;
#pragma unroll
        for (int jt = 0; jt < 4; ++jt) {
            f32x4 st = {0.f, 0.f, 0.f, 0.f};
            if (jt <= rt) {
#pragma unroll
                for (int ks = 0; ks < 4; ++ks) st = MFMA16(*(LAS bf16x8*)(Kt + (jt * 16 + fr) * TP + ks * 64 + fq * 16), qf[ks], st);
            }
            const f32x4 g4 = *(LAS f32x4*)(gv + jt * 16 + fq * 4);
#pragma unroll
            for (int r = 0; r < 4; ++r) { const int j = jt * 16 + fq * 4 + r; const float wgt = (j <= s) ? fexp(cs + g4[r] - mss) : 0.f; sp[jt][r] = st[r] * wgt; rowsum += sp[jt][r]; }
        }
        rowsum += __shfl_xor(rowsum, 16); rowsum += __shfl_xor(rowsum, 32);
        float qn = 0.f;
#pragma unroll
        for (int ks = 0; ks < 4; ++ks) {
            const f32x4 n0 = *(LAS f32x4*)(npv + ks * 32 + fq * 8), n1 = *(LAS f32x4*)(npv + ks * 32 + fq * 8 + 4);
#pragma unroll
            for (int e = 0; e < 4; ++e) { qn += bf2f((unsigned short)qf[ks][e]) * n0[e]; qn += bf2f((unsigned short)qf[ks][4 + e]) * n1[e]; }
        }
        qn += __shfl_xor(qn, 16); qn += __shfl_xor(qn, 32);
        const float inter = expf(cs + mp - mss), den = rowsum + inter * qn, inv = 1.0f / fmaxf(fabsf(den), expf(-mss));
        if (fq == 0) { ex[w * 32 + fr] = inv; ex[w * 32 + 16 + fr] = inter; }
        __builtin_amdgcn_wave_barrier();
        const f32x4 inv4 = *(LAS f32x4*)(ex + w * 32 + fq * 4), int4 = *(LAS f32x4*)(ex + w * 32 + 16 + fq * 4);
        bf16x8 pa[2];
#pragma unroll
        for (int kk = 0; kk < 2; ++kk) { u32x4 u = {pk_bf16(sp[2 * kk][0], sp[2 * kk][1]), pk_bf16(sp[2 * kk][2], sp[2 * kk][3]), pk_bf16(sp[2 * kk + 1][0], sp[2 * kk + 1][1]), pk_bf16(sp[2 * kk + 1][2], sp[2 * kk + 1][3])}; pa[kk] = __builtin_bit_cast(bf16x8, u); }
#pragma unroll
        for (int c = 0; c < 4; ++c) {
            const int vcol = vh * 64 + c * 16;
            f32x4 acc = {0.f, 0.f, 0.f, 0.f};
#pragma unroll
            for (int ks = 0; ks < 4; ++ks) acc = MFMA16(qf[ks], *(LAS bf16x8*)(Ct + (vcol + fr) * TP + ks * 64 + fq * 16), acc);
#pragma unroll
            for (int r = 0; r < 4; ++r) acc[r] *= int4[r];
#pragma unroll
            for (int kk = 0; kk < 2; ++kk) {
                const bf16x8 vbf = cat44(tr_read(Vt + (32 * kk + 4 * fq + q) * TP + (vcol + 4 * p4) * 2), tr_read(Vt + (32 * kk + 16 + 4 * fq + q) * TP + (vcol + 4 * p4) * 2));
                acc = MFMA16(pa[kk], vbf, acc);
            }
#pragma unroll
            for (int r = 0; r < 4; ++r) {
                const size_t tok = tok0 + rt * 16 + fq * 4 + r; const int col = h * 128 + vcol + fr;
                const float op = bf2f(proj[tok * 2560 + 512 + col]);
                cat[tok * 1024 + col] = (bf16_t)(pk_bf16(fsigmoid(op) * acc[r] * inv4[r], 0.f) & 0xffffu);
            }
        }
        __syncthreads();
    }
}

__device__ __forceinline__ void ph_attn(const Params& P, lds_t* lds) {
    const bf16_t* proj = (const bf16_t*)(P.ws + WS_PROJ); float* atto = (float*)(P.ws + WS_ATTO); float* lse = (float*)(P.ws + WS_LSE);
    lds_t* Kt = lds; lds_t* Vt = lds + 256 * TP; LAS float* ex = (LAS float*)(lds + 512 * TP);
    const int tid = threadIdx.x, lane = tid & 63, w = tid >> 6, fr = lane & 15, fq = lane >> 4, q = (lane & 15) >> 2, p4 = lane & 3;
    for (int item = blockIdx.x; item < 3072; item += gridDim.x) {
        const int g = item >> 10, rem = item & 1023, h = rem & 3, x = rem >> 2, b = x >> 5, y = x & 31;
        const int dsh = 2 * g, dil = 1 << dsh, nbsh = 5 - dsh, r = y >> nbsh, nb = y & ((1 << nbsh) - 1);
        const size_t tokb = (size_t)b * SEQ + r;
        for (int p = tid; p < 256 * 16; p += NTHREADS) {
            const int kr = p >> 4, pc = p & 15; const int i = nb * 128 + kr - 128;
            u32x4 kv = {0u, 0u, 0u, 0u}, vv = {0u, 0u, 0u, 0u};
            if (i >= 0) { const bf16_t* src = proj + (tokb + (size_t)i * dil) * 2560 + h * 128 + pc * 8; kv = *(const u32x4*)(src + 1536); vv = *(const u32x4*)(src + 2048); }
            *(LAS u32x4*)(Kt + kr * TP + pc * 16) = kv; *(LAS u32x4*)(Vt + kr * TP + pc * 16) = vv;
        }
        const int qi = w * 16 + fr;
        const size_t tokq = tokb + (size_t)(nb * 128 + qi) * dil;
        bf16x8 qf[4];
#pragma unroll
        for (int ks = 0; ks < 4; ++ks) qf[ks] = __builtin_bit_cast(bf16x8, *(const u32x4*)(proj + tokq * 2560 + 1024 + h * 128 + ks * 32 + fq * 8));
        __syncthreads();
        float pv[9][4]; float mx = -INFINITY;
#pragma unroll
        for (int jj = 0; jj < 9; ++jj) {
            f32x4 st = {0.f, 0.f, 0.f, 0.f};
#pragma unroll
            for (int ks = 0; ks < 4; ++ks) st = MFMA16(*(LAS bf16x8*)(Kt + ((w + jj) * 16 + fr) * TP + ks * 64 + fq * 16), qf[ks], st);
#pragma unroll
            for (int rr = 0; rr < 4; ++rr) {
                const int kj = (w + jj) * 16 + fq * 4 + rr;
                const bool valid = (kj >= qi) && (kj <= qi + 128) && (nb > 0 || kj >= 128);
                pv[jj][rr] = valid ? st[rr] : -INFINITY; mx = fmaxf(mx, pv[jj][rr]);
            }
        }
        mx = fmaxf(mx, __shfl_xor(mx, 16)); mx = fmaxf(mx, __shfl_xor(mx, 32));
        float l = 0.f;
#pragma unroll
        for (int jj = 0; jj < 9; ++jj)
#pragma unroll
            for (int rr = 0; rr < 4; ++rr) { pv[jj][rr] = fexp(pv[jj][rr] - mx); l += pv[jj][rr]; }
        l += __shfl_xor(l, 16); l += __shfl_xor(l, 32);
        if (fq == 0) { ex[w * 16 + fr] = 1.0f / l; lse[((size_t)g * T + tokq) * 4 + h] = mx + logf(l); }
        __builtin_amdgcn_wave_barrier();
        const f32x4 inv4 = *(LAS f32x4*)(ex + w * 16 + fq * 4);
        f32x4 acc[8];
#pragma unroll
        for (int c = 0; c < 8; ++c) acc[c] = (f32x4){0.f, 0.f, 0.f, 0.f};
#pragma unroll
        for (int kk = 0; kk < 5; ++kk) {
            const int ja = 2 * kk, jb = (2 * kk + 1 < 9) ? 2 * kk + 1 : 2 * kk;
            u32x4 u; u.x = pk_bf16(pv[ja][0], pv[ja][1]); u.y = pk_bf16(pv[ja][2], pv[ja][3]);
            if (2 * kk + 1 < 9) { u.z = pk_bf16(pv[jb][0], pv[jb][1]); u.w = pk_bf16(pv[jb][2], pv[jb][3]); } else { u.z = 0u; u.w = 0u; }
            const bf16x8 pa = __builtin_bit_cast(bf16x8, u);
#pragma unroll
            for (int c = 0; c < 8; ++c) {
                const bf16x8 vbf = cat44(tr_read(Vt + ((w + ja) * 16 + 4 * fq + q) * TP + (c * 16 + 4 * p4) * 2), tr_read(Vt + ((w + jb) * 16 + 4 * fq + q) * TP + (c * 16 + 4 * p4) * 2));
                acc[c] = MFMA16(pa, vbf, acc[c]);
            }
        }
#pragma unroll
        for (int rr = 0; rr < 4; ++rr) {
            const size_t tq = tokb + (size_t)(nb * 128 + w * 16 + fq * 4 + rr) * dil;
#pragma unroll
            for (int c = 0; c < 8; ++c) atto[((size_t)g * T + tq) * 512 + h * 128 + c * 16 + fr] = acc[c][rr] * inv4[rr];
        }
        __syncthreads();
    }
}

__device__ __forceinline__ void ph_attn_combine(const Params& P) {
    const float* atto = (const float*)(P.ws + WS_ATTO); const float* lse = (const float*)(P.ws + WS_LSE); bf16_t* cat = (bf16_t*)(P.ws + WS_CAT);
    const size_t gtid = (size_t)blockIdx.x * NTHREADS + threadIdx.x, GT = (size_t)gridDim.x * NTHREADS;
    for (size_t i = gtid; i < (size_t)T * 128; i += GT) {
        const size_t tok = i >> 7; const int c4 = (int)(i & 127) * 4, h = c4 >> 7;
        const float l0 = lse[tok * 4 + h], l1 = lse[((size_t)T + tok) * 4 + h], l2 = lse[((size_t)2 * T + tok) * 4 + h];
        const float mx = fmaxf(l0, fmaxf(l1, l2)), e0 = expf(l0 - mx), e1 = expf(l1 - mx), e2 = expf(l2 - mx), inv = 1.0f / (e0 + e1 + e2);
        const f32x4 o = (*(const f32x4*)(atto + tok * 512 + c4) * e0 + *(const f32x4*)(atto + ((size_t)T + tok) * 512 + c4) * e1 + *(const f32x4*)(atto + ((size_t)2 * T + tok) * 512 + c4) * e2) * inv;
        store_bf16x4(cat + tok * 1024 + 512 + c4, o);
    }
}

constexpr int NPHASES = 33;
__device__ __forceinline__ void grid_barrier(cg::grid_group& grid) {
    asm volatile("s_waitcnt vmcnt(0)" ::: "memory");
    grid.sync();
    __builtin_amdgcn_fence(__ATOMIC_ACQUIRE, "agent");
    asm volatile("s_waitcnt vmcnt(0)" ::: "memory");
}
typedef __attribute__((address_space(4))) const Params* KP4;
__device__ __forceinline__ const Params& phase_params() { KP4 kp = (KP4)__builtin_amdgcn_kernarg_segment_ptr(); asm volatile("" : "+s"(kp)); return *(const Params*)kp; }
__global__ void __launch_bounds__(NTHREADS) fwd_megakernel(Params Pk) {
    extern __shared__ __attribute__((aligned(16))) unsigned char lds_raw[];
    lds_t* lds = (lds_t*)lds_raw;
    cg::grid_group grid = cg::this_grid();
    const int ph_lo = Pk.ph_lo, ph_hi = Pk.ph_hi;
#ifdef ONLY_PHASE
#define PHASE(k, ...) if constexpr ((k) == ONLY_PHASE) { const Params& P = phase_params(); unsigned char* ws = P.ws; (void)ws; __VA_ARGS__; grid_barrier(grid); }
#else
#ifndef PHASE_MASK
#define PHASE_MASK 0xffffffffu
#endif
#define PHASE(k, ...) if (((PHASE_MASK >> (k)) & 1u) && ph_lo <= (k) && (k) < ph_hi) { const Params& P = phase_params(); unsigned char* ws = P.ws; (void)ws; __VA_ARGS__; if ((k) + 1 < ph_hi) grid_barrier(grid); }
#endif
    PHASE(0, phase0(P, lds))
    PHASE(1, ph_inproj2(P, lds, (const bf16_t*)(ws + WS_WABIN), 1536, nullptr))
    PHASE(2, ph_conv0(P); ph_s5_state(P, lds))
    PHASE(3, ph_gates0(P, lds); ph_s5_carry(P))
    PHASE(4, ph_lru_scan(P, lds); ph_s5_out(P, lds))
    PHASE(5, ph_glu(P, lds))
    PHASE(6, ph_outproj2(P, lds, (const bf16_t*)(ws + WS_WABOUT), P.in[I_X]))
    PHASE(7, ph_ln_router(P, lds, 0))
    PHASE(8, ph_route_scatter(P, lds, 0))
    PHASE(9, ph_moe_up2(P, lds, 0))
    PHASE(10, ph_moe_down2(P, lds, 0))
    PHASE(11, ph_combine_ln(P, 0, (float*)(ws + WS_X1F), true))
    PHASE(12, ph_inproj2(P, lds, (const bf16_t*)(ws + WS_WCDIN), 2560, (const int*)P.in[I_POS]); convert_moe_weights(P, 1, lds))
    PHASE(13, ph_conv1(P, lds))
    PHASE(14, ph_qkv(P, lds))
    PHASE(15, ph_m1(P, lds))
    PHASE(16, ph_m2(P); ph_attn(P, lds))
    PHASE(17, ph_m3(P, lds); ph_attn_combine(P))
    PHASE(18, ph_outproj2(P, lds, (const bf16_t*)(ws + WS_WCDOUT), (const float*)(ws + WS_X1F)))
    PHASE(19, ph_ln_router(P, lds, 1))
    PHASE(20, ph_route_scatter(P, lds, 1))
    PHASE(21, ph_moe_up2(P, lds, 1))
    PHASE(22, ph_moe_down2(P, lds, 1))
    PHASE(23, ph_combine_ln(P, 1, P.out, false))
#undef PHASE
}

#ifndef MULTI_LAUNCH
#define MULTI_LAUNCH 0
#endif
extern "C" void kernel_launch(void* const* d_in, const int* in_sizes, int n_in, void* d_out, int out_size, void* d_ws, size_t ws_size, hipStream_t stream) {
    static int grid_blocks = 0;
    if (grid_blocks == 0) {
        if (n_in != N_IN || out_size != T * D || ws_size < WS_END) { fprintf(stderr, "kernel_launch: unexpected shapes (n_in %d out %d ws %zu need %zu)\n", n_in, out_size, ws_size, (size_t)WS_END); grid_blocks = -1; return; }
        int dev = 0, cus = 0, per_cu = 0;
        (void)hipGetDevice(&dev);
        (void)hipDeviceGetAttribute(&cus, hipDeviceAttributeMultiprocessorCount, dev);
        if (hipFuncSetAttribute((const void*)fwd_megakernel, hipFuncAttributeMaxDynamicSharedMemorySize, LDS_BYTES) != hipSuccess) { fprintf(stderr, "kernel_launch: hipFuncSetAttribute failed\n"); grid_blocks = -1; return; }
        (void)hipOccupancyMaxActiveBlocksPerMultiprocessor(&per_cu, (const void*)fwd_megakernel, NTHREADS, LDS_BYTES);
        if (per_cu < 1) { fprintf(stderr, "kernel_launch: occupancy query returned %d\n", per_cu); grid_blocks = -1; return; }
        grid_blocks = cus * per_cu;
    }
    if (grid_blocks < 0) return;
    Params p{};
    for (int i = 0; i < N_IN; ++i) p.in[i] = (const float*)d_in[i];
    p.out = (float*)d_out; p.ws = (unsigned char*)d_ws;
#if MULTI_LAUNCH
    for (int k = 0; k < 24; ++k) { p.ph_lo = k; p.ph_hi = k + 1; hipLaunchKernelGGL(fwd_megakernel, dim3(grid_blocks), dim3(NTHREADS), LDS_BYTES, stream, p); }
#else
    p.ph_lo = 0; p.ph_hi = 24;
    void* args[] = {&p};
    hipError_t e = hipLaunchCooperativeKernel((const void*)fwd_megakernel, dim3(grid_blocks), dim3(NTHREADS), args, LDS_BYTES, stream);
    if (e != hipSuccess) fprintf(stderr, "cooperative launch failed: %s (grid %d)\n", hipGetErrorString(e), grid_blocks);
#endif
}
```

```cpp
#include <hip/hip_runtime.h>
#include <hip/hip_cooperative_groups.h>
#include <cstdio>
#include <cstdint>
namespace cg = cooperative_groups;

#define LAS __attribute__((address_space(3)))
typedef unsigned short bf16_t;
typedef short bf16x8 __attribute__((ext_vector_type(8)));
typedef short bf16x4 __attribute__((ext_vector_type(4)));
typedef float f32x4 __attribute__((ext_vector_type(4)));
typedef unsigned u32x4 __attribute__((ext_vector_type(4)));
typedef unsigned u32x2 __attribute__((ext_vector_type(2)));
typedef LAS unsigned char lds_t;

constexpr int T = 32768, D = 1024, SEQ = 4096;
constexpr int NTHREADS = 512;
constexpr int LDS_BYTES = 160 * 1024;
constexpr float ALPHA = 1.4142135623730951f;
constexpr float LN_EPS = 1e-5f;
constexpr int MOE_ROWS = 139264;
constexpr int S5TC = 32;
constexpr int S5K = S5TC * 16 + 128;

enum { I_X = 0, I_POS, I_AB_WIN, I_AB_CONVW, I_AB_CONVB, I_AB_GRW, I_AB_GRB, I_AB_GIW, I_AB_GIB, I_AB_LAMBDA,
       I_S5_LRE, I_S5_LIM, I_S5_STEP, I_S5_BRE, I_S5_BIM, I_S5_CRE, I_S5_CIM, I_S5_D, I_AB_GLUW, I_AB_GLUB, I_AB_WOUT,
       I_CD_WIN, I_CD_CONVW, I_CD_CONVB, I_CD_WQ, I_CD_WK, I_CD_WV, I_CD_WIF, I_CD_BIF, I_CD_WOUT,
       I_LNM_G, I_LNM_B, I_LNF_G, I_LNF_B, I_R_W, I_R_B, I_M_WIN, I_M_BIN, I_M_WOUT, I_M_BOUT, N_IN };

constexpr size_t MiB = 1ull << 20;
constexpr size_t WS_CTL = 0;
constexpr size_t WS_XB = 1 * MiB;
constexpr size_t WS_WABIN = 65 * MiB;
constexpr size_t WS_WGLU = 68 * MiB;
constexpr size_t WS_WABOUT = 69 * MiB;
constexpr size_t WS_WCDIN = 71 * MiB;
constexpr size_t WS_WCDOUT = 76 * MiB;
constexpr size_t WS_WG = 78 * MiB;
constexpr size_t WS_WQKV = 78 * MiB + 256 * 1024;
constexpr size_t WS_WC = 79 * MiB;
constexpr size_t WS_S5TM = 80 * MiB;
constexpr size_t WS_S5WST = 100 * MiB;
constexpr size_t WS_MWIN = 104 * MiB;
constexpr size_t WS_MWOUT = 232 * MiB;
constexpr size_t WS_PROJ = 296 * MiB;
constexpr size_t WS_CAT = 456 * MiB;
constexpr size_t WS_X1F = 520 * MiB;
constexpr size_t WS_ZF = 648 * MiB;
constexpr size_t WS_HACT = 776 * MiB;
constexpr size_t WS_YB = 1048 * MiB;
constexpr size_t WS_ROUTE = 1320 * MiB;
constexpr size_t WS_SCR = 1328 * MiB;
constexpr size_t WS_XC = WS_SCR;
constexpr size_t WS_AF = WS_SCR + 32 * MiB;
constexpr size_t WS_UF = WS_SCR + 96 * MiB;
constexpr size_t WS_SB = WS_SCR + 160 * MiB;
constexpr size_t WS_S5S = WS_SCR + 192 * MiB;
constexpr size_t WS_S5X = WS_SCR + 208 * MiB;
constexpr size_t WS_XCONV = WS_SCR;
constexpr size_t WS_QB = WS_SCR + 32 * MiB;
constexpr size_t WS_KB = WS_SCR + 64 * MiB;
constexpr size_t WS_VB = WS_SCR + 96 * MiB;
constexpr size_t WS_GATES = WS_SCR + 128 * MiB;
constexpr size_t WS_KVC = WS_SCR + 130 * MiB;
constexpr size_t WS_CPREV = WS_SCR + 258 * MiB;
constexpr size_t WS_MISC = WS_SCR + 322 * MiB;
constexpr size_t WS_ATTO = WS_SCR + 326 * MiB;
constexpr size_t WS_LSE = WS_SCR + 518 * MiB;
constexpr size_t WS_END = WS_SCR + 520 * MiB;

struct Params { const float* in[N_IN]; float* out; unsigned char* ws; int ph_lo, ph_hi; };

__device__ __forceinline__ float bf2f(unsigned short b) { return __uint_as_float(((unsigned)b) << 16); }
typedef __bf16 bf16v2_t __attribute__((ext_vector_type(2)));
typedef float f32x2 __attribute__((ext_vector_type(2)));
__device__ __forceinline__ unsigned pk_bf16(float lo, float hi) { const f32x2 v = {lo, hi}; return __builtin_bit_cast(unsigned, __builtin_convertvector(v, bf16v2_t)); }
__device__ __forceinline__ float wave_sum(float v) {
#pragma unroll
    for (int o = 1; o < 64; o <<= 1) v += __shfl_xor(v, o);
    return v;
}
__device__ __forceinline__ float wave_max(float v) {
#pragma unroll
    for (int o = 1; o < 64; o <<= 1) v = fmaxf(v, __shfl_xor(v, o));
    return v;
}
__device__ __forceinline__ float fsigmoid(float x) { return __builtin_amdgcn_rcpf(1.0f + __builtin_amdgcn_exp2f(-1.4426950408889634f * x)); }
__device__ __forceinline__ float fexp(float x) { return __builtin_amdgcn_exp2f(1.4426950408889634f * x); }
__device__ __forceinline__ float flog(float x) { return 0.6931471805599453f * __builtin_amdgcn_logf(x); }
__device__ __forceinline__ void fsincos(float x, float& sn, float& cs) {
    const float n = rintf(x * 0.15915494309189535f);
    float r = fmaf(-n, 6.28125f, x); r = fmaf(-n, 0.0019353071795864769f, r);
    const float rev = r * 0.15915494309189535f;
    sn = __builtin_amdgcn_sinf(rev); cs = __builtin_amdgcn_cosf(rev);
}
__device__ __forceinline__ float gelu_tanh(float x) { return x * fsigmoid(1.5957691216057308f * (x + 0.044715f * x * x * x)); }
__device__ __forceinline__ float logsigmoidf(float x) { return fminf(x, 0.f) - log1pf(expf(-fabsf(x))); }
__device__ __forceinline__ void unpack8(u32x4 v, float (&f)[8]) {
    f[0] = __uint_as_float(v.x << 16); f[1] = __uint_as_float(v.x & 0xffff0000u);
    f[2] = __uint_as_float(v.y << 16); f[3] = __uint_as_float(v.y & 0xffff0000u);
    f[4] = __uint_as_float(v.z << 16); f[5] = __uint_as_float(v.z & 0xffff0000u);
    f[6] = __uint_as_float(v.w << 16); f[7] = __uint_as_float(v.w & 0xffff0000u);
}
__device__ __forceinline__ u32x4 pack8(const float (&f)[8]) { u32x4 o; o.x = pk_bf16(f[0], f[1]); o.y = pk_bf16(f[2], f[3]); o.z = pk_bf16(f[4], f[5]); o.w = pk_bf16(f[6], f[7]); return o; }
__device__ __forceinline__ bf16x4 tr_read(lds_t* p) { return __builtin_amdgcn_ds_read_tr16_b64_v4i16((LAS bf16x4*)p); }
__device__ __forceinline__ bf16x8 cat44(bf16x4 a, bf16x4 b) { bf16x8 r = {a[0], a[1], a[2], a[3], b[0], b[1], b[2], b[3]}; return r; }
#define MFMA16(a, b, c) __builtin_amdgcn_mfma_f32_16x16x32_bf16((a), (b), (c), 0, 0, 0)

constexpr int E1_PITCH = 144;
constexpr int E1_A = 256 * E1_PITCH;
constexpr int E1_B = 128 * E1_PITCH;
constexpr int E1_BUF = E1_A + E1_B;

template <bool TRANS, class AL, class BL, class EP>
__device__ __forceinline__ void e1_tile(lds_t* lds, int nk, AL aload, BL bload, EP epi) {
    const int tid = threadIdx.x, lane = tid & 63, wave = tid >> 6, wr = wave >> 1, wc = wave & 1, fr = lane & 15, fq = lane >> 4;
    const int prow = tid >> 3, pc = tid & 7;
    f32x4 acc[4][4];
#pragma unroll
    for (int m = 0; m < 4; ++m)
#pragma unroll
        for (int n = 0; n < 4; ++n) acc[m][n] = (f32x4){0.f, 0.f, 0.f, 0.f};
    u32x4 ra[4], rb[2];
#pragma unroll
    for (int i = 0; i < 4; ++i) ra[i] = aload(i, prow + 64 * i, pc);
#pragma unroll
    for (int i = 0; i < 2; ++i) rb[i] = bload(i, prow + 64 * i, pc);
#pragma unroll
    for (int i = 0; i < 4; ++i) *(LAS u32x4*)(lds + (prow + 64 * i) * E1_PITCH + pc * 16) = ra[i];
#pragma unroll
    for (int i = 0; i < 2; ++i) *(LAS u32x4*)(lds + E1_A + (prow + 64 * i) * E1_PITCH + pc * 16) = rb[i];
    __syncthreads();
    for (int t = 0; t < nk; ++t) {
        const bool more = (t + 1 < nk);
        if (more) {
#pragma unroll
            for (int i = 0; i < 4; ++i) ra[i] = aload(i, prow + 64 * i, (t + 1) * 8 + pc);
#pragma unroll
            for (int i = 0; i < 2; ++i) rb[i] = bload(i, prow + 64 * i, (t + 1) * 8 + pc);
        }
        lds_t* Ab = lds + (t & 1) * E1_BUF + (wr * 64 + fr) * E1_PITCH + fq * 16;
        lds_t* Bb = lds + (t & 1) * E1_BUF + E1_A + (wc * 64 + fr) * E1_PITCH + fq * 16;
#pragma unroll
        for (int kk = 0; kk < 2; ++kk) {
            bf16x8 af[4], bfr[4];
#pragma unroll
            for (int m = 0; m < 4; ++m) af[m] = *(LAS bf16x8*)(Ab + m * 16 * E1_PITCH + kk * 64);
#pragma unroll
            for (int n = 0; n < 4; ++n) bfr[n] = *(LAS bf16x8*)(Bb + n * 16 * E1_PITCH + kk * 64);
#pragma unroll
            for (int m = 0; m < 4; ++m)
#pragma unroll
                for (int n = 0; n < 4; ++n) acc[m][n] = TRANS ? MFMA16(bfr[n], af[m], acc[m][n]) : MFMA16(af[m], bfr[n], acc[m][n]);
        }
        if (more) {
            lds_t* nb = lds + ((t + 1) & 1) * E1_BUF;
#pragma unroll
            for (int i = 0; i < 4; ++i) *(LAS u32x4*)(nb + (prow + 64 * i) * E1_PITCH + pc * 16) = ra[i];
#pragma unroll
            for (int i = 0; i < 2; ++i) *(LAS u32x4*)(nb + E1_A + (prow + 64 * i) * E1_PITCH + pc * 16) = rb[i];
        }
        __syncthreads();
    }
    epi(acc, wr, wc, fr, fq);
}


namespace g2 {
constexpr int HTB = 16384;
__device__ __forceinline__ int lds_byte(int r, int c) { const int st = (r >> 4) * 2 + (c >> 5), rr = r & 15, cc = c & 31, ob = rr * 64 + cc * 2; return st * 1024 + (ob ^ (((ob >> 9) & 1) << 5)); }
__device__ __forceinline__ void stage_rc(int b, int& R, int& C) { const int st = b / 1024, sb = b % 1024, swz = sb ^ (((sb >> 9) & 1) << 5); R = (st >> 1) * 16 + swz / 64; C = (st & 1) * 32 + (swz % 64) / 2; }
struct Unit { int pm, pn; };
__device__ __forceinline__ bool static_next(int i, int G, int c, int nM, int nN, Unit& u) {
    const int nwg = nM * nN; const long L = (long)i * G + c; if (L >= nwg) return false;
    int wgid = (int)L; { const int q = nwg / 8, r = nwg % 8, xcd = wgid % 8, off = wgid / 8; wgid = (xcd < r ? xcd * (q + 1) : r * (q + 1) + (xcd - r) * q) + off; }
    const int nig = 8 * nN, gid = wgid / nig, fm = gid * 8, gsz = (nM - fm) < 8 ? (nM - fm) : 8;
    u.pm = fm + ((wgid % nig) % gsz); u.pn = (wgid % nig) / gsz; return true;
}
template <class Sched, class Epi>
__device__ __forceinline__ void gemm_phase(lds_t* lds, const char* Abase, int K, unsigned ldb_bytes, const Sched& S, const Epi& E) {
    const int tid = threadIdx.x, wid = __builtin_amdgcn_readfirstlane(tid >> 6), lane = tid & 63, wr = wid >> 2, wc = wid & 3, fr = lane & 15, fq = lane >> 4;
    const int nt = K / 64;
    int Rs[2], Cs[2]; unsigned voffB[2];
#pragma unroll
    for (int i = 0; i < 2; ++i) { stage_rc(tid * 16 + i * 8192, Rs[i], Cs[i]); voffB[i] = (unsigned)Rs[i] * ldb_bytes + (unsigned)Cs[i] * 2u; }
    const size_t hstepB = (size_t)128 * ldb_bytes;
    const unsigned ldsw = (unsigned)wid * 1024u;
    const int aoff = lds_byte(wr * 64 + fr, fq * 8), boff = lds_byte(wc * 32 + fr, fq * 8);
#define G2_SA(b, h) (((b) * 2 + (h)) * g2::HTB)
#define G2_SB(b, h) ((4 + (b) * 2 + (h)) * g2::HTB)
#define G2_STAGE_A(bufoff, offs, kb) do { _Pragma("unroll") for (int _i = 0; _i < 2; ++_i) \
        __builtin_amdgcn_global_load_lds((const unsigned*)((Abase + (kb)) + (offs)[_i]), (LAS unsigned*)(lds + (bufoff) + ldsw + _i * 8192), 16, 0, 0); } while (0)
#define G2_STAGE_B(bufoff, gbase) do { _Pragma("unroll") for (int _i = 0; _i < 2; ++_i) \
        __builtin_amdgcn_global_load_lds((const unsigned*)((const char*)(gbase) + voffB[_i]), (LAS unsigned*)(lds + (bufoff) + ldsw + _i * 8192), 16, 0, 0); } while (0)
#define G2_LDA(dst, b, h) do { _Pragma("unroll") for (int m = 0; m < 4; ++m) _Pragma("unroll") for (int k = 0; k < 2; ++k) dst[m][k] = *(const LAS bf16x8*)(lds + G2_SA(b, h) + aoff + m * 2048 + k * 1024); } while (0)
#define G2_LDB(dst, b, h) do { _Pragma("unroll") for (int n = 0; n < 2; ++n) _Pragma("unroll") for (int k = 0; k < 2; ++k) dst[n][k] = *(const LAS bf16x8*)(lds + G2_SB(b, h) + boff + n * 2048 + k * 1024); } while (0)
#define G2_MMA(ai, bj, At, Bt) do { __builtin_amdgcn_s_setprio(1); _Pragma("unroll") for (int m = 0; m < 4; ++m) _Pragma("unroll") for (int n = 0; n < 2; ++n) _Pragma("unroll") for (int k = 0; k < 2; ++k) \
        acc[ai][bj][m][n] = __builtin_amdgcn_mfma_f32_16x16x32_bf16(Bt[n][k], At[m][k], acc[ai][bj][m][n], 0, 0, 0); __builtin_amdgcn_s_setprio(0); } while (0)
#define G2_WAIT_V(n) asm volatile("s_waitcnt vmcnt(" #n ")" ::: "memory")
#define G2_WAIT_L(n) asm volatile("s_waitcnt lgkmcnt(" #n ")" ::: "memory")
#define G2_BAR __builtin_amdgcn_s_barrier()
#define G2_SCHED __builtin_amdgcn_sched_barrier(0)
    Unit cur, nxt; int ui = 0;
    if (!S.next(0, cur)) return;
    f32x4 acc[2][2][4][2];
#pragma unroll
    for (int a = 0; a < 2; ++a)
#pragma unroll
        for (int b = 0; b < 2; ++b)
#pragma unroll
            for (int m = 0; m < 4; ++m)
#pragma unroll
                for (int n = 0; n < 2; ++n) acc[a][b][m][n] = (f32x4){0.f, 0.f, 0.f, 0.f};
    bf16x8 At[4][2], B0[2][2], B1[2][2];
    unsigned aoC[2][2], aoN[2][2];
    S.a_off(cur, Rs, Cs, aoC);
    const char* cB = S.b_base(cur);
    G2_STAGE_B(G2_SB(0, 0), cB); G2_STAGE_B(G2_SB(0, 1), cB + hstepB); G2_STAGE_A(G2_SA(0, 0), aoC[0], 0); G2_STAGE_A(G2_SA(0, 1), aoC[1], 0);
    if (wr == 1) G2_BAR;
    G2_WAIT_V(2); G2_BAR;
    G2_STAGE_B(G2_SB(1, 0), cB + 128); G2_STAGE_A(G2_SA(1, 0), aoC[0], 128); G2_STAGE_B(G2_SB(1, 1), cB + hstepB + 128);
    G2_WAIT_V(6); G2_BAR;
    for (;;) {
        const bool has_next = S.next(ui + 1, nxt);
        const char* nB = cB;
#pragma unroll
        for (int h = 0; h < 2; ++h)
#pragma unroll
            for (int i = 0; i < 2; ++i) aoN[h][i] = aoC[h][i];
        if (has_next) { S.a_off(nxt, Rs, Cs, aoN); nB = S.b_base(nxt); }
        for (int t = 0; t < nt; t += 2) {
            const bool last = (t == nt - 2);
            const unsigned k1 = (unsigned)(t + 1) * 128u, k2 = last ? 0u : (unsigned)(t + 2) * 128u, k3 = k2 + 128u;
            unsigned a2o[2][2];
#pragma unroll
            for (int h = 0; h < 2; ++h)
#pragma unroll
                for (int i = 0; i < 2; ++i) a2o[h][i] = last ? aoN[h][i] : aoC[h][i];
            const char* b2 = last ? nB : cB + (size_t)(t + 2) * 128; const char* b3 = b2 + 128;
            G2_LDB(B0, 0, 0); G2_LDB(B1, 0, 1); G2_SCHED; G2_LDA(At, 0, 0); G2_STAGE_A(G2_SA(1, 1), aoC[1], k1);
            G2_WAIT_V(8); G2_WAIT_L(0); G2_BAR; G2_MMA(0, 0, At, B0); G2_MMA(0, 1, At, B1); G2_BAR; G2_SCHED;
            G2_LDA(At, 0, 1); G2_STAGE_B(G2_SB(0, 0), b2); G2_STAGE_B(G2_SB(0, 1), b2 + hstepB); G2_STAGE_A(G2_SA(0, 0), a2o[0], k2);
            G2_WAIT_V(8); G2_WAIT_L(0); G2_BAR; G2_MMA(1, 0, At, B0); G2_MMA(1, 1, At, B1); G2_BAR; G2_SCHED;
            G2_LDB(B0, 1, 0); G2_LDB(B1, 1, 1); G2_SCHED; G2_LDA(At, 1, 0); G2_STAGE_A(G2_SA(0, 1), a2o[1], k2);
            G2_WAIT_V(8); G2_WAIT_L(0); G2_BAR; G2_MMA(0, 0, At, B0); G2_MMA(0, 1, At, B1); G2_BAR; G2_SCHED;
            G2_LDA(At, 1, 1); G2_STAGE_B(G2_SB(1, 0), b3); G2_STAGE_B(G2_SB(1, 1), b3 + hstepB); G2_STAGE_A(G2_SA(1, 0), a2o[0], k3);
            G2_WAIT_V(8); G2_WAIT_L(0); G2_BAR; G2_MMA(1, 0, At, B0); G2_MMA(1, 1, At, B1); G2_BAR; G2_SCHED;
        }
        if (wr == 0) G2_BAR;
        E(acc, cur, wr, wc, fr, fq);
        if (!has_next) break;
#pragma unroll
        for (int a = 0; a < 2; ++a)
#pragma unroll
            for (int b = 0; b < 2; ++b)
#pragma unroll
                for (int m = 0; m < 4; ++m)
#pragma unroll
                    for (int n = 0; n < 2; ++n) acc[a][b][m][n] = (f32x4){0.f, 0.f, 0.f, 0.f};
        cur = nxt; cB = nB; ++ui;
#pragma unroll
        for (int h = 0; h < 2; ++h)
#pragma unroll
            for (int i = 0; i < 2; ++i) aoC[h][i] = aoN[h][i];
        if (wr == 1) G2_BAR;
    }
    G2_WAIT_V(0);
    G2_BAR;
#undef G2_SA
#undef G2_SB
#undef G2_STAGE_A
#undef G2_STAGE_B
#undef G2_LDA
#undef G2_LDB
#undef G2_MMA
#undef G2_WAIT_V
#undef G2_WAIT_L
#undef G2_BAR
#undef G2_SCHED
}
struct DenseSched {
    int G, c, nM, nN, K; const char* Bt;
    __device__ __forceinline__ bool next(int i, Unit& u) const { return static_next(i, G, c, nM, nN, u); }
    __device__ __forceinline__ void a_off(const Unit& u, const int (&Rs)[2], const int (&Cs)[2], unsigned (&ao)[2][2]) const {
#pragma unroll
        for (int h = 0; h < 2; ++h)
#pragma unroll
            for (int i = 0; i < 2; ++i) ao[h][i] = ((unsigned)(u.pm * 256 + h * 128 + Rs[i]) * (unsigned)K + (unsigned)Cs[i]) * 2u;
    }
    __device__ __forceinline__ const char* b_base(const Unit& u) const { return Bt + (size_t)u.pn * 256 * K * 2; }
};
}

template <class RM>
__device__ __forceinline__ void transpose_item(const float* __restrict__ W, int N, bf16_t* __restrict__ WT, int ldwt, int k0, int n0, RM rowmap, LAS float* scr, int lane) {
#pragma unroll 16
    for (int i = 0; i < 64; ++i) scr[i * 65 + lane] = W[(size_t)(k0 + i) * N + n0 + lane];
    __builtin_amdgcn_wave_barrier();
    const int c = lane & 7;
#pragma unroll
    for (int j = 0; j < 8; ++j) {
        const int n = (lane >> 3) + 8 * j;
        const LAS float* s = scr + (8 * c) * 65 + n;
        u32x4 o; o.x = pk_bf16(s[0], s[65]); o.y = pk_bf16(s[2 * 65], s[3 * 65]); o.z = pk_bf16(s[4 * 65], s[5 * 65]); o.w = pk_bf16(s[6 * 65], s[7 * 65]);
        *(u32x4*)(WT + (size_t)rowmap(n0 + n) * ldwt + k0 + 8 * c) = o;
    }
    __builtin_amdgcn_wave_barrier();
}
struct RmId { __device__ __forceinline__ int operator()(int n) const { return n; } };
struct RmMoeIn { __device__ __forceinline__ int operator()(int n) const { const int half = n >> 10, j = n & 1023; return (j >> 7) * 256 + half * 128 + (j & 127); } };
struct RmGate { int gate; __device__ __forceinline__ int operator()(int j) const { return (j >> 5) * 64 + gate * 32 + (j & 31); } };

template <class RM>
__device__ __forceinline__ void transpose_matrix(const float* W, int K, int N, bf16_t* WT, int ldwt, RM rm, LAS float* scr, int gw, int NGW, int lane) {
    const int nkb = K / 64, nnb = N / 64;
    for (int it = gw; it < nkb * nnb; it += NGW) transpose_item(W, N, WT, ldwt, (it / nnb) * 64, (it % nnb) * 64, rm, scr, lane);
}

__device__ __forceinline__ void convert_moe_weights(const Params& P, int layer, lds_t* lds) {
    const int lane = threadIdx.x & 63, wave = threadIdx.x >> 6, gw = blockIdx.x * 8 + wave, NGW = gridDim.x * 8;
    LAS float* scr = (LAS float*)(lds + wave * 16640);
    const float* win = P.in[I_M_WIN] + (size_t)layer * 32 * 1024 * 2048;
    bf16_t* dwin = (bf16_t*)(P.ws + WS_MWIN);
    for (int it = gw; it < 32 * 16 * 32; it += NGW) {
        const int e = it >> 9, r = it & 511, kb = r >> 5, nb = r & 31;
        transpose_item(win + (size_t)e * 1024 * 2048, 2048, dwin + (size_t)e * 2048 * 1024, 1024, kb * 64, nb * 64, RmMoeIn(), scr, lane);
    }
    const float* wout = P.in[I_M_WOUT] + (size_t)layer * 32 * 1024 * 1024;
    bf16_t* dwout = (bf16_t*)(P.ws + WS_MWOUT);
    for (int it = gw; it < 32 * 16 * 16; it += NGW) {
        const int e = it >> 8, r = it & 255, kb = r >> 4, nb = r & 15;
        transpose_item(wout + (size_t)e * 1024 * 1024, 1024, dwout + (size_t)e * 1024 * 1024, 1024, kb * 64, nb * 64, RmId(), scr, lane);
    }
}

__device__ __forceinline__ void s5_precompute(const Params& P, int g, lds_t* lds) {
    const int tid = threadIdx.x;
    LAS float* Bbr = (LAS float*)lds;
    LAS float* Bbi = Bbr + 1024;
    LAS float* Cr = Bbi + 1024;
    LAS float* Ci = Cr + 1024;
    LAS float* ApR = Ci + 1024;
    LAS float* ApI = ApR + 33 * 64;
    LAS float* KJ = ApI + 33 * 64;
    const float* lre = P.in[I_S5_LRE] + g * 64; const float* lim = P.in[I_S5_LIM] + g * 64;
    const float step = expf(P.in[I_S5_STEP][g]);
    for (int idx = tid; idx < 1024; idx += NTHREADS) {
        const int p = idx >> 4;
        const float lr = fminf(lre[p], -1e-4f), li = lim[p];
        const float mag = expf(lr * step); float sn, cs; sincosf(li * step, &sn, &cs);
        const float ar = mag * cs, ai = mag * sn, inv = 1.0f / (lr * lr + li * li);
        const float zr = ((ar - 1.0f) * lr + ai * li) * inv, zi = (ai * lr - (ar - 1.0f) * li) * inv;
        const float br = P.in[I_S5_BRE][g * 1024 + idx], bi = P.in[I_S5_BIM][g * 1024 + idx];
        Bbr[idx] = zr * br - zi * bi; Bbi[idx] = zr * bi + zi * br;
        Cr[idx] = P.in[I_S5_CRE][g * 1024 + idx]; Ci[idx] = P.in[I_S5_CIM][g * 1024 + idx];
    }
    for (int idx = tid; idx < 33 * 64; idx += NTHREADS) {
        const int j = idx >> 6, p = idx & 63;
        const float lr = fminf(lre[p], -1e-4f), li = lim[p];
        const float mag = expf((float)j * lr * step); float sn, cs; sincosf((float)j * li * step, &sn, &cs);
        ApR[idx] = mag * cs; ApI[idx] = mag * sn;
    }
    __syncthreads();
    for (int idx = tid; idx < 8192; idx += NTHREADS) {
        const int j = idx >> 8, h = (idx >> 4) & 15, h2 = idx & 15;
        float s = 0.f;
        for (int p = 0; p < 64; ++p) {
            const float cr = Cr[h * 64 + p], ci = Ci[h * 64 + p], ar = ApR[j * 64 + p], ai = ApI[j * 64 + p];
            const float er = cr * ar - ci * ai, ei = cr * ai + ci * ar;
            s += er * Bbr[p * 16 + h2] - ei * Bbi[p * 16 + h2];
        }
        if (j == 0 && h == h2) s += P.in[I_S5_D][g * 16 + h];
        KJ[idx] = s;
    }
    __syncthreads();
    bf16_t* Tm = (bf16_t*)(P.ws + WS_S5TM) + (size_t)g * 512 * S5K;
    for (int pi = tid; pi < 512 * (S5K / 8); pi += NTHREADS) {
        const int row = pi / (S5K / 8), c8 = (pi % (S5K / 8)) * 8, t = row >> 4, h = row & 15;
        float v[8];
#pragma unroll
        for (int e = 0; e < 8; ++e) {
            const int col = c8 + e;
            if (col < 512) { const int s = col >> 4, h2 = col & 15; v[e] = (s <= t) ? KJ[((t - s) * 16 + h) * 16 + h2] : 0.f; }
            else { const int p = (col - 512) & 63, im = (col - 512) >> 6;
                const float cr = Cr[h * 64 + p], ci = Ci[h * 64 + p], ar = ApR[(t + 1) * 64 + p], ai = ApI[(t + 1) * 64 + p];
                v[e] = im ? -(cr * ai + ci * ar) : (cr * ar - ci * ai); }
        }
        *(u32x4*)(Tm + (size_t)row * S5K + c8) = pack8(v);
    }
    bf16_t* Wst = (bf16_t*)(P.ws + WS_S5WST) + (size_t)g * 128 * 512;
    for (int pi = tid; pi < 128 * 64; pi += NTHREADS) {
        const int row = pi >> 6, c8 = (pi & 63) * 8, p = row & 63, im = row >> 6;
        float v[8];
#pragma unroll
        for (int e = 0; e < 8; ++e) {
            const int col = c8 + e, s = col >> 4, h2 = col & 15;
            const float ar = ApR[(S5TC - 1 - s) * 64 + p], ai = ApI[(S5TC - 1 - s) * 64 + p], br = Bbr[p * 16 + h2], bi = Bbi[p * 16 + h2];
            v[e] = im ? (ar * bi + ai * br) : (ar * br - ai * bi);
        }
        *(u32x4*)(Wst + (size_t)row * 512 + c8) = pack8(v);
    }
    __syncthreads();
}

__device__ __forceinline__ void phase0(const Params& P, lds_t* lds) {
    const int tid = threadIdx.x, lane = tid & 63, wave = tid >> 6, gw = blockIdx.x * 8 + wave, NGW = gridDim.x * 8;
    const size_t gtid = (size_t)blockIdx.x * NTHREADS + tid, GT = (size_t)gridDim.x * NTHREADS;
    unsigned char* ws = P.ws;
    if (blockIdx.x == 0 && tid < 128) ((int*)(ws + WS_CTL))[tid] = 0;
    for (int g = blockIdx.x; g < 32; g += gridDim.x) s5_precompute(P, g, lds);
    {
        const f32x4* x4 = (const f32x4*)P.in[I_X]; u32x4* xb = (u32x4*)(ws + WS_XB);
        for (size_t i = gtid; i < (size_t)T * D / 8; i += GT) { const f32x4 a = x4[2 * i], b = x4[2 * i + 1]; u32x4 o; o.x = pk_bf16(a.x, a.y); o.y = pk_bf16(a.z, a.w); o.z = pk_bf16(b.x, b.y); o.w = pk_bf16(b.z, b.w); xb[i] = o; }
    }
    {
        float* Wc = (float*)(ws + WS_WC);
        for (size_t idx = gtid; idx < 8192; idx += GT) {
            const int which = (int)(idx >> 12), i = (int)((idx >> 3) & 511), gg = (int)(idx & 7), h = i >> 7, ii = i & 127;
            const float* wif = P.in[I_CD_WIF];
            float s = 0.f;
            if (which == 0) {
                const float* wq = P.in[I_CD_WQ] + (size_t)(h * 128 + ii) * 128; const float* wk = P.in[I_CD_WK] + (size_t)(h * 128 + ii) * 128;
                float s2 = 0.f;
                for (int j = 0; j < 128; ++j) { s += wq[j] * wif[(h * 128 + j) * 8 + gg]; s2 += wk[j] * wif[(512 + h * 128 + j) * 8 + gg]; }
                s += s2 * 0.08838834764831845f;
            } else {
                const float* wv = P.in[I_CD_WV] + (size_t)(h * 128 + ii) * 128;
                for (int j = 0; j < 128; ++j) s += wv[j] * wif[(1024 + h * 128 + j) * 8 + gg];
            }
            Wc[idx] = s;
        }
    }
    LAS float* scr = (LAS float*)(lds + wave * 16640);
    transpose_matrix(P.in[I_AB_WIN], 1024, 1536, (bf16_t*)(ws + WS_WABIN), 1024, RmId(), scr, gw, NGW, lane);
    transpose_matrix(P.in[I_AB_GLUW], 512, 512, (bf16_t*)(ws + WS_WGLU), 512, RmId(), scr, gw, NGW, lane);
    transpose_matrix(P.in[I_AB_WOUT], 1024, 1024, (bf16_t*)(ws + WS_WABOUT), 1024, RmId(), scr, gw, NGW, lane);
    transpose_matrix(P.in[I_CD_WIN], 1024, 2560, (bf16_t*)(ws + WS_WCDIN), 1024, RmId(), scr, gw, NGW, lane);
    transpose_matrix(P.in[I_CD_WOUT], 1024, 1024, (bf16_t*)(ws + WS_WCDOUT), 1024, RmId(), scr, gw, NGW, lane);
    for (int it = gw; it < 16; it += NGW) {
        const int gate = it >> 3, h = it & 7;
        transpose_item(P.in[gate ? I_AB_GIW : I_AB_GRW] + h * 4096, 64, (bf16_t*)(ws + WS_WG) + h * 8192, 64, 0, 0, RmGate{gate}, scr, lane);
    }
    for (int it = gw; it < 48; it += NGW) {
        const int which = it >> 4, h = (it >> 2) & 3, kb = (it >> 1) & 1, nb = it & 1;
        transpose_item(P.in[I_CD_WQ + which] + h * 16384, 128, (bf16_t*)(ws + WS_WQKV) + (which * 4 + h) * 16384, 128, kb * 64, nb * 64, RmId(), scr, lane);
    }
    convert_moe_weights(P, 0, lds);
}

__device__ __forceinline__ void store_bf16x4(bf16_t* p, f32x4 v) { u32x2 o; o.x = pk_bf16(v[0], v[1]); o.y = pk_bf16(v[2], v[3]); *(u32x2*)p = o; }

__device__ __forceinline__ void ph_inproj(const Params& P, lds_t* lds, const bf16_t* Wt, int N, const int* pos) {
    const bf16_t* xb = (const bf16_t*)(P.ws + WS_XB); bf16_t* proj = (bf16_t*)(P.ws + WS_PROJ);
    const int nct = N / 128;
    for (int tile = blockIdx.x; tile < 128 * nct; tile += gridDim.x) {
        const int rt = tile / nct, ct = tile % nct;
        e1_tile<true>(lds, 16,
            [=](int, int r, int kp) { return *(const u32x4*)(xb + (size_t)(rt * 256 + r) * 1024 + kp * 8); },
            [=](int, int n, int kp) { return *(const u32x4*)(Wt + (size_t)(ct * 128 + n) * 1024 + kp * 8); },
            [=](f32x4 (&acc)[4][4], int wr, int wc, int fr, int fq) {
                if (pos != nullptr && ct >= 8 && ct < 16 && wc == 0) {
                    float invf[4];
#pragma unroll
                    for (int c = 0; c < 4; ++c) invf[c] = exp2f(-(float)(fq * 4 + c) * (18.931568569324174f / 16.0f));
#pragma unroll
                    for (int m = 0; m < 4; ++m) {
                        const float pf = (float)pos[rt * 256 + wr * 64 + m * 16 + fr];
#pragma unroll
                        for (int c = 0; c < 4; ++c) {
                            float sn, cs; fsincos(pf * invf[c], sn, cs);
                            const float a = acc[m][0][c], b = acc[m][1][c];
                            acc[m][0][c] = a * cs - b * sn; acc[m][1][c] = b * cs + a * sn;
                        }
                    }
                }
                const float sc = (pos != nullptr && ct >= 8 && ct < 12) ? 0.08838834764831845f : 1.0f;
#pragma unroll
                for (int m = 0; m < 4; ++m)
#pragma unroll
                    for (int n = 0; n < 4; ++n)
                        store_bf16x4(proj + (size_t)(rt * 256 + wr * 64 + m * 16 + fr) * N + ct * 128 + wc * 64 + n * 16 + fq * 4, acc[m][n] * sc);
            });
    }
}

__device__ __forceinline__ void ph_conv0(const Params& P) {
    const bf16_t* proj = (const bf16_t*)(P.ws + WS_PROJ); bf16_t* xc = (bf16_t*)(P.ws + WS_XC);
    const int c8 = (threadIdx.x & 63) * 8;
    float w[4][8], bias[8];
#pragma unroll
    for (int e = 0; e < 8; ++e) { bias[e] = P.in[I_AB_CONVB][c8 + e];
#pragma unroll
        for (int k = 0; k < 4; ++k) w[k][e] = P.in[I_AB_CONVW][k * 512 + c8 + e]; }
    const size_t gtid = (size_t)blockIdx.x * NTHREADS + threadIdx.x, GT = (size_t)gridDim.x * NTHREADS;
    for (size_t i = gtid; i < (size_t)T * 64; i += GT) {
        const int tok = (int)(i >> 6), p = tok & (SEQ - 1);
        float a[8];
#pragma unroll
        for (int e = 0; e < 8; ++e) a[e] = bias[e];
#pragma unroll
        for (int k = 0; k < 4; ++k) {
            if (p - 3 + k >= 0) {
                float xv[8]; unpack8(*(const u32x4*)(proj + (size_t)(tok - 3 + k) * 1536 + c8), xv);
#pragma unroll
                for (int e = 0; e < 8; ++e) a[e] += w[k][e] * xv[e];
            }
        }
        *(u32x4*)(xc + (size_t)tok * 512 + c8) = pack8(a);
    }
}

__device__ __forceinline__ void ph_gates0(const Params& P, lds_t* lds) {
    const bf16_t* xc = (const bf16_t*)(P.ws + WS_XC); const bf16_t* Wg = (const bf16_t*)(P.ws + WS_WG);
    float* af = (float*)(P.ws + WS_AF); float* uf = (float*)(P.ws + WS_UF);
    const float* br = P.in[I_AB_GRB]; const float* bi = P.in[I_AB_GIB]; const float* lam = P.in[I_AB_LAMBDA];
    for (int tile = blockIdx.x; tile < 1024; tile += gridDim.x) {
        const int h = tile & 7, rt = tile >> 3;
        e1_tile<true>(lds, 1,
            [=](int, int r, int kp) { return *(const u32x4*)(xc + (size_t)(rt * 256 + r) * 512 + h * 64 + kp * 8); },
            [=](int, int n, int kp) { return *(const u32x4*)(Wg + (size_t)h * 8192 + n * 64 + kp * 8); },
            [=](f32x4 (&acc)[4][4], int wr, int wc, int fr, int fq) {
#pragma unroll
                for (int n = 0; n < 2; ++n) {
                    const int ch = h * 64 + wc * 32 + n * 16 + fq * 4;
                    float sp[4], brv[4], biv[4];
#pragma unroll
                    for (int c = 0; c < 4; ++c) { const float l = -lam[ch + c]; sp[c] = fmaxf(l, 0.f) + flog(1.0f + fexp(-fabsf(l))); brv[c] = br[ch + c]; biv[c] = bi[ch + c]; }
#pragma unroll
                    for (int m = 0; m < 4; ++m) {
                        const size_t row = (size_t)(rt * 256 + wr * 64 + m * 16 + fr);
                        const u32x2 xr = *(const u32x2*)(xc + row * 512 + ch);
                        const float xv[4] = {__uint_as_float(xr.x << 16), __uint_as_float(xr.x & 0xffff0000u), __uint_as_float(xr.y << 16), __uint_as_float(xr.y & 0xffff0000u)};
                        f32x4 a4, u4;
#pragma unroll
                        for (int c = 0; c < 4; ++c) {
                            const float r = fsigmoid(acc[m][n][c] + brv[c]), ig = fsigmoid(acc[m][n + 2][c] + biv[c]);
                            const float la = -8.0f * r * sp[c], x2 = 2.0f * la;
                            const float om = (x2 > -0.01f) ? -x2 * (1.0f + 0.5f * x2 * (1.0f + x2 * (1.0f / 3.0f))) : 1.0f - fexp(x2);
                            a4[c] = fexp(la); u4[c] = sqrtf(om) * ig * xv[c];
                        }
                        *(f32x4*)(af + row * 512 + ch) = a4; *(f32x4*)(uf + row * 512 + ch) = u4;
                    }
                }
            });
    }
}

__device__ __forceinline__ void ph_lru_scan(const Params& P, lds_t* lds) {
    const float* af = (const float*)(P.ws + WS_AF); const float* uf = (const float*)(P.ws + WS_UF);
    const bf16_t* proj = (const bf16_t*)(P.ws + WS_PROJ); bf16_t* cat = (bf16_t*)(P.ws + WS_CAT);
    LAS float* lA = (LAS float*)lds; LAS float* lH = lA + 512;
    const int tid = threadIdx.x, seg = tid >> 4, c = tid & 15;
    for (int item = blockIdx.x; item < 256; item += gridDim.x) {
        const int b = item >> 5, ch = (item & 31) * 16 + c;
        const size_t base = (size_t)b * SEQ + seg * 128;
        float A = 1.f, H = 0.f;
#pragma unroll 8
        for (int i = 0; i < 128; ++i) { const float a = af[(base + i) * 512 + ch], u = uf[(base + i) * 512 + ch]; H = a * H + u; A *= a; }
        lA[tid] = A; lH[tid] = H;
        __syncthreads();
        float carry = 0.f;
        for (int s = 0; s < seg; ++s) carry = lA[s * 16 + c] * carry + lH[s * 16 + c];
        H = carry;
#pragma unroll 8
        for (int i = 0; i < 128; ++i) {
            const float a = af[(base + i) * 512 + ch], u = uf[(base + i) * 512 + ch]; H = a * H + u;
            const float ga = bf2f(proj[(base + i) * 1536 + 512 + ch]);
            cat[(base + i) * 1024 + ch] = (bf16_t)(pk_bf16(H * gelu_tanh(ga), 0.f) & 0xffffu);
        }
        __syncthreads();
    }
}

__device__ __forceinline__ void ph_s5_state(const Params& P, lds_t* lds) {
    const bf16_t* proj = (const bf16_t*)(P.ws + WS_PROJ); const bf16_t* Wst = (const bf16_t*)(P.ws + WS_S5WST); float* S = (float*)(P.ws + WS_S5S);
    for (int tile = blockIdx.x; tile < 128; tile += gridDim.x) {
        const int g = tile & 31, rt = tile >> 5;
        e1_tile<true>(lds, 8,
            [=](int, int r, int kp) { return *(const u32x4*)(proj + (size_t)((rt * 256 + r) * 32 + (kp >> 1)) * 1536 + 1024 + g * 16 + (kp & 1) * 8); },
            [=](int, int n, int kp) { return *(const u32x4*)(Wst + (size_t)g * 65536 + n * 512 + kp * 8); },
            [=](f32x4 (&acc)[4][4], int wr, int wc, int fr, int fq) {
#pragma unroll
                for (int m = 0; m < 4; ++m)
#pragma unroll
                    for (int n = 0; n < 4; ++n) *(f32x4*)(S + ((size_t)(rt * 256 + wr * 64 + m * 16 + fr) * 32 + g) * 128 + wc * 64 + n * 16 + fq * 4) = acc[m][n];
            });
    }
}

__device__ __forceinline__ void ph_s5_carry(const Params& P) {
    const float* S = (const float*)(P.ws + WS_S5S); bf16_t* X = (bf16_t*)(P.ws + WS_S5X);
    if (threadIdx.x >= 64) return;
    const int p = threadIdx.x;
    for (int it = blockIdx.x; it < 256; it += gridDim.x) {
        const int b = it >> 5, g = it & 31;
        const float lr = fminf(P.in[I_S5_LRE][g * 64 + p], -1e-4f), li = P.in[I_S5_LIM][g * 64 + p], step = expf(P.in[I_S5_STEP][g]);
        const float mag = expf((float)S5TC * lr * step); float sn, cs; sincosf((float)S5TC * li * step, &sn, &cs);
        const float cr = mag * cs, ci = mag * sn;
        float xr = 0.f, xi = 0.f;
        for (int c0 = 0; c0 < 128; c0 += 16) {
            float sr[16], si[16];
#pragma unroll
            for (int j = 0; j < 16; ++j) { const size_t o = ((size_t)(b * 128 + c0 + j) * 32 + g) * 128; sr[j] = S[o + p]; si[j] = S[o + 64 + p]; }
#pragma unroll
            for (int j = 0; j < 16; ++j) {
                const size_t o = ((size_t)(b * 128 + c0 + j) * 32 + g) * 128;
                X[o + p] = (bf16_t)(pk_bf16(xr, 0.f) & 0xffffu); X[o + 64 + p] = (bf16_t)(pk_bf16(xi, 0.f) & 0xffffu);
                const float nr = cr * xr - ci * xi + sr[j], ni = cr * xi + ci * xr + si[j];
                xr = nr; xi = ni;
            }
        }
    }
}

__device__ __forceinline__ void ph_s5_out(const Params& P, lds_t* lds) {
    const bf16_t* proj = (const bf16_t*)(P.ws + WS_PROJ); const bf16_t* Tm = (const bf16_t*)(P.ws + WS_S5TM); const bf16_t* X = (const bf16_t*)(P.ws + WS_S5X);
    bf16_t* sb = (bf16_t*)(P.ws + WS_SB);
    for (int tile = blockIdx.x; tile < 512; tile += gridDim.x) {
        const int ct = tile & 3, g = (tile >> 2) & 31, rt = tile >> 7;
        e1_tile<true>(lds, S5K / 64,
            [=](int, int r, int kp) {
                if (kp < 64) return *(const u32x4*)(proj + (size_t)((rt * 256 + r) * 32 + (kp >> 1)) * 1536 + 1024 + g * 16 + (kp & 1) * 8);
                return *(const u32x4*)(X + ((size_t)(rt * 256 + r) * 32 + g) * 128 + (kp - 64) * 8); },
            [=](int, int n, int kp) { return *(const u32x4*)(Tm + (size_t)g * 512 * S5K + (size_t)(ct * 128 + n) * S5K + kp * 8); },
            [=](f32x4 (&acc)[4][4], int wr, int wc, int fr, int fq) {
#pragma unroll
                for (int m = 0; m < 4; ++m)
#pragma unroll
                    for (int n = 0; n < 4; ++n) {
                        const int col = ct * 128 + wc * 64 + n * 16 + fq * 4, t = col >> 4, h0 = col & 15;
                        const size_t tok = (size_t)(rt * 256 + wr * 64 + m * 16 + fr) * 32 + t;
                        f32x4 y = acc[m][n];
#pragma unroll
                        for (int c = 0; c < 4; ++c) y[c] = gelu_tanh(y[c]);
                        store_bf16x4(sb + tok * 512 + g * 16 + h0, y);
                    }
            });
    }
}

__device__ __forceinline__ void ph_glu(const Params& P, lds_t* lds) {
    const bf16_t* sb = (const bf16_t*)(P.ws + WS_SB); const bf16_t* Wt = (const bf16_t*)(P.ws + WS_WGLU); bf16_t* cat = (bf16_t*)(P.ws + WS_CAT);
    const float* gb = P.in[I_AB_GLUB];
    for (int tile = blockIdx.x; tile < 512; tile += gridDim.x) {
        const int rt = tile >> 2, ct = tile & 3;
        e1_tile<true>(lds, 8,
            [=](int, int r, int kp) { return *(const u32x4*)(sb + (size_t)(rt * 256 + r) * 512 + kp * 8); },
            [=](int, int n, int kp) { return *(const u32x4*)(Wt + (size_t)(ct * 128 + n) * 512 + kp * 8); },
            [=](f32x4 (&acc)[4][4], int wr, int wc, int fr, int fq) {
#pragma unroll
                for (int n = 0; n < 4; ++n) {
                    const int col = ct * 128 + wc * 64 + n * 16 + fq * 4;
                    const f32x4 bv = *(const f32x4*)(gb + col);
#pragma unroll
                    for (int m = 0; m < 4; ++m) {
                        const size_t row = (size_t)(rt * 256 + wr * 64 + m * 16 + fr);
                        const u32x2 sr = *(const u32x2*)(sb + row * 512 + col);
                        const float sv[4] = {__uint_as_float(sr.x << 16), __uint_as_float(sr.x & 0xffff0000u), __uint_as_float(sr.y << 16), __uint_as_float(sr.y & 0xffff0000u)};
                        f32x4 y;
#pragma unroll
                        for (int c = 0; c < 4; ++c) y[c] = sv[c] * fsigmoid(acc[m][n][c] + bv[c]);
                        store_bf16x4(cat + row * 1024 + 512 + col, y);
                    }
                }
            });
    }
}

__device__ __forceinline__ void ph_outproj(const Params& P, lds_t* lds, const bf16_t* Wt, const float* xres) {
    const bf16_t* cat = (const bf16_t*)(P.ws + WS_CAT); float* zf = (float*)(P.ws + WS_ZF);
    for (int tile = blockIdx.x; tile < 1024; tile += gridDim.x) {
        const int rt = tile >> 3, ct = tile & 7;
        e1_tile<true>(lds, 16,
            [=](int, int r, int kp) { return *(const u32x4*)(cat + (size_t)(rt * 256 + r) * 1024 + kp * 8); },
            [=](int, int n, int kp) { return *(const u32x4*)(Wt + (size_t)(ct * 128 + n) * 1024 + kp * 8); },
            [=](f32x4 (&acc)[4][4], int wr, int wc, int fr, int fq) {
#pragma unroll
                for (int m = 0; m < 4; ++m)
#pragma unroll
                    for (int n = 0; n < 4; ++n) {
                        const size_t o = (size_t)(rt * 256 + wr * 64 + m * 16 + fr) * 1024 + ct * 128 + wc * 64 + n * 16 + fq * 4;
                        *(f32x4*)(zf + o) = *(const f32x4*)(xres + o) * ALPHA + acc[m][n];
                    }
            });
    }
}

__device__ __forceinline__ void ph_ln_router(const Params& P, lds_t* lds, int layer) {
    const float* zf = (const float*)(P.ws + WS_ZF); float* x1f = (float*)(P.ws + WS_X1F); bf16_t* xb = (bf16_t*)(P.ws + WS_XB);
    const float* lg = P.in[I_LNM_G] + layer * 1024; const float* lb = P.in[I_LNM_B] + layer * 1024;
    const float* rw = P.in[I_R_W] + (size_t)layer * 1024 * 32; const float* rbias = P.in[I_R_B] + layer * 32;
    int* gcount = (int*)(P.ws + WS_CTL) + 64 * layer;
    int* pair_e = (int*)(P.ws + WS_ROUTE); int* pair_rank = pair_e + T * 4; float* pair_gate = (float*)(pair_rank + T * 4);
    LAS float* Wr = (LAS float*)lds;
    LAS int* hist = (LAS int*)(lds + 147456); LAS int* basev = hist + 32;
    LAS int* pinfo = basev + 32;
    const int tid = threadIdx.x, lane = tid & 63, wave = tid >> 6;
    for (int i = tid; i < 32768; i += NTHREADS) { const int k = i >> 5; Wr[((k & 3) * 256 + (k >> 8) * 64 + ((k >> 2) & 63)) * 36 + (i & 31)] = rw[i]; }
    const float myrb = rbias[lane & 31];
    __syncthreads();
    for (int it = blockIdx.x; it < 512; it += gridDim.x) {
        if (tid < 32) hist[tid] = 0;
        __syncthreads();
        for (int pp = 0; pp < 4; ++pp) {
            f32x4 y[2][4];
#pragma unroll
            for (int rr = 0; rr < 2; ++rr)
#pragma unroll
                for (int j = 0; j < 4; ++j) y[rr][j] = *(const f32x4*)(zf + ((size_t)it * 64 + wave * 8 + pp * 2 + rr) * 1024 + j * 256 + lane * 4);
            f32x2 v2[32];
            int woff = lane * 36; asm volatile("" : "+v"(woff));
#pragma unroll
            for (int rr = 0; rr < 2; ++rr) {
                const size_t row = (size_t)it * 64 + wave * 8 + pp * 2 + rr;
                float s = 0.f;
#pragma unroll
                for (int j = 0; j < 4; ++j) s += (y[rr][j][0] + y[rr][j][1]) + (y[rr][j][2] + y[rr][j][3]);
                const float mean = wave_sum(s) * (1.0f / 1024.0f); float s2 = 0.f;
#pragma unroll
                for (int j = 0; j < 4; ++j) { y[rr][j] = y[rr][j] - mean; s2 += (y[rr][j][0] * y[rr][j][0] + y[rr][j][1] * y[rr][j][1]) + (y[rr][j][2] * y[rr][j][2] + y[rr][j][3] * y[rr][j][3]); }
                const float rstd = rsqrtf(wave_sum(s2) * (1.0f / 1024.0f) + LN_EPS);
#pragma unroll
                for (int j = 0; j < 4; ++j) {
                    y[rr][j] = y[rr][j] * rstd * *(const f32x4*)(lg + j * 256 + lane * 4) + *(const f32x4*)(lb + j * 256 + lane * 4);
                    *(f32x4*)(x1f + row * 1024 + j * 256 + lane * 4) = y[rr][j];
                    store_bf16x4(xb + row * 1024 + j * 256 + lane * 4, y[rr][j]);
                }
            }
#pragma unroll
            for (int e = 0; e < 32; ++e) v2[e] = (f32x2){0.f, 0.f};
#pragma unroll
            for (int j = 0; j < 4; ++j)
#pragma unroll
                for (int c = 0; c < 4; ++c) {
                    const LAS float* wrow = Wr + (c * 256 + j * 64) * 36 + woff;
                    const f32x2 yy = {y[0][j][c], y[1][j][c]};
#pragma unroll
                    for (int e4 = 0; e4 < 8; ++e4) {
                        const f32x4 w = *(const LAS f32x4*)(wrow + 4 * e4);
#pragma unroll
                        for (int q = 0; q < 4; ++q) v2[4 * e4 + q] += yy * w[q];
                    }
                    __builtin_amdgcn_sched_barrier(0);
                }
            float v[2][32];
#pragma unroll
            for (int e = 0; e < 32; ++e) { v[0][e] = v2[e][0]; v[1][e] = v2[e][1]; }
#pragma unroll
            for (int rr = 0; rr < 2; ++rr) {
                const int rl = wave * 8 + pp * 2 + rr;
#pragma unroll
                for (int e = 0; e < 32; ++e) v[rr][e] += __shfl_xor(v[rr][e], 32);
#define TR_STEP(OFF, CNT) _Pragma("unroll") for (int e = 0; e < CNT; ++e) { const bool up = (lane & OFF) != 0; const float send = up ? v[rr][e] : v[rr][e + CNT]; const float keep = up ? v[rr][e + CNT] : v[rr][e]; v[rr][e] = keep + __shfl_xor(send, OFF); }
                TR_STEP(16, 16) TR_STEP(8, 8) TR_STEP(4, 4) TR_STEP(2, 2) TR_STEP(1, 1)
#undef TR_STEP
                float val = v[rr][0] + myrb; const int my = lane & 31;
                float topv[4]; int topi[4];
#pragma unroll
                for (int k = 0; k < 4; ++k) {
                    float bv = val; int bi = my;
#pragma unroll
                    for (int off = 16; off >= 1; off >>= 1) { const float ov = __shfl_xor(bv, off); const int oi = __shfl_xor(bi, off); if (ov > bv || (ov == bv && oi < bi)) { bv = ov; bi = oi; } }
                    topv[k] = bv; topi[k] = bi; if (my == bi) val = -INFINITY;
                }
                if (lane == 0) {
                    const float e1 = expf(topv[1] - topv[0]), e2 = expf(topv[2] - topv[0]), e3 = expf(topv[3] - topv[0]);
                    const float inv = 1.0f / (1.0f + e1 + e2 + e3);
                    const float gt[4] = {inv, e1 * inv, e2 * inv, e3 * inv};
#pragma unroll
                    for (int k = 0; k < 4; ++k) { const int lr = __hip_atomic_fetch_add(&hist[topi[k]], 1, __ATOMIC_RELAXED, __HIP_MEMORY_SCOPE_WORKGROUP); pinfo[(rl * 4 + k) * 3 + 0] = topi[k]; pinfo[(rl * 4 + k) * 3 + 1] = lr; pinfo[(rl * 4 + k) * 3 + 2] = __float_as_int(gt[k]); }
                }
            }
        }
        __syncthreads();
        if (tid < 32) { const int c = hist[tid]; basev[tid] = c ? atomicAdd(gcount + tid, c) : 0; }
        __syncthreads();
        if (tid < 256) {
            const int e = pinfo[tid * 3 + 0]; const size_t pi = (size_t)it * 256 + tid;
            pair_e[pi] = e; pair_rank[pi] = basev[e] + pinfo[tid * 3 + 1]; pair_gate[pi] = __int_as_float(pinfo[tid * 3 + 2]);
        }
        __syncthreads();
    }
}

__device__ __forceinline__ void moe_pstart(const Params& P, lds_t* lds, int layer) {
    LAS int* ps = (LAS int*)(lds + 140 * 1024);
    const int* gcount = (const int*)(P.ws + WS_CTL) + 64 * layer;
    if (threadIdx.x == 0) { int a = 0; for (int e = 0; e < 32; ++e) { const int c = gcount[e]; ps[e] = a; ps[40 + e] = c; a += ((c + 255) >> 8) << 8; } ps[32] = a; }
    __syncthreads();
}

__device__ __forceinline__ void ph_route_scatter(const Params& P, lds_t* lds, int layer) {
    moe_pstart(P, lds, layer);
    LAS int* ps = (LAS int*)(lds + 140 * 1024);
    const int* pair_e = (const int*)(P.ws + WS_ROUTE); const int* pair_rank = pair_e + T * 4; const float* pair_gate = (const float*)(pair_rank + T * 4);
    int* dest = (int*)(pair_gate + T * 4); int* row_tok = dest + T * 4; float* row_gate = (float*)(row_tok + MOE_ROWS);
    const size_t gtid = (size_t)blockIdx.x * NTHREADS + threadIdx.x, GT = (size_t)gridDim.x * NTHREADS;
    for (size_t i = gtid; i < (size_t)T * 4; i += GT) {
        const int e = pair_e[i], pos = ps[e] + pair_rank[i];
        row_tok[pos] = (int)(i >> 2); row_gate[pos] = pair_gate[i]; dest[i] = pos;
    }
    for (size_t i = gtid; i < 32 * 256; i += GT) {
        const int e = (int)(i >> 8), pos = ps[e] + ps[40 + e] + (int)(i & 255);
        if (pos < ps[e + 1]) { row_tok[pos] = 0; row_gate[pos] = 0.f; }
    }
}

__device__ __forceinline__ void ph_moe_up(const Params& P, lds_t* lds, int layer) {
    moe_pstart(P, lds, layer);
    LAS int* ps = (LAS int*)(lds + 140 * 1024);
    const bf16_t* xb = (const bf16_t*)(P.ws + WS_XB); const bf16_t* W = (const bf16_t*)(P.ws + WS_MWIN); bf16_t* hact = (bf16_t*)(P.ws + WS_HACT);
    const int* row_tok = (const int*)(P.ws + WS_ROUTE) + 4 * T * 4;
    const float* b_in = P.in[I_M_BIN] + (size_t)layer * 32 * 2048;
    const int nunits = (ps[32] >> 8) * 16;
    for (int unit = blockIdx.x; unit < nunits; unit += gridDim.x) {
        const int rb = unit >> 4, ct = unit & 15;
        int e = 0; while (ps[e + 1] <= rb * 256) ++e;
        int tok[4];
#pragma unroll
        for (int i = 0; i < 4; ++i) tok[i] = row_tok[rb * 256 + (threadIdx.x >> 3) + 64 * i];
        const bf16_t* We = W + (size_t)e * 2048 * 1024; const float* be = b_in + e * 2048;
        e1_tile<true>(lds, 16,
            [=](int i, int, int kp) { return *(const u32x4*)(xb + (size_t)tok[i] * 1024 + kp * 8); },
            [=](int, int n, int kp) { return *(const u32x4*)(We + (size_t)(ct * 128 + n) * 1024 + kp * 8); },
            [=](f32x4 (&acc)[4][4], int wr, int wc, int fr, int fq) {
#pragma unroll
                for (int n = 0; n < 2; ++n) {
                    const int j = ct * 64 + wc * 32 + n * 16 + fq * 4;
                    const f32x4 bg = *(const f32x4*)(be + j), bl = *(const f32x4*)(be + 1024 + j);
#pragma unroll
                    for (int m = 0; m < 4; ++m) {
                        f32x4 y;
#pragma unroll
                        for (int c = 0; c < 4; ++c) {
                            const float gv = fminf(acc[m][n][c] + bg[c], 7.0f), lv = fminf(fmaxf(acc[m][n + 2][c] + bl[c], -7.0f), 7.0f);
                            y[c] = gv * fsigmoid(1.702f * gv) * (lv + 1.0f);
                        }
                        store_bf16x4(hact + (size_t)(rb * 256 + wr * 64 + m * 16 + fr) * 1024 + j, y);
                    }
                }
            });
    }
}

__device__ __forceinline__ void ph_moe_down(const Params& P, lds_t* lds, int layer) {
    moe_pstart(P, lds, layer);
    LAS int* ps = (LAS int*)(lds + 140 * 1024);
    const bf16_t* hact = (const bf16_t*)(P.ws + WS_HACT); const bf16_t* W = (const bf16_t*)(P.ws + WS_MWOUT); bf16_t* yb = (bf16_t*)(P.ws + WS_YB);
    const float* row_gate = (const float*)((const int*)(P.ws + WS_ROUTE) + 4 * T * 4 + MOE_ROWS);
    const float* b_out = P.in[I_M_BOUT] + (size_t)layer * 32 * 1024;
    const int nunits = (ps[32] >> 8) * 8;
    for (int unit = blockIdx.x; unit < nunits; unit += gridDim.x) {
        const int rb = unit >> 3, ct = unit & 7;
        int e = 0; while (ps[e + 1] <= rb * 256) ++e;
        const bf16_t* We = W + (size_t)e * 1024 * 1024; const float* be = b_out + e * 1024;
        e1_tile<true>(lds, 16,
            [=](int, int r, int kp) { return *(const u32x4*)(hact + (size_t)(rb * 256 + r) * 1024 + kp * 8); },
            [=](int, int n, int kp) { return *(const u32x4*)(We + (size_t)(ct * 128 + n) * 1024 + kp * 8); },
            [=](f32x4 (&acc)[4][4], int wr, int wc, int fr, int fq) {
#pragma unroll
                for (int m = 0; m < 4; ++m) {
                    const int row = rb * 256 + wr * 64 + m * 16 + fr; const float gt = row_gate[row];
#pragma unroll
                    for (int n = 0; n < 4; ++n) {
                        const int col = ct * 128 + wc * 64 + n * 16 + fq * 4;
                        store_bf16x4(yb + (size_t)row * 1024 + col, (acc[m][n] + *(const f32x4*)(be + col)) * gt);
                    }
                }
            });
    }
}

struct EpiInproj {
    bf16_t* proj; int N; const int* pos;
    __device__ __forceinline__ void operator()(f32x4 (&acc)[2][2][4][2], const g2::Unit& u, int wr, int wc, int fr, int fq) const {
#pragma unroll
        for (int bj = 0; bj < 2; ++bj) {
            const int ct = 2 * u.pn + bj;
            if (pos != nullptr && ct >= 8 && ct < 16 && wc == 0) {
                float invf[4];
#pragma unroll
                for (int c = 0; c < 4; ++c) invf[c] = exp2f(-(float)(fq * 4 + c) * (18.931568569324174f / 16.0f));
#pragma unroll
                for (int ai = 0; ai < 2; ++ai)
#pragma unroll
                    for (int m = 0; m < 4; ++m) {
                        const float pf = (float)pos[u.pm * 256 + ai * 128 + wr * 64 + m * 16 + fr];
#pragma unroll
                        for (int c = 0; c < 4; ++c) {
                            float sn, cs; fsincos(pf * invf[c], sn, cs);
                            const float a = acc[ai][bj][m][0][c], b = acc[ai][bj][m][1][c];
                            acc[ai][bj][m][0][c] = a * cs - b * sn; acc[ai][bj][m][1][c] = b * cs + a * sn;
                        }
                    }
            }
            const float sc = (pos != nullptr && ct >= 8 && ct < 12) ? 0.08838834764831845f : 1.0f;
#pragma unroll
            for (int ai = 0; ai < 2; ++ai)
#pragma unroll
                for (int m = 0; m < 4; ++m)
#pragma unroll
                    for (int n = 0; n < 2; ++n)
                        store_bf16x4(proj + (size_t)(u.pm * 256 + ai * 128 + wr * 64 + m * 16 + fr) * N + ct * 128 + wc * 32 + n * 16 + fq * 4, acc[ai][bj][m][n] * sc);
        }
    }
};
__device__ __forceinline__ void ph_inproj2(const Params& P, lds_t* lds, const bf16_t* Wt, int N, const int* pos) {
    g2::DenseSched S{(int)gridDim.x, (int)blockIdx.x, T / 256, N / 256, 1024, (const char*)Wt};
    EpiInproj E{(bf16_t*)(P.ws + WS_PROJ), N, pos};
    g2::gemm_phase(lds, (const char*)(P.ws + WS_XB), 1024, 2048u, S, E);
}
struct EpiOutproj {
    float* zf; const float* xres;
    __device__ __forceinline__ void operator()(f32x4 (&acc)[2][2][4][2], const g2::Unit& u, int wr, int wc, int fr, int fq) const {
#pragma unroll
        for (int ai = 0; ai < 2; ++ai)
#pragma unroll
            for (int m = 0; m < 4; ++m)
#pragma unroll
                for (int bj = 0; bj < 2; ++bj)
#pragma unroll
                    for (int n = 0; n < 2; ++n) {
                        const size_t o = (size_t)(u.pm * 256 + ai * 128 + wr * 64 + m * 16 + fr) * 1024 + u.pn * 256 + bj * 128 + wc * 32 + n * 16 + fq * 4;
                        *(f32x4*)(zf + o) = *(const f32x4*)(xres + o) * ALPHA + acc[ai][bj][m][n];
                    }
    }
};
__device__ __forceinline__ void ph_outproj2(const Params& P, lds_t* lds, const bf16_t* Wt, const float* xres) {
    g2::DenseSched S{(int)gridDim.x, (int)blockIdx.x, T / 256, 4, 1024, (const char*)Wt};
    EpiOutproj E{(float*)(P.ws + WS_ZF), xres};
    g2::gemm_phase(lds, (const char*)(P.ws + WS_CAT), 1024, 2048u, S, E);
}
struct MoeSched {
    int G, c, nM, nN; const char* W; size_t wstride; const int* row_tok; LAS int* ps;
    __device__ __forceinline__ bool next(int i, g2::Unit& u) const { return g2::static_next(i, G, c, nM, nN, u); }
    __device__ __forceinline__ int expert(int pm) const { int e = 0; while (ps[e + 1] <= pm * 256) ++e; return e; }
    __device__ __forceinline__ void a_off(const g2::Unit& u, const int (&Rs)[2], const int (&Cs)[2], unsigned (&ao)[2][2]) const {
#pragma unroll
        for (int h = 0; h < 2; ++h)
#pragma unroll
            for (int i = 0; i < 2; ++i) {
                const int r = u.pm * 256 + h * 128 + Rs[i];
                const unsigned row = row_tok ? (unsigned)row_tok[r] : (unsigned)r;
                ao[h][i] = (row * 1024u + (unsigned)Cs[i]) * 2u;
            }
    }
    __device__ __forceinline__ const char* b_base(const g2::Unit& u) const { return W + (size_t)expert(u.pm) * wstride + (size_t)u.pn * 256 * 2048; }
};
struct EpiMoeUp {
    bf16_t* hact; const float* b_in; LAS int* ps;
    __device__ __forceinline__ void operator()(f32x4 (&acc)[2][2][4][2], const g2::Unit& u, int wr, int wc, int fr, int fq) const {
        int e = 0; while (ps[e + 1] <= u.pm * 256) ++e;
        const float* be = b_in + e * 2048;
#pragma unroll
        for (int n = 0; n < 2; ++n) {
            const int j = u.pn * 128 + wc * 32 + n * 16 + fq * 4;
            const f32x4 bg = *(const f32x4*)(be + j), bl = *(const f32x4*)(be + 1024 + j);
#pragma unroll
            for (int ai = 0; ai < 2; ++ai)
#pragma unroll
                for (int m = 0; m < 4; ++m) {
                    f32x4 y;
#pragma unroll
                    for (int c = 0; c < 4; ++c) {
                        const float gv = fminf(acc[ai][0][m][n][c] + bg[c], 7.0f), lv = fminf(fmaxf(acc[ai][1][m][n][c] + bl[c], -7.0f), 7.0f);
                        y[c] = gv * fsigmoid(1.702f * gv) * (lv + 1.0f);
                    }
                    store_bf16x4(hact + (size_t)(u.pm * 256 + ai * 128 + wr * 64 + m * 16 + fr) * 1024 + j, y);
                }
        }
    }
};
__device__ __forceinline__ void ph_moe_up2(const Params& P, lds_t* lds, int layer) {
    moe_pstart(P, lds, layer);
    LAS int* ps = (LAS int*)(lds + 140 * 1024);
    const int* row_tok = (const int*)(P.ws + WS_ROUTE) + 4 * T * 4;
    MoeSched S{(int)gridDim.x, (int)blockIdx.x, ps[32] >> 8, 8, (const char*)(P.ws + WS_MWIN), (size_t)2048 * 1024 * 2, row_tok, ps};
    EpiMoeUp E{(bf16_t*)(P.ws + WS_HACT), P.in[I_M_BIN] + (size_t)layer * 32 * 2048, ps};
    g2::gemm_phase(lds, (const char*)(P.ws + WS_XB), 1024, 2048u, S, E);
}
struct EpiMoeDown {
    bf16_t* yb; const float* b_out; const float* row_gate; LAS int* ps;
    __device__ __forceinline__ void operator()(f32x4 (&acc)[2][2][4][2], const g2::Unit& u, int wr, int wc, int fr, int fq) const {
        int e = 0; while (ps[e + 1] <= u.pm * 256) ++e;
        const float* be = b_out + e * 1024;
#pragma unroll
        for (int ai = 0; ai < 2; ++ai)
#pragma unroll
            for (int m = 0; m < 4; ++m) {
                const int row = u.pm * 256 + ai * 128 + wr * 64 + m * 16 + fr; const float gt = row_gate[row];
#pragma unroll
                for (int bj = 0; bj < 2; ++bj)
#pragma unroll
                    for (int n = 0; n < 2; ++n) {
                        const int col = u.pn * 256 + bj * 128 + wc * 32 + n * 16 + fq * 4;
                        store_bf16x4(yb + (size_t)row * 1024 + col, (acc[ai][bj][m][n] + *(const f32x4*)(be + col)) * gt);
                    }
            }
    }
};
__device__ __forceinline__ void ph_moe_down2(const Params& P, lds_t* lds, int layer) {
    moe_pstart(P, lds, layer);
    LAS int* ps = (LAS int*)(lds + 140 * 1024);
    const float* row_gate = (const float*)((const int*)(P.ws + WS_ROUTE) + 4 * T * 4 + MOE_ROWS);
    MoeSched S{(int)gridDim.x, (int)blockIdx.x, ps[32] >> 8, 4, (const char*)(P.ws + WS_MWOUT), (size_t)1024 * 1024 * 2, nullptr, ps};
    EpiMoeDown E{(bf16_t*)(P.ws + WS_YB), P.in[I_M_BOUT] + (size_t)layer * 32 * 1024, row_gate, ps};
    g2::gemm_phase(lds, (const char*)(P.ws + WS_HACT), 1024, 2048u, S, E);
}

__device__ __forceinline__ void ph_combine_ln(const Params& P, int layer, float* outf, bool write_bf) {
    float* x1f = (float*)(P.ws + WS_X1F); const bf16_t* yb = (const bf16_t*)(P.ws + WS_YB); bf16_t* xb = (bf16_t*)(P.ws + WS_XB);
    const int* dest = (const int*)(P.ws + WS_ROUTE) + 3 * T * 4;
    const float* lg = P.in[I_LNF_G] + layer * 1024; const float* lb = P.in[I_LNF_B] + layer * 1024;
    const int lane = threadIdx.x & 63, gw = blockIdx.x * 8 + (threadIdx.x >> 6), NGW = gridDim.x * 8;
    for (int row0 = gw * 2; row0 < T; row0 += NGW * 2) {
        f32x4 v[2][4]; u32x2 yr[2][4][4];
#pragma unroll
        for (int rr = 0; rr < 2; ++rr) {
            const int row = row0 + rr;
            const int4 d = *(const int4*)(dest + row * 4);
            const int dd[4] = {d.x, d.y, d.z, d.w};
#pragma unroll
            for (int j = 0; j < 4; ++j) {
                v[rr][j] = *(const f32x4*)(x1f + (size_t)row * 1024 + j * 256 + lane * 4);
#pragma unroll
                for (int k = 0; k < 4; ++k) yr[rr][j][k] = *(const u32x2*)(yb + (size_t)dd[k] * 1024 + j * 256 + lane * 4);
            }
        }
#pragma unroll
        for (int rr = 0; rr < 2; ++rr) {
            const int row = row0 + rr; float s = 0.f;
#pragma unroll
            for (int j = 0; j < 4; ++j) {
                v[rr][j] = v[rr][j] * ALPHA;
#pragma unroll
                for (int k = 0; k < 4; ++k) {
                    const u32x2 r = yr[rr][j][k];
                    v[rr][j][0] += __uint_as_float(r.x << 16); v[rr][j][1] += __uint_as_float(r.x & 0xffff0000u); v[rr][j][2] += __uint_as_float(r.y << 16); v[rr][j][3] += __uint_as_float(r.y & 0xffff0000u);
                }
                s += (v[rr][j][0] + v[rr][j][1]) + (v[rr][j][2] + v[rr][j][3]);
            }
            const float mean = wave_sum(s) * (1.0f / 1024.0f); float s2 = 0.f;
#pragma unroll
            for (int j = 0; j < 4; ++j) { v[rr][j] = v[rr][j] - mean; s2 += (v[rr][j][0] * v[rr][j][0] + v[rr][j][1] * v[rr][j][1]) + (v[rr][j][2] * v[rr][j][2] + v[rr][j][3] * v[rr][j][3]); }
            const float rstd = rsqrtf(wave_sum(s2) * (1.0f / 1024.0f) + LN_EPS);
#pragma unroll
            for (int j = 0; j < 4; ++j) {
                const f32x4 o = v[rr][j] * rstd * *(const f32x4*)(lg + j * 256 + lane * 4) + *(const f32x4*)(lb + j * 256 + lane * 4);
                *(f32x4*)(outf + (size_t)row * 1024 + j * 256 + lane * 4) = o;
                if (write_bf) store_bf16x4(xb + (size_t)row * 1024 + j * 256 + lane * 4, o);
            }
        }
    }
}

__device__ __forceinline__ void ph_conv1(const Params& P, lds_t* lds) {
    const bf16_t* proj = (const bf16_t*)(P.ws + WS_PROJ); bf16_t* xconv = (bf16_t*)(P.ws + WS_XCONV); float* gates = (float*)(P.ws + WS_GATES);
    LAS float* Wc = (LAS float*)lds;
    const float* Wcg = (const float*)(P.ws + WS_WC);
    for (int i = threadIdx.x; i < 8192; i += NTHREADS) Wc[i] = Wcg[i];
    __syncthreads();
    const int lane = threadIdx.x & 63, gw = blockIdx.x * 8 + (threadIdx.x >> 6), NGW = gridDim.x * 8, c8 = lane * 8;
    float w[4][8], bias[8];
#pragma unroll
    for (int e = 0; e < 8; ++e) { bias[e] = P.in[I_CD_CONVB][c8 + e];
#pragma unroll
        for (int k = 0; k < 4; ++k) w[k][e] = P.in[I_CD_CONVW][k * 512 + c8 + e]; }
    const float bif = P.in[I_CD_BIF][lane & 7];
    for (int tok = gw; tok < T; tok += NGW) {
        const int p = tok & (SEQ - 1);
        float a[8], xraw[8];
#pragma unroll
        for (int e = 0; e < 8; ++e) { a[e] = bias[e]; xraw[e] = 0.f; }
#pragma unroll
        for (int k = 0; k < 4; ++k) {
            if (p - 3 + k >= 0) {
                float xv[8]; unpack8(*(const u32x4*)(proj + (size_t)(tok - 3 + k) * 2560 + c8), xv);
#pragma unroll
                for (int e = 0; e < 8; ++e) { a[e] += w[k][e] * xv[e]; if (k == 3) xraw[e] = xv[e]; }
            }
        }
#pragma unroll
        for (int e = 0; e < 8; ++e) a[e] = a[e] * fsigmoid(a[e]);
        const u32x4 packed = pack8(a);
        *(u32x4*)(xconv + (size_t)tok * 512 + c8) = packed;
        float ar[8]; unpack8(packed, ar);
        float gs[8];
#pragma unroll
        for (int gg = 0; gg < 8; ++gg) gs[gg] = 0.f;
#pragma unroll
        for (int e = 0; e < 8; ++e) {
            const f32x4 w1a = *(LAS f32x4*)(Wc + (c8 + e) * 8), w1b = *(LAS f32x4*)(Wc + (c8 + e) * 8 + 4);
            const f32x4 w2a = *(LAS f32x4*)(Wc + 4096 + (c8 + e) * 8), w2b = *(LAS f32x4*)(Wc + 4096 + (c8 + e) * 8 + 4);
#pragma unroll
            for (int gg = 0; gg < 4; ++gg) { gs[gg] += ar[e] * w1a[gg] + xraw[e] * w2a[gg]; gs[gg + 4] += ar[e] * w1b[gg] + xraw[e] * w2b[gg]; }
        }
        float mine = 0.f;
#pragma unroll
        for (int gg = 0; gg < 8; ++gg) { const float tsum = wave_sum(gs[gg]); if ((lane & 7) == gg) mine = tsum; }
        if (lane < 8) gates[(size_t)tok * 8 + lane] = mine + bif;
    }
}

__device__ __forceinline__ void ph_qkv(const Params& P, lds_t* lds) {
    const bf16_t* xconv = (const bf16_t*)(P.ws + WS_XCONV); const bf16_t* proj = (const bf16_t*)(P.ws + WS_PROJ); const bf16_t* Wt = (const bf16_t*)(P.ws + WS_WQKV);
    for (int tile = blockIdx.x; tile < 1536; tile += gridDim.x) {
        const int which = tile % 3, rt = (tile / 3) & 127, h = tile / 384;
        const bf16_t* A = which < 2 ? xconv : proj; const int lda = which < 2 ? 512 : 2560;
        bf16_t* out = (bf16_t*)(P.ws + (which == 0 ? WS_QB : (which == 1 ? WS_KB : WS_VB)));
        const float sc = which == 1 ? 0.08838834764831845f : 1.0f;
        const bf16_t* Wh = Wt + (size_t)(which * 4 + h) * 16384;
        e1_tile<true>(lds, 2,
            [=](int, int r, int kp) { return *(const u32x4*)(A + (size_t)(rt * 256 + r) * lda + h * 128 + kp * 8); },
            [=](int, int n, int kp) { return *(const u32x4*)(Wh + n * 128 + kp * 8); },
            [=](f32x4 (&acc)[4][4], int wr, int wc, int fr, int fq) {
#pragma unroll
                for (int m = 0; m < 4; ++m)
#pragma unroll
                    for (int n = 0; n < 4; ++n)
                        store_bf16x4(out + (size_t)(rt * 256 + wr * 64 + m * 16 + fr) * 512 + h * 128 + wc * 64 + n * 16 + fq * 4, acc[m][n] * sc);
            });
    }
}

constexpr int TP = 272;
template <int NROWS>
__device__ __forceinline__ void stage_tile(lds_t* dst, const bf16_t* src, size_t src_ld) {
    constexpr int NP = NROWS * 16 / NTHREADS;
    u32x4 r[NP];
#pragma unroll
    for (int i = 0; i < NP; ++i) { const int p = threadIdx.x + i * NTHREADS; r[i] = *(const u32x4*)(src + (size_t)(p >> 4) * src_ld + (p & 15) * 8); }
#pragma unroll
    for (int i = 0; i < NP; ++i) { const int p = threadIdx.x + i * NTHREADS; *(LAS u32x4*)(dst + (p >> 4) * TP + (p & 15) * 16) = r[i]; }
}

__device__ __forceinline__ void ph_m1(const Params& P, lds_t* lds) {
    const bf16_t* kb = (const bf16_t*)(P.ws + WS_KB); const bf16_t* vb = (const bf16_t*)(P.ws + WS_VB); const float* gates = (const float*)(P.ws + WS_GATES);
    float* kvc = (float*)(P.ws + WS_KVC); float* nchunk = (float*)(P.ws + WS_MISC); float* scal = nchunk + 2 * 2048 * 128;
    lds_t* Kt = lds; lds_t* Vt = lds + 64 * TP; LAS float* wv = (LAS float*)(lds + 128 * TP);
    const int tid = threadIdx.x, lane = tid & 63, w = tid >> 6, fr = lane & 15, fq = lane >> 4, q = (lane & 15) >> 2, p4 = lane & 3;
    for (int item = blockIdx.x; item < 2048; item += gridDim.x) {
        const int bh = item >> 6, n = item & 63, b = bh >> 2, h = bh & 3; const size_t tok0 = (size_t)b * SEQ + n * 64;
        stage_tile<64>(Kt, kb + tok0 * 512 + h * 128, 512);
        stage_tile<64>(Vt, vb + tok0 * 512 + h * 128, 512);
        if (w == 0) {
            const float f = gates[(tok0 + lane) * 8 + 4 + h], ig = gates[(tok0 + lane) * 8 + h];
            float cum = logsigmoidf(f);
#pragma unroll
            for (int off = 1; off < 64; off <<= 1) { const float t = __shfl_up(cum, off); if (lane >= off) cum += t; }
            const float cf = __shfl(cum, 63), te = cf - cum + ig, m = wave_max(te);
            wv[lane] = expf(te - m);
            if (lane == 0) { scal[item] = cf; scal[2048 + item] = m; }
        }
        __syncthreads();
        bf16x8 af[2]; float nsum = 0.f;
#pragma unroll
        for (int ks = 0; ks < 2; ++ks) {
            unsigned pk[4];
#pragma unroll
            for (int t = 0; t < 2; ++t) {
                const int s0 = 32 * ks + 8 * fq + 4 * t;
                const bf16x4 r = tr_read(Kt + (s0 + q) * TP + (16 * w + 4 * p4) * 2);
                const f32x4 ww = *(LAS f32x4*)(wv + s0);
                float x[4];
#pragma unroll
                for (int e = 0; e < 4; ++e) { x[e] = bf2f((unsigned short)r[e]) * ww[e]; nsum += x[e]; }
                pk[2 * t] = pk_bf16(x[0], x[1]); pk[2 * t + 1] = pk_bf16(x[2], x[3]);
            }
            u32x4 u = {pk[0], pk[1], pk[2], pk[3]}; af[ks] = __builtin_bit_cast(bf16x8, u);
        }
        nsum += __shfl_xor(nsum, 16); nsum += __shfl_xor(nsum, 32);
        if (fq == 0) nchunk[(size_t)item * 128 + 16 * w + fr] = nsum;
#pragma unroll
        for (int c = 0; c < 8; ++c) {
            f32x4 acc = {0.f, 0.f, 0.f, 0.f};
#pragma unroll
            for (int ks = 0; ks < 2; ++ks) {
                const int s0 = 32 * ks + 8 * fq;
                const bf16x8 bfv = cat44(tr_read(Vt + (s0 + q) * TP + (16 * c + 4 * p4) * 2), tr_read(Vt + (s0 + 4 + q) * TP + (16 * c + 4 * p4) * 2));
                acc = MFMA16(af[ks], bfv, acc);
            }
            *(f32x4*)(kvc + ((size_t)item * 128 + c * 16 + fr) * 128 + 16 * w + fq * 4) = acc;
        }
        __syncthreads();
    }
}

__device__ __forceinline__ void ph_m2(const Params& P) {
    const float* kvc = (const float*)(P.ws + WS_KVC); bf16_t* cprev = (bf16_t*)(P.ws + WS_CPREV);
    const float* nchunk = (const float*)(P.ws + WS_MISC); float* nprev = (float*)(P.ws + WS_MISC) + 2048 * 128; float* scal = (float*)(P.ws + WS_MISC) + 2 * 2048 * 128;
    const int tid = threadIdx.x;
    for (int it = blockIdx.x; it < 256; it += gridDim.x) {
        const int bh = it >> 3, sl = it & 7, idx = sl * 2048 + tid * 4;
        const bool donv = (sl == 0 && tid < 128);
        f32x4 C = {0.f, 0.f, 0.f, 0.f}; float nv = 0.f, m = -INFINITY;
        for (int n0 = 0; n0 < 64; n0 += 4) {
            f32x4 kv[4]; float nc[4], fc[4], mc[4];
#pragma unroll
            for (int j = 0; j < 4; ++j) {
                const int item = bh * 64 + n0 + j;
                kv[j] = *(const f32x4*)(kvc + (size_t)item * 16384 + idx);
                nc[j] = donv ? nchunk[(size_t)item * 128 + tid] : 0.f;
                fc[j] = scal[item]; mc[j] = scal[2048 + item];
            }
#pragma unroll
            for (int j = 0; j < 4; ++j) {
                const int item = bh * 64 + n0 + j;
                store_bf16x4(cprev + (size_t)item * 16384 + idx, C);
                if (donv) nprev[(size_t)item * 128 + tid] = nv;
                if (sl == 0 && tid == 0) scal[4096 + item] = m;
                const float mn = fmaxf(fc[j] + m, mc[j]), so = expf(fc[j] + m - mn), sn = expf(mc[j] - mn);
                C = C * so + kv[j] * sn; nv = so * nv + sn * nc[j]; m = mn;
            }
        }
    }
}

__device__ __forceinline__ void ph_m3(const Params& P, lds_t* lds) {
    const bf16_t* qb = (const bf16_t*)(P.ws + WS_QB); const bf16_t* kb = (const bf16_t*)(P.ws + WS_KB); const bf16_t* vb = (const bf16_t*)(P.ws + WS_VB);
    const bf16_t* cprev = (const bf16_t*)(P.ws + WS_CPREV); const float* gates = (const float*)(P.ws + WS_GATES);
    const float* nprev = (const float*)(P.ws + WS_MISC) + 2048 * 128; const float* scal = (const float*)(P.ws + WS_MISC) + 2 * 2048 * 128;
    const bf16_t* proj = (const bf16_t*)(P.ws + WS_PROJ); bf16_t* cat = (bf16_t*)(P.ws + WS_CAT);
    lds_t* Qt = lds; lds_t* Kt = lds + 64 * TP; lds_t* Vt = lds + 128 * TP; lds_t* Ct = lds + 192 * TP;
    LAS float* cumf = (LAS float*)(lds + 320 * TP); LAS float* gv = cumf + 64; LAS float* msv = gv + 64; LAS float* npv = msv + 64; LAS float* ex = npv + 128;
    const int tid = threadIdx.x, lane = tid & 63, w = tid >> 6, fr = lane & 15, fq = lane >> 4, q = (lane & 15) >> 2, p4 = lane & 3;
    const int rt = w & 3, vh = w >> 2;
    for (int item = blockIdx.x; item < 2048; item += gridDim.x) {
        const int bh = item >> 6, n = item & 63, b = bh >> 2, h = bh & 3; const size_t tok0 = (size_t)b * SEQ + n * 64;
        stage_tile<64>(Qt, qb + tok0 * 512 + h * 128, 512);
        stage_tile<64>(Kt, kb + tok0 * 512 + h * 128, 512);
        stage_tile<64>(Vt, vb + tok0 * 512 + h * 128, 512);
        stage_tile<128>(Ct, cprev + (size_t)item * 16384, 128);
        if (tid < 128) npv[tid] = nprev[(size_t)item * 128 + tid];
        const float mp = scal[4096 + item];
        if (w == 0) {
            const float f = gates[(tok0 + lane) * 8 + 4 + h], ig = gates[(tok0 + lane) * 8 + h];
            float cum = logsigmoidf(f);
#pragma unroll
            for (int off = 1; off < 64; off <<= 1) { const float t = __shfl_up(cum, off); if (lane >= off) cum += t; }
            const float gg = ig - cum; float pm = gg;
#pragma unroll
            for (int off = 1; off < 64; off <<= 1) { const float t = __shfl_up(pm, off); if (lane >= off) pm = fmaxf(pm, t); }
            cumf[lane] = cum; gv[lane] = gg; msv[lane] = cum + fmaxf(pm, mp);
        }
        __syncthreads();
        bf16x8 qf[4];
#pragma unroll
        for (int ks = 0; ks < 4; ++ks) qf[ks] = *(LAS bf16x8*)(Qt + (rt * 16 + fr) * TP + ks * 64 + fq * 16);
        const int s = rt * 16 + fr; const float cs = cumf[s], mss = msv[s];
        float sp[4][4]; float rowsum = 0.f;
#pragma unroll
        for (int jt = 0; jt < 4; ++jt) {
            f32x4 st = {0.f, 0.f, 0.f, 0.f};
            if (jt <= rt) {
#pragma unroll
                for (int ks = 0; ks < 4; ++ks) st = MFMA16(*(LAS bf16x8*)(Kt + (jt * 16 + fr) * TP + ks * 64 + fq * 16), qf[ks], st);
            }
            const f32x4 g4 = *(LAS f32x4*)(gv + jt * 16 + fq * 4);
#pragma unroll
            for (int r = 0; r < 4; ++r) { const int j = jt * 16 + fq * 4 + r; const float wgt = (j <= s) ? fexp(cs + g4[r] - mss) : 0.f; sp[jt][r] = st[r] * wgt; rowsum += sp[jt][r]; }
        }
        rowsum += __shfl_xor(rowsum, 16); rowsum += __shfl_xor(rowsum, 32);
        float qn = 0.f;
#pragma unroll
        for (int ks = 0; ks < 4; ++ks) {
            const f32x4 n0 = *(LAS f32x4*)(npv + ks * 32 + fq * 8), n1 = *(LAS f32x4*)(npv + ks * 32 + fq * 8 + 4);
#pragma unroll
            for (int e = 0; e < 4; ++e) { qn += bf2f((unsigned short)qf[ks][e]) * n0[e]; qn += bf2f((unsigned short)qf[ks][4 + e]) * n1[e]; }
        }
        qn += __shfl_xor(qn, 16); qn += __shfl_xor(qn, 32);
        const float inter = expf(cs + mp - mss), den = rowsum + inter * qn, inv = 1.0f / fmaxf(fabsf(den), expf(-mss));
        if (fq == 0) { ex[w * 32 + fr] = inv; ex[w * 32 + 16 + fr] = inter; }
        __builtin_amdgcn_wave_barrier();
        const f32x4 inv4 = *(LAS f32x4*)(ex + w * 32 + fq * 4), int4 = *(LAS f32x4*)(ex + w * 32 + 16 + fq * 4);
        bf16x8 pa[2];
#pragma unroll
        for (int kk = 0; kk < 2; ++kk) { u32x4 u = {pk_bf16(sp[2 * kk][0], sp[2 * kk][1]), pk_bf16(sp[2 * kk][2], sp[2 * kk][3]), pk_bf16(sp[2 * kk + 1][0], sp[2 * kk + 1][1]), pk_bf16(sp[2 * kk + 1][2], sp[2 * kk + 1][3])}; pa[kk] = __builtin_bit_cast(bf16x8, u); }
#pragma unroll
        for (int c = 0; c < 4; ++c) {
            const int vcol = vh * 64 + c * 16;
            f32x4 acc = {0.f, 0.f, 0.f, 0.f};
#pragma unroll
            for (int ks = 0; ks < 4; ++ks) acc = MFMA16(qf[ks], *(LAS bf16x8*)(Ct + (vcol + fr) * TP + ks * 64 + fq * 16), acc);
#pragma unroll
            for (int r = 0; r < 4; ++r) acc[r] *= int4[r];
#pragma unroll
            for (int kk = 0; kk < 2; ++kk) {
                const bf16x8 vbf = cat44(tr_read(Vt + (32 * kk + 4 * fq + q) * TP + (vcol + 4 * p4) * 2), tr_read(Vt + (32 * kk + 16 + 4 * fq + q) * TP + (vcol + 4 * p4) * 2));
                acc = MFMA16(pa[kk], vbf, acc);
            }
#pragma unroll
            for (int r = 0; r < 4; ++r) {
                const size_t tok = tok0 + rt * 16 + fq * 4 + r; const int col = h * 128 + vcol + fr;
                const float op = bf2f(proj[tok * 2560 + 512 + col]);
                cat[tok * 1024 + col] = (bf16_t)(pk_bf16(fsigmoid(op) * acc[r] * inv4[r], 0.f) & 0xffffu);
            }
        }
        __syncthreads();
    }
}

__device__ __forceinline__ void ph_attn(const Params& P, lds_t* lds) {
    const bf16_t* proj = (const bf16_t*)(P.ws + WS_PROJ); float* atto = (float*)(P.ws + WS_ATTO); float* lse = (float*)(P.ws + WS_LSE);
    lds_t* Kt = lds; lds_t* Vt = lds + 256 * TP; LAS float* ex = (LAS float*)(lds + 512 * TP);
    const int tid = threadIdx.x, lane = tid & 63, w = tid >> 6, fr = lane & 15, fq = lane >> 4, q = (lane & 15) >> 2, p4 = lane & 3;
    for (int item = blockIdx.x; item < 3072; item += gridDim.x) {
        const int g = item >> 10, rem = item & 1023, h = rem & 3, x = rem >> 2, b = x >> 5, y = x & 31;
        const int dsh = 2 * g, dil = 1 << dsh, nbsh = 5 - dsh, r = y >> nbsh, nb = y & ((1 << nbsh) - 1);
        const size_t tokb = (size_t)b * SEQ + r;
#pragma unroll
        for (int kvsel = 0; kvsel < 2; ++kvsel) {
            u32x4 rg[8];
#pragma unroll
            for (int it8 = 0; it8 < 8; ++it8) {
                const int p = tid + it8 * NTHREADS, kr = p >> 4, pc = p & 15; const int i = nb * 128 + kr - 128;
                rg[it8] = (u32x4){0u, 0u, 0u, 0u};
                if (i >= 0) rg[it8] = *(const u32x4*)(proj + (tokb + (size_t)i * dil) * 2560 + (kvsel ? 2048 : 1536) + h * 128 + pc * 8);
            }
#pragma unroll
            for (int it8 = 0; it8 < 8; ++it8) { const int p = tid + it8 * NTHREADS, kr = p >> 4, pc = p & 15; *(LAS u32x4*)((kvsel ? Vt : Kt) + kr * TP + pc * 16) = rg[it8]; }
        }
        const int qi = w * 16 + fr;
        const size_t tokq = tokb + (size_t)(nb * 128 + qi) * dil;
        bf16x8 qf[4];
#pragma unroll
        for (int ks = 0; ks < 4; ++ks) qf[ks] = __builtin_bit_cast(bf16x8, *(const u32x4*)(proj + tokq * 2560 + 1024 + h * 128 + ks * 32 + fq * 8));
        __syncthreads();
        float pv[9][4]; float mx = -INFINITY;
#pragma unroll
        for (int jj = 0; jj < 9; ++jj) {
            f32x4 st = {0.f, 0.f, 0.f, 0.f};
#pragma unroll
            for (int ks = 0; ks < 4; ++ks) st = MFMA16(*(LAS bf16x8*)(Kt + ((w + jj) * 16 + fr) * TP + ks * 64 + fq * 16), qf[ks], st);
#pragma unroll
            for (int rr = 0; rr < 4; ++rr) {
                const int kj = (w + jj) * 16 + fq * 4 + rr;
                const bool valid = (kj >= qi) && (kj <= qi + 128) && (nb > 0 || kj >= 128);
                pv[jj][rr] = valid ? st[rr] : -INFINITY; mx = fmaxf(mx, pv[jj][rr]);
            }
        }
        mx = fmaxf(mx, __shfl_xor(mx, 16)); mx = fmaxf(mx, __shfl_xor(mx, 32));
        float l = 0.f;
#pragma unroll
        for (int jj = 0; jj < 9; ++jj)
#pragma unroll
            for (int rr = 0; rr < 4; ++rr) { pv[jj][rr] = fexp(pv[jj][rr] - mx); l += pv[jj][rr]; }
        l += __shfl_xor(l, 16); l += __shfl_xor(l, 32);
        if (fq == 0) { ex[w * 16 + fr] = 1.0f / l; lse[((size_t)g * T + tokq) * 4 + h] = mx + logf(l); }
        __builtin_amdgcn_wave_barrier();
        const f32x4 inv4 = *(LAS f32x4*)(ex + w * 16 + fq * 4);
        f32x4 acc[8];
#pragma unroll
        for (int c = 0; c < 8; ++c) acc[c] = (f32x4){0.f, 0.f, 0.f, 0.f};
#pragma unroll
        for (int kk = 0; kk < 5; ++kk) {
            const int ja = 2 * kk, jb = (2 * kk + 1 < 9) ? 2 * kk + 1 : 2 * kk;
            u32x4 u; u.x = pk_bf16(pv[ja][0], pv[ja][1]); u.y = pk_bf16(pv[ja][2], pv[ja][3]);
            if (2 * kk + 1 < 9) { u.z = pk_bf16(pv[jb][0], pv[jb][1]); u.w = pk_bf16(pv[jb][2], pv[jb][3]); } else { u.z = 0u; u.w = 0u; }
            const bf16x8 pa = __builtin_bit_cast(bf16x8, u);
#pragma unroll
            for (int c = 0; c < 8; ++c) {
                const bf16x8 vbf = cat44(tr_read(Vt + ((w + ja) * 16 + 4 * fq + q) * TP + (c * 16 + 4 * p4) * 2), tr_read(Vt + ((w + jb) * 16 + 4 * fq + q) * TP + (c * 16 + 4 * p4) * 2));
                acc[c] = MFMA16(pa, vbf, acc[c]);
            }
        }
#pragma unroll
        for (int rr = 0; rr < 4; ++rr) {
            const size_t tq = tokb + (size_t)(nb * 128 + w * 16 + fq * 4 + rr) * dil;
#pragma unroll
            for (int c = 0; c < 8; ++c) atto[((size_t)g * T + tq) * 512 + h * 128 + c * 16 + fr] = acc[c][rr] * inv4[rr];
        }
        __syncthreads();
    }
}

__device__ __forceinline__ void ph_attn_combine(const Params& P) {
    const float* atto = (const float*)(P.ws + WS_ATTO); const float* lse = (const float*)(P.ws + WS_LSE); bf16_t* cat = (bf16_t*)(P.ws + WS_CAT);
    const size_t gtid = (size_t)blockIdx.x * NTHREADS + threadIdx.x, GT = (size_t)gridDim.x * NTHREADS;
    for (size_t i = gtid; i < (size_t)T * 128; i += GT) {
        const size_t tok = i >> 7; const int c4 = (int)(i & 127) * 4, h = c4 >> 7;
        const float l0 = lse[tok * 4 + h], l1 = lse[((size_t)T + tok) * 4 + h], l2 = lse[((size_t)2 * T + tok) * 4 + h];
        const float mx = fmaxf(l0, fmaxf(l1, l2)), e0 = expf(l0 - mx), e1 = expf(l1 - mx), e2 = expf(l2 - mx), inv = 1.0f / (e0 + e1 + e2);
        const f32x4 o = (*(const f32x4*)(atto + tok * 512 + c4) * e0 + *(const f32x4*)(atto + ((size_t)T + tok) * 512 + c4) * e1 + *(const f32x4*)(atto + ((size_t)2 * T + tok) * 512 + c4) * e2) * inv;
        store_bf16x4(cat + tok * 1024 + 512 + c4, o);
    }
}

constexpr int NPHASES = 33;
__device__ __forceinline__ void grid_barrier(cg::grid_group& grid) {
    asm volatile("s_waitcnt vmcnt(0)" ::: "memory");
    grid.sync();
    __builtin_amdgcn_fence(__ATOMIC_ACQUIRE, "agent");
    asm volatile("s_waitcnt vmcnt(0)" ::: "memory");
}
typedef __attribute__((address_space(4))) const Params* KP4;
__device__ __forceinline__ const Params& phase_params() { KP4 kp = (KP4)__builtin_amdgcn_kernarg_segment_ptr(); asm volatile("" : "+s"(kp)); return *(const Params*)kp; }
__global__ void __launch_bounds__(NTHREADS) fwd_megakernel(Params Pk) {
    extern __shared__ __attribute__((aligned(16))) unsigned char lds_raw[];
    lds_t* lds = (lds_t*)lds_raw;
    cg::grid_group grid = cg::this_grid();
    const int ph_lo = Pk.ph_lo, ph_hi = Pk.ph_hi;
#ifdef ONLY_PHASE
#define PHASE(k, ...) if constexpr ((k) == ONLY_PHASE) { const Params& P = phase_params(); unsigned char* ws = P.ws; (void)ws; __VA_ARGS__; grid_barrier(grid); }
#else
#ifndef PHASE_MASK
#define PHASE_MASK 0xffffffffu
#endif
#ifndef REPEAT_MASK
#define REPEAT_MASK 0u
#endif
#define PHASE(k, ...) if (((PHASE_MASK >> (k)) & 1u) && ph_lo <= (k) && (k) < ph_hi) { const Params& P = phase_params(); unsigned char* ws = P.ws; (void)ws; \
    if constexpr (((REPEAT_MASK >> (k)) & 1u) != 0u) { __VA_ARGS__; grid_barrier(grid); } \
    __VA_ARGS__; if ((k) + 1 < ph_hi) grid_barrier(grid); }
#endif
    PHASE(0, phase0(P, lds))
    PHASE(1, ph_inproj2(P, lds, (const bf16_t*)(ws + WS_WABIN), 1536, nullptr))
    PHASE(2, ph_conv0(P); ph_s5_state(P, lds))
    PHASE(3, ph_gates0(P, lds); ph_s5_carry(P))
    PHASE(4, ph_lru_scan(P, lds); ph_s5_out(P, lds))
    PHASE(5, ph_glu(P, lds))
    PHASE(6, ph_outproj2(P, lds, (const bf16_t*)(ws + WS_WABOUT), P.in[I_X]))
    PHASE(7, ph_ln_router(P, lds, 0))
    PHASE(8, ph_route_scatter(P, lds, 0))
    PHASE(9, ph_moe_up2(P, lds, 0))
    PHASE(10, ph_moe_down2(P, lds, 0))
    PHASE(11, ph_combine_ln(P, 0, (float*)(ws + WS_X1F), true))
    PHASE(12, ph_inproj2(P, lds, (const bf16_t*)(ws + WS_WCDIN), 2560, (const int*)P.in[I_POS]); convert_moe_weights(P, 1, lds))
    PHASE(13, ph_conv1(P, lds))
    PHASE(14, ph_qkv(P, lds))
    PHASE(15, ph_m1(P, lds))
    PHASE(16, ph_m2(P); ph_attn(P, lds))
    PHASE(17, ph_m3(P, lds); ph_attn_combine(P))
    PHASE(18, ph_outproj2(P, lds, (const bf16_t*)(ws + WS_WCDOUT), (const float*)(ws + WS_X1F)))
    PHASE(19, ph_ln_router(P, lds, 1))
    PHASE(20, ph_route_scatter(P, lds, 1))
    PHASE(21, ph_moe_up2(P, lds, 1))
    PHASE(22, ph_moe_down2(P, lds, 1))
    PHASE(23, ph_combine_ln(P, 1, P.out, false))
#undef PHASE
}

#ifndef MULTI_LAUNCH
#define MULTI_LAUNCH 0
#endif
extern "C" void kernel_launch(void* const* d_in, const int* in_sizes, int n_in, void* d_out, int out_size, void* d_ws, size_t ws_size, hipStream_t stream) {
    static int grid_blocks = 0;
    if (grid_blocks == 0) {
        if (n_in != N_IN || out_size != T * D || ws_size < WS_END) { fprintf(stderr, "kernel_launch: unexpected shapes (n_in %d out %d ws %zu need %zu)\n", n_in, out_size, ws_size, (size_t)WS_END); grid_blocks = -1; return; }
        int dev = 0, cus = 0, per_cu = 0;
        (void)hipGetDevice(&dev);
        (void)hipDeviceGetAttribute(&cus, hipDeviceAttributeMultiprocessorCount, dev);
        if (hipFuncSetAttribute((const void*)fwd_megakernel, hipFuncAttributeMaxDynamicSharedMemorySize, LDS_BYTES) != hipSuccess) { fprintf(stderr, "kernel_launch: hipFuncSetAttribute failed\n"); grid_blocks = -1; return; }
        (void)hipOccupancyMaxActiveBlocksPerMultiprocessor(&per_cu, (const void*)fwd_megakernel, NTHREADS, LDS_BYTES);
        if (per_cu < 1) { fprintf(stderr, "kernel_launch: occupancy query returned %d\n", per_cu); grid_blocks = -1; return; }
        grid_blocks = cus * per_cu;
    }
    if (grid_blocks < 0) return;
    Params p{};
    for (int i = 0; i < N_IN; ++i) p.in[i] = (const float*)d_in[i];
    p.out = (float*)d_out; p.ws = (unsigned char*)d_ws;
#if MULTI_LAUNCH
    for (int k = 0; k < 24; ++k) { p.ph_lo = k; p.ph_hi = k + 1; hipLaunchKernelGGL(fwd_megakernel, dim3(grid_blocks), dim3(NTHREADS), LDS_BYTES, stream, p); }
#else
    p.ph_lo = 0; p.ph_hi = 24;
    void* args[] = {&p};
    hipError_t e = hipLaunchCooperativeKernel((const void*)fwd_megakernel, dim3(grid_blocks), dim3(NTHREADS), args, LDS_BYTES, stream);
    if (e != hipSuccess) fprintf(stderr, "cooperative launch failed: %s (grid %d)\n", hipGetErrorString(e), grid_blocks);
#endif
}
```

```cpp
#include <hip/hip_runtime.h>
#include <hip/hip_cooperative_groups.h>
#include <cstdio>
#include <cstdint>
namespace cg = cooperative_groups;

#define LAS __attribute__((address_space(3)))
typedef unsigned short bf16_t;
typedef short bf16x8 __attribute__((ext_vector_type(8)));
typedef short bf16x4 __attribute__((ext_vector_type(4)));
typedef float f32x4 __attribute__((ext_vector_type(4)));
typedef unsigned u32x4 __attribute__((ext_vector_type(4)));
typedef unsigned u32x2 __attribute__((ext_vector_type(2)));
typedef LAS unsigned char lds_t;

constexpr int T = 32768, D = 1024, SEQ = 4096;
constexpr int NTHREADS = 512;
constexpr int LDS_BYTES = 160 * 1024;
constexpr float ALPHA = 1.4142135623730951f;
constexpr float LN_EPS = 1e-5f;
constexpr int MOE_ROWS = 139264;
constexpr int S5TC = 32;
constexpr int S5K = S5TC * 16 + 128;

enum { I_X = 0, I_POS, I_AB_WIN, I_AB_CONVW, I_AB_CONVB, I_AB_GRW, I_AB_GRB, I_AB_GIW, I_AB_GIB, I_AB_LAMBDA,
       I_S5_LRE, I_S5_LIM, I_S5_STEP, I_S5_BRE, I_S5_BIM, I_S5_CRE, I_S5_CIM, I_S5_D, I_AB_GLUW, I_AB_GLUB, I_AB_WOUT,
       I_CD_WIN, I_CD_CONVW, I_CD_CONVB, I_CD_WQ, I_CD_WK, I_CD_WV, I_CD_WIF, I_CD_BIF, I_CD_WOUT,
       I_LNM_G, I_LNM_B, I_LNF_G, I_LNF_B, I_R_W, I_R_B, I_M_WIN, I_M_BIN, I_M_WOUT, I_M_BOUT, N_IN };

constexpr size_t MiB = 1ull << 20;
constexpr size_t WS_CTL = 0;
constexpr size_t WS_XB = 1 * MiB;
constexpr size_t WS_WABIN = 65 * MiB;
constexpr size_t WS_WGLU = 68 * MiB;
constexpr size_t WS_WABOUT = 69 * MiB;
constexpr size_t WS_WCDIN = 71 * MiB;
constexpr size_t WS_WCDOUT = 76 * MiB;
constexpr size_t WS_WG = 78 * MiB;
constexpr size_t WS_WQKV = 78 * MiB + 256 * 1024;
constexpr size_t WS_WC = 79 * MiB;
constexpr size_t WS_S5TM = 80 * MiB;
constexpr size_t WS_S5WST = 100 * MiB;
constexpr size_t WS_MWIN = 104 * MiB;
constexpr size_t WS_MWOUT = 232 * MiB;
constexpr size_t WS_PROJ = 296 * MiB;
constexpr size_t WS_CAT = 456 * MiB;
constexpr size_t WS_X1F = 520 * MiB;
constexpr size_t WS_ZF = 648 * MiB;
constexpr size_t WS_HACT = 776 * MiB;
constexpr size_t WS_YB = 1048 * MiB;
constexpr size_t WS_ROUTE = 1320 * MiB;
constexpr size_t WS_SCR = 1328 * MiB;
constexpr size_t WS_XC = WS_SCR;
constexpr size_t WS_AF = WS_SCR + 32 * MiB;
constexpr size_t WS_UF = WS_SCR + 96 * MiB;
constexpr size_t WS_SB = WS_SCR + 160 * MiB;
constexpr size_t WS_S5S = WS_SCR + 192 * MiB;
constexpr size_t WS_S5X = WS_SCR + 208 * MiB;
constexpr size_t WS_XCONV = WS_SCR;
constexpr size_t WS_QB = WS_SCR + 32 * MiB;
constexpr size_t WS_KB = WS_SCR + 64 * MiB;
constexpr size_t WS_VB = WS_SCR + 96 * MiB;
constexpr size_t WS_GATES = WS_SCR + 128 * MiB;
constexpr size_t WS_KVC = WS_SCR + 130 * MiB;
constexpr size_t WS_CPREV = WS_SCR + 258 * MiB;
constexpr size_t WS_MISC = WS_SCR + 322 * MiB;
constexpr size_t WS_ATTO = WS_SCR + 326 * MiB;
constexpr size_t WS_LSE = WS_SCR + 518 * MiB;
constexpr size_t WS_END = WS_SCR + 520 * MiB;

struct Params { const float* in[N_IN]; float* out; unsigned char* ws; int ph_lo, ph_hi; };

__device__ __forceinline__ float bf2f(unsigned short b) { return __uint_as_float(((unsigned)b) << 16); }
typedef __bf16 bf16v2_t __attribute__((ext_vector_type(2)));
typedef float f32x2 __attribute__((ext_vector_type(2)));
__device__ __forceinline__ unsigned pk_bf16(float lo, float hi) { const f32x2 v = {lo, hi}; return __builtin_bit_cast(unsigned, __builtin_convertvector(v, bf16v2_t)); }
__device__ __forceinline__ float wave_sum(float v) {
#pragma unroll
    for (int o = 1; o < 64; o <<= 1) v += __shfl_xor(v, o);
    return v;
}
__device__ __forceinline__ float wave_max(float v) {
#pragma unroll
    for (int o = 1; o < 64; o <<= 1) v = fmaxf(v, __shfl_xor(v, o));
    return v;
}
__device__ __forceinline__ float fsigmoid(float x) { return __builtin_amdgcn_rcpf(1.0f + __builtin_amdgcn_exp2f(-1.4426950408889634f * x)); }
__device__ __forceinline__ float fexp(float x) { return __builtin_amdgcn_exp2f(1.4426950408889634f * x); }
__device__ __forceinline__ float flog(float x) { return 0.6931471805599453f * __builtin_amdgcn_logf(x); }
__device__ __forceinline__ void fsincos(float x, float& sn, float& cs) {
    const float n = rintf(x * 0.15915494309189535f);
    float r = fmaf(-n, 6.28125f, x); r = fmaf(-n, 0.0019353071795864769f, r);
    const float rev = r * 0.15915494309189535f;
    sn = __builtin_amdgcn_sinf(rev); cs = __builtin_amdgcn_cosf(rev);
}
__device__ __forceinline__ float gelu_tanh(float x) { return x * fsigmoid(1.5957691216057308f * (x + 0.044715f * x * x * x)); }
__device__ __forceinline__ float logsigmoidf(float x) { return fminf(x, 0.f) - log1pf(expf(-fabsf(x))); }
__device__ __forceinline__ void unpack8(u32x4 v, float (&f)[8]) {
    f[0] = __uint_as_float(v.x << 16); f[1] = __uint_as_float(v.x & 0xffff0000u);
    f[2] = __uint_as_float(v.y << 16); f[3] = __uint_as_float(v.y & 0xffff0000u);
    f[4] = __uint_as_float(v.z << 16); f[5] = __uint_as_float(v.z & 0xffff0000u);
    f[6] = __uint_as_float(v.w << 16); f[7] = __uint_as_float(v.w & 0xffff0000u);
}
__device__ __forceinline__ u32x4 pack8(const float (&f)[8]) { u32x4 o; o.x = pk_bf16(f[0], f[1]); o.y = pk_bf16(f[2], f[3]); o.z = pk_bf16(f[4], f[5]); o.w = pk_bf16(f[6], f[7]); return o; }
__device__ __forceinline__ bf16x4 tr_read(lds_t* p) { return __builtin_amdgcn_ds_read_tr16_b64_v4i16((LAS bf16x4*)p); }
__device__ __forceinline__ bf16x8 cat44(bf16x4 a, bf16x4 b) { bf16x8 r = {a[0], a[1], a[2], a[3], b[0], b[1], b[2], b[3]}; return r; }
#define MFMA16(a, b, c) __builtin_amdgcn_mfma_f32_16x16x32_bf16((a), (b), (c), 0, 0, 0)

constexpr int E1_PITCH = 144;
constexpr int E1_A = 256 * E1_PITCH;
constexpr int E1_B = 128 * E1_PITCH;
constexpr int E1_BUF = E1_A + E1_B;

template <bool TRANS, class AL, class BL, class EP>
__device__ __forceinline__ void e1_tile(lds_t* lds, int nk, AL aload, BL bload, EP epi) {
    const int tid = threadIdx.x, lane = tid & 63, wave = tid >> 6, wr = wave >> 1, wc = wave & 1, fr = lane & 15, fq = lane >> 4;
    const int prow = tid >> 3, pc = tid & 7;
    f32x4 acc[4][4];
#pragma unroll
    for (int m = 0; m < 4; ++m)
#pragma unroll
        for (int n = 0; n < 4; ++n) acc[m][n] = (f32x4){0.f, 0.f, 0.f, 0.f};
    u32x4 ra[4], rb[2];
#pragma unroll
    for (int i = 0; i < 4; ++i) ra[i] = aload(i, prow + 64 * i, pc);
#pragma unroll
    for (int i = 0; i < 2; ++i) rb[i] = bload(i, prow + 64 * i, pc);
#pragma unroll
    for (int i = 0; i < 4; ++i) *(LAS u32x4*)(lds + (prow + 64 * i) * E1_PITCH + pc * 16) = ra[i];
#pragma unroll
    for (int i = 0; i < 2; ++i) *(LAS u32x4*)(lds + E1_A + (prow + 64 * i) * E1_PITCH + pc * 16) = rb[i];
    __syncthreads();
    for (int t = 0; t < nk; ++t) {
        const bool more = (t + 1 < nk);
        if (more) {
#pragma unroll
            for (int i = 0; i < 4; ++i) ra[i] = aload(i, prow + 64 * i, (t + 1) * 8 + pc);
#pragma unroll
            for (int i = 0; i < 2; ++i) rb[i] = bload(i, prow + 64 * i, (t + 1) * 8 + pc);
        }
        lds_t* Ab = lds + (t & 1) * E1_BUF + (wr * 64 + fr) * E1_PITCH + fq * 16;
        lds_t* Bb = lds + (t & 1) * E1_BUF + E1_A + (wc * 64 + fr) * E1_PITCH + fq * 16;
#pragma unroll
        for (int kk = 0; kk < 2; ++kk) {
            bf16x8 af[4], bfr[4];
#pragma unroll
            for (int m = 0; m < 4; ++m) af[m] = *(LAS bf16x8*)(Ab + m * 16 * E1_PITCH + kk * 64);
#pragma unroll
            for (int n = 0; n < 4; ++n) bfr[n] = *(LAS bf16x8*)(Bb + n * 16 * E1_PITCH + kk * 64);
#pragma unroll
            for (int m = 0; m < 4; ++m)
#pragma unroll
                for (int n = 0; n < 4; ++n) acc[m][n] = TRANS ? MFMA16(bfr[n], af[m], acc[m][n]) : MFMA16(af[m], bfr[n], acc[m][n]);
        }
        if (more) {
            lds_t* nb = lds + ((t + 1) & 1) * E1_BUF;
#pragma unroll
            for (int i = 0; i < 4; ++i) *(LAS u32x4*)(nb + (prow + 64 * i) * E1_PITCH + pc * 16) = ra[i];
#pragma unroll
            for (int i = 0; i < 2; ++i) *(LAS u32x4*)(nb + E1_A + (prow + 64 * i) * E1_PITCH + pc * 16) = rb[i];
        }
        __syncthreads();
    }
    epi(acc, wr, wc, fr, fq);
}


namespace g2 {
constexpr int HTB = 16384;
__device__ __forceinline__ int lds_byte(int r, int c) { const int st = (r >> 4) * 2 + (c >> 5), rr = r & 15, cc = c & 31, ob = rr * 64 + cc * 2; return st * 1024 + (ob ^ (((ob >> 9) & 1) << 5)); }
__device__ __forceinline__ void stage_rc(int b, int& R, int& C) { const int st = b / 1024, sb = b % 1024, swz = sb ^ (((sb >> 9) & 1) << 5); R = (st >> 1) * 16 + swz / 64; C = (st & 1) * 32 + (swz % 64) / 2; }
struct Unit { int pm, pn; };
__device__ __forceinline__ bool static_next(int i, int G, int c, int nM, int nN, Unit& u) {
    const int nwg = nM * nN; const long L = (long)i * G + c; if (L >= nwg) return false;
    int wgid = (int)L; { const int q = nwg / 8, r = nwg % 8, xcd = wgid % 8, off = wgid / 8; wgid = (xcd < r ? xcd * (q + 1) : r * (q + 1) + (xcd - r) * q) + off; }
    const int nig = 8 * nN, gid = wgid / nig, fm = gid * 8, gsz = (nM - fm) < 8 ? (nM - fm) : 8;
    u.pm = fm + ((wgid % nig) % gsz); u.pn = (wgid % nig) / gsz; return true;
}
template <class Sched, class Epi>
__device__ __forceinline__ void gemm_phase(lds_t* lds, const char* Abase, int K, unsigned ldb_bytes, const Sched& S, const Epi& E) {
    const int tid = threadIdx.x, wid = __builtin_amdgcn_readfirstlane(tid >> 6), lane = tid & 63, wr = wid >> 2, wc = wid & 3, fr = lane & 15, fq = lane >> 4;
    const int nt = K / 64;
    int Rs[2], Cs[2]; unsigned voffB[2];
#pragma unroll
    for (int i = 0; i < 2; ++i) { stage_rc(tid * 16 + i * 8192, Rs[i], Cs[i]); voffB[i] = (unsigned)Rs[i] * ldb_bytes + (unsigned)Cs[i] * 2u; }
    const size_t hstepB = (size_t)128 * ldb_bytes;
    const unsigned ldsw = (unsigned)wid * 1024u;
    const int aoff = lds_byte(wr * 64 + fr, fq * 8), boff = lds_byte(wc * 32 + fr, fq * 8);
#define G2_SA(b, h) (((b) * 2 + (h)) * g2::HTB)
#define G2_SB(b, h) ((4 + (b) * 2 + (h)) * g2::HTB)
#define G2_STAGE_A(bufoff, offs, kb) do { _Pragma("unroll") for (int _i = 0; _i < 2; ++_i) \
        __builtin_amdgcn_global_load_lds((const unsigned*)((Abase + (kb)) + (offs)[_i]), (LAS unsigned*)(lds + (bufoff) + ldsw + _i * 8192), 16, 0, 0); } while (0)
#define G2_STAGE_B(bufoff, gbase) do { _Pragma("unroll") for (int _i = 0; _i < 2; ++_i) \
        __builtin_amdgcn_global_load_lds((const unsigned*)((const char*)(gbase) + voffB[_i]), (LAS unsigned*)(lds + (bufoff) + ldsw + _i * 8192), 16, 0, 0); } while (0)
#define G2_LDA(dst, b, h) do { _Pragma("unroll") for (int m = 0; m < 4; ++m) _Pragma("unroll") for (int k = 0; k < 2; ++k) dst[m][k] = *(const LAS bf16x8*)(lds + G2_SA(b, h) + aoff + m * 2048 + k * 1024); } while (0)
#define G2_LDB(dst, b, h) do { _Pragma("unroll") for (int n = 0; n < 2; ++n) _Pragma("unroll") for (int k = 0; k < 2; ++k) dst[n][k] = *(const LAS bf16x8*)(lds + G2_SB(b, h) + boff + n * 2048 + k * 1024); } while (0)
#define G2_MMA(ai, bj, At, Bt) do { __builtin_amdgcn_s_setprio(1); _Pragma("unroll") for (int m = 0; m < 4; ++m) _Pragma("unroll") for (int n = 0; n < 2; ++n) _Pragma("unroll") for (int k = 0; k < 2; ++k) \
        acc[ai][bj][m][n] = __builtin_amdgcn_mfma_f32_16x16x32_bf16(Bt[n][k], At[m][k], acc[ai][bj][m][n], 0, 0, 0); __builtin_amdgcn_s_setprio(0); } while (0)
#define G2_WAIT_V(n) asm volatile("s_waitcnt vmcnt(" #n ")" ::: "memory")
#define G2_WAIT_L(n) asm volatile("s_waitcnt lgkmcnt(" #n ")" ::: "memory")
#define G2_BAR __builtin_amdgcn_s_barrier()
#define G2_SCHED __builtin_amdgcn_sched_barrier(0)
    Unit cur, nxt; int ui = 0;
    if (!S.next(0, cur)) return;
    f32x4 acc[2][2][4][2];
#pragma unroll
    for (int a = 0; a < 2; ++a)
#pragma unroll
        for (int b = 0; b < 2; ++b)
#pragma unroll
            for (int m = 0; m < 4; ++m)
#pragma unroll
                for (int n = 0; n < 2; ++n) acc[a][b][m][n] = (f32x4){0.f, 0.f, 0.f, 0.f};
    bf16x8 At[4][2], B0[2][2], B1[2][2];
    unsigned aoC[2][2], aoN[2][2];
    S.a_off(cur, Rs, Cs, aoC);
    const char* cB = S.b_base(cur);
    G2_STAGE_B(G2_SB(0, 0), cB); G2_STAGE_B(G2_SB(0, 1), cB + hstepB); G2_STAGE_A(G2_SA(0, 0), aoC[0], 0); G2_STAGE_A(G2_SA(0, 1), aoC[1], 0);
    if (wr == 1) G2_BAR;
    G2_WAIT_V(2); G2_BAR;
    G2_STAGE_B(G2_SB(1, 0), cB + 128); G2_STAGE_A(G2_SA(1, 0), aoC[0], 128); G2_STAGE_B(G2_SB(1, 1), cB + hstepB + 128);
    G2_WAIT_V(6); G2_BAR;
    for (;;) {
        const bool has_next = S.next(ui + 1, nxt);
        const char* nB = cB;
#pragma unroll
        for (int h = 0; h < 2; ++h)
#pragma unroll
            for (int i = 0; i < 2; ++i) aoN[h][i] = aoC[h][i];
        if (has_next) { S.a_off(nxt, Rs, Cs, aoN); nB = S.b_base(nxt); }
        for (int t = 0; t < nt; t += 2) {
            const bool last = (t == nt - 2);
            const unsigned k1 = (unsigned)(t + 1) * 128u, k2 = last ? 0u : (unsigned)(t + 2) * 128u, k3 = k2 + 128u;
            unsigned a2o[2][2];
#pragma unroll
            for (int h = 0; h < 2; ++h)
#pragma unroll
                for (int i = 0; i < 2; ++i) a2o[h][i] = last ? aoN[h][i] : aoC[h][i];
            const char* b2 = last ? nB : cB + (size_t)(t + 2) * 128; const char* b3 = b2 + 128;
            G2_LDB(B0, 0, 0); G2_LDB(B1, 0, 1); G2_SCHED; G2_LDA(At, 0, 0); G2_STAGE_A(G2_SA(1, 1), aoC[1], k1);
            G2_WAIT_V(8); G2_WAIT_L(0); G2_BAR; G2_MMA(0, 0, At, B0); G2_MMA(0, 1, At, B1); G2_BAR; G2_SCHED;
            G2_LDA(At, 0, 1); G2_STAGE_B(G2_SB(0, 0), b2); G2_STAGE_B(G2_SB(0, 1), b2 + hstepB); G2_STAGE_A(G2_SA(0, 0), a2o[0], k2);
            G2_WAIT_V(8); G2_WAIT_L(0); G2_BAR; G2_MMA(1, 0, At, B0); G2_MMA(1, 1, At, B1); G2_BAR; G2_SCHED;
            G2_LDB(B0, 1, 0); G2_LDB(B1, 1, 1); G2_SCHED; G2_LDA(At, 1, 0); G2_STAGE_A(G2_SA(0, 1), a2o[1], k2);
            G2_WAIT_V(8); G2_WAIT_L(0); G2_BAR; G2_MMA(0, 0, At, B0); G2_MMA(0, 1, At, B1); G2_BAR; G2_SCHED;
            G2_LDA(At, 1, 1); G2_STAGE_B(G2_SB(1, 0), b3); G2_STAGE_B(G2_SB(1, 1), b3 + hstepB); G2_STAGE_A(G2_SA(1, 0), a2o[0], k3);
            G2_WAIT_V(8); G2_WAIT_L(0); G2_BAR; G2_MMA(1, 0, At, B0); G2_MMA(1, 1, At, B1); G2_BAR; G2_SCHED;
        }
        if (wr == 0) G2_BAR;
        E(acc, cur, wr, wc, fr, fq);
        if (!has_next) break;
#pragma unroll
        for (int a = 0; a < 2; ++a)
#pragma unroll
            for (int b = 0; b < 2; ++b)
#pragma unroll
                for (int m = 0; m < 4; ++m)
#pragma unroll
                    for (int n = 0; n < 2; ++n) acc[a][b][m][n] = (f32x4){0.f, 0.f, 0.f, 0.f};
        cur = nxt; cB = nB; ++ui;
#pragma unroll
        for (int h = 0; h < 2; ++h)
#pragma unroll
            for (int i = 0; i < 2; ++i) aoC[h][i] = aoN[h][i];
        if (wr == 1) G2_BAR;
    }
    G2_WAIT_V(0);
    G2_BAR;
#undef G2_SA
#undef G2_SB
#undef G2_STAGE_A
#undef G2_STAGE_B
#undef G2_LDA
#undef G2_LDB
#undef G2_MMA
#undef G2_WAIT_V
#undef G2_WAIT_L
#undef G2_BAR
#undef G2_SCHED
}
struct DenseSched {
    int G, c, nM, nN, K; const char* Bt;
    __device__ __forceinline__ bool next(int i, Unit& u) const { return static_next(i, G, c, nM, nN, u); }
    __device__ __forceinline__ void a_off(const Unit& u, const int (&Rs)[2], const int (&Cs)[2], unsigned (&ao)[2][2]) const {
#pragma unroll
        for (int h = 0; h < 2; ++h)
#pragma unroll
            for (int i = 0; i < 2; ++i) ao[h][i] = ((unsigned)(u.pm * 256 + h * 128 + Rs[i]) * (unsigned)K + (unsigned)Cs[i]) * 2u;
    }
    __device__ __forceinline__ const char* b_base(const Unit& u) const { return Bt + (size_t)u.pn * 256 * K * 2; }
};
}

template <class RM>
__device__ __forceinline__ void transpose_item(const float* __restrict__ W, int N, bf16_t* __restrict__ WT, int ldwt, int k0, int n0, RM rowmap, LAS float* scr, int lane) {
#pragma unroll 16
    for (int i = 0; i < 64; ++i) scr[i * 65 + lane] = W[(size_t)(k0 + i) * N + n0 + lane];
    __builtin_amdgcn_wave_barrier();
    const int c = lane & 7;
#pragma unroll
    for (int j = 0; j < 8; ++j) {
        const int n = (lane >> 3) + 8 * j;
        const LAS float* s = scr + (8 * c) * 65 + n;
        u32x4 o; o.x = pk_bf16(s[0], s[65]); o.y = pk_bf16(s[2 * 65], s[3 * 65]); o.z = pk_bf16(s[4 * 65], s[5 * 65]); o.w = pk_bf16(s[6 * 65], s[7 * 65]);
        *(u32x4*)(WT + (size_t)rowmap(n0 + n) * ldwt + k0 + 8 * c) = o;
    }
    __builtin_amdgcn_wave_barrier();
}
struct RmId { __device__ __forceinline__ int operator()(int n) const { return n; } };
struct RmMoeIn { __device__ __forceinline__ int operator()(int n) const { const int half = n >> 10, j = n & 1023; return (j >> 7) * 256 + half * 128 + (j & 127); } };
struct RmGate { int gate; __device__ __forceinline__ int operator()(int j) const { return (j >> 5) * 64 + gate * 32 + (j & 31); } };

template <class RM>
__device__ __forceinline__ void transpose_matrix(const float* W, int K, int N, bf16_t* WT, int ldwt, RM rm, LAS float* scr, int gw, int NGW, int lane) {
    const int nkb = K / 64, nnb = N / 64;
    for (int it = gw; it < nkb * nnb; it += NGW) transpose_item(W, N, WT, ldwt, (it / nnb) * 64, (it % nnb) * 64, rm, scr, lane);
}

__device__ __forceinline__ void convert_moe_weights(const Params& P, int layer, lds_t* lds) {
    const int lane = threadIdx.x & 63, wave = threadIdx.x >> 6, gw = blockIdx.x * 8 + wave, NGW = gridDim.x * 8;
    LAS float* scr = (LAS float*)(lds + wave * 16640);
    const float* win = P.in[I_M_WIN] + (size_t)layer * 32 * 1024 * 2048;
    bf16_t* dwin = (bf16_t*)(P.ws + WS_MWIN);
    for (int it = gw; it < 32 * 16 * 32; it += NGW) {
        const int e = it >> 9, r = it & 511, kb = r >> 5, nb = r & 31;
        transpose_item(win + (size_t)e * 1024 * 2048, 2048, dwin + (size_t)e * 2048 * 1024, 1024, kb * 64, nb * 64, RmMoeIn(), scr, lane);
    }
    const float* wout = P.in[I_M_WOUT] + (size_t)layer * 32 * 1024 * 1024;
    bf16_t* dwout = (bf16_t*)(P.ws + WS_MWOUT);
    for (int it = gw; it < 32 * 16 * 16; it += NGW) {
        const int e = it >> 8, r = it & 255, kb = r >> 4, nb = r & 15;
        transpose_item(wout + (size_t)e * 1024 * 1024, 1024, dwout + (size_t)e * 1024 * 1024, 1024, kb * 64, nb * 64, RmId(), scr, lane);
    }
}

__device__ __forceinline__ void s5_precompute(const Params& P, int g, lds_t* lds) {
    const int tid = threadIdx.x;
    LAS float* Bbr = (LAS float*)lds;
    LAS float* Bbi = Bbr + 1024;
    LAS float* Cr = Bbi + 1024;
    LAS float* Ci = Cr + 1024;
    LAS float* ApR = Ci + 1024;
    LAS float* ApI = ApR + 33 * 64;
    LAS float* KJ = ApI + 33 * 64;
    const float* lre = P.in[I_S5_LRE] + g * 64; const float* lim = P.in[I_S5_LIM] + g * 64;
    const float step = expf(P.in[I_S5_STEP][g]);
    for (int idx = tid; idx < 1024; idx += NTHREADS) {
        const int p = idx >> 4;
        const float lr = fminf(lre[p], -1e-4f), li = lim[p];
        const float mag = expf(lr * step); float sn, cs; sincosf(li * step, &sn, &cs);
        const float ar = mag * cs, ai = mag * sn, inv = 1.0f / (lr * lr + li * li);
        const float zr = ((ar - 1.0f) * lr + ai * li) * inv, zi = (ai * lr - (ar - 1.0f) * li) * inv;
        const float br = P.in[I_S5_BRE][g * 1024 + idx], bi = P.in[I_S5_BIM][g * 1024 + idx];
        Bbr[idx] = zr * br - zi * bi; Bbi[idx] = zr * bi + zi * br;
        Cr[idx] = P.in[I_S5_CRE][g * 1024 + idx]; Ci[idx] = P.in[I_S5_CIM][g * 1024 + idx];
    }
    for (int idx = tid; idx < 33 * 64; idx += NTHREADS) {
        const int j = idx >> 6, p = idx & 63;
        const float lr = fminf(lre[p], -1e-4f), li = lim[p];
        const float mag = expf((float)j * lr * step); float sn, cs; sincosf((float)j * li * step, &sn, &cs);
        ApR[idx] = mag * cs; ApI[idx] = mag * sn;
    }
    __syncthreads();
    for (int idx = tid; idx < 8192; idx += NTHREADS) {
        const int j = idx >> 8, h = (idx >> 4) & 15, h2 = idx & 15;
        float s = 0.f;
        for (int p = 0; p < 64; ++p) {
            const float cr = Cr[h * 64 + p], ci = Ci[h * 64 + p], ar = ApR[j * 64 + p], ai = ApI[j * 64 + p];
            const float er = cr * ar - ci * ai, ei = cr * ai + ci * ar;
            s += er * Bbr[p * 16 + h2] - ei * Bbi[p * 16 + h2];
        }
        if (j == 0 && h == h2) s += P.in[I_S5_D][g * 16 + h];
        KJ[idx] = s;
    }
    __syncthreads();
    bf16_t* Tm = (bf16_t*)(P.ws + WS_S5TM) + (size_t)g * 512 * S5K;
    for (int pi = tid; pi < 512 * (S5K / 8); pi += NTHREADS) {
        const int row = pi / (S5K / 8), c8 = (pi % (S5K / 8)) * 8, t = row >> 4, h = row & 15;
        float v[8];
#pragma unroll
        for (int e = 0; e < 8; ++e) {
            const int col = c8 + e;
            if (col < 512) { const int s = col >> 4, h2 = col & 15; v[e] = (s <= t) ? KJ[((t - s) * 16 + h) * 16 + h2] : 0.f; }
            else { const int p = (col - 512) & 63, im = (col - 512) >> 6;
                const float cr = Cr[h * 64 + p], ci = Ci[h * 64 + p], ar = ApR[(t + 1) * 64 + p], ai = ApI[(t + 1) * 64 + p];
                v[e] = im ? -(cr * ai + ci * ar) : (cr * ar - ci * ai); }
        }
        *(u32x4*)(Tm + (size_t)row * S5K + c8) = pack8(v);
    }
    bf16_t* Wst = (bf16_t*)(P.ws + WS_S5WST) + (size_t)g * 128 * 512;
    for (int pi = tid; pi < 128 * 64; pi += NTHREADS) {
        const int row = pi >> 6, c8 = (pi & 63) * 8, p = row & 63, im = row >> 6;
        float v[8];
#pragma unroll
        for (int e = 0; e < 8; ++e) {
            const int col = c8 + e, s = col >> 4, h2 = col & 15;
            const float ar = ApR[(S5TC - 1 - s) * 64 + p], ai = ApI[(S5TC - 1 - s) * 64 + p], br = Bbr[p * 16 + h2], bi = Bbi[p * 16 + h2];
            v[e] = im ? (ar * bi + ai * br) : (ar * br - ai * bi);
        }
        *(u32x4*)(Wst + (size_t)row * 512 + c8) = pack8(v);
    }
    __syncthreads();
}

__device__ __forceinline__ void phase0(const Params& P, lds_t* lds) {
    const int tid = threadIdx.x, lane = tid & 63, wave = tid >> 6, gw = blockIdx.x * 8 + wave, NGW = gridDim.x * 8;
    const size_t gtid = (size_t)blockIdx.x * NTHREADS + tid, GT = (size_t)gridDim.x * NTHREADS;
    unsigned char* ws = P.ws;
    if (blockIdx.x == 0 && tid < 128) ((int*)(ws + WS_CTL))[tid] = 0;
    for (int g = blockIdx.x; g < 32; g += gridDim.x) s5_precompute(P, g, lds);
    {
        const f32x4* x4 = (const f32x4*)P.in[I_X]; u32x4* xb = (u32x4*)(ws + WS_XB);
        for (size_t i = gtid; i < (size_t)T * D / 8; i += GT) { const f32x4 a = x4[2 * i], b = x4[2 * i + 1]; u32x4 o; o.x = pk_bf16(a.x, a.y); o.y = pk_bf16(a.z, a.w); o.z = pk_bf16(b.x, b.y); o.w = pk_bf16(b.z, b.w); xb[i] = o; }
    }
    {
        float* Wc = (float*)(ws + WS_WC);
        for (size_t idx = gtid; idx < 8192; idx += GT) {
            const int which = (int)(idx >> 12), i = (int)((idx >> 3) & 511), gg = (int)(idx & 7), h = i >> 7, ii = i & 127;
            const float* wif = P.in[I_CD_WIF];
            float s = 0.f;
            if (which == 0) {
                const float* wq = P.in[I_CD_WQ] + (size_t)(h * 128 + ii) * 128; const float* wk = P.in[I_CD_WK] + (size_t)(h * 128 + ii) * 128;
                float s2 = 0.f;
                for (int j = 0; j < 128; ++j) { s += wq[j] * wif[(h * 128 + j) * 8 + gg]; s2 += wk[j] * wif[(512 + h * 128 + j) * 8 + gg]; }
                s += s2 * 0.08838834764831845f;
            } else {
                const float* wv = P.in[I_CD_WV] + (size_t)(h * 128 + ii) * 128;
                for (int j = 0; j < 128; ++j) s += wv[j] * wif[(1024 + h * 128 + j) * 8 + gg];
            }
            Wc[idx] = s;
        }
    }
    LAS float* scr = (LAS float*)(lds + wave * 16640);
    transpose_matrix(P.in[I_AB_WIN], 1024, 1536, (bf16_t*)(ws + WS_WABIN), 1024, RmId(), scr, gw, NGW, lane);
    transpose_matrix(P.in[I_AB_GLUW], 512, 512, (bf16_t*)(ws + WS_WGLU), 512, RmId(), scr, gw, NGW, lane);
    transpose_matrix(P.in[I_AB_WOUT], 1024, 1024, (bf16_t*)(ws + WS_WABOUT), 1024, RmId(), scr, gw, NGW, lane);
    transpose_matrix(P.in[I_CD_WIN], 1024, 2560, (bf16_t*)(ws + WS_WCDIN), 1024, RmId(), scr, gw, NGW, lane);
    transpose_matrix(P.in[I_CD_WOUT], 1024, 1024, (bf16_t*)(ws + WS_WCDOUT), 1024, RmId(), scr, gw, NGW, lane);
    for (int it = gw; it < 16; it += NGW) {
        const int gate = it >> 3, h = it & 7;
        transpose_item(P.in[gate ? I_AB_GIW : I_AB_GRW] + h * 4096, 64, (bf16_t*)(ws + WS_WG) + h * 8192, 64, 0, 0, RmGate{gate}, scr, lane);
    }
    for (int it = gw; it < 48; it += NGW) {
        const int which = it >> 4, h = (it >> 2) & 3, kb = (it >> 1) & 1, nb = it & 1;
        transpose_item(P.in[I_CD_WQ + which] + h * 16384, 128, (bf16_t*)(ws + WS_WQKV) + (which * 4 + h) * 16384, 128, kb * 64, nb * 64, RmId(), scr, lane);
    }
    convert_moe_weights(P, 0, lds);
}

__device__ __forceinline__ void store_bf16x4(bf16_t* p, f32x4 v) { u32x2 o; o.x = pk_bf16(v[0], v[1]); o.y = pk_bf16(v[2], v[3]); *(u32x2*)p = o; }

__device__ __forceinline__ void ph_inproj(const Params& P, lds_t* lds, const bf16_t* Wt, int N, const int* pos) {
    const bf16_t* xb = (const bf16_t*)(P.ws + WS_XB); bf16_t* proj = (bf16_t*)(P.ws + WS_PROJ);
    const int nct = N / 128;
    for (int tile = blockIdx.x; tile < 128 * nct; tile += gridDim.x) {
        const int rt = tile / nct, ct = tile % nct;
        e1_tile<true>(lds, 16,
            [=](int, int r, int kp) { return *(const u32x4*)(xb + (size_t)(rt * 256 + r) * 1024 + kp * 8); },
            [=](int, int n, int kp) { return *(const u32x4*)(Wt + (size_t)(ct * 128 + n) * 1024 + kp * 8); },
            [=](f32x4 (&acc)[4][4], int wr, int wc, int fr, int fq) {
                if (pos != nullptr && ct >= 8 && ct < 16 && wc == 0) {
                    float invf[4];
#pragma unroll
                    for (int c = 0; c < 4; ++c) invf[c] = exp2f(-(float)(fq * 4 + c) * (18.931568569324174f / 16.0f));
#pragma unroll
                    for (int m = 0; m < 4; ++m) {
                        const float pf = (float)pos[rt * 256 + wr * 64 + m * 16 + fr];
#pragma unroll
                        for (int c = 0; c < 4; ++c) {
                            float sn, cs; fsincos(pf * invf[c], sn, cs);
                            const float a = acc[m][0][c], b = acc[m][1][c];
                            acc[m][0][c] = a * cs - b * sn; acc[m][1][c] = b * cs + a * sn;
                        }
                    }
                }
                const float sc = (pos != nullptr && ct >= 8 && ct < 12) ? 0.08838834764831845f : 1.0f;
#pragma unroll
                for (int m = 0; m < 4; ++m)
#pragma unroll
                    for (int n = 0; n < 4; ++n)
                        store_bf16x4(proj + (size_t)(rt * 256 + wr * 64 + m * 16 + fr) * N + ct * 128 + wc * 64 + n * 16 + fq * 4, acc[m][n] * sc);
            });
    }
}

__device__ __forceinline__ void ph_conv0(const Params& P) {
    const bf16_t* proj = (const bf16_t*)(P.ws + WS_PROJ); bf16_t* xc = (bf16_t*)(P.ws + WS_XC);
    const int c8 = (threadIdx.x & 63) * 8;
    float w[4][8], bias[8];
#pragma unroll
    for (int e = 0; e < 8; ++e) { bias[e] = P.in[I_AB_CONVB][c8 + e];
#pragma unroll
        for (int k = 0; k < 4; ++k) w[k][e] = P.in[I_AB_CONVW][k * 512 + c8 + e]; }
    const size_t gtid = (size_t)blockIdx.x * NTHREADS + threadIdx.x, GT = (size_t)gridDim.x * NTHREADS;
    for (size_t i = gtid; i < (size_t)T * 64; i += GT) {
        const int tok = (int)(i >> 6), p = tok & (SEQ - 1);
        float a[8];
#pragma unroll
        for (int e = 0; e < 8; ++e) a[e] = bias[e];
#pragma unroll
        for (int k = 0; k < 4; ++k) {
            if (p - 3 + k >= 0) {
                float xv[8]; unpack8(*(const u32x4*)(proj + (size_t)(tok - 3 + k) * 1536 + c8), xv);
#pragma unroll
                for (int e = 0; e < 8; ++e) a[e] += w[k][e] * xv[e];
            }
        }
        *(u32x4*)(xc + (size_t)tok * 512 + c8) = pack8(a);
    }
}

__device__ __forceinline__ void ph_gates0(const Params& P, lds_t* lds) {
    const bf16_t* xc = (const bf16_t*)(P.ws + WS_XC); const bf16_t* Wg = (const bf16_t*)(P.ws + WS_WG);
    float* af = (float*)(P.ws + WS_AF); float* uf = (float*)(P.ws + WS_UF);
    const float* br = P.in[I_AB_GRB]; const float* bi = P.in[I_AB_GIB]; const float* lam = P.in[I_AB_LAMBDA];
    for (int tile = blockIdx.x; tile < 1024; tile += gridDim.x) {
        const int h = tile & 7, rt = tile >> 3;
        e1_tile<true>(lds, 1,
            [=](int, int r, int kp) { return *(const u32x4*)(xc + (size_t)(rt * 256 + r) * 512 + h * 64 + kp * 8); },
            [=](int, int n, int kp) { return *(const u32x4*)(Wg + (size_t)h * 8192 + n * 64 + kp * 8); },
            [=](f32x4 (&acc)[4][4], int wr, int wc, int fr, int fq) {
#pragma unroll
                for (int n = 0; n < 2; ++n) {
                    const int ch = h * 64 + wc * 32 + n * 16 + fq * 4;
                    float sp[4], brv[4], biv[4];
#pragma unroll
                    for (int c = 0; c < 4; ++c) { const float l = -lam[ch + c]; sp[c] = fmaxf(l, 0.f) + flog(1.0f + fexp(-fabsf(l))); brv[c] = br[ch + c]; biv[c] = bi[ch + c]; }
#pragma unroll
                    for (int m = 0; m < 4; ++m) {
                        const size_t row = (size_t)(rt * 256 + wr * 64 + m * 16 + fr);
                        const u32x2 xr = *(const u32x2*)(xc + row * 512 + ch);
                        const float xv[4] = {__uint_as_float(xr.x << 16), __uint_as_float(xr.x & 0xffff0000u), __uint_as_float(xr.y << 16), __uint_as_float(xr.y & 0xffff0000u)};
                        f32x4 a4, u4;
#pragma unroll
                        for (int c = 0; c < 4; ++c) {
                            const float r = fsigmoid(acc[m][n][c] + brv[c]), ig = fsigmoid(acc[m][n + 2][c] + biv[c]);
                            const float la = -8.0f * r * sp[c], x2 = 2.0f * la;
                            const float om = (x2 > -0.01f) ? -x2 * (1.0f + 0.5f * x2 * (1.0f + x2 * (1.0f / 3.0f))) : 1.0f - fexp(x2);
                            a4[c] = fexp(la); u4[c] = sqrtf(om) * ig * xv[c];
                        }
                        *(f32x4*)(af + row * 512 + ch) = a4; *(f32x4*)(uf + row * 512 + ch) = u4;
                    }
                }
            });
    }
}

__device__ __forceinline__ void ph_lru_scan(const Params& P, lds_t* lds) {
    const float* af = (const float*)(P.ws + WS_AF); const float* uf = (const float*)(P.ws + WS_UF);
    const bf16_t* proj = (const bf16_t*)(P.ws + WS_PROJ); bf16_t* cat = (bf16_t*)(P.ws + WS_CAT);
    LAS float* lA = (LAS float*)lds; LAS float* lH = lA + 512;
    const int tid = threadIdx.x, seg = tid >> 4, c = tid & 15;
    for (int item = blockIdx.x; item < 256; item += gridDim.x) {
        const int b = item >> 5, ch = (item & 31) * 16 + c;
        const size_t base = (size_t)b * SEQ + seg * 128;
        float A = 1.f, H = 0.f;
#pragma unroll 8
        for (int i = 0; i < 128; ++i) { const float a = af[(base + i) * 512 + ch], u = uf[(base + i) * 512 + ch]; H = a * H + u; A *= a; }
        lA[tid] = A; lH[tid] = H;
        __syncthreads();
        float carry = 0.f;
        for (int s = 0; s < seg; ++s) carry = lA[s * 16 + c] * carry + lH[s * 16 + c];
        H = carry;
#pragma unroll 8
        for (int i = 0; i < 128; ++i) {
            const float a = af[(base + i) * 512 + ch], u = uf[(base + i) * 512 + ch]; H = a * H + u;
            const float ga = bf2f(proj[(base + i) * 1536 + 512 + ch]);
            cat[(base + i) * 1024 + ch] = (bf16_t)(pk_bf16(H * gelu_tanh(ga), 0.f) & 0xffffu);
        }
        __syncthreads();
    }
}

__device__ __forceinline__ void ph_s5_state(const Params& P, lds_t* lds) {
    const bf16_t* proj = (const bf16_t*)(P.ws + WS_PROJ); const bf16_t* Wst = (const bf16_t*)(P.ws + WS_S5WST); float* S = (float*)(P.ws + WS_S5S);
    for (int tile = blockIdx.x; tile < 128; tile += gridDim.x) {
        const int g = tile & 31, rt = tile >> 5;
        e1_tile<true>(lds, 8,
            [=](int, int r, int kp) { return *(const u32x4*)(proj + (size_t)((rt * 256 + r) * 32 + (kp >> 1)) * 1536 + 1024 + g * 16 + (kp & 1) * 8); },
            [=](int, int n, int kp) { return *(const u32x4*)(Wst + (size_t)g * 65536 + n * 512 + kp * 8); },
            [=](f32x4 (&acc)[4][4], int wr, int wc, int fr, int fq) {
#pragma unroll
                for (int m = 0; m < 4; ++m)
#pragma unroll
                    for (int n = 0; n < 4; ++n) *(f32x4*)(S + ((size_t)(rt * 256 + wr * 64 + m * 16 + fr) * 32 + g) * 128 + wc * 64 + n * 16 + fq * 4) = acc[m][n];
            });
    }
}

__device__ __forceinline__ void ph_s5_carry(const Params& P) {
    const float* S = (const float*)(P.ws + WS_S5S); bf16_t* X = (bf16_t*)(P.ws + WS_S5X);
    if (threadIdx.x >= 64) return;
    const int p = threadIdx.x;
    for (int it = blockIdx.x; it < 256; it += gridDim.x) {
        const int b = it >> 5, g = it & 31;
        const float lr = fminf(P.in[I_S5_LRE][g * 64 + p], -1e-4f), li = P.in[I_S5_LIM][g * 64 + p], step = expf(P.in[I_S5_STEP][g]);
        const float mag = expf((float)S5TC * lr * step); float sn, cs; sincosf((float)S5TC * li * step, &sn, &cs);
        const float cr = mag * cs, ci = mag * sn;
        float xr = 0.f, xi = 0.f;
        for (int c0 = 0; c0 < 128; c0 += 16) {
            float sr[16], si[16];
#pragma unroll
            for (int j = 0; j < 16; ++j) { const size_t o = ((size_t)(b * 128 + c0 + j) * 32 + g) * 128; sr[j] = S[o + p]; si[j] = S[o + 64 + p]; }
#pragma unroll
            for (int j = 0; j < 16; ++j) {
                const size_t o = ((size_t)(b * 128 + c0 + j) * 32 + g) * 128;
                X[o + p] = (bf16_t)(pk_bf16(xr, 0.f) & 0xffffu); X[o + 64 + p] = (bf16_t)(pk_bf16(xi, 0.f) & 0xffffu);
                const float nr = cr * xr - ci * xi + sr[j], ni = cr * xi + ci * xr + si[j];
                xr = nr; xi = ni;
            }
        }
    }
}

__device__ __forceinline__ void ph_s5_out(const Params& P, lds_t* lds) {
    const bf16_t* proj = (const bf16_t*)(P.ws + WS_PROJ); const bf16_t* Tm = (const bf16_t*)(P.ws + WS_S5TM); const bf16_t* X = (const bf16_t*)(P.ws + WS_S5X);
    bf16_t* sb = (bf16_t*)(P.ws + WS_SB);
    for (int tile = blockIdx.x; tile < 512; tile += gridDim.x) {
        const int ct = tile & 3, g = (tile >> 2) & 31, rt = tile >> 7;
        e1_tile<true>(lds, S5K / 64,
            [=](int, int r, int kp) {
                if (kp < 64) return *(const u32x4*)(proj + (size_t)((rt * 256 + r) * 32 + (kp >> 1)) * 1536 + 1024 + g * 16 + (kp & 1) * 8);
                return *(const u32x4*)(X + ((size_t)(rt * 256 + r) * 32 + g) * 128 + (kp - 64) * 8); },
            [=](int, int n, int kp) { return *(const u32x4*)(Tm + (size_t)g * 512 * S5K + (size_t)(ct * 128 + n) * S5K + kp * 8); },
            [=](f32x4 (&acc)[4][4], int wr, int wc, int fr, int fq) {
#pragma unroll
                for (int m = 0; m < 4; ++m)
#pragma unroll
                    for (int n = 0; n < 4; ++n) {
                        const int col = ct * 128 + wc * 64 + n * 16 + fq * 4, t = col >> 4, h0 = col & 15;
                        const size_t tok = (size_t)(rt * 256 + wr * 64 + m * 16 + fr) * 32 + t;
                        f32x4 y = acc[m][n];
#pragma unroll
                        for (int c = 0; c < 4; ++c) y[c] = gelu_tanh(y[c]);
                        store_bf16x4(sb + tok * 512 + g * 16 + h0, y);
                    }
            });
    }
}

__device__ __forceinline__ void ph_glu(const Params& P, lds_t* lds) {
    const bf16_t* sb = (const bf16_t*)(P.ws + WS_SB); const bf16_t* Wt = (const bf16_t*)(P.ws + WS_WGLU); bf16_t* cat = (bf16_t*)(P.ws + WS_CAT);
    const float* gb = P.in[I_AB_GLUB];
    for (int tile = blockIdx.x; tile < 512; tile += gridDim.x) {
        const int rt = tile >> 2, ct = tile & 3;
        e1_tile<true>(lds, 8,
            [=](int, int r, int kp) { return *(const u32x4*)(sb + (size_t)(rt * 256 + r) * 512 + kp * 8); },
            [=](int, int n, int kp) { return *(const u32x4*)(Wt + (size_t)(ct * 128 + n) * 512 + kp * 8); },
            [=](f32x4 (&acc)[4][4], int wr, int wc, int fr, int fq) {
#pragma unroll
                for (int n = 0; n < 4; ++n) {
                    const int col = ct * 128 + wc * 64 + n * 16 + fq * 4;
                    const f32x4 bv = *(const f32x4*)(gb + col);
#pragma unroll
                    for (int m = 0; m < 4; ++m) {
                        const size_t row = (size_t)(rt * 256 + wr * 64 + m * 16 + fr);
                        const u32x2 sr = *(const u32x2*)(sb + row * 512 + col);
                        const float sv[4] = {__uint_as_float(sr.x << 16), __uint_as_float(sr.x & 0xffff0000u), __uint_as_float(sr.y << 16), __uint_as_float(sr.y & 0xffff0000u)};
                        f32x4 y;
#pragma unroll
                        for (int c = 0; c < 4; ++c) y[c] = sv[c] * fsigmoid(acc[m][n][c] + bv[c]);
                        store_bf16x4(cat + row * 1024 + 512 + col, y);
                    }
                }
            });
    }
}

__device__ __forceinline__ void ph_outproj(const Params& P, lds_t* lds, const bf16_t* Wt, const float* xres) {
    const bf16_t* cat = (const bf16_t*)(P.ws + WS_CAT); float* zf = (float*)(P.ws + WS_ZF);
    for (int tile = blockIdx.x; tile < 1024; tile += gridDim.x) {
        const int rt = tile >> 3, ct = tile & 7;
        e1_tile<true>(lds, 16,
            [=](int, int r, int kp) { return *(const u32x4*)(cat + (size_t)(rt * 256 + r) * 1024 + kp * 8); },
            [=](int, int n, int kp) { return *(const u32x4*)(Wt + (size_t)(ct * 128 + n) * 1024 + kp * 8); },
            [=](f32x4 (&acc)[4][4], int wr, int wc, int fr, int fq) {
#pragma unroll
                for (int m = 0; m < 4; ++m)
#pragma unroll
                    for (int n = 0; n < 4; ++n) {
                        const size_t o = (size_t)(rt * 256 + wr * 64 + m * 16 + fr) * 1024 + ct * 128 + wc * 64 + n * 16 + fq * 4;
                        *(f32x4*)(zf + o) = *(const f32x4*)(xres + o) * ALPHA + acc[m][n];
                    }
            });
    }
}

__device__ __forceinline__ void ph_ln_router(const Params& P, lds_t* lds, int layer) {
    const float* zf = (const float*)(P.ws + WS_ZF); float* x1f = (float*)(P.ws + WS_X1F); bf16_t* xb = (bf16_t*)(P.ws + WS_XB);
    const float* lg = P.in[I_LNM_G] + layer * 1024; const float* lb = P.in[I_LNM_B] + layer * 1024;
    const float* rw = P.in[I_R_W] + (size_t)layer * 1024 * 32; const float* rbias = P.in[I_R_B] + layer * 32;
    int* gcount = (int*)(P.ws + WS_CTL) + 64 * layer;
    int* pair_e = (int*)(P.ws + WS_ROUTE); int* pair_rank = pair_e + T * 4; float* pair_gate = (float*)(pair_rank + T * 4);
    LAS float* Wr = (LAS float*)lds;
    LAS int* hist = (LAS int*)(lds + 147456); LAS int* basev = hist + 32;
    LAS int* pinfo = basev + 32;
    const int tid = threadIdx.x, lane = tid & 63, wave = tid >> 6;
    for (int i = tid; i < 32768; i += NTHREADS) { const int k = i >> 5; Wr[((k & 3) * 256 + (k >> 8) * 64 + ((k >> 2) & 63)) * 36 + (i & 31)] = rw[i]; }
    const float myrb = rbias[lane & 31];
    __syncthreads();
    for (int it = blockIdx.x; it < 512; it += gridDim.x) {
        if (tid < 32) hist[tid] = 0;
        __syncthreads();
        for (int pp = 0; pp < 4; ++pp) {
            f32x4 y[2][4];
#pragma unroll
            for (int rr = 0; rr < 2; ++rr)
#pragma unroll
                for (int j = 0; j < 4; ++j) y[rr][j] = *(const f32x4*)(zf + ((size_t)it * 64 + wave * 8 + pp * 2 + rr) * 1024 + j * 256 + lane * 4);
            f32x2 v2[32];
            int woff = lane * 36; asm volatile("" : "+v"(woff));
#pragma unroll
            for (int rr = 0; rr < 2; ++rr) {
                const size_t row = (size_t)it * 64 + wave * 8 + pp * 2 + rr;
                float s = 0.f;
#pragma unroll
                for (int j = 0; j < 4; ++j) s += (y[rr][j][0] + y[rr][j][1]) + (y[rr][j][2] + y[rr][j][3]);
                const float mean = wave_sum(s) * (1.0f / 1024.0f); float s2 = 0.f;
#pragma unroll
                for (int j = 0; j < 4; ++j) { y[rr][j] = y[rr][j] - mean; s2 += (y[rr][j][0] * y[rr][j][0] + y[rr][j][1] * y[rr][j][1]) + (y[rr][j][2] * y[rr][j][2] + y[rr][j][3] * y[rr][j][3]); }
                const float rstd = rsqrtf(wave_sum(s2) * (1.0f / 1024.0f) + LN_EPS);
#pragma unroll
                for (int j = 0; j < 4; ++j) {
                    y[rr][j] = y[rr][j] * rstd * *(const f32x4*)(lg + j * 256 + lane * 4) + *(const f32x4*)(lb + j * 256 + lane * 4);
                    *(f32x4*)(x1f + row * 1024 + j * 256 + lane * 4) = y[rr][j];
                    store_bf16x4(xb + row * 1024 + j * 256 + lane * 4, y[rr][j]);
                }
            }
#pragma unroll
            for (int e = 0; e < 32; ++e) v2[e] = (f32x2){0.f, 0.f};
#pragma unroll
            for (int j = 0; j < 4; ++j)
#pragma unroll
                for (int c = 0; c < 4; ++c) {
                    const LAS float* wrow = Wr + (c * 256 + j * 64) * 36 + woff;
                    const f32x2 yy = {y[0][j][c], y[1][j][c]};
#pragma unroll
                    for (int e4 = 0; e4 < 8; ++e4) {
                        const f32x4 w = *(const LAS f32x4*)(wrow + 4 * e4);
#pragma unroll
                        for (int q = 0; q < 4; ++q) v2[4 * e4 + q] += yy * w[q];
                    }
                    __builtin_amdgcn_sched_barrier(0);
                }
            float v[2][32];
#pragma unroll
            for (int e = 0; e < 32; ++e) { v[0][e] = v2[e][0]; v[1][e] = v2[e][1]; }
#pragma unroll
            for (int rr = 0; rr < 2; ++rr) {
                const int rl = wave * 8 + pp * 2 + rr;
#pragma unroll
                for (int e = 0; e < 32; ++e) v[rr][e] += __shfl_xor(v[rr][e], 32);
#define TR_STEP(OFF, CNT) _Pragma("unroll") for (int e = 0; e < CNT; ++e) { const bool up = (lane & OFF) != 0; const float send = up ? v[rr][e] : v[rr][e + CNT]; const float keep = up ? v[rr][e + CNT] : v[rr][e]; v[rr][e] = keep + __shfl_xor(send, OFF); }
                TR_STEP(16, 16) TR_STEP(8, 8) TR_STEP(4, 4) TR_STEP(2, 2) TR_STEP(1, 1)
#undef TR_STEP
                float val = v[rr][0] + myrb; const int my = lane & 31;
                float topv[4]; int topi[4];
#pragma unroll
                for (int k = 0; k < 4; ++k) {
                    float bv = val; int bi = my;
#pragma unroll
                    for (int off = 16; off >= 1; off >>= 1) { const float ov = __shfl_xor(bv, off); const int oi = __shfl_xor(bi, off); if (ov > bv || (ov == bv && oi < bi)) { bv = ov; bi = oi; } }
                    topv[k] = bv; topi[k] = bi; if (my == bi) val = -INFINITY;
                }
                if (lane == 0) {
                    const float e1 = expf(topv[1] - topv[0]), e2 = expf(topv[2] - topv[0]), e3 = expf(topv[3] - topv[0]);
                    const float inv = 1.0f / (1.0f + e1 + e2 + e3);
                    const float gt[4] = {inv, e1 * inv, e2 * inv, e3 * inv};
#pragma unroll
                    for (int k = 0; k < 4; ++k) { const int lr = __hip_atomic_fetch_add(&hist[topi[k]], 1, __ATOMIC_RELAXED, __HIP_MEMORY_SCOPE_WORKGROUP); pinfo[(rl * 4 + k) * 3 + 0] = topi[k]; pinfo[(rl * 4 + k) * 3 + 1] = lr; pinfo[(rl * 4 + k) * 3 + 2] = __float_as_int(gt[k]); }
                }
            }
        }
        __syncthreads();
        if (tid < 32) { const int c = hist[tid]; basev[tid] = c ? atomicAdd(gcount + tid, c) : 0; }
        __syncthreads();
        if (tid < 256) {
            const int e = pinfo[tid * 3 + 0]; const size_t pi = (size_t)it * 256 + tid;
            pair_e[pi] = e; pair_rank[pi] = basev[e] + pinfo[tid * 3 + 1]; pair_gate[pi] = __int_as_float(pinfo[tid * 3 + 2]);
        }
        __syncthreads();
    }
}

__device__ __forceinline__ void moe_pstart(const Params& P, lds_t* lds, int layer) {
    LAS int* ps = (LAS int*)(lds + 140 * 1024);
    const int* gcount = (const int*)(P.ws + WS_CTL) + 64 * layer;
    if (threadIdx.x == 0) { int a = 0; for (int e = 0; e < 32; ++e) { const int c = gcount[e]; ps[e] = a; ps[40 + e] = c; a += ((c + 255) >> 8) << 8; } ps[32] = a; }
    __syncthreads();
}

__device__ __forceinline__ void ph_route_scatter(const Params& P, lds_t* lds, int layer) {
    moe_pstart(P, lds, layer);
    LAS int* ps = (LAS int*)(lds + 140 * 1024);
    const int* pair_e = (const int*)(P.ws + WS_ROUTE); const int* pair_rank = pair_e + T * 4; const float* pair_gate = (const float*)(pair_rank + T * 4);
    int* dest = (int*)(pair_gate + T * 4); int* row_tok = dest + T * 4; float* row_gate = (float*)(row_tok + MOE_ROWS);
    const size_t gtid = (size_t)blockIdx.x * NTHREADS + threadIdx.x, GT = (size_t)gridDim.x * NTHREADS;
    for (size_t i = gtid; i < (size_t)T * 4; i += GT) {
        const int e = pair_e[i], pos = ps[e] + pair_rank[i];
        row_tok[pos] = (int)(i >> 2); row_gate[pos] = pair_gate[i]; dest[i] = pos;
    }
    for (size_t i = gtid; i < 32 * 256; i += GT) {
        const int e = (int)(i >> 8), pos = ps[e] + ps[40 + e] + (int)(i & 255);
        if (pos < ps[e + 1]) { row_tok[pos] = 0; row_gate[pos] = 0.f; }
    }
}

__device__ __forceinline__ void ph_moe_up(const Params& P, lds_t* lds, int layer) {
    moe_pstart(P, lds, layer);
    LAS int* ps = (LAS int*)(lds + 140 * 1024);
    const bf16_t* xb = (const bf16_t*)(P.ws + WS_XB); const bf16_t* W = (const bf16_t*)(P.ws + WS_MWIN); bf16_t* hact = (bf16_t*)(P.ws + WS_HACT);
    const int* row_tok = (const int*)(P.ws + WS_ROUTE) + 4 * T * 4;
    const float* b_in = P.in[I_M_BIN] + (size_t)layer * 32 * 2048;
    const int nunits = (ps[32] >> 8) * 16;
    for (int unit = blockIdx.x; unit < nunits; unit += gridDim.x) {
        const int rb = unit >> 4, ct = unit & 15;
        int e = 0; while (ps[e + 1] <= rb * 256) ++e;
        int tok[4];
#pragma unroll
        for (int i = 0; i < 4; ++i) tok[i] = row_tok[rb * 256 + (threadIdx.x >> 3) + 64 * i];
        const bf16_t* We = W + (size_t)e * 2048 * 1024; const float* be = b_in + e * 2048;
        e1_tile<true>(lds, 16,
            [=](int i, int, int kp) { return *(const u32x4*)(xb + (size_t)tok[i] * 1024 + kp * 8); },
            [=](int, int n, int kp) { return *(const u32x4*)(We + (size_t)(ct * 128 + n) * 1024 + kp * 8); },
            [=](f32x4 (&acc)[4][4], int wr, int wc, int fr, int fq) {
#pragma unroll
                for (int n = 0; n < 2; ++n) {
                    const int j = ct * 64 + wc * 32 + n * 16 + fq * 4;
                    const f32x4 bg = *(const f32x4*)(be + j), bl = *(const f32x4*)(be + 1024 + j);
#pragma unroll
                    for (int m = 0; m < 4; ++m) {
                        f32x4 y;
#pragma unroll
                        for (int c = 0; c < 4; ++c) {
                            const float gv = fminf(acc[m][n][c] + bg[c], 7.0f), lv = fminf(fmaxf(acc[m][n + 2][c] + bl[c], -7.0f), 7.0f);
                            y[c] = gv * fsigmoid(1.702f * gv) * (lv + 1.0f);
                        }
                        store_bf16x4(hact + (size_t)(rb * 256 + wr * 64 + m * 16 + fr) * 1024 + j, y);
                    }
                }
            });
    }
}

__device__ __forceinline__ void ph_moe_down(const Params& P, lds_t* lds, int layer) {
    moe_pstart(P, lds, layer);
    LAS int* ps = (LAS int*)(lds + 140 * 1024);
    const bf16_t* hact = (const bf16_t*)(P.ws + WS_HACT); const bf16_t* W = (const bf16_t*)(P.ws + WS_MWOUT); bf16_t* yb = (bf16_t*)(P.ws + WS_YB);
    const float* row_gate = (const float*)((const int*)(P.ws + WS_ROUTE) + 4 * T * 4 + MOE_ROWS);
    const float* b_out = P.in[I_M_BOUT] + (size_t)layer * 32 * 1024;
    const int nunits = (ps[32] >> 8) * 8;
    for (int unit = blockIdx.x; unit < nunits; unit += gridDim.x) {
        const int rb = unit >> 3, ct = unit & 7;
        int e = 0; while (ps[e + 1] <= rb * 256) ++e;
        const bf16_t* We = W + (size_t)e * 1024 * 1024; const float* be = b_out + e * 1024;
        e1_tile<true>(lds, 16,
            [=](int, int r, int kp) { return *(const u32x4*)(hact + (size_t)(rb * 256 + r) * 1024 + kp * 8); },
            [=](int, int n, int kp) { return *(const u32x4*)(We + (size_t)(ct * 128 + n) * 1024 + kp * 8); },
            [=](f32x4 (&acc)[4][4], int wr, int wc, int fr, int fq) {
#pragma unroll
                for (int m = 0; m < 4; ++m) {
                    const int row = rb * 256 + wr * 64 + m * 16 + fr; const float gt = row_gate[row];
#pragma unroll
                    for (int n = 0; n < 4; ++n) {
                        const int col = ct * 128 + wc * 64 + n * 16 + fq * 4;
                        store_bf16x4(yb + (size_t)row * 1024 + col, (acc[m][n] + *(const f32x4*)(be + col)) * gt);
                    }
                }
            });
    }
}

struct EpiInproj {
    bf16_t* proj; int N; const int* pos;
    __device__ __forceinline__ void operator()(f32x4 (&acc)[2][2][4][2], const g2::Unit& u, int wr, int wc, int fr, int fq) const {
#pragma unroll
        for (int bj = 0; bj < 2; ++bj) {
            const int ct = 2 * u.pn + bj;
            if (pos != nullptr && ct >= 8 && ct < 16 && wc == 0) {
                float invf[4];
#pragma unroll
                for (int c = 0; c < 4; ++c) invf[c] = exp2f(-(float)(fq * 4 + c) * (18.931568569324174f / 16.0f));
#pragma unroll
                for (int ai = 0; ai < 2; ++ai)
#pragma unroll
                    for (int m = 0; m < 4; ++m) {
                        const float pf = (float)pos[u.pm * 256 + ai * 128 + wr * 64 + m * 16 + fr];
#pragma unroll
                        for (int c = 0; c < 4; ++c) {
                            float sn, cs; fsincos(pf * invf[c], sn, cs);
                            const float a = acc[ai][bj][m][0][c], b = acc[ai][bj][m][1][c];
                            acc[ai][bj][m][0][c] = a * cs - b * sn; acc[ai][bj][m][1][c] = b * cs + a * sn;
                        }
                    }
            }
            const float sc = (pos != nullptr && ct >= 8 && ct < 12) ? 0.08838834764831845f : 1.0f;
#pragma unroll
            for (int ai = 0; ai < 2; ++ai)
#pragma unroll
                for (int m = 0; m < 4; ++m)
#pragma unroll
                    for (int n = 0; n < 2; ++n)
                        store_bf16x4(proj + (size_t)(u.pm * 256 + ai * 128 + wr * 64 + m * 16 + fr) * N + ct * 128 + wc * 32 + n * 16 + fq * 4, acc[ai][bj][m][n] * sc);
        }
    }
};
__device__ __forceinline__ void ph_inproj2(const Params& P, lds_t* lds, const bf16_t* Wt, int N, const int* pos) {
    g2::DenseSched S{(int)gridDim.x, (int)blockIdx.x, T / 256, N / 256, 1024, (const char*)Wt};
    EpiInproj E{(bf16_t*)(P.ws + WS_PROJ), N, pos};
    g2::gemm_phase(lds, (const char*)(P.ws + WS_XB), 1024, 2048u, S, E);
}
struct EpiOutproj {
    float* zf; const float* xres;
    __device__ __forceinline__ void operator()(f32x4 (&acc)[2][2][4][2], const g2::Unit& u, int wr, int wc, int fr, int fq) const {
#pragma unroll
        for (int ai = 0; ai < 2; ++ai)
#pragma unroll
            for (int m = 0; m < 4; ++m)
#pragma unroll
                for (int bj = 0; bj < 2; ++bj)
#pragma unroll
                    for (int n = 0; n < 2; ++n) {
                        const size_t o = (size_t)(u.pm * 256 + ai * 128 + wr * 64 + m * 16 + fr) * 1024 + u.pn * 256 + bj * 128 + wc * 32 + n * 16 + fq * 4;
                        *(f32x4*)(zf + o) = *(const f32x4*)(xres + o) * ALPHA + acc[ai][bj][m][n];
                    }
    }
};
__device__ __forceinline__ void ph_outproj2(const Params& P, lds_t* lds, const bf16_t* Wt, const float* xres) {
    g2::DenseSched S{(int)gridDim.x, (int)blockIdx.x, T / 256, 4, 1024, (const char*)Wt};
    EpiOutproj E{(float*)(P.ws + WS_ZF), xres};
    g2::gemm_phase(lds, (const char*)(P.ws + WS_CAT), 1024, 2048u, S, E);
}
struct MoeSched {
    int G, c, nM, nN; const char* W; size_t wstride; const int* row_tok; LAS int* ps;
    __device__ __forceinline__ bool next(int i, g2::Unit& u) const { return g2::static_next(i, G, c, nM, nN, u); }
    __device__ __forceinline__ int expert(int pm) const { int e = 0; while (ps[e + 1] <= pm * 256) ++e; return e; }
    __device__ __forceinline__ void a_off(const g2::Unit& u, const int (&Rs)[2], const int (&Cs)[2], unsigned (&ao)[2][2]) const {
#pragma unroll
        for (int h = 0; h < 2; ++h)
#pragma unroll
            for (int i = 0; i < 2; ++i) {
                const int r = u.pm * 256 + h * 128 + Rs[i];
                const unsigned row = row_tok ? (unsigned)row_tok[r] : (unsigned)r;
                ao[h][i] = (row * 1024u + (unsigned)Cs[i]) * 2u;
            }
    }
    __device__ __forceinline__ const char* b_base(const g2::Unit& u) const { return W + (size_t)expert(u.pm) * wstride + (size_t)u.pn * 256 * 2048; }
};
struct EpiMoeUp {
    bf16_t* hact; const float* b_in; LAS int* ps;
    __device__ __forceinline__ void operator()(f32x4 (&acc)[2][2][4][2], const g2::Unit& u, int wr, int wc, int fr, int fq) const {
        int e = 0; while (ps[e + 1] <= u.pm * 256) ++e;
        const float* be = b_in + e * 2048;
#pragma unroll
        for (int n = 0; n < 2; ++n) {
            const int j = u.pn * 128 + wc * 32 + n * 16 + fq * 4;
            const f32x4 bg = *(const f32x4*)(be + j), bl = *(const f32x4*)(be + 1024 + j);
#pragma unroll
            for (int ai = 0; ai < 2; ++ai)
#pragma unroll
                for (int m = 0; m < 4; ++m) {
                    f32x4 y;
#pragma unroll
                    for (int c = 0; c < 4; ++c) {
                        const float gv = fminf(acc[ai][0][m][n][c] + bg[c], 7.0f), lv = fminf(fmaxf(acc[ai][1][m][n][c] + bl[c], -7.0f), 7.0f);
                        y[c] = gv * fsigmoid(1.702f * gv) * (lv + 1.0f);
                    }
                    store_bf16x4(hact + (size_t)(u.pm * 256 + ai * 128 + wr * 64 + m * 16 + fr) * 1024 + j, y);
                }
        }
    }
};
__device__ __forceinline__ void ph_moe_up2(const Params& P, lds_t* lds, int layer) {
    moe_pstart(P, lds, layer);
    LAS int* ps = (LAS int*)(lds + 140 * 1024);
    const int* row_tok = (const int*)(P.ws + WS_ROUTE) + 4 * T * 4;
    MoeSched S{(int)gridDim.x, (int)blockIdx.x, ps[32] >> 8, 8, (const char*)(P.ws + WS_MWIN), (size_t)2048 * 1024 * 2, row_tok, ps};
    EpiMoeUp E{(bf16_t*)(P.ws + WS_HACT), P.in[I_M_BIN] + (size_t)layer * 32 * 2048, ps};
    g2::gemm_phase(lds, (const char*)(P.ws + WS_XB), 1024, 2048u, S, E);
}
struct EpiMoeDown {
    bf16_t* yb; const float* b_out; const float* row_gate; LAS int* ps;
    __device__ __forceinline__ void operator()(f32x4 (&acc)[2][2][4][2], const g2::Unit& u, int wr, int wc, int fr, int fq) const {
        int e = 0; while (ps[e + 1] <= u.pm * 256) ++e;
        const float* be = b_out + e * 1024;
#pragma unroll
        for (int ai = 0; ai < 2; ++ai)
#pragma unroll
            for (int m = 0; m < 4; ++m) {
                const int row = u.pm * 256 + ai * 128 + wr * 64 + m * 16 + fr; const float gt = row_gate[row];
#pragma unroll
                for (int bj = 0; bj < 2; ++bj)
#pragma unroll
                    for (int n = 0; n < 2; ++n) {
                        const int col = u.pn * 256 + bj * 128 + wc * 32 + n * 16 + fq * 4;
                        store_bf16x4(yb + (size_t)row * 1024 + col, (acc[ai][bj][m][n] + *(const f32x4*)(be + col)) * gt);
                    }
            }
    }
};
__device__ __forceinline__ void ph_moe_down2(const Params& P, lds_t* lds, int layer) {
    moe_pstart(P, lds, layer);
    LAS int* ps = (LAS int*)(lds + 140 * 1024);
    const float* row_gate = (const float*)((const int*)(P.ws + WS_ROUTE) + 4 * T * 4 + MOE_ROWS);
    MoeSched S{(int)gridDim.x, (int)blockIdx.x, ps[32] >> 8, 4, (const char*)(P.ws + WS_MWOUT), (size_t)1024 * 1024 * 2, nullptr, ps};
    EpiMoeDown E{(bf16_t*)(P.ws + WS_YB), P.in[I_M_BOUT] + (size_t)layer * 32 * 1024, row_gate, ps};
    g2::gemm_phase(lds, (const char*)(P.ws + WS_HACT), 1024, 2048u, S, E);
}

__device__ __forceinline__ void ph_combine_ln(const Params& P, int layer, float* outf, bool write_bf) {
    float* x1f = (float*)(P.ws + WS_X1F); const bf16_t* yb = (const bf16_t*)(P.ws + WS_YB); bf16_t* xb = (bf16_t*)(P.ws + WS_XB);
    const int* dest = (const int*)(P.ws + WS_ROUTE) + 3 * T * 4;
    const float* lg = P.in[I_LNF_G] + layer * 1024; const float* lb = P.in[I_LNF_B] + layer * 1024;
    const int lane = threadIdx.x & 63, gw = blockIdx.x * 8 + (threadIdx.x >> 6), NGW = gridDim.x * 8;
    for (int row0 = gw * 2; row0 < T; row0 += NGW * 2) {
        f32x4 v[2][4]; u32x2 yr[2][4][4];
#pragma unroll
        for (int rr = 0; rr < 2; ++rr) {
            const int row = row0 + rr;
            const int4 d = *(const int4*)(dest + row * 4);
            const int dd[4] = {d.x, d.y, d.z, d.w};
#pragma unroll
            for (int j = 0; j < 4; ++j) {
                v[rr][j] = *(const f32x4*)(x1f + (size_t)row * 1024 + j * 256 + lane * 4);
#pragma unroll
                for (int k = 0; k < 4; ++k) yr[rr][j][k] = *(const u32x2*)(yb + (size_t)dd[k] * 1024 + j * 256 + lane * 4);
            }
        }
#pragma unroll
        for (int rr = 0; rr < 2; ++rr) {
            const int row = row0 + rr; float s = 0.f;
#pragma unroll
            for (int j = 0; j < 4; ++j) {
                v[rr][j] = v[rr][j] * ALPHA;
#pragma unroll
                for (int k = 0; k < 4; ++k) {
                    const u32x2 r = yr[rr][j][k];
                    v[rr][j][0] += __uint_as_float(r.x << 16); v[rr][j][1] += __uint_as_float(r.x & 0xffff0000u); v[rr][j][2] += __uint_as_float(r.y << 16); v[rr][j][3] += __uint_as_float(r.y & 0xffff0000u);
                }
                s += (v[rr][j][0] + v[rr][j][1]) + (v[rr][j][2] + v[rr][j][3]);
            }
            const float mean = wave_sum(s) * (1.0f / 1024.0f); float s2 = 0.f;
#pragma unroll
            for (int j = 0; j < 4; ++j) { v[rr][j] = v[rr][j] - mean; s2 += (v[rr][j][0] * v[rr][j][0] + v[rr][j][1] * v[rr][j][1]) + (v[rr][j][2] * v[rr][j][2] + v[rr][j][3] * v[rr][j][3]); }
            const float rstd = rsqrtf(wave_sum(s2) * (1.0f / 1024.0f) + LN_EPS);
#pragma unroll
            for (int j = 0; j < 4; ++j) {
                const f32x4 o = v[rr][j] * rstd * *(const f32x4*)(lg + j * 256 + lane * 4) + *(const f32x4*)(lb + j * 256 + lane * 4);
                *(f32x4*)(outf + (size_t)row * 1024 + j * 256 + lane * 4) = o;
                if (write_bf) store_bf16x4(xb + (size_t)row * 1024 + j * 256 + lane * 4, o);
            }
        }
    }
}

__device__ __forceinline__ void ph_conv1(const Params& P, lds_t* lds) {
    const bf16_t* proj = (const bf16_t*)(P.ws + WS_PROJ); bf16_t* xconv = (bf16_t*)(P.ws + WS_XCONV); float* gates = (float*)(P.ws + WS_GATES);
    LAS float* Wc = (LAS float*)lds;
    const float* Wcg = (const float*)(P.ws + WS_WC);
    for (int i = threadIdx.x; i < 8192; i += NTHREADS) Wc[i] = Wcg[i];
    __syncthreads();
    const int lane = threadIdx.x & 63, gw = blockIdx.x * 8 + (threadIdx.x >> 6), NGW = gridDim.x * 8, c8 = lane * 8;
    float w[4][8], bias[8];
#pragma unroll
    for (int e = 0; e < 8; ++e) { bias[e] = P.in[I_CD_CONVB][c8 + e];
#pragma unroll
        for (int k = 0; k < 4; ++k) w[k][e] = P.in[I_CD_CONVW][k * 512 + c8 + e]; }
    const float bif = P.in[I_CD_BIF][lane & 7];
    for (int tok = gw; tok < T; tok += NGW) {
        const int p = tok & (SEQ - 1);
        float a[8], xraw[8];
#pragma unroll
        for (int e = 0; e < 8; ++e) { a[e] = bias[e]; xraw[e] = 0.f; }
#pragma unroll
        for (int k = 0; k < 4; ++k) {
            if (p - 3 + k >= 0) {
                float xv[8]; unpack8(*(const u32x4*)(proj + (size_t)(tok - 3 + k) * 2560 + c8), xv);
#pragma unroll
                for (int e = 0; e < 8; ++e) { a[e] += w[k][e] * xv[e]; if (k == 3) xraw[e] = xv[e]; }
            }
        }
#pragma unroll
        for (int e = 0; e < 8; ++e) a[e] = a[e] * fsigmoid(a[e]);
        const u32x4 packed = pack8(a);
        *(u32x4*)(xconv + (size_t)tok * 512 + c8) = packed;
        float ar[8]; unpack8(packed, ar);
        float gs[8];
#pragma unroll
        for (int gg = 0; gg < 8; ++gg) gs[gg] = 0.f;
#pragma unroll
        for (int e = 0; e < 8; ++e) {
            const f32x4 w1a = *(LAS f32x4*)(Wc + (c8 + e) * 8), w1b = *(LAS f32x4*)(Wc + (c8 + e) * 8 + 4);
            const f32x4 w2a = *(LAS f32x4*)(Wc + 4096 + (c8 + e) * 8), w2b = *(LAS f32x4*)(Wc + 4096 + (c8 + e) * 8 + 4);
#pragma unroll
            for (int gg = 0; gg < 4; ++gg) { gs[gg] += ar[e] * w1a[gg] + xraw[e] * w2a[gg]; gs[gg + 4] += ar[e] * w1b[gg] + xraw[e] * w2b[gg]; }
        }
        float mine = 0.f;
#pragma unroll
        for (int gg = 0; gg < 8; ++gg) { const float tsum = wave_sum(gs[gg]); if ((lane & 7) == gg) mine = tsum; }
        if (lane < 8) gates[(size_t)tok * 8 + lane] = mine + bif;
    }
}

__device__ __forceinline__ void ph_qkv(const Params& P, lds_t* lds) {
    const bf16_t* xconv = (const bf16_t*)(P.ws + WS_XCONV); const bf16_t* proj = (const bf16_t*)(P.ws + WS_PROJ); const bf16_t* Wt = (const bf16_t*)(P.ws + WS_WQKV);
    for (int tile = blockIdx.x; tile < 1536; tile += gridDim.x) {
        const int which = tile % 3, rt = (tile / 3) & 127, h = tile / 384;
        const bf16_t* A = which < 2 ? xconv : proj; const int lda = which < 2 ? 512 : 2560;
        bf16_t* out = (bf16_t*)(P.ws + (which == 0 ? WS_QB : (which == 1 ? WS_KB : WS_VB)));
        const float sc = which == 1 ? 0.08838834764831845f : 1.0f;
        const bf16_t* Wh = Wt + (size_t)(which * 4 + h) * 16384;
        e1_tile<true>(lds, 2,
            [=](int, int r, int kp) { return *(const u32x4*)(A + (size_t)(rt * 256 + r) * lda + h * 128 + kp * 8); },
            [=](int, int n, int kp) { return *(const u32x4*)(Wh + n * 128 + kp * 8); },
            [=](f32x4 (&acc)[4][4], int wr, int wc, int fr, int fq) {
#pragma unroll
                for (int m = 0; m < 4; ++m)
#pragma unroll
                    for (int n = 0; n < 4; ++n)
                        store_bf16x4(out + (size_t)(rt * 256 + wr * 64 + m * 16 + fr) * 512 + h * 128 + wc * 64 + n * 16 + fq * 4, acc[m][n] * sc);
            });
    }
}

constexpr int TP = 272;
template <int NROWS>
__device__ __forceinline__ void stage_tile(lds_t* dst, const bf16_t* src, size_t src_ld) {
    constexpr int NP = NROWS * 16 / NTHREADS;
    u32x4 r[NP];
#pragma unroll
    for (int i = 0; i < NP; ++i) { const int p = threadIdx.x + i * NTHREADS; r[i] = *(const u32x4*)(src + (size_t)(p >> 4) * src_ld + (p & 15) * 8); }
#pragma unroll
    for (int i = 0; i < NP; ++i) { const int p = threadIdx.x + i * NTHREADS; *(LAS u32x4*)(dst + (p >> 4) * TP + (p & 15) * 16) = r[i]; }
}

__device__ __forceinline__ void ph_m1(const Params& P, lds_t* lds) {
    const bf16_t* kb = (const bf16_t*)(P.ws + WS_KB); const bf16_t* vb = (const bf16_t*)(P.ws + WS_VB); const float* gates = (const float*)(P.ws + WS_GATES);
    float* kvc = (float*)(P.ws + WS_KVC); float* nchunk = (float*)(P.ws + WS_MISC); float* scal = nchunk + 2 * 2048 * 128;
    lds_t* Kt = lds; lds_t* Vt = lds + 64 * TP; LAS float* wv = (LAS float*)(lds + 128 * TP);
    const int tid = threadIdx.x, lane = tid & 63, w = tid >> 6, fr = lane & 15, fq = lane >> 4, q = (lane & 15) >> 2, p4 = lane & 3;
    for (int item = blockIdx.x; item < 2048; item += gridDim.x) {
        const int bh = item >> 6, n = item & 63, b = bh >> 2, h = bh & 3; const size_t tok0 = (size_t)b * SEQ + n * 64;
        stage_tile<64>(Kt, kb + tok0 * 512 + h * 128, 512);
        stage_tile<64>(Vt, vb + tok0 * 512 + h * 128, 512);
        if (w == 0) {
            const float f = gates[(tok0 + lane) * 8 + 4 + h], ig = gates[(tok0 + lane) * 8 + h];
            float cum = logsigmoidf(f);
#pragma unroll
            for (int off = 1; off < 64; off <<= 1) { const float t = __shfl_up(cum, off); if (lane >= off) cum += t; }
            const float cf = __shfl(cum, 63), te = cf - cum + ig, m = wave_max(te);
            wv[lane] = expf(te - m);
            if (lane == 0) { scal[item] = cf; scal[2048 + item] = m; }
        }
        __syncthreads();
        bf16x8 af[2]; float nsum = 0.f;
#pragma unroll
        for (int ks = 0; ks < 2; ++ks) {
            unsigned pk[4];
#pragma unroll
            for (int t = 0; t < 2; ++t) {
                const int s0 = 32 * ks + 8 * fq + 4 * t;
                const bf16x4 r = tr_read(Kt + (s0 + q) * TP + (16 * w + 4 * p4) * 2);
                const f32x4 ww = *(LAS f32x4*)(wv + s0);
                float x[4];
#pragma unroll
                for (int e = 0; e < 4; ++e) { x[e] = bf2f((unsigned short)r[e]) * ww[e]; nsum += x[e]; }
                pk[2 * t] = pk_bf16(x[0], x[1]); pk[2 * t + 1] = pk_bf16(x[2], x[3]);
            }
            u32x4 u = {pk[0], pk[1], pk[2], pk[3]}; af[ks] = __builtin_bit_cast(bf16x8, u);
        }
        nsum += __shfl_xor(nsum, 16); nsum += __shfl_xor(nsum, 32);
        if (fq == 0) nchunk[(size_t)item * 128 + 16 * w + fr] = nsum;
#pragma unroll
        for (int c = 0; c < 8; ++c) {
            f32x4 acc = {0.f, 0.f, 0.f, 0.f};
#pragma unroll
            for (int ks = 0; ks < 2; ++ks) {
                const int s0 = 32 * ks + 8 * fq;
                const bf16x8 bfv = cat44(tr_read(Vt + (s0 + q) * TP + (16 * c + 4 * p4) * 2), tr_read(Vt + (s0 + 4 + q) * TP + (16 * c + 4 * p4) * 2));
                acc = MFMA16(af[ks], bfv, acc);
            }
            *(f32x4*)(kvc + ((size_t)item * 128 + c * 16 + fr) * 128 + 16 * w + fq * 4) = acc;
        }
        __syncthreads();
    }
}

__device__ __forceinline__ void ph_m2(const Params& P) {
    const float* kvc = (const float*)(P.ws + WS_KVC); bf16_t* cprev = (bf16_t*)(P.ws + WS_CPREV);
    const float* nchunk = (const float*)(P.ws + WS_MISC); float* nprev = (float*)(P.ws + WS_MISC) + 2048 * 128; float* scal = (float*)(P.ws + WS_MISC) + 2 * 2048 * 128;
    const int tid = threadIdx.x;
    for (int it = blockIdx.x; it < 256; it += gridDim.x) {
        const int bh = it >> 3, sl = it & 7, idx = sl * 2048 + tid * 4;
        const bool donv = (sl == 0 && tid < 128);
        f32x4 C = {0.f, 0.f, 0.f, 0.f}; float nv = 0.f, m = -INFINITY;
        for (int n0 = 0; n0 < 64; n0 += 4) {
            f32x4 kv[4]; float nc[4], fc[4], mc[4];
#pragma unroll
            for (int j = 0; j < 4; ++j) {
                const int item = bh * 64 + n0 + j;
                kv[j] = *(const f32x4*)(kvc + (size_t)item * 16384 + idx);
                nc[j] = donv ? nchunk[(size_t)item * 128 + tid] : 0.f;
                fc[j] = scal[item]; mc[j] = scal[2048 + item];
            }
#pragma unroll
            for (int j = 0; j < 4; ++j) {
                const int item = bh * 64 + n0 + j;
                store_bf16x4(cprev + (size_t)item * 16384 + idx, C);
                if (donv) nprev[(size_t)item * 128 + tid] = nv;
                if (sl == 0 && tid == 0) scal[4096 + item] = m;
                const float mn = fmaxf(fc[j] + m, mc[j]), so = expf(fc[j] + m - mn), sn = expf(mc[j] - mn);
                C = C * so + kv[j] * sn; nv = so * nv + sn * nc[j]; m = mn;
            }
        }
    }
}

__device__ __forceinline__ void ph_m3(const Params& P, lds_t* lds) {
    const bf16_t* qb = (const bf16_t*)(P.ws + WS_QB); const bf16_t* kb = (const bf16_t*)(P.ws + WS_KB); const bf16_t* vb = (const bf16_t*)(P.ws + WS_VB);
    const bf16_t* cprev = (const bf16_t*)(P.ws + WS_CPREV); const float* gates = (const float*)(P.ws + WS_GATES);
    const float* nprev = (const float*)(P.ws + WS_MISC) + 2048 * 128; const float* scal = (const float*)(P.ws + WS_MISC) + 2 * 2048 * 128;
    const bf16_t* proj = (const bf16_t*)(P.ws + WS_PROJ); bf16_t* cat = (bf16_t*)(P.ws + WS_CAT);
    lds_t* Qt = lds; lds_t* Kt = lds + 64 * TP; lds_t* Vt = lds + 128 * TP; lds_t* Ct = lds + 192 * TP;
    LAS float* cumf = (LAS float*)(lds + 320 * TP); LAS float* gv = cumf + 64; LAS float* msv = gv + 64; LAS float* npv = msv + 64; LAS float* ex = npv + 128;
    const int tid = threadIdx.x, lane = tid & 63, w = tid >> 6, fr = lane & 15, fq = lane >> 4, q = (lane & 15) >> 2, p4 = lane & 3;
    const int rt = w & 3, vh = w >> 2;
    for (int item = blockIdx.x; item < 2048; item += gridDim.x) {
        const int bh = item >> 6, n = item & 63, b = bh >> 2, h = bh & 3; const size_t tok0 = (size_t)b * SEQ + n * 64;
        stage_tile<64>(Qt, qb + tok0 * 512 + h * 128, 512);
        stage_tile<64>(Kt, kb + tok0 * 512 + h * 128, 512);
        stage_tile<64>(Vt, vb + tok0 * 512 + h * 128, 512);
        stage_tile<128>(Ct, cprev + (size_t)item * 16384, 128);
        if (tid < 128) npv[tid] = nprev[(size_t)item * 128 + tid];
        const float mp = scal[4096 + item];
        if (w == 0) {
            const float f = gates[(tok0 + lane) * 8 + 4 + h], ig = gates[(tok0 + lane) * 8 + h];
            float cum = logsigmoidf(f);
#pragma unroll
            for (int off = 1; off < 64; off <<= 1) { const float t = __shfl_up(cum, off); if (lane >= off) cum += t; }
            const float gg = ig - cum; float pm = gg;
#pragma unroll
            for (int off = 1; off < 64; off <<= 1) { const float t = __shfl_up(pm, off); if (lane >= off) pm = fmaxf(pm, t); }
            cumf[lane] = cum; gv[lane] = gg; msv[lane] = cum + fmaxf(pm, mp);
        }
        __syncthreads();
        bf16x8 qf[4];
#pragma unroll
        for (int ks = 0; ks < 4; ++ks) qf[ks] = *(LAS bf16x8*)(Qt + (rt * 16 + fr) * TP + ks * 64 + fq * 16);
        const int s = rt * 16 + fr; const float cs = cumf[s], mss = msv[s];
        float sp[4][4]; float rowsum = 0.f;
#pragma unroll
        for (int jt = 0; jt < 4; ++jt) {
            f32x4 st = {0.f, 0.f, 0.f, 0.f};
            if (jt <= rt) {
#pragma unroll
                for (int ks = 0; ks < 4; ++ks) st = MFMA16(*(LAS bf16x8*)(Kt + (jt * 16 + fr) * TP + ks * 64 + fq * 16), qf[ks], st);
            }
            const f32x4 g4 = *(LAS f32x4*)(gv + jt * 16 + fq * 4);
#pragma unroll
            for (int r = 0; r < 4; ++r) { const int j = jt * 16 + fq * 4 + r; const float wgt = (j <= s) ? fexp(cs + g4[r] - mss) : 0.f; sp[jt][r] = st[r] * wgt; rowsum += sp[jt][r]; }
        }
        rowsum += __shfl_xor(rowsum, 16); rowsum += __shfl_xor(rowsum, 32);
        float qn = 0.f;
#pragma unroll
        for (int ks = 0; ks < 4; ++ks) {
            const f32x4 n0 = *(LAS f32x4*)(npv + ks * 32 + fq * 8), n1 = *(LAS f32x4*)(npv + ks * 32 + fq * 8 + 4);
#pragma unroll
            for (int e = 0; e < 4; ++e) { qn += bf2f((unsigned short)qf[ks][e]) * n0[e]; qn += bf2f((unsigned short)qf[ks][4 + e]) * n1[e]; }
        }
        qn += __shfl_xor(qn, 16); qn += __shfl_xor(qn, 32);
        const float inter = expf(cs + mp - mss), den = rowsum + inter * qn, inv = 1.0f / fmaxf(fabsf(den), expf(-mss));
        if (fq == 0) { ex[w * 32 + fr] = inv; ex[w * 32 + 16 + fr] = inter; }
        __builtin_amdgcn_wave_barrier();
        const f32x4 inv4 = *(LAS f32x4*)(ex + w * 32 + fq * 4), int4 = *(LAS f32x4*)(ex + w * 32 + 16 + fq * 4);
        bf16x8 pa[2];
#pragma unroll
        for (int kk = 0; kk < 2; ++kk) { u32x4 u = {pk_bf16(sp[2 * kk][0], sp[2 * kk][1]), pk_bf16(sp[2 * kk][2], sp[2 * kk][3]), pk_bf16(sp[2 * kk + 1][0], sp[2 * kk + 1][1]), pk_bf16(sp[2 * kk + 1][2], sp[2 * kk + 1][3])}; pa[kk] = __builtin_bit_cast(bf16x8, u); }
#pragma unroll
        for (int c = 0; c < 4; ++c) {
            const int vcol = vh * 64 + c * 16;
            f32x4 acc = {0.f, 0.f, 0.f, 0.f};
#pragma unroll
            for (int ks = 0; ks < 4; ++ks) acc = MFMA16(qf[ks], *(LAS bf16x8*)(Ct + (vcol + fr) * TP + ks * 64 + fq * 16), acc);
#pragma unroll
            for (int r = 0; r < 4; ++r) acc[r] *= int4[r];
#pragma unroll
            for (int kk = 0; kk < 2; ++kk) {
                const bf16x8 vbf = cat44(tr_read(Vt + (32 * kk + 4 * fq + q) * TP + (vcol + 4 * p4) * 2), tr_read(Vt + (32 * kk + 16 + 4 * fq + q) * TP + (vcol + 4 * p4) * 2));
                acc = MFMA16(pa[kk], vbf, acc);
            }
#pragma unroll
            for (int r = 0; r < 4; ++r) {
                const size_t tok = tok0 + rt * 16 + fq * 4 + r; const int col = h * 128 + vcol + fr;
                const float op = bf2f(proj[tok * 2560 + 512 + col]);
                cat[tok * 1024 + col] = (bf16_t)(pk_bf16(fsigmoid(op) * acc[r] * inv4[r], 0.f) & 0xffffu);
            }
        }
        __syncthreads();
    }
}

__device__ __forceinline__ void ph_attn(const Params& P, lds_t* lds) {
    const bf16_t* proj = (const bf16_t*)(P.ws + WS_PROJ); float* atto = (float*)(P.ws + WS_ATTO); float* lse = (float*)(P.ws + WS_LSE);
    lds_t* Kt = lds; lds_t* Vt = lds + 256 * TP; LAS float* ex = (LAS float*)(lds + 512 * TP);
    const int tid = threadIdx.x, lane = tid & 63, w = tid >> 6, fr = lane & 15, fq = lane >> 4, q = (lane & 15) >> 2, p4 = lane & 3;
    for (int item = blockIdx.x; item < 3072; item += gridDim.x) {
        const int g = item >> 10, rem = item & 1023, h = rem & 3, x = rem >> 2, b = x >> 5, y = x & 31;
        const int dsh = 2 * g, dil = 1 << dsh, nbsh = 5 - dsh, r = y >> nbsh, nb = y & ((1 << nbsh) - 1);
        const size_t tokb = (size_t)b * SEQ + r;
#pragma unroll
        for (int kvsel = 0; kvsel < 2; ++kvsel) {
            u32x4 rg[8];
#pragma unroll
            for (int it8 = 0; it8 < 8; ++it8) {
                const int p = tid + it8 * NTHREADS, kr = p >> 4, pc = p & 15; const int i = nb * 128 + kr - 128;
                rg[it8] = (u32x4){0u, 0u, 0u, 0u};
                if (i >= 0) rg[it8] = *(const u32x4*)(proj + (tokb + (size_t)i * dil) * 2560 + (kvsel ? 2048 : 1536) + h * 128 + pc * 8);
            }
#pragma unroll
            for (int it8 = 0; it8 < 8; ++it8) { const int p = tid + it8 * NTHREADS, kr = p >> 4, pc = p & 15; *(LAS u32x4*)((kvsel ? Vt : Kt) + kr * TP + pc * 16) = rg[it8]; }
        }
        const int qi = w * 16 + fr;
        const size_t tokq = tokb + (size_t)(nb * 128 + qi) * dil;
        bf16x8 qf[4];
#pragma unroll
        for (int ks = 0; ks < 4; ++ks) qf[ks] = __builtin_bit_cast(bf16x8, *(const u32x4*)(proj + tokq * 2560 + 1024 + h * 128 + ks * 32 + fq * 8));
        __syncthreads();
        float pv[9][4]; float mx = -INFINITY;
#pragma unroll
        for (int jj = 0; jj < 9; ++jj) {
            f32x4 st = {0.f, 0.f, 0.f, 0.f};
#pragma unroll
            for (int ks = 0; ks < 4; ++ks) st = MFMA16(*(LAS bf16x8*)(Kt + ((w + jj) * 16 + fr) * TP + ks * 64 + fq * 16), qf[ks], st);
#pragma unroll
            for (int rr = 0; rr < 4; ++rr) {
                const int kj = (w + jj) * 16 + fq * 4 + rr;
                const bool valid = (kj >= qi) && (kj <= qi + 128) && (nb > 0 || kj >= 128);
                pv[jj][rr] = valid ? st[rr] : -INFINITY; mx = fmaxf(mx, pv[jj][rr]);
            }
        }
        mx = fmaxf(mx, __shfl_xor(mx, 16)); mx = fmaxf(mx, __shfl_xor(mx, 32));
        float l = 0.f;
#pragma unroll
        for (int jj = 0; jj < 9; ++jj)
#pragma unroll
            for (int rr = 0; rr < 4; ++rr) { pv[jj][rr] = fexp(pv[jj][rr] - mx); l += pv[jj][rr]; }
        l += __shfl_xor(l, 16); l += __shfl_xor(l, 32);
        if (fq == 0) { ex[w * 16 + fr] = 1.0f / l; lse[((size_t)g * T + tokq) * 4 + h] = mx + logf(l); }
        __builtin_amdgcn_wave_barrier();
        const f32x4 inv4 = *(LAS f32x4*)(ex + w * 16 + fq * 4);
        f32x4 acc[8];
#pragma unroll
        for (int c = 0; c < 8; ++c) acc[c] = (f32x4){0.f, 0.f, 0.f, 0.f};
#pragma unroll
        for (int kk = 0; kk < 5; ++kk) {
            const int ja = 2 * kk, jb = (2 * kk + 1 < 9) ? 2 * kk + 1 : 2 * kk;
            u32x4 u; u.x = pk_bf16(pv[ja][0], pv[ja][1]); u.y = pk_bf16(pv[ja][2], pv[ja][3]);
            if (2 * kk + 1 < 9) { u.z = pk_bf16(pv[jb][0], pv[jb][1]); u.w = pk_bf16(pv[jb][2], pv[jb][3]); } else { u.z = 0u; u.w = 0u; }
            const bf16x8 pa = __builtin_bit_cast(bf16x8, u);
#pragma unroll
            for (int c = 0; c < 8; ++c) {
                const bf16x8 vbf = cat44(tr_read(Vt + ((w + ja) * 16 + 4 * fq + q) * TP + (c * 16 + 4 * p4) * 2), tr_read(Vt + ((w + jb) * 16 + 4 * fq + q) * TP + (c * 16 + 4 * p4) * 2));
                acc[c] = MFMA16(pa, vbf, acc[c]);
            }
        }
#pragma unroll
        for (int rr = 0; rr < 4; ++rr) {
            const size_t tq = tokb + (size_t)(nb * 128 + w * 16 + fq * 4 + rr) * dil;
#pragma unroll
            for (int c = 0; c < 8; ++c) atto[((size_t)g * T + tq) * 512 + h * 128 + c * 16 + fr] = acc[c][rr] * inv4[rr];
        }
        __syncthreads();
    }
}

__device__ __forceinline__ void ph_attn_combine(const Params& P) {
    const float* atto = (const float*)(P.ws + WS_ATTO); const float* lse = (const float*)(P.ws + WS_LSE); bf16_t* cat = (bf16_t*)(P.ws + WS_CAT);
    const size_t gtid = (size_t)blockIdx.x * NTHREADS + threadIdx.x, GT = (size_t)gridDim.x * NTHREADS;
    for (size_t i = gtid; i < (size_t)T * 128; i += GT) {
        const size_t tok = i >> 7; const int c4 = (int)(i & 127) * 4, h = c4 >> 7;
        const float l0 = lse[tok * 4 + h], l1 = lse[((size_t)T + tok) * 4 + h], l2 = lse[((size_t)2 * T + tok) * 4 + h];
        const float mx = fmaxf(l0, fmaxf(l1, l2)), e0 = expf(l0 - mx), e1 = expf(l1 - mx), e2 = expf(l2 - mx), inv = 1.0f / (e0 + e1 + e2);
        const f32x4 o = (*(const f32x4*)(atto + tok * 512 + c4) * e0 + *(const f32x4*)(atto + ((size_t)T + tok) * 512 + c4) * e1 + *(const f32x4*)(atto + ((size_t)2 * T + tok) * 512 + c4) * e2) * inv;
        store_bf16x4(cat + tok * 1024 + 512 + c4, o);
    }
}

constexpr int NPHASES = 33;
__device__ __forceinline__ void grid_barrier_cg(cg::grid_group& grid) {
    asm volatile("s_waitcnt vmcnt(0)" ::: "memory");
    grid.sync();
    __builtin_amdgcn_fence(__ATOMIC_ACQUIRE, "agent");
    asm volatile("s_waitcnt vmcnt(0)" ::: "memory");
}
#define XB_TMO      128
#define XB_XCNT(j)  (256  + 64 * (j))
#define XB_XSUB(j)  (1280 + 64 * (j))
#define XB_XGEN(j)  (2304 + 64 * (j))
#define XB_TOP      3328
#define XB_TOPGEN   3392
#define XCD_BAR_WORDS 3456
#define XB_SPIN_CAP (1u << 22)
__device__ __forceinline__ unsigned xb_ld(unsigned* p)              { return __hip_atomic_load(p, __ATOMIC_RELAXED, __HIP_MEMORY_SCOPE_AGENT); }
__device__ __forceinline__ unsigned xb_add(unsigned* p, unsigned v) { return __hip_atomic_fetch_add(p, v, __ATOMIC_RELAXED, __HIP_MEMORY_SCOPE_AGENT); }
__device__ __forceinline__ unsigned xb_xcc_id() { return (unsigned)__builtin_amdgcn_s_getreg((3 << 11) | 20) & 0xFu; }
#define XB_SPIN(cond, bar) do { unsigned _sp = 0; while (cond) { __builtin_amdgcn_s_sleep(1); \
    if ((++_sp & 255u) == 0u) { if (xb_ld(&(bar)[XB_TMO])) break; if (_sp > XB_SPIN_CAP) { atomicAdd(&(bar)[XB_TMO], 1u); break; } } } } while (0)
struct XcdBarrier { unsigned* bar; unsigned x; volatile LAS unsigned* st; };
__device__ __forceinline__ XcdBarrier xcd_barrier_post(unsigned* bar, volatile LAS unsigned* st) {
    XcdBarrier b; b.bar = bar; b.x = xb_xcc_id(); b.st = st;
    if (threadIdx.x == 0) (void)xb_add(&bar[XB_XCNT(b.x)], 1u);
    return b;
}
__device__ __forceinline__ void xcd_barrier_complete(unsigned* bar, unsigned x, unsigned& nloc, unsigned& nx) {
    const unsigned G = gridDim.x * gridDim.y * gridDim.z;
    unsigned sum, cnt, mine, sp = 0u;
    for (;;) {
        sum = 0u; cnt = 0u; mine = 0u;
#pragma unroll
        for (unsigned j = 0; j < 16; ++j) { const unsigned c = xb_ld(&bar[XB_XCNT(j)]); sum += c; cnt += (c > 0u) ? 1u : 0u; mine = (j == x) ? c : mine; }
        if (sum == G) break;
        __builtin_amdgcn_s_sleep(1);
        if ((++sp & 255u) == 0u) { if (xb_ld(&bar[XB_TMO])) break; if (sp > XB_SPIN_CAP) { atomicAdd(&bar[XB_TMO], 1u); break; } }
    }
    nloc = mine > 0u ? mine : 1u; nx = cnt > 0u ? cnt : 1u;
}
__device__ __forceinline__ void xcd_barrier(const XcdBarrier& b) {
    asm volatile("s_waitcnt vmcnt(0)" ::: "memory");
    __syncthreads();
    if (threadIdx.x == 0) {
        unsigned* bar = b.bar;
        __builtin_amdgcn_s_waitcnt(0);
        unsigned nloc = b.st[0], nx = b.st[1];
        if (nloc == 0u) { xcd_barrier_complete(bar, b.x, nloc, nx); b.st[0] = nloc; b.st[1] = nx; }
        const unsigned old = xb_add(&bar[XB_XSUB(b.x)], 1u);
        const unsigned gen = old / nloc;
        if (old + 1u == (gen + 1u) * nloc) {
            __builtin_amdgcn_fence(__ATOMIC_RELEASE, "agent");
            asm volatile("s_waitcnt vmcnt(0)" ::: "memory");
            const unsigned og = xb_add(&bar[XB_TOP], 1u);
            const unsigned tg = og / nx;
            if (og + 1u == (tg + 1u) * nx) xb_add(&bar[XB_TOPGEN], 1u);
            else XB_SPIN(xb_ld(&bar[XB_TOPGEN]) == tg, bar);
            __builtin_amdgcn_fence(__ATOMIC_ACQUIRE, "agent");
            xb_add(&bar[XB_XGEN(b.x)], 1u);
            asm volatile("s_waitcnt vmcnt(0)" ::: "memory");
        } else {
            XB_SPIN(xb_ld(&bar[XB_XGEN(b.x)]) == gen, bar);
            __builtin_amdgcn_fence(__ATOMIC_ACQUIRE, "agent");
            asm volatile("s_waitcnt vmcnt(0)" ::: "memory");
        }
    }
    __syncthreads();
}
typedef __attribute__((address_space(4))) const Params* KP4;
__device__ __forceinline__ const Params& phase_params() { KP4 kp = (KP4)__builtin_amdgcn_kernarg_segment_ptr(); asm volatile("" : "+s"(kp)); return *(const Params*)kp; }
__global__ void __launch_bounds__(NTHREADS) fwd_megakernel(Params Pk) {
    extern __shared__ __attribute__((aligned(16))) unsigned char lds_raw[];
    lds_t* lds = (lds_t*)lds_raw;
    cg::grid_group grid = cg::this_grid();
    const int ph_lo = Pk.ph_lo, ph_hi = Pk.ph_hi;
    unsigned* barw = (unsigned*)(Pk.ws + WS_CTL) + 4096;
    volatile LAS unsigned* bst = (volatile LAS unsigned*)(lds + LDS_BYTES - 64);
    if (ph_lo == 0) { if (blockIdx.x == 0) for (int i = threadIdx.x; i < XCD_BAR_WORDS; i += NTHREADS) barw[i] = 0u; }
    if (threadIdx.x == 0) { bst[0] = 0u; bst[1] = 0u; }
    XcdBarrier xbar; xbar.bar = barw; xbar.x = 0; xbar.st = bst;
#define SEAM(k) do { if ((k) == 0) { grid_barrier_cg(grid); xbar = xcd_barrier_post(barw, bst); } else xcd_barrier(xbar); } while (0)
#ifdef ONLY_PHASE
#define PHASE(k, ...) if constexpr ((k) == ONLY_PHASE) { const Params& P = phase_params(); unsigned char* ws = P.ws; (void)ws; __VA_ARGS__; grid_barrier_cg(grid); xcd_barrier(xbar); }
#else
#ifndef PHASE_MASK
#define PHASE_MASK 0xffffffffu
#endif
#ifndef REPEAT_MASK
#define REPEAT_MASK 0u
#endif
#define PHASE(k, ...) if (((PHASE_MASK >> (k)) & 1u) && ph_lo <= (k) && (k) < ph_hi) { const Params& P = phase_params(); unsigned char* ws = P.ws; (void)ws; \
    if constexpr (((REPEAT_MASK >> (k)) & 1u) != 0u) { __VA_ARGS__; SEAM(k); } \
    __VA_ARGS__; if ((k) + 1 < ph_hi) SEAM(k); }
#endif
    PHASE(0, phase0(P, lds))
    PHASE(1, ph_inproj2(P, lds, (const bf16_t*)(ws + WS_WABIN), 1536, nullptr))
    PHASE(2, ph_conv0(P); ph_s5_state(P, lds))
    PHASE(3, ph_gates0(P, lds); ph_s5_carry(P))
    PHASE(4, ph_lru_scan(P, lds); ph_s5_out(P, lds))
    PHASE(5, ph_glu(P, lds))
    PHASE(6, ph_outproj2(P, lds, (const bf16_t*)(ws + WS_WABOUT), P.in[I_X]))
    PHASE(7, ph_ln_router(P, lds, 0))
    PHASE(8, ph_route_scatter(P, lds, 0))
    PHASE(9, ph_moe_up2(P, lds, 0))
    PHASE(10, ph_moe_down2(P, lds, 0))
    PHASE(11, ph_combine_ln(P, 0, (float*)(ws + WS_X1F), true))
    PHASE(12, ph_inproj2(P, lds, (const bf16_t*)(ws + WS_WCDIN), 2560, (const int*)P.in[I_POS]); convert_moe_weights(P, 1, lds))
    PHASE(13, ph_conv1(P, lds))
    PHASE(14, ph_qkv(P, lds))
    PHASE(15, ph_m1(P, lds))
    PHASE(16, ph_m2(P); ph_attn(P, lds))
    PHASE(17, ph_m3(P, lds); ph_attn_combine(P))
    PHASE(18, ph_outproj2(P, lds, (const bf16_t*)(ws + WS_WCDOUT), (const float*)(ws + WS_X1F)))
    PHASE(19, ph_ln_router(P, lds, 1))
    PHASE(20, ph_route_scatter(P, lds, 1))
    PHASE(21, ph_moe_up2(P, lds, 1))
    PHASE(22, ph_moe_down2(P, lds, 1))
#ifdef EXTRA_BARRIERS
    for (int xb_ = 0; xb_ < EXTRA_BARRIERS; ++xb_) xcd_barrier(xbar);
#endif
    PHASE(23, ph_combine_ln(P, 1, P.out, false))
#undef PHASE
}

#ifndef MULTI_LAUNCH
#define MULTI_LAUNCH 0
#endif
extern "C" void kernel_launch(void* const* d_in, const int* in_sizes, int n_in, void* d_out, int out_size, void* d_ws, size_t ws_size, hipStream_t stream) {
    static int grid_blocks = 0;
    if (grid_blocks == 0) {
        if (n_in != N_IN || out_size != T * D || ws_size < WS_END) { fprintf(stderr, "kernel_launch: unexpected shapes (n_in %d out %d ws %zu need %zu)\n", n_in, out_size, ws_size, (size_t)WS_END); grid_blocks = -1; return; }
        int dev = 0, cus = 0, per_cu = 0;
        (void)hipGetDevice(&dev);
        (void)hipDeviceGetAttribute(&cus, hipDeviceAttributeMultiprocessorCount, dev);
        if (hipFuncSetAttribute((const void*)fwd_megakernel, hipFuncAttributeMaxDynamicSharedMemorySize, LDS_BYTES) != hipSuccess) { fprintf(stderr, "kernel_launch: hipFuncSetAttribute failed\n"); grid_blocks = -1; return; }
        (void)hipOccupancyMaxActiveBlocksPerMultiprocessor(&per_cu, (const void*)fwd_megakernel, NTHREADS, LDS_BYTES);
        if (per_cu < 1) { fprintf(stderr, "kernel_launch: occupancy query returned %d\n", per_cu); grid_blocks = -1; return; }
        grid_blocks = cus * per_cu;
    }
    if (grid_blocks < 0) return;
    Params p{};
    for (int i = 0; i < N_IN; ++i) p.in[i] = (const float*)d_in[i];
    p.out = (float*)d_out; p.ws = (unsigned char*)d_ws;
#if MULTI_LAUNCH
    for (int k = 0; k < 24; ++k) { p.ph_lo = k; p.ph_hi = k + 1; hipLaunchKernelGGL(fwd_megakernel, dim3(grid_blocks), dim3(NTHREADS), LDS_BYTES, stream, p); }
#else
    p.ph_lo = 0; p.ph_hi = 24;
    void* args[] = {&p};
    hipError_t e = hipLaunchCooperativeKernel((const void*)fwd_megakernel, dim3(grid_blocks), dim3(NTHREADS), args, LDS_BYTES, stream);
    if (e != hipSuccess) fprintf(stderr, "cooperative launch failed: %s (grid %d)\n", hipGetErrorString(e), grid_blocks);
#endif
}
```

```cpp
#include <hip/hip_runtime.h>
#include <hip/hip_cooperative_groups.h>
#include <cstdio>
#include <cstdint>
namespace cg = cooperative_groups;

#define LAS __attribute__((address_space(3)))
typedef unsigned short bf16_t;
typedef short bf16x8 __attribute__((ext_vector_type(8)));
typedef short bf16x4 __attribute__((ext_vector_type(4)));
typedef float f32x4 __attribute__((ext_vector_type(4)));
typedef unsigned u32x4 __attribute__((ext_vector_type(4)));
typedef unsigned u32x2 __attribute__((ext_vector_type(2)));
typedef LAS unsigned char lds_t;

constexpr int T = 32768, D = 1024, SEQ = 4096;
constexpr int NTHREADS = 512;
constexpr int LDS_BYTES = 160 * 1024;
constexpr float ALPHA = 1.4142135623730951f;
constexpr float LN_EPS = 1e-5f;
constexpr int MOE_ROWS = 139264;
constexpr int S5TC = 32;
constexpr int S5K = S5TC * 16 + 128;

enum { I_X = 0, I_POS, I_AB_WIN, I_AB_CONVW, I_AB_CONVB, I_AB_GRW, I_AB_GRB, I_AB_GIW, I_AB_GIB, I_AB_LAMBDA,
       I_S5_LRE, I_S5_LIM, I_S5_STEP, I_S5_BRE, I_S5_BIM, I_S5_CRE, I_S5_CIM, I_S5_D, I_AB_GLUW, I_AB_GLUB, I_AB_WOUT,
       I_CD_WIN, I_CD_CONVW, I_CD_CONVB, I_CD_WQ, I_CD_WK, I_CD_WV, I_CD_WIF, I_CD_BIF, I_CD_WOUT,
       I_LNM_G, I_LNM_B, I_LNF_G, I_LNF_B, I_R_W, I_R_B, I_M_WIN, I_M_BIN, I_M_WOUT, I_M_BOUT, N_IN };

constexpr size_t MiB = 1ull << 20;
constexpr size_t WS_CTL = 0;
constexpr size_t WS_XB = 1 * MiB;
constexpr size_t WS_WABIN = 65 * MiB;
constexpr size_t WS_WGLU = 68 * MiB;
constexpr size_t WS_WABOUT = 69 * MiB;
constexpr size_t WS_WCDIN = 71 * MiB;
constexpr size_t WS_WCDOUT = 76 * MiB;
constexpr size_t WS_WG = 78 * MiB;
constexpr size_t WS_WQKV = 78 * MiB + 256 * 1024;
constexpr size_t WS_WC = 79 * MiB;
constexpr size_t WS_S5TM = 80 * MiB;
constexpr size_t WS_S5WST = 100 * MiB;
constexpr size_t WS_MWIN = 104 * MiB;
constexpr size_t WS_MWOUT = 232 * MiB;
constexpr size_t WS_PROJ = 296 * MiB;
constexpr size_t WS_CAT = 456 * MiB;
constexpr size_t WS_X1F = 520 * MiB;
constexpr size_t WS_ZF = 648 * MiB;
constexpr size_t WS_HACT = 776 * MiB;
constexpr size_t WS_YB = 1048 * MiB;
constexpr size_t WS_ROUTE = 1320 * MiB;
constexpr size_t WS_SCR = 1328 * MiB;
constexpr size_t WS_XC = WS_SCR;
constexpr size_t WS_AF = WS_SCR + 32 * MiB;
constexpr size_t WS_UF = WS_SCR + 96 * MiB;
constexpr size_t WS_SB = WS_SCR + 160 * MiB;
constexpr size_t WS_S5S = WS_SCR + 192 * MiB;
constexpr size_t WS_S5X = WS_SCR + 208 * MiB;
constexpr size_t WS_XCONV = WS_SCR;
constexpr size_t WS_QB = WS_SCR + 32 * MiB;
constexpr size_t WS_KB = WS_SCR + 64 * MiB;
constexpr size_t WS_VB = WS_SCR + 96 * MiB;
constexpr size_t WS_GATES = WS_SCR + 128 * MiB;
constexpr size_t WS_KVC = WS_SCR + 130 * MiB;
constexpr size_t WS_CPREV = WS_SCR + 258 * MiB;
constexpr size_t WS_MISC = WS_SCR + 322 * MiB;
constexpr size_t WS_ATTO = WS_SCR + 326 * MiB;
constexpr size_t WS_LSE = WS_SCR + 518 * MiB;
constexpr size_t WS_END = WS_SCR + 520 * MiB;

struct Params { const float* in[N_IN]; float* out; unsigned char* ws; int ph_lo, ph_hi; };

__device__ __forceinline__ float bf2f(unsigned short b) { return __uint_as_float(((unsigned)b) << 16); }
typedef __bf16 bf16v2_t __attribute__((ext_vector_type(2)));
typedef float f32x2 __attribute__((ext_vector_type(2)));
__device__ __forceinline__ unsigned pk_bf16(float lo, float hi) { const f32x2 v = {lo, hi}; return __builtin_bit_cast(unsigned, __builtin_convertvector(v, bf16v2_t)); }
__device__ __forceinline__ float wave_sum(float v) {
#pragma unroll
    for (int o = 1; o < 64; o <<= 1) v += __shfl_xor(v, o);
    return v;
}
__device__ __forceinline__ float wave_max(float v) {
#pragma unroll
    for (int o = 1; o < 64; o <<= 1) v = fmaxf(v, __shfl_xor(v, o));
    return v;
}
__device__ __forceinline__ float fsigmoid(float x) { return __builtin_amdgcn_rcpf(1.0f + __builtin_amdgcn_exp2f(-1.4426950408889634f * x)); }
__device__ __forceinline__ float fexp(float x) { return __builtin_amdgcn_exp2f(1.4426950408889634f * x); }
__device__ __forceinline__ float flog(float x) { return 0.6931471805599453f * __builtin_amdgcn_logf(x); }
__device__ __forceinline__ void fsincos(float x, float& sn, float& cs) {
    const float n = rintf(x * 0.15915494309189535f);
    float r = fmaf(-n, 6.28125f, x); r = fmaf(-n, 0.0019353071795864769f, r);
    const float rev = r * 0.15915494309189535f;
    sn = __builtin_amdgcn_sinf(rev); cs = __builtin_amdgcn_cosf(rev);
}
__device__ __forceinline__ float gelu_tanh(float x) { return x * fsigmoid(1.5957691216057308f * (x + 0.044715f * x * x * x)); }
__device__ __forceinline__ float logsigmoidf(float x) { return fminf(x, 0.f) - log1pf(expf(-fabsf(x))); }
__device__ __forceinline__ void unpack8(u32x4 v, float (&f)[8]) {
    f[0] = __uint_as_float(v.x << 16); f[1] = __uint_as_float(v.x & 0xffff0000u);
    f[2] = __uint_as_float(v.y << 16); f[3] = __uint_as_float(v.y & 0xffff0000u);
    f[4] = __uint_as_float(v.z << 16); f[5] = __uint_as_float(v.z & 0xffff0000u);
    f[6] = __uint_as_float(v.w << 16); f[7] = __uint_as_float(v.w & 0xffff0000u);
}
__device__ __forceinline__ u32x4 pack8(const float (&f)[8]) { u32x4 o; o.x = pk_bf16(f[0], f[1]); o.y = pk_bf16(f[2], f[3]); o.z = pk_bf16(f[4], f[5]); o.w = pk_bf16(f[6], f[7]); return o; }
__device__ __forceinline__ bf16x4 tr_read(lds_t* p) { return __builtin_amdgcn_ds_read_tr16_b64_v4i16((LAS bf16x4*)p); }
__device__ __forceinline__ bf16x8 cat44(bf16x4 a, bf16x4 b) { bf16x8 r = {a[0], a[1], a[2], a[3], b[0], b[1], b[2], b[3]}; return r; }
#define MFMA16(a, b, c) __builtin_amdgcn_mfma_f32_16x16x32_bf16((a), (b), (c), 0, 0, 0)

constexpr int E1_PITCH = 144;
constexpr int E1_A = 256 * E1_PITCH;
constexpr int E1_B = 128 * E1_PITCH;
constexpr int E1_BUF = E1_A + E1_B;

template <bool TRANS, class AL, class BL, class EP>
__device__ __forceinline__ void e1_tile(lds_t* lds, int nk, AL aload, BL bload, EP epi) {
    const int tid = threadIdx.x, lane = tid & 63, wave = tid >> 6, wr = wave >> 1, wc = wave & 1, fr = lane & 15, fq = lane >> 4;
    const int prow = tid >> 3, pc = tid & 7;
    f32x4 acc[4][4];
#pragma unroll
    for (int m = 0; m < 4; ++m)
#pragma unroll
        for (int n = 0; n < 4; ++n) acc[m][n] = (f32x4){0.f, 0.f, 0.f, 0.f};
    u32x4 ra[4], rb[2];
#pragma unroll
    for (int i = 0; i < 4; ++i) ra[i] = aload(i, prow + 64 * i, pc);
#pragma unroll
    for (int i = 0; i < 2; ++i) rb[i] = bload(i, prow + 64 * i, pc);
#pragma unroll
    for (int i = 0; i < 4; ++i) *(LAS u32x4*)(lds + (prow + 64 * i) * E1_PITCH + pc * 16) = ra[i];
#pragma unroll
    for (int i = 0; i < 2; ++i) *(LAS u32x4*)(lds + E1_A + (prow + 64 * i) * E1_PITCH + pc * 16) = rb[i];
    __syncthreads();
    for (int t = 0; t < nk; ++t) {
        const bool more = (t + 1 < nk);
        if (more) {
#pragma unroll
            for (int i = 0; i < 4; ++i) ra[i] = aload(i, prow + 64 * i, (t + 1) * 8 + pc);
#pragma unroll
            for (int i = 0; i < 2; ++i) rb[i] = bload(i, prow + 64 * i, (t + 1) * 8 + pc);
        }
        lds_t* Ab = lds + (t & 1) * E1_BUF + (wr * 64 + fr) * E1_PITCH + fq * 16;
        lds_t* Bb = lds + (t & 1) * E1_BUF + E1_A + (wc * 64 + fr) * E1_PITCH + fq * 16;
#pragma unroll
        for (int kk = 0; kk < 2; ++kk) {
            bf16x8 af[4], bfr[4];
#pragma unroll
            for (int m = 0; m < 4; ++m) af[m] = *(LAS bf16x8*)(Ab + m * 16 * E1_PITCH + kk * 64);
#pragma unroll
            for (int n = 0; n < 4; ++n) bfr[n] = *(LAS bf16x8*)(Bb + n * 16 * E1_PITCH + kk * 64);
#pragma unroll
            for (int m = 0; m < 4; ++m)
#pragma unroll
                for (int n = 0; n < 4; ++n) acc[m][n] = TRANS ? MFMA16(bfr[n], af[m], acc[m][n]) : MFMA16(af[m], bfr[n], acc[m][n]);
        }
        if (more) {
            lds_t* nb = lds + ((t + 1) & 1) * E1_BUF;
#pragma unroll
            for (int i = 0; i < 4; ++i) *(LAS u32x4*)(nb + (prow + 64 * i) * E1_PITCH + pc * 16) = ra[i];
#pragma unroll
            for (int i = 0; i < 2; ++i) *(LAS u32x4*)(nb + E1_A + (prow + 64 * i) * E1_PITCH + pc * 16) = rb[i];
        }
        __syncthreads();
    }
    epi(acc, wr, wc, fr, fq);
}


namespace g2 {
constexpr int HTB = 16384;
__device__ __forceinline__ int lds_byte(int r, int c) { const int st = (r >> 4) * 2 + (c >> 5), rr = r & 15, cc = c & 31, ob = rr * 64 + cc * 2; return st * 1024 + (ob ^ (((ob >> 9) & 1) << 5)); }
__device__ __forceinline__ void stage_rc(int b, int& R, int& C) { const int st = b / 1024, sb = b % 1024, swz = sb ^ (((sb >> 9) & 1) << 5); R = (st >> 1) * 16 + swz / 64; C = (st & 1) * 32 + (swz % 64) / 2; }
struct Unit { int pm, pn; };
__device__ __forceinline__ bool static_next(int i, int G, int c, int nM, int nN, Unit& u) {
    const int nwg = nM * nN; const long L = (long)i * G + c; if (L >= nwg) return false;
    int wgid = (int)L; { const int q = nwg / 8, r = nwg % 8, xcd = wgid % 8, off = wgid / 8; wgid = (xcd < r ? xcd * (q + 1) : r * (q + 1) + (xcd - r) * q) + off; }
    const int nig = 8 * nN, gid = wgid / nig, fm = gid * 8, gsz = (nM - fm) < 8 ? (nM - fm) : 8;
    u.pm = fm + ((wgid % nig) % gsz); u.pn = (wgid % nig) / gsz; return true;
}
template <class Sched, class Epi>
__device__ __forceinline__ void gemm_phase(lds_t* lds, const char* Abase, int K, unsigned ldb_bytes, const Sched& S, const Epi& E) {
    const int tid = threadIdx.x, wid = __builtin_amdgcn_readfirstlane(tid >> 6), lane = tid & 63, wr = wid >> 2, wc = wid & 3, fr = lane & 15, fq = lane >> 4;
    const int nt = K / 64;
    int Rs[2], Cs[2]; unsigned voffB[2];
#pragma unroll
    for (int i = 0; i < 2; ++i) { stage_rc(tid * 16 + i * 8192, Rs[i], Cs[i]); voffB[i] = (unsigned)Rs[i] * ldb_bytes + (unsigned)Cs[i] * 2u; }
    const size_t hstepB = (size_t)128 * ldb_bytes;
    const unsigned ldsw = (unsigned)wid * 1024u;
    const int aoff = lds_byte(wr * 64 + fr, fq * 8), boff = lds_byte(wc * 32 + fr, fq * 8);
#define G2_SA(b, h) (((b) * 2 + (h)) * g2::HTB)
#define G2_SB(b, h) ((4 + (b) * 2 + (h)) * g2::HTB)
#define G2_STAGE_A(bufoff, offs, kb) do { _Pragma("unroll") for (int _i = 0; _i < 2; ++_i) \
        __builtin_amdgcn_global_load_lds((const unsigned*)((Abase + (kb)) + (offs)[_i]), (LAS unsigned*)(lds + (bufoff) + ldsw + _i * 8192), 16, 0, 0); } while (0)
#define G2_STAGE_B(bufoff, gbase) do { _Pragma("unroll") for (int _i = 0; _i < 2; ++_i) \
        __builtin_amdgcn_global_load_lds((const unsigned*)((const char*)(gbase) + voffB[_i]), (LAS unsigned*)(lds + (bufoff) + ldsw + _i * 8192), 16, 0, 0); } while (0)
#define G2_LDA(dst, b, h) do { _Pragma("unroll") for (int m = 0; m < 4; ++m) _Pragma("unroll") for (int k = 0; k < 2; ++k) dst[m][k] = *(const LAS bf16x8*)(lds + G2_SA(b, h) + aoff + m * 2048 + k * 1024); } while (0)
#define G2_LDB(dst, b, h) do { _Pragma("unroll") for (int n = 0; n < 2; ++n) _Pragma("unroll") for (int k = 0; k < 2; ++k) dst[n][k] = *(const LAS bf16x8*)(lds + G2_SB(b, h) + boff + n * 2048 + k * 1024); } while (0)
#define G2_MMA(ai, bj, At, Bt) do { __builtin_amdgcn_s_setprio(1); _Pragma("unroll") for (int m = 0; m < 4; ++m) _Pragma("unroll") for (int n = 0; n < 2; ++n) _Pragma("unroll") for (int k = 0; k < 2; ++k) \
        acc[ai][bj][m][n] = __builtin_amdgcn_mfma_f32_16x16x32_bf16(Bt[n][k], At[m][k], acc[ai][bj][m][n], 0, 0, 0); __builtin_amdgcn_s_setprio(0); } while (0)
#define G2_WAIT_V(n) asm volatile("s_waitcnt vmcnt(" #n ")" ::: "memory")
#define G2_WAIT_L(n) asm volatile("s_waitcnt lgkmcnt(" #n ")" ::: "memory")
#define G2_BAR __builtin_amdgcn_s_barrier()
#define G2_SCHED __builtin_amdgcn_sched_barrier(0)
    Unit cur, nxt; int ui = 0;
    if (!S.next(0, cur)) return;
    f32x4 acc[2][2][4][2];
#pragma unroll
    for (int a = 0; a < 2; ++a)
#pragma unroll
        for (int b = 0; b < 2; ++b)
#pragma unroll
            for (int m = 0; m < 4; ++m)
#pragma unroll
                for (int n = 0; n < 2; ++n) acc[a][b][m][n] = (f32x4){0.f, 0.f, 0.f, 0.f};
    bf16x8 At[4][2], B0[2][2], B1[2][2];
    unsigned aoC[2][2], aoN[2][2];
    S.a_off(cur, Rs, Cs, aoC);
    const char* cB = S.b_base(cur);
    G2_STAGE_B(G2_SB(0, 0), cB); G2_STAGE_B(G2_SB(0, 1), cB + hstepB); G2_STAGE_A(G2_SA(0, 0), aoC[0], 0); G2_STAGE_A(G2_SA(0, 1), aoC[1], 0);
    if (wr == 1) G2_BAR;
    G2_WAIT_V(2); G2_BAR;
    G2_STAGE_B(G2_SB(1, 0), cB + 128); G2_STAGE_A(G2_SA(1, 0), aoC[0], 128); G2_STAGE_B(G2_SB(1, 1), cB + hstepB + 128);
    G2_WAIT_V(6); G2_BAR;
    for (;;) {
        const bool has_next = S.next(ui + 1, nxt);
        const char* nB = cB;
#pragma unroll
        for (int h = 0; h < 2; ++h)
#pragma unroll
            for (int i = 0; i < 2; ++i) aoN[h][i] = aoC[h][i];
        if (has_next) { S.a_off(nxt, Rs, Cs, aoN); nB = S.b_base(nxt); }
        for (int t = 0; t < nt; t += 2) {
            const bool last = (t == nt - 2);
            const unsigned k1 = (unsigned)(t + 1) * 128u, k2 = last ? 0u : (unsigned)(t + 2) * 128u, k3 = k2 + 128u;
            unsigned a2o[2][2];
#pragma unroll
            for (int h = 0; h < 2; ++h)
#pragma unroll
                for (int i = 0; i < 2; ++i) a2o[h][i] = last ? aoN[h][i] : aoC[h][i];
            const char* b2 = last ? nB : cB + (size_t)(t + 2) * 128; const char* b3 = b2 + 128;
            G2_LDB(B0, 0, 0); G2_LDB(B1, 0, 1); G2_SCHED; G2_LDA(At, 0, 0); G2_STAGE_A(G2_SA(1, 1), aoC[1], k1);
            G2_WAIT_V(8); G2_WAIT_L(0); G2_BAR; G2_MMA(0, 0, At, B0); G2_MMA(0, 1, At, B1); G2_BAR; G2_SCHED;
            G2_LDA(At, 0, 1); G2_STAGE_B(G2_SB(0, 0), b2); G2_STAGE_B(G2_SB(0, 1), b2 + hstepB); G2_STAGE_A(G2_SA(0, 0), a2o[0], k2);
            G2_WAIT_V(8); G2_WAIT_L(0); G2_BAR; G2_MMA(1, 0, At, B0); G2_MMA(1, 1, At, B1); G2_BAR; G2_SCHED;
            G2_LDB(B0, 1, 0); G2_LDB(B1, 1, 1); G2_SCHED; G2_LDA(At, 1, 0); G2_STAGE_A(G2_SA(0, 1), a2o[1], k2);
            G2_WAIT_V(8); G2_WAIT_L(0); G2_BAR; G2_MMA(0, 0, At, B0); G2_MMA(0, 1, At, B1); G2_BAR; G2_SCHED;
            G2_LDA(At, 1, 1); G2_STAGE_B(G2_SB(1, 0), b3); G2_STAGE_B(G2_SB(1, 1), b3 + hstepB); G2_STAGE_A(G2_SA(1, 0), a2o[0], k3);
            G2_WAIT_V(8); G2_WAIT_L(0); G2_BAR; G2_MMA(1, 0, At, B0); G2_MMA(1, 1, At, B1); G2_BAR; G2_SCHED;
        }
        if (wr == 0) G2_BAR;
        E(acc, cur, wr, wc, fr, fq);
        if (!has_next) break;
#pragma unroll
        for (int a = 0; a < 2; ++a)
#pragma unroll
            for (int b = 0; b < 2; ++b)
#pragma unroll
                for (int m = 0; m < 4; ++m)
#pragma unroll
                    for (int n = 0; n < 2; ++n) acc[a][b][m][n] = (f32x4){0.f, 0.f, 0.f, 0.f};
        cur = nxt; cB = nB; ++ui;
#pragma unroll
        for (int h = 0; h < 2; ++h)
#pragma unroll
            for (int i = 0; i < 2; ++i) aoC[h][i] = aoN[h][i];
        if (wr == 1) G2_BAR;
    }
    G2_WAIT_V(0);
    G2_BAR;
#undef G2_SA
#undef G2_SB
#undef G2_STAGE_A
#undef G2_STAGE_B
#undef G2_LDA
#undef G2_LDB
#undef G2_MMA
#undef G2_WAIT_V
#undef G2_WAIT_L
#undef G2_BAR
#undef G2_SCHED
}
struct DenseSched {
    int G, c, nM, nN, K; const char* Bt;
    __device__ __forceinline__ bool next(int i, Unit& u) const { return static_next(i, G, c, nM, nN, u); }
    __device__ __forceinline__ void a_off(const Unit& u, const int (&Rs)[2], const int (&Cs)[2], unsigned (&ao)[2][2]) const {
#pragma unroll
        for (int h = 0; h < 2; ++h)
#pragma unroll
            for (int i = 0; i < 2; ++i) ao[h][i] = ((unsigned)(u.pm * 256 + h * 128 + Rs[i]) * (unsigned)K + (unsigned)Cs[i]) * 2u;
    }
    __device__ __forceinline__ const char* b_base(const Unit& u) const { return Bt + (size_t)u.pn * 256 * K * 2; }
};
}

template <class RM>
__device__ __forceinline__ void transpose_item(const float* __restrict__ W, int N, bf16_t* __restrict__ WT, int ldwt, int k0, int n0, RM rowmap, LAS float* scr, int lane) {
#pragma unroll 16
    for (int i = 0; i < 64; ++i) scr[i * 65 + lane] = W[(size_t)(k0 + i) * N + n0 + lane];
    __builtin_amdgcn_wave_barrier();
    const int c = lane & 7;
#pragma unroll
    for (int j = 0; j < 8; ++j) {
        const int n = (lane >> 3) + 8 * j;
        const LAS float* s = scr + (8 * c) * 65 + n;
        u32x4 o; o.x = pk_bf16(s[0], s[65]); o.y = pk_bf16(s[2 * 65], s[3 * 65]); o.z = pk_bf16(s[4 * 65], s[5 * 65]); o.w = pk_bf16(s[6 * 65], s[7 * 65]);
        *(u32x4*)(WT + (size_t)rowmap(n0 + n) * ldwt + k0 + 8 * c) = o;
    }
    __builtin_amdgcn_wave_barrier();
}
struct RmId { __device__ __forceinline__ int operator()(int n) const { return n; } };
struct RmMoeIn { __device__ __forceinline__ int operator()(int n) const { const int half = n >> 10, j = n & 1023; return (j >> 7) * 256 + half * 128 + (j & 127); } };
struct RmGate { int gate; __device__ __forceinline__ int operator()(int j) const { return (j >> 5) * 64 + gate * 32 + (j & 31); } };

template <class RM>
__device__ __forceinline__ void transpose_matrix(const float* W, int K, int N, bf16_t* WT, int ldwt, RM rm, LAS float* scr, int gw, int NGW, int lane) {
    const int nkb = K / 64, nnb = N / 64;
    for (int it = gw; it < nkb * nnb; it += NGW) transpose_item(W, N, WT, ldwt, (it / nnb) * 64, (it % nnb) * 64, rm, scr, lane);
}

__device__ __forceinline__ void convert_moe_weights(const Params& P, int layer, lds_t* lds) {
    const int lane = threadIdx.x & 63, wave = threadIdx.x >> 6, gw = blockIdx.x * 8 + wave, NGW = gridDim.x * 8;
    LAS float* scr = (LAS float*)(lds + wave * 16640);
    const float* win = P.in[I_M_WIN] + (size_t)layer * 32 * 1024 * 2048;
    bf16_t* dwin = (bf16_t*)(P.ws + WS_MWIN);
    for (int it = gw; it < 32 * 16 * 32; it += NGW) {
        const int e = it >> 9, r = it & 511, kb = r >> 5, nb = r & 31;
        transpose_item(win + (size_t)e * 1024 * 2048, 2048, dwin + (size_t)e * 2048 * 1024, 1024, kb * 64, nb * 64, RmMoeIn(), scr, lane);
    }
    const float* wout = P.in[I_M_WOUT] + (size_t)layer * 32 * 1024 * 1024;
    bf16_t* dwout = (bf16_t*)(P.ws + WS_MWOUT);
    for (int it = gw; it < 32 * 16 * 16; it += NGW) {
        const int e = it >> 8, r = it & 255, kb = r >> 4, nb = r & 15;
        transpose_item(wout + (size_t)e * 1024 * 1024, 1024, dwout + (size_t)e * 1024 * 1024, 1024, kb * 64, nb * 64, RmId(), scr, lane);
    }
}

__device__ __forceinline__ void s5_precompute(const Params& P, int g, lds_t* lds) {
    const int tid = threadIdx.x;
    LAS float* Bbr = (LAS float*)lds;
    LAS float* Bbi = Bbr + 1024;
    LAS float* Cr = Bbi + 1024;
    LAS float* Ci = Cr + 1024;
    LAS float* ApR = Ci + 1024;
    LAS float* ApI = ApR + 33 * 64;
    LAS float* KJ = ApI + 33 * 64;
    const float* lre = P.in[I_S5_LRE] + g * 64; const float* lim = P.in[I_S5_LIM] + g * 64;
    const float step = expf(P.in[I_S5_STEP][g]);
    for (int idx = tid; idx < 1024; idx += NTHREADS) {
        const int p = idx >> 4;
        const float lr = fminf(lre[p], -1e-4f), li = lim[p];
        const float mag = expf(lr * step); float sn, cs; sincosf(li * step, &sn, &cs);
        const float ar = mag * cs, ai = mag * sn, inv = 1.0f / (lr * lr + li * li);
        const float zr = ((ar - 1.0f) * lr + ai * li) * inv, zi = (ai * lr - (ar - 1.0f) * li) * inv;
        const float br = P.in[I_S5_BRE][g * 1024 + idx], bi = P.in[I_S5_BIM][g * 1024 + idx];
        Bbr[idx] = zr * br - zi * bi; Bbi[idx] = zr * bi + zi * br;
        Cr[idx] = P.in[I_S5_CRE][g * 1024 + idx]; Ci[idx] = P.in[I_S5_CIM][g * 1024 + idx];
    }
    for (int idx = tid; idx < 33 * 64; idx += NTHREADS) {
        const int j = idx >> 6, p = idx & 63;
        const float lr = fminf(lre[p], -1e-4f), li = lim[p];
        const float mag = expf((float)j * lr * step); float sn, cs; sincosf((float)j * li * step, &sn, &cs);
        ApR[idx] = mag * cs; ApI[idx] = mag * sn;
    }
    __syncthreads();
    for (int idx = tid; idx < 8192; idx += NTHREADS) {
        const int j = idx >> 8, h = (idx >> 4) & 15, h2 = idx & 15;
        float s = 0.f;
        for (int p = 0; p < 64; ++p) {
            const float cr = Cr[h * 64 + p], ci = Ci[h * 64 + p], ar = ApR[j * 64 + p], ai = ApI[j * 64 + p];
            const float er = cr * ar - ci * ai, ei = cr * ai + ci * ar;
            s += er * Bbr[p * 16 + h2] - ei * Bbi[p * 16 + h2];
        }
        if (j == 0 && h == h2) s += P.in[I_S5_D][g * 16 + h];
        KJ[idx] = s;
    }
    __syncthreads();
    bf16_t* Tm = (bf16_t*)(P.ws + WS_S5TM) + (size_t)g * 512 * S5K;
    for (int pi = tid; pi < 512 * (S5K / 8); pi += NTHREADS) {
        const int row = pi / (S5K / 8), c8 = (pi % (S5K / 8)) * 8, t = row >> 4, h = row & 15;
        float v[8];
#pragma unroll
        for (int e = 0; e < 8; ++e) {
            const int col = c8 + e;
            if (col < 512) { const int s = col >> 4, h2 = col & 15; v[e] = (s <= t) ? KJ[((t - s) * 16 + h) * 16 + h2] : 0.f; }
            else { const int p = (col - 512) & 63, im = (col - 512) >> 6;
                const float cr = Cr[h * 64 + p], ci = Ci[h * 64 + p], ar = ApR[(t + 1) * 64 + p], ai = ApI[(t + 1) * 64 + p];
                v[e] = im ? -(cr * ai + ci * ar) : (cr * ar - ci * ai); }
        }
        *(u32x4*)(Tm + (size_t)row * S5K + c8) = pack8(v);
    }
    bf16_t* Wst = (bf16_t*)(P.ws + WS_S5WST) + (size_t)g * 128 * 512;
    for (int pi = tid; pi < 128 * 64; pi += NTHREADS) {
        const int row = pi >> 6, c8 = (pi & 63) * 8, p = row & 63, im = row >> 6;
        float v[8];
#pragma unroll
        for (int e = 0; e < 8; ++e) {
            const int col = c8 + e, s = col >> 4, h2 = col & 15;
            const float ar = ApR[(S5TC - 1 - s) * 64 + p], ai = ApI[(S5TC - 1 - s) * 64 + p], br = Bbr[p * 16 + h2], bi = Bbi[p * 16 + h2];
            v[e] = im ? (ar * bi + ai * br) : (ar * br - ai * bi);
        }
        *(u32x4*)(Wst + (size_t)row * 512 + c8) = pack8(v);
    }
    __syncthreads();
}

__device__ __forceinline__ void phase0(const Params& P, lds_t* lds) {
    const int tid = threadIdx.x, lane = tid & 63, wave = tid >> 6, gw = blockIdx.x * 8 + wave, NGW = gridDim.x * 8;
    const size_t gtid = (size_t)blockIdx.x * NTHREADS + tid, GT = (size_t)gridDim.x * NTHREADS;
    unsigned char* ws = P.ws;
    for (int g = blockIdx.x; g < 32; g += gridDim.x) s5_precompute(P, g, lds);
    {
        const f32x4* x4 = (const f32x4*)P.in[I_X]; u32x4* xb = (u32x4*)(ws + WS_XB);
        for (size_t i = gtid; i < (size_t)T * D / 8; i += GT) { const f32x4 a = x4[2 * i], b = x4[2 * i + 1]; u32x4 o; o.x = pk_bf16(a.x, a.y); o.y = pk_bf16(a.z, a.w); o.z = pk_bf16(b.x, b.y); o.w = pk_bf16(b.z, b.w); xb[i] = o; }
    }
    {
        float* Wc = (float*)(ws + WS_WC);
        for (size_t idx = gtid; idx < 8192; idx += GT) {
            const int which = (int)(idx >> 12), i = (int)((idx >> 3) & 511), gg = (int)(idx & 7), h = i >> 7, ii = i & 127;
            const float* wif = P.in[I_CD_WIF];
            float s = 0.f;
            if (which == 0) {
                const float* wq = P.in[I_CD_WQ] + (size_t)(h * 128 + ii) * 128; const float* wk = P.in[I_CD_WK] + (size_t)(h * 128 + ii) * 128;
                float s2 = 0.f;
                for (int j = 0; j < 128; ++j) { s += wq[j] * wif[(h * 128 + j) * 8 + gg]; s2 += wk[j] * wif[(512 + h * 128 + j) * 8 + gg]; }
                s += s2 * 0.08838834764831845f;
            } else {
                const float* wv = P.in[I_CD_WV] + (size_t)(h * 128 + ii) * 128;
                for (int j = 0; j < 128; ++j) s += wv[j] * wif[(1024 + h * 128 + j) * 8 + gg];
            }
            Wc[idx] = s;
        }
    }
    LAS float* scr = (LAS float*)(lds + wave * 16640);
    transpose_matrix(P.in[I_AB_WIN], 1024, 1536, (bf16_t*)(ws + WS_WABIN), 1024, RmId(), scr, gw, NGW, lane);
    transpose_matrix(P.in[I_AB_GLUW], 512, 512, (bf16_t*)(ws + WS_WGLU), 512, RmId(), scr, gw, NGW, lane);
    transpose_matrix(P.in[I_AB_WOUT], 1024, 1024, (bf16_t*)(ws + WS_WABOUT), 1024, RmId(), scr, gw, NGW, lane);
    transpose_matrix(P.in[I_CD_WIN], 1024, 2560, (bf16_t*)(ws + WS_WCDIN), 1024, RmId(), scr, gw, NGW, lane);
    transpose_matrix(P.in[I_CD_WOUT], 1024, 1024, (bf16_t*)(ws + WS_WCDOUT), 1024, RmId(), scr, gw, NGW, lane);
    for (int it = gw; it < 16; it += NGW) {
        const int gate = it >> 3, h = it & 7;
        transpose_item(P.in[gate ? I_AB_GIW : I_AB_GRW] + h * 4096, 64, (bf16_t*)(ws + WS_WG) + h * 8192, 64, 0, 0, RmGate{gate}, scr, lane);
    }
    for (int it = gw; it < 48; it += NGW) {
        const int which = it >> 4, h = (it >> 2) & 3, kb = (it >> 1) & 1, nb = it & 1;
        transpose_item(P.in[I_CD_WQ + which] + h * 16384, 128, (bf16_t*)(ws + WS_WQKV) + (which * 4 + h) * 16384, 128, kb * 64, nb * 64, RmId(), scr, lane);
    }
    convert_moe_weights(P, 0, lds);
}

__device__ __forceinline__ void store_bf16x4(bf16_t* p, f32x4 v) { u32x2 o; o.x = pk_bf16(v[0], v[1]); o.y = pk_bf16(v[2], v[3]); *(u32x2*)p = o; }

__device__ __forceinline__ void ph_inproj(const Params& P, lds_t* lds, const bf16_t* Wt, int N, const int* pos) {
    const bf16_t* xb = (const bf16_t*)(P.ws + WS_XB); bf16_t* proj = (bf16_t*)(P.ws + WS_PROJ);
    const int nct = N / 128;
    for (int tile = blockIdx.x; tile < 128 * nct; tile += gridDim.x) {
        const int rt = tile / nct, ct = tile % nct;
        e1_tile<true>(lds, 16,
            [=](int, int r, int kp) { return *(const u32x4*)(xb + (size_t)(rt * 256 + r) * 1024 + kp * 8); },
            [=](int, int n, int kp) { return *(const u32x4*)(Wt + (size_t)(ct * 128 + n) * 1024 + kp * 8); },
            [=](f32x4 (&acc)[4][4], int wr, int wc, int fr, int fq) {
                if (pos != nullptr && ct >= 8 && ct < 16 && wc == 0) {
                    float invf[4];
#pragma unroll
                    for (int c = 0; c < 4; ++c) invf[c] = exp2f(-(float)(fq * 4 + c) * (18.931568569324174f / 16.0f));
#pragma unroll
                    for (int m = 0; m < 4; ++m) {
                        const float pf = (float)pos[rt * 256 + wr * 64 + m * 16 + fr];
#pragma unroll
                        for (int c = 0; c < 4; ++c) {
                            float sn, cs; fsincos(pf * invf[c], sn, cs);
                            const float a = acc[m][0][c], b = acc[m][1][c];
                            acc[m][0][c] = a * cs - b * sn; acc[m][1][c] = b * cs + a * sn;
                        }
                    }
                }
                const float sc = (pos != nullptr && ct >= 8 && ct < 12) ? 0.08838834764831845f : 1.0f;
#pragma unroll
                for (int m = 0; m < 4; ++m)
#pragma unroll
                    for (int n = 0; n < 4; ++n)
                        store_bf16x4(proj + (size_t)(rt * 256 + wr * 64 + m * 16 + fr) * N + ct * 128 + wc * 64 + n * 16 + fq * 4, acc[m][n] * sc);
            });
    }
}

__device__ __forceinline__ void ph_conv0(const Params& P) {
    const bf16_t* proj = (const bf16_t*)(P.ws + WS_PROJ); bf16_t* xc = (bf16_t*)(P.ws + WS_XC);
    const int c8 = (threadIdx.x & 63) * 8;
    float w[4][8], bias[8];
#pragma unroll
    for (int e = 0; e < 8; ++e) { bias[e] = P.in[I_AB_CONVB][c8 + e];
#pragma unroll
        for (int k = 0; k < 4; ++k) w[k][e] = P.in[I_AB_CONVW][k * 512 + c8 + e]; }
    const size_t gtid = (size_t)blockIdx.x * NTHREADS + threadIdx.x, GT = (size_t)gridDim.x * NTHREADS;
    for (size_t i = gtid; i < (size_t)T * 64; i += GT) {
        const int tok = (int)(i >> 6), p = tok & (SEQ - 1);
        float a[8];
#pragma unroll
        for (int e = 0; e < 8; ++e) a[e] = bias[e];
#pragma unroll
        for (int k = 0; k < 4; ++k) {
            if (p - 3 + k >= 0) {
                float xv[8]; unpack8(*(const u32x4*)(proj + (size_t)(tok - 3 + k) * 1536 + c8), xv);
#pragma unroll
                for (int e = 0; e < 8; ++e) a[e] += w[k][e] * xv[e];
            }
        }
        *(u32x4*)(xc + (size_t)tok * 512 + c8) = pack8(a);
    }
}

__device__ __forceinline__ void ph_gates0(const Params& P, lds_t* lds) {
    const bf16_t* xc = (const bf16_t*)(P.ws + WS_XC); const bf16_t* Wg = (const bf16_t*)(P.ws + WS_WG);
    bf16_t* af = (bf16_t*)(P.ws + WS_AF); bf16_t* uf = (bf16_t*)(P.ws + WS_UF);
    const float* br = P.in[I_AB_GRB]; const float* bi = P.in[I_AB_GIB]; const float* lam = P.in[I_AB_LAMBDA];
    for (int tile = blockIdx.x; tile < 1024; tile += gridDim.x) {
        const int h = tile & 7, rt = tile >> 3;
        e1_tile<true>(lds, 1,
            [=](int, int r, int kp) { return *(const u32x4*)(xc + (size_t)(rt * 256 + r) * 512 + h * 64 + kp * 8); },
            [=](int, int n, int kp) { return *(const u32x4*)(Wg + (size_t)h * 8192 + n * 64 + kp * 8); },
            [=](f32x4 (&acc)[4][4], int wr, int wc, int fr, int fq) {
#pragma unroll
                for (int n = 0; n < 2; ++n) {
                    const int ch = h * 64 + wc * 32 + n * 16 + fq * 4;
                    float sp[4], brv[4], biv[4];
#pragma unroll
                    for (int c = 0; c < 4; ++c) { const float l = -lam[ch + c]; sp[c] = fmaxf(l, 0.f) + flog(1.0f + fexp(-fabsf(l))); brv[c] = br[ch + c]; biv[c] = bi[ch + c]; }
#pragma unroll
                    for (int m = 0; m < 4; ++m) {
                        const size_t row = (size_t)(rt * 256 + wr * 64 + m * 16 + fr);
                        const u32x2 xr = *(const u32x2*)(xc + row * 512 + ch);
                        const float xv[4] = {__uint_as_float(xr.x << 16), __uint_as_float(xr.x & 0xffff0000u), __uint_as_float(xr.y << 16), __uint_as_float(xr.y & 0xffff0000u)};
                        f32x4 a4, u4;
#pragma unroll
                        for (int c = 0; c < 4; ++c) {
                            const float r = fsigmoid(acc[m][n][c] + brv[c]), ig = fsigmoid(acc[m][n + 2][c] + biv[c]);
                            const float la = -8.0f * r * sp[c], x2 = 2.0f * la;
                            const float om = (x2 > -0.01f) ? -x2 * (1.0f + 0.5f * x2 * (1.0f + x2 * (1.0f / 3.0f))) : 1.0f - fexp(x2);
                            a4[c] = la; u4[c] = sqrtf(om) * ig * xv[c];
                        }
                        store_bf16x4(af + row * 512 + ch, a4); store_bf16x4(uf + row * 512 + ch, u4);
                    }
                }
            });
    }
}

__device__ __forceinline__ void ph_lru_scan(const Params& P, lds_t* lds) {
    const bf16_t* af = (const bf16_t*)(P.ws + WS_AF); const bf16_t* uf = (const bf16_t*)(P.ws + WS_UF);
    const bf16_t* proj = (const bf16_t*)(P.ws + WS_PROJ); bf16_t* cat = (bf16_t*)(P.ws + WS_CAT);
    LAS float* lA = (LAS float*)lds; LAS float* lH = lA + 512;
    const int tid = threadIdx.x, seg = tid >> 4, c = tid & 15;
    for (int item = blockIdx.x; item < 256; item += gridDim.x) {
        const int b = item >> 5, ch = (item & 31) * 16 + c;
        const size_t base = (size_t)b * SEQ + seg * 128;
        float A = 1.f, H = 0.f;
#pragma unroll 8
        for (int i = 0; i < 128; ++i) { const float a = fexp(bf2f(af[(base + i) * 512 + ch])), u = bf2f(uf[(base + i) * 512 + ch]); H = a * H + u; A *= a; }
        lA[tid] = A; lH[tid] = H;
        __syncthreads();
        float carry = 0.f;
        for (int s = 0; s < seg; ++s) carry = lA[s * 16 + c] * carry + lH[s * 16 + c];
        H = carry;
#pragma unroll 8
        for (int i = 0; i < 128; ++i) {
            const float a = fexp(bf2f(af[(base + i) * 512 + ch])), u = bf2f(uf[(base + i) * 512 + ch]); H = a * H + u;
            const float ga = bf2f(proj[(base + i) * 1536 + 512 + ch]);
            cat[(base + i) * 1024 + ch] = (bf16_t)(pk_bf16(H * gelu_tanh(ga), 0.f) & 0xffffu);
        }
        __syncthreads();
    }
}

__device__ __forceinline__ void ph_s5_state(const Params& P, lds_t* lds) {
    const bf16_t* proj = (const bf16_t*)(P.ws + WS_PROJ); const bf16_t* Wst = (const bf16_t*)(P.ws + WS_S5WST); float* S = (float*)(P.ws + WS_S5S);
    for (int tile = blockIdx.x; tile < 128; tile += gridDim.x) {
        const int g = tile & 31, rt = tile >> 5;
        e1_tile<true>(lds, 8,
            [=](int, int r, int kp) { return *(const u32x4*)(proj + (size_t)((rt * 256 + r) * 32 + (kp >> 1)) * 1536 + 1024 + g * 16 + (kp & 1) * 8); },
            [=](int, int n, int kp) { return *(const u32x4*)(Wst + (size_t)g * 65536 + n * 512 + kp * 8); },
            [=](f32x4 (&acc)[4][4], int wr, int wc, int fr, int fq) {
#pragma unroll
                for (int m = 0; m < 4; ++m)
#pragma unroll
                    for (int n = 0; n < 4; ++n) *(f32x4*)(S + ((size_t)(rt * 256 + wr * 64 + m * 16 + fr) * 32 + g) * 128 + wc * 64 + n * 16 + fq * 4) = acc[m][n];
            });
    }
}

__device__ __forceinline__ void ph_s5_carry(const Params& P) {
    const float* S = (const float*)(P.ws + WS_S5S); bf16_t* X = (bf16_t*)(P.ws + WS_S5X);
    if (threadIdx.x >= 64) return;
    const int p = threadIdx.x;
    for (int it = blockIdx.x; it < 256; it += gridDim.x) {
        const int b = it >> 5, g = it & 31;
        const float lr = fminf(P.in[I_S5_LRE][g * 64 + p], -1e-4f), li = P.in[I_S5_LIM][g * 64 + p], step = expf(P.in[I_S5_STEP][g]);
        const float mag = expf((float)S5TC * lr * step); float sn, cs; sincosf((float)S5TC * li * step, &sn, &cs);
        const float cr = mag * cs, ci = mag * sn;
        float xr = 0.f, xi = 0.f;
        for (int c0 = 0; c0 < 128; c0 += 16) {
            float sr[16], si[16];
#pragma unroll
            for (int j = 0; j < 16; ++j) { const size_t o = ((size_t)(b * 128 + c0 + j) * 32 + g) * 128; sr[j] = S[o + p]; si[j] = S[o + 64 + p]; }
#pragma unroll
            for (int j = 0; j < 16; ++j) {
                const size_t o = ((size_t)(b * 128 + c0 + j) * 32 + g) * 128;
                X[o + p] = (bf16_t)(pk_bf16(xr, 0.f) & 0xffffu); X[o + 64 + p] = (bf16_t)(pk_bf16(xi, 0.f) & 0xffffu);
                const float nr = cr * xr - ci * xi + sr[j], ni = cr * xi + ci * xr + si[j];
                xr = nr; xi = ni;
            }
        }
    }
}

__device__ __forceinline__ void ph_s5_out(const Params& P, lds_t* lds) {
    const bf16_t* proj = (const bf16_t*)(P.ws + WS_PROJ); const bf16_t* Tm = (const bf16_t*)(P.ws + WS_S5TM); const bf16_t* X = (const bf16_t*)(P.ws + WS_S5X);
    bf16_t* sb = (bf16_t*)(P.ws + WS_SB);
    for (int tile = blockIdx.x; tile < 512; tile += gridDim.x) {
        const int ct = tile & 3, g = (tile >> 2) & 31, rt = tile >> 7;
        const int nkl = 2 * ct + 2;
        e1_tile<true>(lds, nkl + 2,
            [=](int, int r, int kp0) {
                const int kp = kp0 < nkl * 8 ? kp0 : kp0 - nkl * 8 + 64;
                if (kp < 64) return *(const u32x4*)(proj + (size_t)((rt * 256 + r) * 32 + (kp >> 1)) * 1536 + 1024 + g * 16 + (kp & 1) * 8);
                return *(const u32x4*)(X + ((size_t)(rt * 256 + r) * 32 + g) * 128 + (kp - 64) * 8); },
            [=](int, int n, int kp0) { const int kp = kp0 < nkl * 8 ? kp0 : kp0 - nkl * 8 + 64; return *(const u32x4*)(Tm + (size_t)g * 512 * S5K + (size_t)(ct * 128 + n) * S5K + kp * 8); },
            [=](f32x4 (&acc)[4][4], int wr, int wc, int fr, int fq) {
#pragma unroll
                for (int m = 0; m < 4; ++m)
#pragma unroll
                    for (int n = 0; n < 4; ++n) {
                        const int col = ct * 128 + wc * 64 + n * 16 + fq * 4, t = col >> 4, h0 = col & 15;
                        const size_t tok = (size_t)(rt * 256 + wr * 64 + m * 16 + fr) * 32 + t;
                        f32x4 y = acc[m][n];
#pragma unroll
                        for (int c = 0; c < 4; ++c) y[c] = gelu_tanh(y[c]);
                        store_bf16x4(sb + tok * 512 + g * 16 + h0, y);
                    }
            });
    }
}

__device__ __forceinline__ void ph_glu(const Params& P, lds_t* lds) {
    const bf16_t* sb = (const bf16_t*)(P.ws + WS_SB); const bf16_t* Wt = (const bf16_t*)(P.ws + WS_WGLU); bf16_t* cat = (bf16_t*)(P.ws + WS_CAT);
    const float* gb = P.in[I_AB_GLUB];
    for (int tile = blockIdx.x; tile < 512; tile += gridDim.x) {
        const int rt = tile >> 2, ct = tile & 3;
        e1_tile<true>(lds, 8,
            [=](int, int r, int kp) { return *(const u32x4*)(sb + (size_t)(rt * 256 + r) * 512 + kp * 8); },
            [=](int, int n, int kp) { return *(const u32x4*)(Wt + (size_t)(ct * 128 + n) * 512 + kp * 8); },
            [=](f32x4 (&acc)[4][4], int wr, int wc, int fr, int fq) {
#pragma unroll
                for (int n = 0; n < 4; ++n) {
                    const int col = ct * 128 + wc * 64 + n * 16 + fq * 4;
                    const f32x4 bv = *(const f32x4*)(gb + col);
#pragma unroll
                    for (int m = 0; m < 4; ++m) {
                        const size_t row = (size_t)(rt * 256 + wr * 64 + m * 16 + fr);
                        const u32x2 sr = *(const u32x2*)(sb + row * 512 + col);
                        const float sv[4] = {__uint_as_float(sr.x << 16), __uint_as_float(sr.x & 0xffff0000u), __uint_as_float(sr.y << 16), __uint_as_float(sr.y & 0xffff0000u)};
                        f32x4 y;
#pragma unroll
                        for (int c = 0; c < 4; ++c) y[c] = sv[c] * fsigmoid(acc[m][n][c] + bv[c]);
                        store_bf16x4(cat + row * 1024 + 512 + col, y);
                    }
                }
            });
    }
}

__device__ __forceinline__ void ph_outproj(const Params& P, lds_t* lds, const bf16_t* Wt, const float* xres) {
    const bf16_t* cat = (const bf16_t*)(P.ws + WS_CAT); float* zf = (float*)(P.ws + WS_ZF);
    for (int tile = blockIdx.x; tile < 1024; tile += gridDim.x) {
        const int rt = tile >> 3, ct = tile & 7;
        e1_tile<true>(lds, 16,
            [=](int, int r, int kp) { return *(const u32x4*)(cat + (size_t)(rt * 256 + r) * 1024 + kp * 8); },
            [=](int, int n, int kp) { return *(const u32x4*)(Wt + (size_t)(ct * 128 + n) * 1024 + kp * 8); },
            [=](f32x4 (&acc)[4][4], int wr, int wc, int fr, int fq) {
#pragma unroll
                for (int m = 0; m < 4; ++m)
#pragma unroll
                    for (int n = 0; n < 4; ++n) {
                        const size_t o = (size_t)(rt * 256 + wr * 64 + m * 16 + fr) * 1024 + ct * 128 + wc * 64 + n * 16 + fq * 4;
                        *(f32x4*)(zf + o) = *(const f32x4*)(xres + o) * ALPHA + acc[m][n];
                    }
            });
    }
}

__device__ __forceinline__ void ph_ln_router(const Params& P, lds_t* lds, int layer, const float* xres, int dummy = 0) {
    const bf16_t* mixb = (const bf16_t*)(P.ws + WS_ZF); float* x1f = (float*)(P.ws + WS_X1F); bf16_t* xb = (bf16_t*)(P.ws + WS_XB);
    const float* lg = P.in[I_LNM_G] + layer * 1024; const float* lb = P.in[I_LNM_B] + layer * 1024;
    const float* rw = P.in[I_R_W] + (size_t)layer * 1024 * 32; const float* rbias = P.in[I_R_B] + layer * 32;
    int* gcount = (int*)(P.ws + WS_CTL) + 64 * layer + 32 * dummy;
    int* pair_e = (int*)(P.ws + WS_ROUTE); int* pair_rank = pair_e + T * 4; float* pair_gate = (float*)(pair_rank + T * 4);
    LAS float* Wr = (LAS float*)lds;
    LAS int* hist = (LAS int*)(lds + 147456); LAS int* basev = hist + 32;
    LAS int* pinfo = basev + 32;
    const int tid = threadIdx.x, lane = tid & 63, wave = tid >> 6;
    for (int i = tid; i < 32768; i += NTHREADS) { const int k = i >> 5; Wr[((k & 3) * 256 + (k >> 8) * 64 + ((k >> 2) & 63)) * 36 + (i & 31)] = rw[i]; }
    const float myrb = rbias[lane & 31];
    __syncthreads();
    for (int it = blockIdx.x; it < 512; it += gridDim.x) {
        if (tid < 32) hist[tid] = 0;
        __syncthreads();
        for (int pp = 0; pp < 4; ++pp) {
            f32x4 y[2][4];
#pragma unroll
            for (int rr = 0; rr < 2; ++rr)
#pragma unroll
                for (int j = 0; j < 4; ++j) {
                    const size_t o = ((size_t)it * 64 + wave * 8 + pp * 2 + rr) * 1024 + j * 256 + lane * 4;
                    const u32x2 mr = *(const u32x2*)(mixb + o);
                    y[rr][j] = *(const f32x4*)(xres + o) * ALPHA + (f32x4){__uint_as_float(mr.x << 16), __uint_as_float(mr.x & 0xffff0000u), __uint_as_float(mr.y << 16), __uint_as_float(mr.y & 0xffff0000u)};
                }
            f32x2 v2[32];
            int woff = lane * 36; asm volatile("" : "+v"(woff));
#pragma unroll
            for (int rr = 0; rr < 2; ++rr) {
                const size_t row = (size_t)it * 64 + wave * 8 + pp * 2 + rr;
                float s = 0.f;
#pragma unroll
                for (int j = 0; j < 4; ++j) s += (y[rr][j][0] + y[rr][j][1]) + (y[rr][j][2] + y[rr][j][3]);
                const float mean = wave_sum(s) * (1.0f / 1024.0f); float s2 = 0.f;
#pragma unroll
                for (int j = 0; j < 4; ++j) { y[rr][j] = y[rr][j] - mean; s2 += (y[rr][j][0] * y[rr][j][0] + y[rr][j][1] * y[rr][j][1]) + (y[rr][j][2] * y[rr][j][2] + y[rr][j][3] * y[rr][j][3]); }
                const float rstd = rsqrtf(wave_sum(s2) * (1.0f / 1024.0f) + LN_EPS);
#pragma unroll
                for (int j = 0; j < 4; ++j) {
                    y[rr][j] = y[rr][j] * rstd * *(const f32x4*)(lg + j * 256 + lane * 4) + *(const f32x4*)(lb + j * 256 + lane * 4);
                    *(f32x4*)(x1f + row * 1024 + j * 256 + lane * 4) = y[rr][j];
                    store_bf16x4(xb + row * 1024 + j * 256 + lane * 4, y[rr][j]);
                }
            }
#pragma unroll
            for (int e = 0; e < 32; ++e) v2[e] = (f32x2){0.f, 0.f};
#pragma unroll
            for (int j = 0; j < 4; ++j)
#pragma unroll
                for (int c = 0; c < 4; ++c) {
                    const LAS float* wrow = Wr + (c * 256 + j * 64) * 36 + woff;
                    const f32x2 yy = {y[0][j][c], y[1][j][c]};
#pragma unroll
                    for (int e4 = 0; e4 < 8; ++e4) {
                        const f32x4 w = *(const LAS f32x4*)(wrow + 4 * e4);
#pragma unroll
                        for (int q = 0; q < 4; ++q) v2[4 * e4 + q] += yy * w[q];
                    }
                    __builtin_amdgcn_sched_barrier(0);
                }
            float v[2][32];
#pragma unroll
            for (int e = 0; e < 32; ++e) { v[0][e] = v2[e][0]; v[1][e] = v2[e][1]; }
#pragma unroll
            for (int rr = 0; rr < 2; ++rr) {
                const int rl = wave * 8 + pp * 2 + rr;
#pragma unroll
                for (int e = 0; e < 32; ++e) v[rr][e] += __shfl_xor(v[rr][e], 32);
#define TR_STEP(OFF, CNT) _Pragma("unroll") for (int e = 0; e < CNT; ++e) { const bool up = (lane & OFF) != 0; const float send = up ? v[rr][e] : v[rr][e + CNT]; const float keep = up ? v[rr][e + CNT] : v[rr][e]; v[rr][e] = keep + __shfl_xor(send, OFF); }
                TR_STEP(16, 16) TR_STEP(8, 8) TR_STEP(4, 4) TR_STEP(2, 2) TR_STEP(1, 1)
#undef TR_STEP
                float val = v[rr][0] + myrb; const int my = lane & 31;
                float topv[4]; int topi[4];
#pragma unroll
                for (int k = 0; k < 4; ++k) {
                    float bv = val; int bi = my;
#pragma unroll
                    for (int off = 16; off >= 1; off >>= 1) { const float ov = __shfl_xor(bv, off); const int oi = __shfl_xor(bi, off); if (ov > bv || (ov == bv && oi < bi)) { bv = ov; bi = oi; } }
                    topv[k] = bv; topi[k] = bi; if (my == bi) val = -INFINITY;
                }
                if (lane == 0) {
                    const float e1 = expf(topv[1] - topv[0]), e2 = expf(topv[2] - topv[0]), e3 = expf(topv[3] - topv[0]);
                    const float inv = 1.0f / (1.0f + e1 + e2 + e3);
                    const float gt[4] = {inv, e1 * inv, e2 * inv, e3 * inv};
#pragma unroll
                    for (int k = 0; k < 4; ++k) { const int lr = __hip_atomic_fetch_add(&hist[topi[k]], 1, __ATOMIC_RELAXED, __HIP_MEMORY_SCOPE_WORKGROUP); pinfo[(rl * 4 + k) * 3 + 0] = topi[k]; pinfo[(rl * 4 + k) * 3 + 1] = lr; pinfo[(rl * 4 + k) * 3 + 2] = __float_as_int(gt[k]); }
                }
            }
        }
        __syncthreads();
        if (tid < 32) { const int c = hist[tid]; basev[tid] = c ? atomicAdd(gcount + tid, c) : 0; }
        __syncthreads();
        if (tid < 256) {
            const int e = pinfo[tid * 3 + 0]; const size_t pi = (size_t)it * 256 + tid;
            pair_e[pi] = e; pair_rank[pi] = basev[e] + pinfo[tid * 3 + 1]; pair_gate[pi] = __int_as_float(pinfo[tid * 3 + 2]);
        }
        __syncthreads();
    }
}

__device__ __forceinline__ void moe_pstart(const Params& P, lds_t* lds, int layer) {
    LAS int* ps = (LAS int*)(lds + 140 * 1024);
    const int* gcount = (const int*)(P.ws + WS_CTL) + 64 * layer;
    if (threadIdx.x == 0) { int a = 0; for (int e = 0; e < 32; ++e) { const int c = gcount[e]; ps[e] = a; ps[40 + e] = c; a += ((c + 255) >> 8) << 8; } ps[32] = a; }
    __syncthreads();
}

__device__ __forceinline__ void ph_route_scatter(const Params& P, lds_t* lds, int layer) {
    moe_pstart(P, lds, layer);
    LAS int* ps = (LAS int*)(lds + 140 * 1024);
    const int* pair_e = (const int*)(P.ws + WS_ROUTE); const int* pair_rank = pair_e + T * 4; const float* pair_gate = (const float*)(pair_rank + T * 4);
    int* dest = (int*)(pair_gate + T * 4); int* row_tok = dest + T * 4; float* row_gate = (float*)(row_tok + MOE_ROWS);
    const size_t gtid = (size_t)blockIdx.x * NTHREADS + threadIdx.x, GT = (size_t)gridDim.x * NTHREADS;
    for (size_t i = gtid; i < (size_t)T * 4; i += GT) {
        const int e = pair_e[i], pos = ps[e] + pair_rank[i];
        row_tok[pos] = (int)(i >> 2); row_gate[pos] = pair_gate[i]; dest[i] = pos;
    }
    for (size_t i = gtid; i < 32 * 256; i += GT) {
        const int e = (int)(i >> 8), pos = ps[e] + ps[40 + e] + (int)(i & 255);
        if (pos < ps[e + 1]) { row_tok[pos] = 0; row_gate[pos] = 0.f; }
    }
}

__device__ __forceinline__ void ph_moe_up(const Params& P, lds_t* lds, int layer) {
    moe_pstart(P, lds, layer);
    LAS int* ps = (LAS int*)(lds + 140 * 1024);
    const bf16_t* xb = (const bf16_t*)(P.ws + WS_XB); const bf16_t* W = (const bf16_t*)(P.ws + WS_MWIN); bf16_t* hact = (bf16_t*)(P.ws + WS_HACT);
    const int* row_tok = (const int*)(P.ws + WS_ROUTE) + 4 * T * 4;
    const float* b_in = P.in[I_M_BIN] + (size_t)layer * 32 * 2048;
    const int nunits = (ps[32] >> 8) * 16;
    for (int unit = blockIdx.x; unit < nunits; unit += gridDim.x) {
        const int rb = unit >> 4, ct = unit & 15;
        int e = 0; while (ps[e + 1] <= rb * 256) ++e;
        int tok[4];
#pragma unroll
        for (int i = 0; i < 4; ++i) tok[i] = row_tok[rb * 256 + (threadIdx.x >> 3) + 64 * i];
        const bf16_t* We = W + (size_t)e * 2048 * 1024; const float* be = b_in + e * 2048;
        e1_tile<true>(lds, 16,
            [=](int i, int, int kp) { return *(const u32x4*)(xb + (size_t)tok[i] * 1024 + kp * 8); },
            [=](int, int n, int kp) { return *(const u32x4*)(We + (size_t)(ct * 128 + n) * 1024 + kp * 8); },
            [=](f32x4 (&acc)[4][4], int wr, int wc, int fr, int fq) {
#pragma unroll
                for (int n = 0; n < 2; ++n) {
                    const int j = ct * 64 + wc * 32 + n * 16 + fq * 4;
                    const f32x4 bg = *(const f32x4*)(be + j), bl = *(const f32x4*)(be + 1024 + j);
#pragma unroll
                    for (int m = 0; m < 4; ++m) {
                        f32x4 y;
#pragma unroll
                        for (int c = 0; c < 4; ++c) {
                            const float gv = fminf(acc[m][n][c] + bg[c], 7.0f), lv = fminf(fmaxf(acc[m][n + 2][c] + bl[c], -7.0f), 7.0f);
                            y[c] = gv * fsigmoid(1.702f * gv) * (lv + 1.0f);
                        }
                        store_bf16x4(hact + (size_t)(rb * 256 + wr * 64 + m * 16 + fr) * 1024 + j, y);
                    }
                }
            });
    }
}

__device__ __forceinline__ void ph_moe_down(const Params& P, lds_t* lds, int layer) {
    moe_pstart(P, lds, layer);
    LAS int* ps = (LAS int*)(lds + 140 * 1024);
    const bf16_t* hact = (const bf16_t*)(P.ws + WS_HACT); const bf16_t* W = (const bf16_t*)(P.ws + WS_MWOUT); bf16_t* yb = (bf16_t*)(P.ws + WS_YB);
    const float* row_gate = (const float*)((const int*)(P.ws + WS_ROUTE) + 4 * T * 4 + MOE_ROWS);
    const float* b_out = P.in[I_M_BOUT] + (size_t)layer * 32 * 1024;
    const int nunits = (ps[32] >> 8) * 8;
    for (int unit = blockIdx.x; unit < nunits; unit += gridDim.x) {
        const int rb = unit >> 3, ct = unit & 7;
        int e = 0; while (ps[e + 1] <= rb * 256) ++e;
        const bf16_t* We = W + (size_t)e * 1024 * 1024; const float* be = b_out + e * 1024;
        e1_tile<true>(lds, 16,
            [=](int, int r, int kp) { return *(const u32x4*)(hact + (size_t)(rb * 256 + r) * 1024 + kp * 8); },
            [=](int, int n, int kp) { return *(const u32x4*)(We + (size_t)(ct * 128 + n) * 1024 + kp * 8); },
            [=](f32x4 (&acc)[4][4], int wr, int wc, int fr, int fq) {
#pragma unroll
                for (int m = 0; m < 4; ++m) {
                    const int row = rb * 256 + wr * 64 + m * 16 + fr; const float gt = row_gate[row];
#pragma unroll
                    for (int n = 0; n < 4; ++n) {
                        const int col = ct * 128 + wc * 64 + n * 16 + fq * 4;
                        store_bf16x4(yb + (size_t)row * 1024 + col, (acc[m][n] + *(const f32x4*)(be + col)) * gt);
                    }
                }
            });
    }
}

struct EpiInproj {
    bf16_t* proj; int N; const int* pos;
    __device__ __forceinline__ void operator()(f32x4 (&acc)[2][2][4][2], const g2::Unit& u, int wr, int wc, int fr, int fq) const {
#pragma unroll
        for (int bj = 0; bj < 2; ++bj) {
            const int ct = 2 * u.pn + bj;
            if (pos != nullptr && ct >= 8 && ct < 16 && wc == 0) {
                float invf[4];
#pragma unroll
                for (int c = 0; c < 4; ++c) invf[c] = exp2f(-(float)(fq * 4 + c) * (18.931568569324174f / 16.0f));
#pragma unroll
                for (int ai = 0; ai < 2; ++ai)
#pragma unroll
                    for (int m = 0; m < 4; ++m) {
                        const float pf = (float)pos[u.pm * 256 + ai * 128 + wr * 64 + m * 16 + fr];
#pragma unroll
                        for (int c = 0; c < 4; ++c) {
                            float sn, cs; fsincos(pf * invf[c], sn, cs);
                            const float a = acc[ai][bj][m][0][c], b = acc[ai][bj][m][1][c];
                            acc[ai][bj][m][0][c] = a * cs - b * sn; acc[ai][bj][m][1][c] = b * cs + a * sn;
                        }
                    }
            }
            const float sc = (pos != nullptr && ct >= 8 && ct < 12) ? 0.08838834764831845f : 1.0f;
#pragma unroll
            for (int ai = 0; ai < 2; ++ai)
#pragma unroll
                for (int m = 0; m < 4; ++m)
#pragma unroll
                    for (int n = 0; n < 2; ++n)
                        store_bf16x4(proj + (size_t)(u.pm * 256 + ai * 128 + wr * 64 + m * 16 + fr) * N + ct * 128 + wc * 32 + n * 16 + fq * 4, acc[ai][bj][m][n] * sc);
        }
    }
};
__device__ __forceinline__ void ph_inproj2(const Params& P, lds_t* lds, const bf16_t* Wt, int N, const int* pos) {
    g2::DenseSched S{(int)gridDim.x, (int)blockIdx.x, T / 256, N / 256, 1024, (const char*)Wt};
    EpiInproj E{(bf16_t*)(P.ws + WS_PROJ), N, pos};
    g2::gemm_phase(lds, (const char*)(P.ws + WS_XB), 1024, 2048u, S, E);
}
struct EpiOutproj {
    bf16_t* mixb;
    __device__ __forceinline__ void operator()(f32x4 (&acc)[2][2][4][2], const g2::Unit& u, int wr, int wc, int fr, int fq) const {
#pragma unroll
        for (int ai = 0; ai < 2; ++ai)
#pragma unroll
            for (int m = 0; m < 4; ++m)
#pragma unroll
                for (int bj = 0; bj < 2; ++bj)
#pragma unroll
                    for (int n = 0; n < 2; ++n) {
                        const size_t o = (size_t)(u.pm * 256 + ai * 128 + wr * 64 + m * 16 + fr) * 1024 + u.pn * 256 + bj * 128 + wc * 32 + n * 16 + fq * 4;
                        store_bf16x4(mixb + o, acc[ai][bj][m][n]);
                    }
    }
};
__device__ __forceinline__ void ph_outproj2(const Params& P, lds_t* lds, const bf16_t* Wt) {
    g2::DenseSched S{(int)gridDim.x, (int)blockIdx.x, T / 256, 4, 1024, (const char*)Wt};
    EpiOutproj E{(bf16_t*)(P.ws + WS_ZF)};
    g2::gemm_phase(lds, (const char*)(P.ws + WS_CAT), 1024, 2048u, S, E);
}
struct MoeSched {
    int G, c, nM, nN; const char* W; size_t wstride; const int* row_tok; LAS int* ps;
    __device__ __forceinline__ bool next(int i, g2::Unit& u) const { return g2::static_next(i, G, c, nM, nN, u); }
    __device__ __forceinline__ int expert(int pm) const { int e = 0; while (ps[e + 1] <= pm * 256) ++e; return e; }
    __device__ __forceinline__ void a_off(const g2::Unit& u, const int (&Rs)[2], const int (&Cs)[2], unsigned (&ao)[2][2]) const {
#pragma unroll
        for (int h = 0; h < 2; ++h)
#pragma unroll
            for (int i = 0; i < 2; ++i) {
                const int r = u.pm * 256 + h * 128 + Rs[i];
                const unsigned row = row_tok ? (unsigned)row_tok[r] : (unsigned)r;
                ao[h][i] = (row * 1024u + (unsigned)Cs[i]) * 2u;
            }
    }
    __device__ __forceinline__ const char* b_base(const g2::Unit& u) const { return W + (size_t)expert(u.pm) * wstride + (size_t)u.pn * 256 * 2048; }
};
struct EpiMoeUp {
    bf16_t* hact; const float* b_in; LAS int* ps;
    __device__ __forceinline__ void operator()(f32x4 (&acc)[2][2][4][2], const g2::Unit& u, int wr, int wc, int fr, int fq) const {
        int e = 0; while (ps[e + 1] <= u.pm * 256) ++e;
        const float* be = b_in + e * 2048;
#pragma unroll
        for (int n = 0; n < 2; ++n) {
            const int j = u.pn * 128 + wc * 32 + n * 16 + fq * 4;
            const f32x4 bg = *(const f32x4*)(be + j), bl = *(const f32x4*)(be + 1024 + j);
#pragma unroll
            for (int ai = 0; ai < 2; ++ai)
#pragma unroll
                for (int m = 0; m < 4; ++m) {
                    f32x4 y;
#pragma unroll
                    for (int c = 0; c < 4; ++c) {
                        const float gv = fminf(acc[ai][0][m][n][c] + bg[c], 7.0f), lv = fminf(fmaxf(acc[ai][1][m][n][c] + bl[c], -7.0f), 7.0f);
                        y[c] = gv * fsigmoid(1.702f * gv) * (lv + 1.0f);
                    }
                    store_bf16x4(hact + (size_t)(u.pm * 256 + ai * 128 + wr * 64 + m * 16 + fr) * 1024 + j, y);
                }
        }
    }
};
__device__ __forceinline__ void ph_moe_up2(const Params& P, lds_t* lds, int layer) {
    moe_pstart(P, lds, layer);
    LAS int* ps = (LAS int*)(lds + 140 * 1024);
    const int* row_tok = (const int*)(P.ws + WS_ROUTE) + 4 * T * 4;
    MoeSched S{(int)gridDim.x, (int)blockIdx.x, ps[32] >> 8, 8, (const char*)(P.ws + WS_MWIN), (size_t)2048 * 1024 * 2, row_tok, ps};
    EpiMoeUp E{(bf16_t*)(P.ws + WS_HACT), P.in[I_M_BIN] + (size_t)layer * 32 * 2048, ps};
    g2::gemm_phase(lds, (const char*)(P.ws + WS_XB), 1024, 2048u, S, E);
}
struct EpiMoeDown {
    bf16_t* yb; const float* b_out; const float* row_gate; LAS int* ps;
    __device__ __forceinline__ void operator()(f32x4 (&acc)[2][2][4][2], const g2::Unit& u, int wr, int wc, int fr, int fq) const {
        int e = 0; while (ps[e + 1] <= u.pm * 256) ++e;
        const float* be = b_out + e * 1024;
#pragma unroll
        for (int ai = 0; ai < 2; ++ai)
#pragma unroll
            for (int m = 0; m < 4; ++m) {
                const int row = u.pm * 256 + ai * 128 + wr * 64 + m * 16 + fr; const float gt = row_gate[row];
#pragma unroll
                for (int bj = 0; bj < 2; ++bj)
#pragma unroll
                    for (int n = 0; n < 2; ++n) {
                        const int col = u.pn * 256 + bj * 128 + wc * 32 + n * 16 + fq * 4;
                        store_bf16x4(yb + (size_t)row * 1024 + col, (acc[ai][bj][m][n] + *(const f32x4*)(be + col)) * gt);
                    }
            }
    }
};
__device__ __forceinline__ void ph_moe_down2(const Params& P, lds_t* lds, int layer) {
    moe_pstart(P, lds, layer);
    LAS int* ps = (LAS int*)(lds + 140 * 1024);
    const float* row_gate = (const float*)((const int*)(P.ws + WS_ROUTE) + 4 * T * 4 + MOE_ROWS);
    MoeSched S{(int)gridDim.x, (int)blockIdx.x, ps[32] >> 8, 4, (const char*)(P.ws + WS_MWOUT), (size_t)1024 * 1024 * 2, nullptr, ps};
    EpiMoeDown E{(bf16_t*)(P.ws + WS_YB), P.in[I_M_BOUT] + (size_t)layer * 32 * 1024, row_gate, ps};
    g2::gemm_phase(lds, (const char*)(P.ws + WS_HACT), 1024, 2048u, S, E);
}

__device__ __forceinline__ void ph_combine_ln(const Params& P, int layer, float* outf, bool write_bf) {
    float* x1f = (float*)(P.ws + WS_X1F); const bf16_t* yb = (const bf16_t*)(P.ws + WS_YB); bf16_t* xb = (bf16_t*)(P.ws + WS_XB);
    const int* dest = (const int*)(P.ws + WS_ROUTE) + 3 * T * 4;
    const float* lg = P.in[I_LNF_G] + layer * 1024; const float* lb = P.in[I_LNF_B] + layer * 1024;
    const int lane = threadIdx.x & 63, gw = blockIdx.x * 8 + (threadIdx.x >> 6), NGW = gridDim.x * 8;
    for (int row0 = gw * 2; row0 < T; row0 += NGW * 2) {
        f32x4 v[2][4]; u32x2 yr[2][4][4];
#pragma unroll
        for (int rr = 0; rr < 2; ++rr) {
            const int row = row0 + rr;
            const int4 d = *(const int4*)(dest + row * 4);
            const int dd[4] = {d.x, d.y, d.z, d.w};
#pragma unroll
            for (int j = 0; j < 4; ++j) {
                v[rr][j] = *(const f32x4*)(x1f + (size_t)row * 1024 + j * 256 + lane * 4);
#pragma unroll
                for (int k = 0; k < 4; ++k) yr[rr][j][k] = *(const u32x2*)(yb + (size_t)dd[k] * 1024 + j * 256 + lane * 4);
            }
        }
#pragma unroll
        for (int rr = 0; rr < 2; ++rr) {
            const int row = row0 + rr; float s = 0.f;
#pragma unroll
            for (int j = 0; j < 4; ++j) {
                v[rr][j] = v[rr][j] * ALPHA;
#pragma unroll
                for (int k = 0; k < 4; ++k) {
                    const u32x2 r = yr[rr][j][k];
                    v[rr][j][0] += __uint_as_float(r.x << 16); v[rr][j][1] += __uint_as_float(r.x & 0xffff0000u); v[rr][j][2] += __uint_as_float(r.y << 16); v[rr][j][3] += __uint_as_float(r.y & 0xffff0000u);
                }
                s += (v[rr][j][0] + v[rr][j][1]) + (v[rr][j][2] + v[rr][j][3]);
            }
            const float mean = wave_sum(s) * (1.0f / 1024.0f); float s2 = 0.f;
#pragma unroll
            for (int j = 0; j < 4; ++j) { v[rr][j] = v[rr][j] - mean; s2 += (v[rr][j][0] * v[rr][j][0] + v[rr][j][1] * v[rr][j][1]) + (v[rr][j][2] * v[rr][j][2] + v[rr][j][3] * v[rr][j][3]); }
            const float rstd = rsqrtf(wave_sum(s2) * (1.0f / 1024.0f) + LN_EPS);
#pragma unroll
            for (int j = 0; j < 4; ++j) {
                const f32x4 o = v[rr][j] * rstd * *(const f32x4*)(lg + j * 256 + lane * 4) + *(const f32x4*)(lb + j * 256 + lane * 4);
                *(f32x4*)(outf + (size_t)row * 1024 + j * 256 + lane * 4) = o;
                if (write_bf) store_bf16x4(xb + (size_t)row * 1024 + j * 256 + lane * 4, o);
            }
        }
    }
}

__device__ __forceinline__ void ph_conv1(const Params& P, lds_t* lds) {
    const bf16_t* proj = (const bf16_t*)(P.ws + WS_PROJ); bf16_t* xconv = (bf16_t*)(P.ws + WS_XCONV); float* gates = (float*)(P.ws + WS_GATES);
    LAS float* Wc = (LAS float*)lds;
    const float* Wcg = (const float*)(P.ws + WS_WC);
    for (int i = threadIdx.x; i < 8192; i += NTHREADS) Wc[i] = Wcg[i];
    __syncthreads();
    const int lane = threadIdx.x & 63, gw = blockIdx.x * 8 + (threadIdx.x >> 6), NGW = gridDim.x * 8, c8 = lane * 8;
    float w[4][8], bias[8];
#pragma unroll
    for (int e = 0; e < 8; ++e) { bias[e] = P.in[I_CD_CONVB][c8 + e];
#pragma unroll
        for (int k = 0; k < 4; ++k) w[k][e] = P.in[I_CD_CONVW][k * 512 + c8 + e]; }
    const float bif = P.in[I_CD_BIF][lane & 7];
    for (int tok = gw; tok < T; tok += NGW) {
        const int p = tok & (SEQ - 1);
        float a[8], xraw[8];
#pragma unroll
        for (int e = 0; e < 8; ++e) { a[e] = bias[e]; xraw[e] = 0.f; }
#pragma unroll
        for (int k = 0; k < 4; ++k) {
            if (p - 3 + k >= 0) {
                float xv[8]; unpack8(*(const u32x4*)(proj + (size_t)(tok - 3 + k) * 2560 + c8), xv);
#pragma unroll
                for (int e = 0; e < 8; ++e) { a[e] += w[k][e] * xv[e]; if (k == 3) xraw[e] = xv[e]; }
            }
        }
#pragma unroll
        for (int e = 0; e < 8; ++e) a[e] = a[e] * fsigmoid(a[e]);
        const u32x4 packed = pack8(a);
        *(u32x4*)(xconv + (size_t)tok * 512 + c8) = packed;
        float ar[8]; unpack8(packed, ar);
        float gs[8];
#pragma unroll
        for (int gg = 0; gg < 8; ++gg) gs[gg] = 0.f;
#pragma unroll
        for (int e = 0; e < 8; ++e) {
            const f32x4 w1a = *(LAS f32x4*)(Wc + (c8 + e) * 8), w1b = *(LAS f32x4*)(Wc + (c8 + e) * 8 + 4);
            const f32x4 w2a = *(LAS f32x4*)(Wc + 4096 + (c8 + e) * 8), w2b = *(LAS f32x4*)(Wc + 4096 + (c8 + e) * 8 + 4);
#pragma unroll
            for (int gg = 0; gg < 4; ++gg) { gs[gg] += ar[e] * w1a[gg] + xraw[e] * w2a[gg]; gs[gg + 4] += ar[e] * w1b[gg] + xraw[e] * w2b[gg]; }
        }
        float mine = 0.f;
#pragma unroll
        for (int gg = 0; gg < 8; ++gg) { const float tsum = wave_sum(gs[gg]); if ((lane & 7) == gg) mine = tsum; }
        if (lane < 8) gates[(size_t)tok * 8 + lane] = mine + bif;
    }
}

__device__ __forceinline__ void ph_qkv(const Params& P, lds_t* lds) {
    const bf16_t* xconv = (const bf16_t*)(P.ws + WS_XCONV); const bf16_t* proj = (const bf16_t*)(P.ws + WS_PROJ); const bf16_t* Wt = (const bf16_t*)(P.ws + WS_WQKV);
    for (int tile = blockIdx.x; tile < 1536; tile += gridDim.x) {
        const int which = tile % 3, rt = (tile / 3) & 127, h = tile / 384;
        const bf16_t* A = which < 2 ? xconv : proj; const int lda = which < 2 ? 512 : 2560;
        bf16_t* out = (bf16_t*)(P.ws + (which == 0 ? WS_QB : (which == 1 ? WS_KB : WS_VB)));
        const float sc = which == 1 ? 0.08838834764831845f : 1.0f;
        const bf16_t* Wh = Wt + (size_t)(which * 4 + h) * 16384;
        e1_tile<true>(lds, 2,
            [=](int, int r, int kp) { return *(const u32x4*)(A + (size_t)(rt * 256 + r) * lda + h * 128 + kp * 8); },
            [=](int, int n, int kp) { return *(const u32x4*)(Wh + n * 128 + kp * 8); },
            [=](f32x4 (&acc)[4][4], int wr, int wc, int fr, int fq) {
#pragma unroll
                for (int m = 0; m < 4; ++m)
#pragma unroll
                    for (int n = 0; n < 4; ++n)
                        store_bf16x4(out + (size_t)(rt * 256 + wr * 64 + m * 16 + fr) * 512 + h * 128 + wc * 64 + n * 16 + fq * 4, acc[m][n] * sc);
            });
    }
}

constexpr int TP = 272;
template <int NROWS>
__device__ __forceinline__ void stage_tile(lds_t* dst, const bf16_t* src, size_t src_ld) {
    constexpr int NP = NROWS * 16 / NTHREADS;
    u32x4 r[NP];
#pragma unroll
    for (int i = 0; i < NP; ++i) { const int p = threadIdx.x + i * NTHREADS; r[i] = *(const u32x4*)(src + (size_t)(p >> 4) * src_ld + (p & 15) * 8); }
#pragma unroll
    for (int i = 0; i < NP; ++i) { const int p = threadIdx.x + i * NTHREADS; *(LAS u32x4*)(dst + (p >> 4) * TP + (p & 15) * 16) = r[i]; }
}

__device__ __forceinline__ void ph_m1(const Params& P, lds_t* lds) {
    const bf16_t* kb = (const bf16_t*)(P.ws + WS_KB); const bf16_t* vb = (const bf16_t*)(P.ws + WS_VB); const float* gates = (const float*)(P.ws + WS_GATES);
    float* kvc = (float*)(P.ws + WS_KVC); float* nchunk = (float*)(P.ws + WS_MISC); float* scal = nchunk + 2 * 2048 * 128;
    lds_t* Kt = lds; lds_t* Vt = lds + 64 * TP; LAS float* wv = (LAS float*)(lds + 128 * TP);
    const int tid = threadIdx.x, lane = tid & 63, w = tid >> 6, fr = lane & 15, fq = lane >> 4, q = (lane & 15) >> 2, p4 = lane & 3;
    for (int item = blockIdx.x; item < 2048; item += gridDim.x) {
        const int bh = item >> 6, n = item & 63, b = bh >> 2, h = bh & 3; const size_t tok0 = (size_t)b * SEQ + n * 64;
        stage_tile<64>(Kt, kb + tok0 * 512 + h * 128, 512);
        stage_tile<64>(Vt, vb + tok0 * 512 + h * 128, 512);
        if (w == 0) {
            const float f = gates[(tok0 + lane) * 8 + 4 + h], ig = gates[(tok0 + lane) * 8 + h];
            float cum = logsigmoidf(f);
#pragma unroll
            for (int off = 1; off < 64; off <<= 1) { const float t = __shfl_up(cum, off); if (lane >= off) cum += t; }
            const float cf = __shfl(cum, 63), te = cf - cum + ig, m = wave_max(te);
            wv[lane] = expf(te - m);
            if (lane == 0) { scal[item] = cf; scal[2048 + item] = m; }
        }
        __syncthreads();
        bf16x8 af[2]; float nsum = 0.f;
#pragma unroll
        for (int ks = 0; ks < 2; ++ks) {
            unsigned pk[4];
#pragma unroll
            for (int t = 0; t < 2; ++t) {
                const int s0 = 32 * ks + 8 * fq + 4 * t;
                const bf16x4 r = tr_read(Kt + (s0 + q) * TP + (16 * w + 4 * p4) * 2);
                const f32x4 ww = *(LAS f32x4*)(wv + s0);
                float x[4];
#pragma unroll
                for (int e = 0; e < 4; ++e) { x[e] = bf2f((unsigned short)r[e]) * ww[e]; nsum += x[e]; }
                pk[2 * t] = pk_bf16(x[0], x[1]); pk[2 * t + 1] = pk_bf16(x[2], x[3]);
            }
            u32x4 u = {pk[0], pk[1], pk[2], pk[3]}; af[ks] = __builtin_bit_cast(bf16x8, u);
        }
        nsum += __shfl_xor(nsum, 16); nsum += __shfl_xor(nsum, 32);
        if (fq == 0) nchunk[(size_t)item * 128 + 16 * w + fr] = nsum;
#pragma unroll
        for (int c = 0; c < 8; ++c) {
            f32x4 acc = {0.f, 0.f, 0.f, 0.f};
#pragma unroll
            for (int ks = 0; ks < 2; ++ks) {
                const int s0 = 32 * ks + 8 * fq;
                const bf16x8 bfv = cat44(tr_read(Vt + (s0 + q) * TP + (16 * c + 4 * p4) * 2), tr_read(Vt + (s0 + 4 + q) * TP + (16 * c + 4 * p4) * 2));
                acc = MFMA16(af[ks], bfv, acc);
            }
            *(f32x4*)(kvc + ((size_t)item * 128 + c * 16 + fr) * 128 + 16 * w + fq * 4) = acc;
        }
        __syncthreads();
    }
}

__device__ __forceinline__ void ph_m2(const Params& P) {
    const float* kvc = (const float*)(P.ws + WS_KVC); bf16_t* cprev = (bf16_t*)(P.ws + WS_CPREV);
    const float* nchunk = (const float*)(P.ws + WS_MISC); float* nprev = (float*)(P.ws + WS_MISC) + 2048 * 128; float* scal = (float*)(P.ws + WS_MISC) + 2 * 2048 * 128;
    const int tid = threadIdx.x;
    for (int it = blockIdx.x; it < 256; it += gridDim.x) {
        const int bh = it >> 3, sl = it & 7, idx = sl * 2048 + tid * 4;
        const bool donv = (sl == 0 && tid < 128);
        f32x4 C = {0.f, 0.f, 0.f, 0.f}; float nv = 0.f, m = -INFINITY;
        for (int n0 = 0; n0 < 64; n0 += 4) {
            f32x4 kv[4]; float nc[4], fc[4], mc[4];
#pragma unroll
            for (int j = 0; j < 4; ++j) {
                const int item = bh * 64 + n0 + j;
                kv[j] = *(const f32x4*)(kvc + (size_t)item * 16384 + idx);
                nc[j] = donv ? nchunk[(size_t)item * 128 + tid] : 0.f;
                fc[j] = scal[item]; mc[j] = scal[2048 + item];
            }
#pragma unroll
            for (int j = 0; j < 4; ++j) {
                const int item = bh * 64 + n0 + j;
                store_bf16x4(cprev + (size_t)item * 16384 + idx, C);
                if (donv) nprev[(size_t)item * 128 + tid] = nv;
                if (sl == 0 && tid == 0) scal[4096 + item] = m;
                const float mn = fmaxf(fc[j] + m, mc[j]), so = expf(fc[j] + m - mn), sn = expf(mc[j] - mn);
                C = C * so + kv[j] * sn; nv = so * nv + sn * nc[j]; m = mn;
            }
        }
    }
}

__device__ __forceinline__ void ph_m3(const Params& P, lds_t* lds) {
    const bf16_t* qb = (const bf16_t*)(P.ws + WS_QB); const bf16_t* kb = (const bf16_t*)(P.ws + WS_KB); const bf16_t* vb = (const bf16_t*)(P.ws + WS_VB);
    const bf16_t* cprev = (const bf16_t*)(P.ws + WS_CPREV); const float* gates = (const float*)(P.ws + WS_GATES);
    const float* nprev = (const float*)(P.ws + WS_MISC) + 2048 * 128; const float* scal = (const float*)(P.ws + WS_MISC) + 2 * 2048 * 128;
    const bf16_t* proj = (const bf16_t*)(P.ws + WS_PROJ); bf16_t* cat = (bf16_t*)(P.ws + WS_CAT);
    lds_t* Qt = lds; lds_t* Kt = lds + 64 * TP; lds_t* Vt = lds + 128 * TP; lds_t* Ct = lds + 192 * TP;
    LAS float* cumf = (LAS float*)(lds + 320 * TP); LAS float* gv = cumf + 64; LAS float* msv = gv + 64; LAS float* npv = msv + 64; LAS float* ex = npv + 128;
    const int tid = threadIdx.x, lane = tid & 63, w = tid >> 6, fr = lane & 15, fq = lane >> 4, q = (lane & 15) >> 2, p4 = lane & 3;
    const int rt = w & 3, vh = w >> 2;
    for (int item = blockIdx.x; item < 2048; item += gridDim.x) {
        const int bh = item >> 6, n = item & 63, b = bh >> 2, h = bh & 3; const size_t tok0 = (size_t)b * SEQ + n * 64;
        stage_tile<64>(Qt, qb + tok0 * 512 + h * 128, 512);
        stage_tile<64>(Kt, kb + tok0 * 512 + h * 128, 512);
        stage_tile<64>(Vt, vb + tok0 * 512 + h * 128, 512);
        stage_tile<128>(Ct, cprev + (size_t)item * 16384, 128);
        if (tid < 128) npv[tid] = nprev[(size_t)item * 128 + tid];
        const float mp = scal[4096 + item];
        if (w == 0) {
            const float f = gates[(tok0 + lane) * 8 + 4 + h], ig = gates[(tok0 + lane) * 8 + h];
            float cum = logsigmoidf(f);
#pragma unroll
            for (int off = 1; off < 64; off <<= 1) { const float t = __shfl_up(cum, off); if (lane >= off) cum += t; }
            const float gg = ig - cum; float pm = gg;
#pragma unroll
            for (int off = 1; off < 64; off <<= 1) { const float t = __shfl_up(pm, off); if (lane >= off) pm = fmaxf(pm, t); }
            cumf[lane] = cum; gv[lane] = gg; msv[lane] = cum + fmaxf(pm, mp);
        }
        __syncthreads();
        bf16x8 qf[4];
#pragma unroll
        for (int ks = 0; ks < 4; ++ks) qf[ks] = *(LAS bf16x8*)(Qt + (rt * 16 + fr) * TP + ks * 64 + fq * 16);
        const int s = rt * 16 + fr; const float cs = cumf[s], mss = msv[s];
        float sp[4][4]; float rowsum = 0.f;
#pragma unroll
        for (int jt = 0; jt < 4; ++jt) {
            f32x4 st = {0.f, 0.f, 0.f, 0.f};
            if (jt <= rt) {
#pragma unroll
                for (int ks = 0; ks < 4; ++ks) st = MFMA16(*(LAS bf16x8*)(Kt + (jt * 16 + fr) * TP + ks * 64 + fq * 16), qf[ks], st);
            }
            const f32x4 g4 = *(LAS f32x4*)(gv + jt * 16 + fq * 4);
#pragma unroll
            for (int r = 0; r < 4; ++r) { const int j = jt * 16 + fq * 4 + r; const float wgt = (j <= s) ? fexp(cs + g4[r] - mss) : 0.f; sp[jt][r] = st[r] * wgt; rowsum += sp[jt][r]; }
        }
        rowsum += __shfl_xor(rowsum, 16); rowsum += __shfl_xor(rowsum, 32);
        float qn = 0.f;
#pragma unroll
        for (int ks = 0; ks < 4; ++ks) {
            const f32x4 n0 = *(LAS f32x4*)(npv + ks * 32 + fq * 8), n1 = *(LAS f32x4*)(npv + ks * 32 + fq * 8 + 4);
#pragma unroll
            for (int e = 0; e < 4; ++e) { qn += bf2f((unsigned short)qf[ks][e]) * n0[e]; qn += bf2f((unsigned short)qf[ks][4 + e]) * n1[e]; }
        }
        qn += __shfl_xor(qn, 16); qn += __shfl_xor(qn, 32);
        const float inter = expf(cs + mp - mss), den = rowsum + inter * qn, inv = 1.0f / fmaxf(fabsf(den), expf(-mss));
        if (fq == 0) { ex[w * 32 + fr] = inv; ex[w * 32 + 16 + fr] = inter; }
        __builtin_amdgcn_wave_barrier();
        const f32x4 inv4 = *(LAS f32x4*)(ex + w * 32 + fq * 4), int4 = *(LAS f32x4*)(ex + w * 32 + 16 + fq * 4);
        bf16x8 pa[2];
#pragma unroll
        for (int kk = 0; kk < 2; ++kk) { u32x4 u = {pk_bf16(sp[2 * kk][0], sp[2 * kk][1]), pk_bf16(sp[2 * kk][2], sp[2 * kk][3]), pk_bf16(sp[2 * kk + 1][0], sp[2 * kk + 1][1]), pk_bf16(sp[2 * kk + 1][2], sp[2 * kk + 1][3])}; pa[kk] = __builtin_bit_cast(bf16x8, u); }
#pragma unroll
        for (int c = 0; c < 4; ++c) {
            const int vcol = vh * 64 + c * 16;
            f32x4 acc = {0.f, 0.f, 0.f, 0.f};
#pragma unroll
            for (int ks = 0; ks < 4; ++ks) acc = MFMA16(qf[ks], *(LAS bf16x8*)(Ct + (vcol + fr) * TP + ks * 64 + fq * 16), acc);
#pragma unroll
            for (int r = 0; r < 4; ++r) acc[r] *= int4[r];
#pragma unroll
            for (int kk = 0; kk < 2; ++kk) {
                const bf16x8 vbf = cat44(tr_read(Vt + (32 * kk + 4 * fq + q) * TP + (vcol + 4 * p4) * 2), tr_read(Vt + (32 * kk + 16 + 4 * fq + q) * TP + (vcol + 4 * p4) * 2));
                acc = MFMA16(pa[kk], vbf, acc);
            }
#pragma unroll
            for (int r = 0; r < 4; ++r) {
                const size_t tok = tok0 + rt * 16 + fq * 4 + r; const int col = h * 128 + vcol + fr;
                const float op = bf2f(proj[tok * 2560 + 512 + col]);
                cat[tok * 1024 + col] = (bf16_t)(pk_bf16(fsigmoid(op) * acc[r] * inv4[r], 0.f) & 0xffffu);
            }
        }
        __syncthreads();
    }
}

__device__ __forceinline__ void ph_attn(const Params& P, lds_t* lds) {
    const bf16_t* proj = (const bf16_t*)(P.ws + WS_PROJ); float* atto = (float*)(P.ws + WS_ATTO); float* lse = (float*)(P.ws + WS_LSE);
    lds_t* Kt = lds; lds_t* Vt = lds + 256 * TP; LAS float* ex = (LAS float*)(lds + 512 * TP);
    const int tid = threadIdx.x, lane = tid & 63, w = tid >> 6, fr = lane & 15, fq = lane >> 4, q = (lane & 15) >> 2, p4 = lane & 3;
    for (int item = blockIdx.x; item < 3072; item += gridDim.x) {
        const int g = item >> 10, rem = item & 1023, h = rem & 3, x = rem >> 2, b = x >> 5, y = x & 31;
        const int dsh = 2 * g, dil = 1 << dsh, nbsh = 5 - dsh, r = y >> nbsh, nb = y & ((1 << nbsh) - 1);
        const size_t tokb = (size_t)b * SEQ + r;
#pragma unroll
        for (int kvsel = 0; kvsel < 2; ++kvsel) {
            u32x4 rg[8];
#pragma unroll
            for (int it8 = 0; it8 < 8; ++it8) {
                const int p = tid + it8 * NTHREADS, kr = p >> 4, pc = p & 15; const int i = nb * 128 + kr - 128;
                rg[it8] = (u32x4){0u, 0u, 0u, 0u};
                if (i >= 0) rg[it8] = *(const u32x4*)(proj + (tokb + (size_t)i * dil) * 2560 + (kvsel ? 2048 : 1536) + h * 128 + pc * 8);
            }
#pragma unroll
            for (int it8 = 0; it8 < 8; ++it8) { const int p = tid + it8 * NTHREADS, kr = p >> 4, pc = p & 15; *(LAS u32x4*)((kvsel ? Vt : Kt) + kr * TP + pc * 16) = rg[it8]; }
        }
        const int qi = w * 16 + fr;
        const size_t tokq = tokb + (size_t)(nb * 128 + qi) * dil;
        bf16x8 qf[4];
#pragma unroll
        for (int ks = 0; ks < 4; ++ks) qf[ks] = __builtin_bit_cast(bf16x8, *(const u32x4*)(proj + tokq * 2560 + 1024 + h * 128 + ks * 32 + fq * 8));
        __syncthreads();
        float pv[9][4]; float mx = -INFINITY;
#pragma unroll
        for (int jj = 0; jj < 9; ++jj) {
            f32x4 st = {0.f, 0.f, 0.f, 0.f};
#pragma unroll
            for (int ks = 0; ks < 4; ++ks) st = MFMA16(*(LAS bf16x8*)(Kt + ((w + jj) * 16 + fr) * TP + ks * 64 + fq * 16), qf[ks], st);
#pragma unroll
            for (int rr = 0; rr < 4; ++rr) {
                const int kj = (w + jj) * 16 + fq * 4 + rr;
                const bool valid = (kj >= qi) && (kj <= qi + 128) && (nb > 0 || kj >= 128);
                pv[jj][rr] = valid ? st[rr] : -INFINITY; mx = fmaxf(mx, pv[jj][rr]);
            }
        }
        mx = fmaxf(mx, __shfl_xor(mx, 16)); mx = fmaxf(mx, __shfl_xor(mx, 32));
        float l = 0.f;
#pragma unroll
        for (int jj = 0; jj < 9; ++jj)
#pragma unroll
            for (int rr = 0; rr < 4; ++rr) { pv[jj][rr] = fexp(pv[jj][rr] - mx); l += pv[jj][rr]; }
        l += __shfl_xor(l, 16); l += __shfl_xor(l, 32);
        if (fq == 0) { ex[w * 16 + fr] = 1.0f / l; lse[((size_t)g * T + tokq) * 4 + h] = mx + logf(l); }
        __builtin_amdgcn_wave_barrier();
        const f32x4 inv4 = *(LAS f32x4*)(ex + w * 16 + fq * 4);
        f32x4 acc[8];
#pragma unroll
        for (int c = 0; c < 8; ++c) acc[c] = (f32x4){0.f, 0.f, 0.f, 0.f};
#pragma unroll
        for (int kk = 0; kk < 5; ++kk) {
            const int ja = 2 * kk, jb = (2 * kk + 1 < 9) ? 2 * kk + 1 : 2 * kk;
            u32x4 u; u.x = pk_bf16(pv[ja][0], pv[ja][1]); u.y = pk_bf16(pv[ja][2], pv[ja][3]);
            if (2 * kk + 1 < 9) { u.z = pk_bf16(pv[jb][0], pv[jb][1]); u.w = pk_bf16(pv[jb][2], pv[jb][3]); } else { u.z = 0u; u.w = 0u; }
            const bf16x8 pa = __builtin_bit_cast(bf16x8, u);
#pragma unroll
            for (int c = 0; c < 8; ++c) {
                const bf16x8 vbf = cat44(tr_read(Vt + ((w + ja) * 16 + 4 * fq + q) * TP + (c * 16 + 4 * p4) * 2), tr_read(Vt + ((w + jb) * 16 + 4 * fq + q) * TP + (c * 16 + 4 * p4) * 2));
                acc[c] = MFMA16(pa, vbf, acc[c]);
            }
        }
#pragma unroll
        for (int rr = 0; rr < 4; ++rr) {
            const size_t tq = tokb + (size_t)(nb * 128 + w * 16 + fq * 4 + rr) * dil;
#pragma unroll
            for (int c = 0; c < 8; ++c) atto[((size_t)g * T + tq) * 512 + h * 128 + c * 16 + fr] = acc[c][rr] * inv4[rr];
        }
        __syncthreads();
    }
}

__device__ __forceinline__ void ph_attn_combine(const Params& P) {
    const float* atto = (const float*)(P.ws + WS_ATTO); const float* lse = (const float*)(P.ws + WS_LSE); bf16_t* cat = (bf16_t*)(P.ws + WS_CAT);
    const size_t gtid = (size_t)blockIdx.x * NTHREADS + threadIdx.x, GT = (size_t)gridDim.x * NTHREADS;
    for (size_t i = gtid; i < (size_t)T * 128; i += GT) {
        const size_t tok = i >> 7; const int c4 = (int)(i & 127) * 4, h = c4 >> 7;
        const float l0 = lse[tok * 4 + h], l1 = lse[((size_t)T + tok) * 4 + h], l2 = lse[((size_t)2 * T + tok) * 4 + h];
        const float mx = fmaxf(l0, fmaxf(l1, l2)), e0 = expf(l0 - mx), e1 = expf(l1 - mx), e2 = expf(l2 - mx), inv = 1.0f / (e0 + e1 + e2);
        const f32x4 o = (*(const f32x4*)(atto + tok * 512 + c4) * e0 + *(const f32x4*)(atto + ((size_t)T + tok) * 512 + c4) * e1 + *(const f32x4*)(atto + ((size_t)2 * T + tok) * 512 + c4) * e2) * inv;
        store_bf16x4(cat + tok * 1024 + 512 + c4, o);
    }
}

constexpr int NPHASES = 33;
__device__ __forceinline__ void grid_barrier_cg(cg::grid_group& grid) {
    asm volatile("s_waitcnt vmcnt(0)" ::: "memory");
    grid.sync();
    __builtin_amdgcn_fence(__ATOMIC_ACQUIRE, "agent");
    asm volatile("s_waitcnt vmcnt(0)" ::: "memory");
}
#define XB_TMO      128
#define XB_XCNT(j)  (256  + 64 * (j))
#define XB_XSUB(j)  (1280 + 64 * (j))
#define XB_XGEN(j)  (2304 + 64 * (j))
#define XB_TOP      3328
#define XB_TOPGEN   3392
#define XCD_BAR_WORDS 3456
#define XB_SPIN_CAP (1u << 22)
__device__ __forceinline__ unsigned xb_ld(unsigned* p)              { return __hip_atomic_load(p, __ATOMIC_RELAXED, __HIP_MEMORY_SCOPE_AGENT); }
__device__ __forceinline__ unsigned xb_add(unsigned* p, unsigned v) { return __hip_atomic_fetch_add(p, v, __ATOMIC_RELAXED, __HIP_MEMORY_SCOPE_AGENT); }
__device__ __forceinline__ unsigned xb_xcc_id() { return (unsigned)__builtin_amdgcn_s_getreg((3 << 11) | 20) & 0xFu; }
#define XB_SPIN(cond, bar) do { unsigned _sp = 0; while (cond) { __builtin_amdgcn_s_sleep(1); \
    if ((++_sp & 255u) == 0u) { if (xb_ld(&(bar)[XB_TMO])) break; if (_sp > XB_SPIN_CAP) { atomicAdd(&(bar)[XB_TMO], 1u); break; } } } } while (0)
struct XcdBarrier { unsigned* bar; unsigned x; volatile LAS unsigned* st; };
__device__ __forceinline__ XcdBarrier xcd_barrier_post(unsigned* bar, volatile LAS unsigned* st) {
    XcdBarrier b; b.bar = bar; b.x = xb_xcc_id(); b.st = st;
    if (threadIdx.x == 0) (void)xb_add(&bar[XB_XCNT(b.x)], 1u);
    return b;
}
__device__ __forceinline__ void xcd_barrier_complete(unsigned* bar, unsigned x, unsigned& nloc, unsigned& nx) {
    const unsigned G = gridDim.x * gridDim.y * gridDim.z;
    unsigned sum, cnt, mine, sp = 0u;
    for (;;) {
        sum = 0u; cnt = 0u; mine = 0u;
#pragma unroll
        for (unsigned j = 0; j < 16; ++j) { const unsigned c = xb_ld(&bar[XB_XCNT(j)]); sum += c; cnt += (c > 0u) ? 1u : 0u; mine = (j == x) ? c : mine; }
        if (sum == G) break;
        __builtin_amdgcn_s_sleep(1);
        if ((++sp & 255u) == 0u) { if (xb_ld(&bar[XB_TMO])) break; if (sp > XB_SPIN_CAP) { atomicAdd(&bar[XB_TMO], 1u); break; } }
    }
    nloc = mine > 0u ? mine : 1u; nx = cnt > 0u ? cnt : 1u;
}
__device__ __forceinline__ void xcd_barrier(const XcdBarrier& b) {
    asm volatile("s_waitcnt vmcnt(0)" ::: "memory");
    __syncthreads();
    if (threadIdx.x == 0) {
        unsigned* bar = b.bar;
        __builtin_amdgcn_s_waitcnt(0);
        unsigned nloc = b.st[0], nx = b.st[1];
        if (nloc == 0u) { xcd_barrier_complete(bar, b.x, nloc, nx); b.st[0] = nloc; b.st[1] = nx; }
        const unsigned old = xb_add(&bar[XB_XSUB(b.x)], 1u);
        const unsigned gen = old / nloc;
        if (old + 1u == (gen + 1u) * nloc) {
            __builtin_amdgcn_fence(__ATOMIC_RELEASE, "agent");
            asm volatile("s_waitcnt vmcnt(0)" ::: "memory");
            const unsigned og = xb_add(&bar[XB_TOP], 1u);
            const unsigned tg = og / nx;
            if (og + 1u == (tg + 1u) * nx) xb_add(&bar[XB_TOPGEN], 1u);
            else XB_SPIN(xb_ld(&bar[XB_TOPGEN]) == tg, bar);
            __builtin_amdgcn_fence(__ATOMIC_ACQUIRE, "agent");
            xb_add(&bar[XB_XGEN(b.x)], 1u);
            asm volatile("s_waitcnt vmcnt(0)" ::: "memory");
        } else {
            XB_SPIN(xb_ld(&bar[XB_XGEN(b.x)]) == gen, bar);
            __builtin_amdgcn_fence(__ATOMIC_ACQUIRE, "agent");
            asm volatile("s_waitcnt vmcnt(0)" ::: "memory");
        }
    }
    __syncthreads();
}
typedef __attribute__((address_space(4))) const Params* KP4;
__device__ __forceinline__ const Params& phase_params() { KP4 kp = (KP4)__builtin_amdgcn_kernarg_segment_ptr(); asm volatile("" : "+s"(kp)); return *(const Params*)kp; }
__global__ void __launch_bounds__(NTHREADS) fwd_megakernel(Params Pk) {
    extern __shared__ __attribute__((aligned(16))) unsigned char lds_raw[];
    lds_t* lds = (lds_t*)lds_raw;
    cg::grid_group grid = cg::this_grid();
    const int ph_lo = Pk.ph_lo, ph_hi = Pk.ph_hi;
    unsigned* barw = (unsigned*)(Pk.ws + WS_CTL) + 4096;
    volatile LAS unsigned* bst = (volatile LAS unsigned*)(lds + LDS_BYTES - 64);
    if (threadIdx.x == 0) { bst[0] = 0u; bst[1] = 0u; }
    if (ph_hi < 0) grid_barrier_cg(grid);
    XcdBarrier xbar = xcd_barrier_post(barw, bst);
#define SEAM(k) xcd_barrier(xbar)
#ifdef ONLY_PHASE
#define PHASE(k, ...) if constexpr ((k) == ONLY_PHASE) { const Params& P = phase_params(); unsigned char* ws = P.ws; (void)ws; __VA_ARGS__; xcd_barrier(xbar); }
#else
#ifndef PHASE_MASK
#define PHASE_MASK 0xffffffffu
#endif
#ifndef REPEAT_MASK
#define REPEAT_MASK 0u
#endif
#define PHASE(k, ...) if (((PHASE_MASK >> (k)) & 1u) && ph_lo <= (k) && (k) < ph_hi) { const Params& P = phase_params(); unsigned char* ws = P.ws; (void)ws; \
    if constexpr (((REPEAT_MASK >> (k)) & 1u) != 0u) { __VA_ARGS__; SEAM(k); } \
    __VA_ARGS__; if ((k) + 1 < ph_hi) SEAM(k); }
#endif
    PHASE(0, phase0(P, lds))
    PHASE(1, ph_inproj2(P, lds, (const bf16_t*)(ws + WS_WABIN), 1536, nullptr))
    PHASE(2, ph_conv0(P); ph_s5_state(P, lds))
    PHASE(3, ph_gates0(P, lds); ph_s5_carry(P))
    PHASE(4, ph_lru_scan(P, lds); ph_s5_out(P, lds))
    PHASE(5, ph_glu(P, lds))
    PHASE(6, ph_outproj2(P, lds, (const bf16_t*)(ws + WS_WABOUT)))
#ifdef PROBE_LN7
    PHASE(7, ph_ln_router(P, lds, 0, P.in[I_X], 1); xcd_barrier(xbar); ph_ln_router(P, lds, 0, P.in[I_X]))
#else
    PHASE(7, ph_ln_router(P, lds, 0, P.in[I_X]))
#endif
    PHASE(8, ph_route_scatter(P, lds, 0))
    PHASE(9, ph_moe_up2(P, lds, 0))
    PHASE(10, ph_moe_down2(P, lds, 0))
#ifdef PROBE_LN11
    PHASE(11, ph_combine_ln(P, 0, (float*)(ws + WS_ZF), false); xcd_barrier(xbar); ph_combine_ln(P, 0, (float*)(ws + WS_X1F), true))
#else
    PHASE(11, ph_combine_ln(P, 0, (float*)(ws + WS_X1F), true))
#endif
    PHASE(12, ph_inproj2(P, lds, (const bf16_t*)(ws + WS_WCDIN), 2560, (const int*)P.in[I_POS]); convert_moe_weights(P, 1, lds))
    PHASE(13, ph_conv1(P, lds))
    PHASE(14, ph_qkv(P, lds))
    PHASE(15, ph_m1(P, lds))
    PHASE(16, ph_m2(P); ph_attn(P, lds))
    PHASE(17, ph_m3(P, lds); ph_attn_combine(P))
    PHASE(18, ph_outproj2(P, lds, (const bf16_t*)(ws + WS_WCDOUT)))
    PHASE(19, ph_ln_router(P, lds, 1, (const float*)(ws + WS_X1F)))
    PHASE(20, ph_route_scatter(P, lds, 1))
    PHASE(21, ph_moe_up2(P, lds, 1))
    PHASE(22, ph_moe_down2(P, lds, 1))
#ifdef EXTRA_BARRIERS
    for (int xb_ = 0; xb_ < EXTRA_BARRIERS; ++xb_) xcd_barrier(xbar);
#endif
    PHASE(23, ph_combine_ln(P, 1, P.out, false))
#undef PHASE
}

#ifndef MULTI_LAUNCH
#define MULTI_LAUNCH 0
#endif
extern "C" void kernel_launch(void* const* d_in, const int* in_sizes, int n_in, void* d_out, int out_size, void* d_ws, size_t ws_size, hipStream_t stream) {
    static int grid_blocks = 0;
    if (grid_blocks == 0) {
        if (n_in != N_IN || out_size != T * D || ws_size < WS_END) { fprintf(stderr, "kernel_launch: unexpected shapes (n_in %d out %d ws %zu need %zu)\n", n_in, out_size, ws_size, (size_t)WS_END); grid_blocks = -1; return; }
        int dev = 0, cus = 0, per_cu = 0;
        (void)hipGetDevice(&dev);
        (void)hipDeviceGetAttribute(&cus, hipDeviceAttributeMultiprocessorCount, dev);
        if (hipFuncSetAttribute((const void*)fwd_megakernel, hipFuncAttributeMaxDynamicSharedMemorySize, LDS_BYTES) != hipSuccess) { fprintf(stderr, "kernel_launch: hipFuncSetAttribute failed\n"); grid_blocks = -1; return; }
        (void)hipOccupancyMaxActiveBlocksPerMultiprocessor(&per_cu, (const void*)fwd_megakernel, NTHREADS, LDS_BYTES);
        if (per_cu < 1) { fprintf(stderr, "kernel_launch: occupancy query returned %d\n", per_cu); grid_blocks = -1; return; }
        grid_blocks = cus * per_cu;
    }
    if (grid_blocks < 0) return;
    (void)hipMemsetAsync((unsigned char*)d_ws + WS_CTL, 0, 65536, stream);
    Params p{};
    for (int i = 0; i < N_IN; ++i) p.in[i] = (const float*)d_in[i];
    p.out = (float*)d_out; p.ws = (unsigned char*)d_ws;
#if MULTI_LAUNCH
    for (int k = 0; k < 24; ++k) { p.ph_lo = k; p.ph_hi = k + 1; hipLaunchKernelGGL(fwd_megakernel, dim3(grid_blocks), dim3(NTHREADS), LDS_BYTES, stream, p); }
#else
    p.ph_lo = 0; p.ph_hi = 24;
    void* args[] = {&p};
    hipError_t e = hipLaunchCooperativeKernel((const void*)fwd_megakernel, dim3(grid_blocks), dim3(NTHREADS), args, LDS_BYTES, stream);
    if (e != hipSuccess) fprintf(stderr, "cooperative launch failed: %s (grid %d)\n", hipGetErrorString(e), grid_blocks);
#endif
}
```

```cpp
#include <hip/hip_runtime.h>
#include <hip/hip_cooperative_groups.h>
#include <cstdio>
#include <cstdint>
namespace cg = cooperative_groups;

#define LAS __attribute__((address_space(3)))
typedef unsigned short bf16_t;
typedef short bf16x8 __attribute__((ext_vector_type(8)));
typedef short bf16x4 __attribute__((ext_vector_type(4)));
typedef float f32x4 __attribute__((ext_vector_type(4)));
typedef unsigned u32x4 __attribute__((ext_vector_type(4)));
typedef unsigned u32x2 __attribute__((ext_vector_type(2)));
typedef LAS unsigned char lds_t;

constexpr int T = 32768, D = 1024, SEQ = 4096;
constexpr int NTHREADS = 512;
constexpr int LDS_BYTES = 160 * 1024;
constexpr int PS_OFF = LDS_BYTES - 1024;
constexpr int MTAB_OFF = 128 * 1024;
constexpr float ALPHA = 1.4142135623730951f;
constexpr float LN_EPS = 1e-5f;
constexpr int MOE_ROWS = 139264;
constexpr int S5TC = 32;
constexpr int S5K = S5TC * 16 + 128;

enum { I_X = 0, I_POS, I_AB_WIN, I_AB_CONVW, I_AB_CONVB, I_AB_GRW, I_AB_GRB, I_AB_GIW, I_AB_GIB, I_AB_LAMBDA,
       I_S5_LRE, I_S5_LIM, I_S5_STEP, I_S5_BRE, I_S5_BIM, I_S5_CRE, I_S5_CIM, I_S5_D, I_AB_GLUW, I_AB_GLUB, I_AB_WOUT,
       I_CD_WIN, I_CD_CONVW, I_CD_CONVB, I_CD_WQ, I_CD_WK, I_CD_WV, I_CD_WIF, I_CD_BIF, I_CD_WOUT,
       I_LNM_G, I_LNM_B, I_LNF_G, I_LNF_B, I_R_W, I_R_B, I_M_WIN, I_M_BIN, I_M_WOUT, I_M_BOUT, N_IN };

constexpr size_t MiB = 1ull << 20;
constexpr size_t WS_CTL = 0;
constexpr size_t WS_XB = 1 * MiB;
constexpr size_t WS_WABIN = 65 * MiB;
constexpr size_t WS_WGLU = 68 * MiB;
constexpr size_t WS_WABOUT = 69 * MiB;
constexpr size_t WS_WCDIN = 71 * MiB;
constexpr size_t WS_WCDOUT = 76 * MiB;
constexpr size_t WS_WG = 78 * MiB;
constexpr size_t WS_WQKV = 78 * MiB + 256 * 1024;
constexpr size_t WS_WC = 79 * MiB;
constexpr size_t WS_S5TM = 80 * MiB;
constexpr size_t WS_S5WST = 100 * MiB;
constexpr size_t WS_MWIN = 104 * MiB;
constexpr size_t WS_MWOUT = 232 * MiB;
constexpr size_t WS_PROJ = 296 * MiB;
constexpr size_t WS_CAT = 456 * MiB;
constexpr size_t WS_X1F = 520 * MiB;
constexpr size_t WS_ZF = 648 * MiB;
constexpr size_t WS_HACT = 776 * MiB;
constexpr size_t WS_YB = 1048 * MiB;
constexpr size_t WS_ROUTE = 1320 * MiB;
constexpr size_t WS_SCR = 1328 * MiB;
constexpr size_t WS_XC = WS_SCR;
constexpr size_t WS_AF = WS_SCR + 32 * MiB;
constexpr size_t WS_UF = WS_SCR + 96 * MiB;
constexpr size_t WS_SB = WS_SCR + 160 * MiB;
constexpr size_t WS_S5S = WS_SCR + 192 * MiB;
constexpr size_t WS_S5X = WS_SCR + 208 * MiB;
constexpr size_t WS_XCONV = WS_SCR;
constexpr size_t WS_QB = WS_SCR + 32 * MiB;
constexpr size_t WS_KB = WS_SCR + 64 * MiB;
constexpr size_t WS_VB = WS_SCR + 96 * MiB;
constexpr size_t WS_GATES = WS_SCR + 128 * MiB;
constexpr size_t WS_KVC = WS_SCR + 130 * MiB;
constexpr size_t WS_CPREV = WS_SCR + 258 * MiB;
constexpr size_t WS_MISC = WS_SCR + 322 * MiB;
constexpr size_t WS_ATTO = WS_SCR + 326 * MiB;
constexpr size_t WS_LSE = WS_SCR + 518 * MiB;
constexpr size_t WS_MW1 = WS_SCR + 520 * MiB;
constexpr size_t WS_END = WS_MW1 + 192 * MiB;

struct Params { const float* in[N_IN]; float* out; unsigned char* ws; int ph_lo, ph_hi; };

__device__ __forceinline__ float bf2f(unsigned short b) { return __uint_as_float(((unsigned)b) << 16); }
typedef __bf16 bf16v2_t __attribute__((ext_vector_type(2)));
typedef float f32x2 __attribute__((ext_vector_type(2)));
__device__ __forceinline__ unsigned pk_bf16(float lo, float hi) { const f32x2 v = {lo, hi}; return __builtin_bit_cast(unsigned, __builtin_convertvector(v, bf16v2_t)); }
__device__ __forceinline__ float wave_sum(float v) {
#pragma unroll
    for (int o = 1; o < 64; o <<= 1) v += __shfl_xor(v, o);
    return v;
}
__device__ __forceinline__ float wave_max(float v) {
#pragma unroll
    for (int o = 1; o < 64; o <<= 1) v = fmaxf(v, __shfl_xor(v, o));
    return v;
}
__device__ __forceinline__ float fsigmoid(float x) { return __builtin_amdgcn_rcpf(1.0f + __builtin_amdgcn_exp2f(-1.4426950408889634f * x)); }
__device__ __forceinline__ float fexp(float x) { return __builtin_amdgcn_exp2f(1.4426950408889634f * x); }
__device__ __forceinline__ float flog(float x) { return 0.6931471805599453f * __builtin_amdgcn_logf(x); }
__device__ __forceinline__ void fsincos(float x, float& sn, float& cs) {
    const float n = rintf(x * 0.15915494309189535f);
    float r = fmaf(-n, 6.28125f, x); r = fmaf(-n, 0.0019353071795864769f, r);
    const float rev = r * 0.15915494309189535f;
    sn = __builtin_amdgcn_sinf(rev); cs = __builtin_amdgcn_cosf(rev);
}
__device__ __forceinline__ float gelu_tanh(float x) { return x * fsigmoid(1.5957691216057308f * (x + 0.044715f * x * x * x)); }
__device__ __forceinline__ float logsigmoidf(float x) { return fminf(x, 0.f) - log1pf(expf(-fabsf(x))); }
__device__ __forceinline__ void unpack8(u32x4 v, float (&f)[8]) {
    f[0] = __uint_as_float(v.x << 16); f[1] = __uint_as_float(v.x & 0xffff0000u);
    f[2] = __uint_as_float(v.y << 16); f[3] = __uint_as_float(v.y & 0xffff0000u);
    f[4] = __uint_as_float(v.z << 16); f[5] = __uint_as_float(v.z & 0xffff0000u);
    f[6] = __uint_as_float(v.w << 16); f[7] = __uint_as_float(v.w & 0xffff0000u);
}
__device__ __forceinline__ u32x4 pack8(const float (&f)[8]) { u32x4 o; o.x = pk_bf16(f[0], f[1]); o.y = pk_bf16(f[2], f[3]); o.z = pk_bf16(f[4], f[5]); o.w = pk_bf16(f[6], f[7]); return o; }
__device__ __forceinline__ bf16x4 tr_read(lds_t* p) { return __builtin_amdgcn_ds_read_tr16_b64_v4i16((LAS bf16x4*)p); }
__device__ __forceinline__ bf16x8 cat44(bf16x4 a, bf16x4 b) { bf16x8 r = {a[0], a[1], a[2], a[3], b[0], b[1], b[2], b[3]}; return r; }
#define MFMA16(a, b, c) __builtin_amdgcn_mfma_f32_16x16x32_bf16((a), (b), (c), 0, 0, 0)
typedef int i32x8 __attribute__((ext_vector_type(8)));
__device__ __forceinline__ f32x4 mfma_fp8(i32x8 a, i32x8 b, f32x4 c) { return __builtin_amdgcn_mfma_scale_f32_16x16x128_f8f6f4(a, b, c, 0, 0, 0, 0x7f7f7f7f, 0, 0x7f7f7f7f); }
typedef int i32x4 __attribute__((ext_vector_type(4)));
__device__ __forceinline__ i32x8 ld_frag8(lds_t* p) { const i32x4 lo = *(const LAS i32x4*)p, hi = *(const LAS i32x4*)(p + 1024); return __builtin_shufflevector(lo, hi, 0, 1, 2, 3, 4, 5, 6, 7); }
__device__ __forceinline__ unsigned pk_fp8x4(f32x4 v) {
    unsigned w = 0;
    w = __builtin_amdgcn_cvt_pk_fp8_f32(fminf(fmaxf(v[0], -448.f), 448.f), fminf(fmaxf(v[1], -448.f), 448.f), w, false);
    w = __builtin_amdgcn_cvt_pk_fp8_f32(fminf(fmaxf(v[2], -448.f), 448.f), fminf(fmaxf(v[3], -448.f), 448.f), w, true);
    return w;
}
constexpr float FP8_SX = 4.0f, FP8_SWIN = 32.0f, FP8_SH = 8.0f, FP8_SWOUT = 64.0f;

constexpr int E1_PITCH = 144;
constexpr int E1_A = 256 * E1_PITCH;
constexpr int E1_B = 128 * E1_PITCH;
constexpr int E1_BUF = E1_A + E1_B;

template <bool TRANS, class NK, class AL, class BL, class EP>
__device__ __forceinline__ void e1_stream(lds_t* lds, int ntiles, NK nkf, AL aload, BL bload, EP epi) {
    if (ntiles <= 0) return;
    const int tid = threadIdx.x, lane = tid & 63, wave = tid >> 6, wr = wave >> 1, wc = wave & 1, fr = lane & 15, fq = lane >> 4;
    const int prow = tid >> 3, pc = tid & 7;
    f32x4 acc[4][4];
#pragma unroll
    for (int m = 0; m < 4; ++m)
#pragma unroll
        for (int n = 0; n < 4; ++n) acc[m][n] = (f32x4){0.f, 0.f, 0.f, 0.f};
    u32x4 ra0[4], rb0[2], ra1[4], rb1[2];
#define E1S_LOAD(RA, RB, J, TT) do { _Pragma("unroll") for (int i = 0; i < 4; ++i) RA[i] = aload((J), i, prow + 64 * i, (TT) * 8 + pc); \
        _Pragma("unroll") for (int i = 0; i < 2; ++i) RB[i] = bload((J), i, prow + 64 * i, (TT) * 8 + pc); } while (0)
#define E1S_WRITE(RA, RB, BUF) do { lds_t* nb_ = lds + (BUF) * E1_BUF; \
        _Pragma("unroll") for (int i = 0; i < 4; ++i) *(LAS u32x4*)(nb_ + (prow + 64 * i) * E1_PITCH + pc * 16) = RA[i]; \
        _Pragma("unroll") for (int i = 0; i < 2; ++i) *(LAS u32x4*)(nb_ + E1_A + (prow + 64 * i) * E1_PITCH + pc * 16) = RB[i]; } while (0)
#define E1S_ADV(J, TT, V) do { if ((TT) + 1 < nkf(J)) { ++(TT); } else { ++(J); (TT) = 0; } (V) = (J) < ntiles; } while (0)
#define E1S_COMPUTE(BUF) do { lds_t* Ab = lds + (BUF) * E1_BUF + (wr * 64 + fr) * E1_PITCH + fq * 16; lds_t* Bb = lds + (BUF) * E1_BUF + E1_A + (wc * 64 + fr) * E1_PITCH + fq * 16; \
        _Pragma("unroll") for (int kk = 0; kk < 2; ++kk) { bf16x8 af[4], bfr[4]; \
            _Pragma("unroll") for (int m = 0; m < 4; ++m) af[m] = *(LAS bf16x8*)(Ab + m * 16 * E1_PITCH + kk * 64); \
            _Pragma("unroll") for (int n = 0; n < 4; ++n) bfr[n] = *(LAS bf16x8*)(Bb + n * 16 * E1_PITCH + kk * 64); \
            _Pragma("unroll") for (int m = 0; m < 4; ++m) _Pragma("unroll") for (int n = 0; n < 4; ++n) acc[m][n] = TRANS ? MFMA16(bfr[n], af[m], acc[m][n]) : MFMA16(af[m], bfr[n], acc[m][n]); } \
        if (t0 + 1 == nkf(j0)) { epi(j0, acc, wr, wc, fr, fq); \
            _Pragma("unroll") for (int m = 0; m < 4; ++m) _Pragma("unroll") for (int n = 0; n < 4; ++n) acc[m][n] = (f32x4){0.f, 0.f, 0.f, 0.f}; } } while (0)
    int j0 = 0, t0 = 0, j1 = 0, t1 = 0, j2, t2; bool v1, v2;
    E1S_ADV(j1, t1, v1); j2 = j1; t2 = t1; v2 = v1; if (v1) E1S_ADV(j2, t2, v2);
    E1S_LOAD(ra0, rb0, 0, 0);
    if (v1) E1S_LOAD(ra1, rb1, j1, t1);
    E1S_WRITE(ra0, rb0, 0);
    __syncthreads();
    int cb = 0;
    for (;;) {
        if (v2) E1S_LOAD(ra0, rb0, j2, t2);
        E1S_COMPUTE(cb);
        if (v1) E1S_WRITE(ra1, rb1, cb ^ 1);
        __syncthreads();
        if (!v1) break;
        j0 = j1; t0 = t1; j1 = j2; t1 = t2; v1 = v2; if (v2) E1S_ADV(j2, t2, v2); cb ^= 1;
        if (v2) E1S_LOAD(ra1, rb1, j2, t2);
        E1S_COMPUTE(cb);
        if (v1) E1S_WRITE(ra0, rb0, cb ^ 1);
        __syncthreads();
        if (!v1) break;
        j0 = j1; t0 = t1; j1 = j2; t1 = t2; v1 = v2; if (v2) E1S_ADV(j2, t2, v2); cb ^= 1;
    }
#undef E1S_LOAD
#undef E1S_WRITE
#undef E1S_ADV
#undef E1S_COMPUTE
}
__device__ __forceinline__ int wg_tiles(int total) { const int b = (int)blockIdx.x, G = (int)gridDim.x; return b < total ? (total - b + G - 1) / G : 0; }

namespace g2 {
constexpr int HTB = 16384;
__device__ __forceinline__ int lds_byte(int r, int c) { const int st = (r >> 4) * 2 + (c >> 5), rr = r & 15, cc = c & 31, ob = rr * 64 + cc * 2; return st * 1024 + (ob ^ (((ob >> 9) & 1) << 5)); }
__device__ __forceinline__ void stage_rc(int b, int& R, int& C) { const int st = b / 1024, sb = b % 1024, swz = sb ^ (((sb >> 9) & 1) << 5); R = (st >> 1) * 16 + swz / 64; C = (st & 1) * 32 + (swz % 64) / 2; }
struct Unit { int pm, pn, idx; };
__device__ __forceinline__ bool static_next(int i, int G, int c, int nM, int nN, Unit& u) {
    const int nwg = nM * nN; const long L = (long)i * G + c; if (L >= nwg) return false;
    int wgid = (int)L; { const int q = nwg / 8, r = nwg % 8, xcd = wgid % 8, off = wgid / 8; wgid = (xcd < r ? xcd * (q + 1) : r * (q + 1) + (xcd - r) * q) + off; }
    const int nig = 8 * nN, gid = wgid / nig, fm = gid * 8, gsz = (nM - fm) < 8 ? (nM - fm) : 8;
    u.pm = fm + ((wgid % nig) % gsz); u.pn = (wgid % nig) / gsz; u.idx = i; return true;
}
template <bool FP8, class Sched, class Epi>
__device__ __forceinline__ void gemm_phase(lds_t* lds, const char* Abase, int nt  , unsigned ldb_bytes, const Sched& S, const Epi& E) {
    const int tid = threadIdx.x, wid = __builtin_amdgcn_readfirstlane(tid >> 6), lane = tid & 63, wr = wid >> 2, wc = wid & 3, fr = lane & 15, fq = lane >> 4;
    unsigned voffB0; { int R0, C0; stage_rc(tid * 16, R0, C0); voffB0 = (unsigned)R0 * ldb_bytes + (unsigned)C0 * 2u; }
    const size_t hstepB = (size_t)128 * ldb_bytes;
    const unsigned ldsw = (unsigned)wid * 1024u;
    const int aoff = lds_byte(wr * 64 + fr, fq * 8), boff = lds_byte(wc * 32 + fr, fq * 8);
#define G2_SA(b, h) (((b) * 2 + (h)) * g2::HTB)
#define G2_SB(b, h) ((4 + (b) * 2 + (h)) * g2::HTB)
#define G2_STAGE_A(bufoff, offs, kb) do { _Pragma("unroll") for (int _i = 0; _i < 2; ++_i) \
        __builtin_amdgcn_global_load_lds((const unsigned*)((Abase + (kb)) + (offs)[_i]), (LAS unsigned*)(lds + (bufoff) + ldsw + _i * 8192), 16, 0, 0); } while (0)
#define G2_STAGE_B(bufoff, gbase) do { _Pragma("unroll") for (int _i = 0; _i < 2; ++_i) \
        __builtin_amdgcn_global_load_lds((const unsigned*)(((const char*)(gbase) + (size_t)_i * 64 * ldb_bytes) + voffB0), (LAS unsigned*)(lds + (bufoff) + ldsw + _i * 8192), 16, 0, 0); } while (0)
#define G2_LDA(dst, b, h) do { _Pragma("unroll") for (int m = 0; m < 4; ++m) { if constexpr (FP8) { if (m < 2) dst##8[m] = ld_frag8(lds + G2_SA(b, h) + aoff + m * 2048); } \
        else { _Pragma("unroll") for (int k = 0; k < 2; ++k) dst[m][k] = *(const LAS bf16x8*)(lds + G2_SA(b, h) + aoff + m * 2048 + k * 1024); } } } while (0)
#define G2_LDB(dst, b, h) do { _Pragma("unroll") for (int n = 0; n < 2; ++n) { if constexpr (FP8) dst##8[n] = ld_frag8(lds + G2_SB(b, h) + boff + n * 2048); \
        else { _Pragma("unroll") for (int k = 0; k < 2; ++k) dst[n][k] = *(const LAS bf16x8*)(lds + G2_SB(b, h) + boff + n * 2048 + k * 1024); } } } while (0)
#define G2_MMA(ai, bj, At, Bt) do { __builtin_amdgcn_s_setprio(1); _Pragma("unroll") for (int m = 0; m < 4; ++m) _Pragma("unroll") for (int n = 0; n < 2; ++n) { \
        if constexpr (FP8) acc[ai][bj][m][n] = mfma_fp8(Bt##8[n], At##8[m], acc[ai][bj][m][n]); \
        else { _Pragma("unroll") for (int k = 0; k < 2; ++k) acc[ai][bj][m][n] = __builtin_amdgcn_mfma_f32_16x16x32_bf16(Bt[n][k], At[m][k], acc[ai][bj][m][n], 0, 0, 0); } } \
        __builtin_amdgcn_s_setprio(0); } while (0)
#define G2_MMAP(ai, b, h) do { if constexpr (!FP8) { G2_MMA(ai, 0, At, B0); G2_MMA(ai, 1, At, B1); } else { __builtin_amdgcn_s_setprio(1); \
        _Pragma("unroll") for (int m = 0; m < 2; ++m) _Pragma("unroll") for (int n = 0; n < 2; ++n) { acc[ai][0][m][n] = mfma_fp8(B08[n], At8[m], acc[ai][0][m][n]); acc[ai][1][m][n] = mfma_fp8(B18[n], At8[m], acc[ai][1][m][n]); } \
        At8[0] = ld_frag8(lds + G2_SA(b, h) + aoff + 2 * 2048); At8[1] = ld_frag8(lds + G2_SA(b, h) + aoff + 3 * 2048); \
        _Pragma("unroll") for (int m = 0; m < 2; ++m) _Pragma("unroll") for (int n = 0; n < 2; ++n) { acc[ai][0][m + 2][n] = mfma_fp8(B08[n], At8[m], acc[ai][0][m + 2][n]); acc[ai][1][m + 2][n] = mfma_fp8(B18[n], At8[m], acc[ai][1][m + 2][n]); } \
        __builtin_amdgcn_s_setprio(0); } } while (0)
#define G2_WAIT_V(n) asm volatile("s_waitcnt vmcnt(" #n ")" ::: "memory")
#define G2_WAIT_L(n) asm volatile("s_waitcnt lgkmcnt(" #n ")" ::: "memory")
#define G2_BAR __builtin_amdgcn_s_barrier()
#define G2_SCHED __builtin_amdgcn_sched_barrier(0)
#define G2_SCHED8 do { if constexpr (FP8) __builtin_amdgcn_sched_barrier(0); } while (0)
    Unit cur, nxt; int ui = 0;
    if (!S.next(0, cur)) return;
    f32x4 acc[2][2][4][2];
#pragma unroll
    for (int a = 0; a < 2; ++a)
#pragma unroll
        for (int b = 0; b < 2; ++b)
#pragma unroll
            for (int m = 0; m < 4; ++m)
#pragma unroll
                for (int n = 0; n < 2; ++n) acc[a][b][m][n] = (f32x4){0.f, 0.f, 0.f, 0.f};
    bf16x8 At[4][2], B0[2][2], B1[2][2]; i32x8 At8[2], B08[2], B18[2];
    unsigned aoC[2][2], aoN[2][2];
    S.a_off(cur, aoC);
    const char* cB = S.b_base(cur);
    G2_STAGE_B(G2_SB(0, 0), cB); G2_STAGE_B(G2_SB(0, 1), cB + hstepB); G2_STAGE_A(G2_SA(0, 0), aoC[0], 0); G2_STAGE_A(G2_SA(0, 1), aoC[1], 0);
    if (wr == 1) G2_BAR;
    G2_WAIT_V(2); G2_BAR;
    G2_STAGE_B(G2_SB(1, 0), cB + 128); G2_STAGE_A(G2_SA(1, 0), aoC[0], 128); G2_STAGE_B(G2_SB(1, 1), cB + hstepB + 128);
    G2_WAIT_V(6); G2_BAR;
    for (;;) {
        const bool has_next = S.next(ui + 1, nxt);
        const char* nB = cB;
        if constexpr (!Sched::CHEAP_AOFF) {
#pragma unroll
            for (int h = 0; h < 2; ++h)
#pragma unroll
                for (int i = 0; i < 2; ++i) aoN[h][i] = aoC[h][i];
            if (has_next) S.a_off(nxt, aoN);
        }
        if (has_next) nB = S.b_base(nxt);
#pragma unroll 1
        for (int t = 0; t < nt; t += 2) {
            const bool last = (t == nt - 2);
            const unsigned k1 = (unsigned)(t + 1) * 128u, k2 = last ? 0u : (unsigned)(t + 2) * 128u, k3 = k2 + 128u;
            unsigned a2o[2][2];
#pragma unroll
            for (int h = 0; h < 2; ++h)
#pragma unroll
                for (int i = 0; i < 2; ++i) a2o[h][i] = (!Sched::CHEAP_AOFF && last) ? aoN[h][i] : aoC[h][i];
            if constexpr (Sched::CHEAP_AOFF) { if (last && has_next) S.a_off(nxt, a2o); }
            const char* b2 = last ? nB : cB + (size_t)(t + 2) * 128; const char* b3 = b2 + 128;
            G2_LDB(B0, 0, 0); G2_LDB(B1, 0, 1); G2_SCHED; G2_LDA(At, 0, 0); G2_STAGE_A(G2_SA(1, 1), aoC[1], k1);
            G2_WAIT_V(8); G2_WAIT_L(0); G2_BAR; G2_MMAP(0, 0, 0); G2_BAR; G2_SCHED;
            G2_LDA(At, 0, 1); G2_STAGE_B(G2_SB(0, 0), b2); G2_STAGE_B(G2_SB(0, 1), b2 + hstepB); G2_STAGE_A(G2_SA(0, 0), a2o[0], k2);
            G2_WAIT_V(8); G2_WAIT_L(0); G2_BAR; G2_MMAP(1, 0, 1); G2_BAR; G2_SCHED;
            G2_LDB(B0, 1, 0); G2_LDB(B1, 1, 1); G2_SCHED; G2_LDA(At, 1, 0); G2_STAGE_A(G2_SA(0, 1), a2o[1], k2);
            G2_WAIT_V(8); G2_WAIT_L(0); G2_BAR; G2_MMAP(0, 1, 0); G2_BAR; G2_SCHED;
            G2_LDA(At, 1, 1); G2_STAGE_B(G2_SB(1, 0), b3); G2_STAGE_B(G2_SB(1, 1), b3 + hstepB); G2_STAGE_A(G2_SA(1, 0), a2o[0], k3);
            G2_WAIT_V(8); G2_WAIT_L(0); G2_BAR; G2_MMAP(1, 1, 1); G2_BAR; G2_SCHED;
        }
        if (wr == 0) G2_BAR;
        { int lane_e = (int)(threadIdx.x & 63); asm volatile("" : "+v"(lane_e));
          E(acc, cur, wr, wc, lane_e & 15, lane_e >> 4); }
        if (!has_next) break;
#pragma unroll
        for (int a = 0; a < 2; ++a)
#pragma unroll
            for (int b = 0; b < 2; ++b)
#pragma unroll
                for (int m = 0; m < 4; ++m)
#pragma unroll
                    for (int n = 0; n < 2; ++n) acc[a][b][m][n] = (f32x4){0.f, 0.f, 0.f, 0.f};
        cur = nxt; cB = nB; ++ui;
        if constexpr (Sched::CHEAP_AOFF) S.a_off(cur, aoC);
        else {
#pragma unroll
            for (int h = 0; h < 2; ++h)
#pragma unroll
                for (int i = 0; i < 2; ++i) aoC[h][i] = aoN[h][i];
        }
        if (wr == 1) G2_BAR;
    }
    G2_WAIT_V(0);
    G2_BAR;
#undef G2_SA
#undef G2_SB
#undef G2_STAGE_A
#undef G2_STAGE_B
#undef G2_LDA
#undef G2_LDB
#undef G2_MMA
#undef G2_MMAP
#undef G2_WAIT_V
#undef G2_WAIT_L
#undef G2_BAR
#undef G2_SCHED
#undef G2_SCHED8
}
struct DenseSched {
    static constexpr bool CHEAP_AOFF = false;
    int G, c, nM, nN, K; const char* Bt;
    __device__ __forceinline__ bool next(int i, Unit& u) const { return static_next(i, G, c, nM, nN, u); }
    __device__ __forceinline__ void a_off(const Unit& u, unsigned (&ao)[2][2]) const {
        int Rs[2], Cs[2];
#pragma unroll
        for (int i = 0; i < 2; ++i) stage_rc((int)threadIdx.x * 16 + i * 8192, Rs[i], Cs[i]);
#pragma unroll
        for (int h = 0; h < 2; ++h)
#pragma unroll
            for (int i = 0; i < 2; ++i) ao[h][i] = ((unsigned)(u.pm * 256 + h * 128 + Rs[i]) * (unsigned)K + (unsigned)Cs[i]) * 2u;
    }
    __device__ __forceinline__ const char* b_base(const Unit& u) const { return Bt + (size_t)u.pn * 256 * K * 2; }
};
}

template <class RM>
__device__ __forceinline__ void transpose_item(const float* __restrict__ W, int N, bf16_t* __restrict__ WT, int ldwt, int k0, int n0, RM rowmap, LAS float* scr, int lane) {
#pragma unroll 16
    for (int i = 0; i < 64; ++i) scr[i * 65 + lane] = W[(size_t)(k0 + i) * N + n0 + lane];
    __builtin_amdgcn_wave_barrier();
    const int c = lane & 7;
#pragma unroll
    for (int j = 0; j < 8; ++j) {
        const int n = (lane >> 3) + 8 * j;
        const LAS float* s = scr + (8 * c) * 65 + n;
        u32x4 o; o.x = pk_bf16(s[0], s[65]); o.y = pk_bf16(s[2 * 65], s[3 * 65]); o.z = pk_bf16(s[4 * 65], s[5 * 65]); o.w = pk_bf16(s[6 * 65], s[7 * 65]);
        *(u32x4*)(WT + (size_t)rowmap(n0 + n) * ldwt + k0 + 8 * c) = o;
    }
    __builtin_amdgcn_wave_barrier();
}
template <class RM>
__device__ __forceinline__ void transpose_item_fp8(const float* __restrict__ W, int N, unsigned char* __restrict__ WT, int ldwt, int k0, int n0, RM rowmap, float scale, LAS float* scr, int lane) {
#pragma unroll 16
    for (int i = 0; i < 64; ++i) scr[i * 65 + lane] = W[(size_t)(k0 + i) * N + n0 + lane];
    __builtin_amdgcn_wave_barrier();
    const int c = lane & 7;
#pragma unroll
    for (int j = 0; j < 8; ++j) {
        const int n = (lane >> 3) + 8 * j;
        const LAS float* sp = scr + (8 * c) * 65 + n;
        u32x2 o; o.x = pk_fp8x4((f32x4){sp[0], sp[65], sp[2 * 65], sp[3 * 65]} * scale); o.y = pk_fp8x4((f32x4){sp[4 * 65], sp[5 * 65], sp[6 * 65], sp[7 * 65]} * scale);
        *(u32x2*)(WT + (size_t)rowmap(n0 + n) * ldwt + k0 + 8 * c) = o;
    }
    __builtin_amdgcn_wave_barrier();
}
struct RmId { __device__ __forceinline__ int operator()(int n) const { return n; } };
struct RmMoeIn { __device__ __forceinline__ int operator()(int n) const { const int half = n >> 10, j = n & 1023; return (j >> 7) * 256 + half * 128 + (j & 127); } };
struct RmGate { int gate; __device__ __forceinline__ int operator()(int j) const { return (j >> 5) * 64 + gate * 32 + (j & 31); } };

template <class RM>
__device__ __forceinline__ void transpose_matrix(const float* W, int K, int N, bf16_t* WT, int ldwt, RM rm, LAS float* scr, int gw, int NGW, int lane, int first_wave) {
    const int nkb = K / 64, nnb = N / 64;
    int it = gw - first_wave; if (it < 0) it += NGW;
    for (; it < nkb * nnb; it += NGW) transpose_item(W, N, WT, ldwt, (it / nnb) * 64, (it % nnb) * 64, rm, scr, lane);
}

constexpr int CONV_ITEMS = 24576, TAIL_QUOTA = 48;
__device__ __forceinline__ void convert_item(const Params& P, int layer, int r, LAS float* scr, int lane) {
    unsigned char* dst = P.ws + (layer ? WS_MW1 : WS_MWIN);
    if (r < 16384) {
        const int e = r >> 9, rr = r & 511, kb = rr >> 5, nb = rr & 31;
        transpose_item_fp8(P.in[I_M_WIN] + ((size_t)layer * 32 + e) * 1024 * 2048, 2048, dst + (size_t)e * 2048 * 1024, 1024, kb * 64, nb * 64, RmMoeIn(), FP8_SWIN, scr, lane);
    } else {
        const int r2 = r - 16384, e = r2 >> 8, rr = r2 & 255, kb = rr >> 4, nb = rr & 15;
        transpose_item_fp8(P.in[I_M_WOUT] + ((size_t)layer * 32 + e) * 1024 * 1024, 1024, dst + (size_t)32 * 2048 * 1024 + (size_t)e * 1024 * 1024, 1024, kb * 64, nb * 64, RmId(), FP8_SWOUT, scr, lane);
    }
}
__device__ __forceinline__ void convert_range_wg(const Params& P, int layer, int first, int count, lds_t* lds) {
    const int lane = threadIdx.x & 63, wave = threadIdx.x >> 6;
    LAS float* scr = (LAS float*)(lds + wave * 16640);
    const int end = (first + count < CONV_ITEMS) ? first + count : CONV_ITEMS;
    for (int r = first + wave; r < end; r += 8) convert_item(P, layer, r, scr, lane);
}
__device__ __forceinline__ void convert_moe_weights(const Params& P, int layer, int first, lds_t* lds, int skip_wgs = 0) {
    if ((int)blockIdx.x < skip_wgs) return;
    const int lane = threadIdx.x & 63, wave = threadIdx.x >> 6, gw = ((int)blockIdx.x - skip_wgs) * 8 + wave, NGW = ((int)gridDim.x - skip_wgs) * 8;
    LAS float* scr = (LAS float*)(lds + wave * 16640);
    for (int r = first + gw; r < CONV_ITEMS; r += NGW) convert_item(P, layer, r, scr, lane);
}
__device__ __forceinline__ int tail_idle(int nunits, int G) { const int r = nunits % G; return r ? G - r : 0; }
__device__ __forceinline__ int tail_done_up(int nM, int G) { const int d = tail_idle(nM * 8, G) * TAIL_QUOTA; return d < CONV_ITEMS ? d : CONV_ITEMS; }
__device__ __forceinline__ int tail_done_all(int nM, int G) { const int d = tail_done_up(nM, G) + tail_idle(nM * 4, G) * TAIL_QUOTA; return d < CONV_ITEMS ? d : CONV_ITEMS; }

__device__ __forceinline__ void s5_precompute(const Params& P, int g, lds_t* lds) {
    const int tid = threadIdx.x;
    LAS float* Bbr = (LAS float*)lds;
    LAS float* Bbi = Bbr + 1024;
    LAS float* Cr = Bbi + 1024;
    LAS float* Ci = Cr + 1024;
    LAS float* ApR = Ci + 1024;
    LAS float* ApI = ApR + 33 * 64;
    LAS float* KJ = ApI + 33 * 64;
    const float* lre = P.in[I_S5_LRE] + g * 64; const float* lim = P.in[I_S5_LIM] + g * 64;
    const float step = expf(P.in[I_S5_STEP][g]);
    for (int idx = tid; idx < 1024; idx += NTHREADS) {
        const int p = idx >> 4;
        const float lr = fminf(lre[p], -1e-4f), li = lim[p];
        const float mag = expf(lr * step); float sn, cs; sincosf(li * step, &sn, &cs);
        const float ar = mag * cs, ai = mag * sn, inv = 1.0f / (lr * lr + li * li);
        const float zr = ((ar - 1.0f) * lr + ai * li) * inv, zi = (ai * lr - (ar - 1.0f) * li) * inv;
        const float br = P.in[I_S5_BRE][g * 1024 + idx], bi = P.in[I_S5_BIM][g * 1024 + idx];
        Bbr[idx] = zr * br - zi * bi; Bbi[idx] = zr * bi + zi * br;
        Cr[idx] = P.in[I_S5_CRE][g * 1024 + idx]; Ci[idx] = P.in[I_S5_CIM][g * 1024 + idx];
    }
    for (int idx = tid; idx < 33 * 64; idx += NTHREADS) {
        const int j = idx >> 6, p = idx & 63;
        const float lr = fminf(lre[p], -1e-4f), li = lim[p];
        const float mag = fexp((float)j * lr * step); float sn, cs; fsincos((float)j * li * step, sn, cs);
        ApR[idx] = mag * cs; ApI[idx] = mag * sn;
    }
    __syncthreads();
    {
        const int h = (tid >> 4) & 15, h2 = tid & 15, jh = tid >> 8;
        float gr[64], gi[64];
#pragma unroll
        for (int p = 0; p < 64; ++p) { const float cr = Cr[h * 64 + p], ci = Ci[h * 64 + p], br = Bbr[p * 16 + h2], bi = Bbi[p * 16 + h2]; gr[p] = cr * br - ci * bi; gi[p] = cr * bi + ci * br; }
        for (int j = jh * 16; j < jh * 16 + 16; ++j) {
            float s0 = 0.f, s1 = 0.f;
#pragma unroll
            for (int p = 0; p < 64; p += 2) { s0 += gr[p] * ApR[j * 64 + p] - gi[p] * ApI[j * 64 + p]; s1 += gr[p + 1] * ApR[j * 64 + p + 1] - gi[p + 1] * ApI[j * 64 + p + 1]; }
            float sres = s0 + s1;
            if (j == 0 && h == h2) sres += P.in[I_S5_D][g * 16 + h];
            KJ[(j * 16 + h) * 16 + h2] = sres;
        }
    }
    __syncthreads();
    bf16_t* Tm = (bf16_t*)(P.ws + WS_S5TM) + (size_t)g * 512 * S5K;
    for (int pi = tid; pi < 512 * (S5K / 8); pi += NTHREADS) {
        const int row = pi / (S5K / 8), c8 = (pi % (S5K / 8)) * 8, t = row >> 4, h = row & 15;
        float v[8];
#pragma unroll
        for (int e = 0; e < 8; ++e) {
            const int col = c8 + e;
            if (col < 512) { const int s = col >> 4, h2 = col & 15; v[e] = (s <= t) ? KJ[((t - s) * 16 + h) * 16 + h2] : 0.f; }
            else { const int p = (col - 512) & 63, im = (col - 512) >> 6;
                const float cr = Cr[h * 64 + p], ci = Ci[h * 64 + p], ar = ApR[(t + 1) * 64 + p], ai = ApI[(t + 1) * 64 + p];
                v[e] = im ? -(cr * ai + ci * ar) : (cr * ar - ci * ai); }
        }
        *(u32x4*)(Tm + (size_t)row * S5K + c8) = pack8(v);
    }
    bf16_t* Wst = (bf16_t*)(P.ws + WS_S5WST) + (size_t)g * 128 * 512;
    for (int pi = tid; pi < 128 * 64; pi += NTHREADS) {
        const int row = pi >> 6, c8 = (pi & 63) * 8, p = row & 63, im = row >> 6;
        float v[8];
#pragma unroll
        for (int e = 0; e < 8; ++e) {
            const int col = c8 + e, s = col >> 4, h2 = col & 15;
            const float ar = ApR[(S5TC - 1 - s) * 64 + p], ai = ApI[(S5TC - 1 - s) * 64 + p], br = Bbr[p * 16 + h2], bi = Bbi[p * 16 + h2];
            v[e] = im ? (ar * bi + ai * br) : (ar * br - ai * bi);
        }
        *(u32x4*)(Wst + (size_t)row * 512 + c8) = pack8(v);
    }
    __syncthreads();
}

__device__ __forceinline__ void phase0(const Params& P, lds_t* lds) {
    const int tid = threadIdx.x, lane = tid & 63, wave = tid >> 6, gw = blockIdx.x * 8 + wave, NGW = gridDim.x * 8;
    const size_t gtid = (size_t)blockIdx.x * NTHREADS + tid, GT = (size_t)gridDim.x * NTHREADS;
    unsigned char* ws = P.ws;
#ifdef PROBE_BLK
#define P0_STAMP(k) do { if ((int)blockIdx.x == PROBE_BLK && tid == 0 && (k) == PROBE_PT) *(unsigned long long*)(ws + WS_CTL + 60000) = __builtin_amdgcn_s_memrealtime(); } while (0)
#else
#define P0_STAMP(k)
#endif
    P0_STAMP(0);
    for (int g = blockIdx.x; g < 32; g += gridDim.x) s5_precompute(P, g, lds);
    P0_STAMP(1);
    {
        const f32x4* x4 = (const f32x4*)P.in[I_X]; u32x4* xb = (u32x4*)(ws + WS_XB);
        for (size_t i0 = gtid; i0 < (size_t)T * D / 8; i0 += 4 * GT) {
            f32x4 a[4], b[4];
#pragma unroll
            for (int j = 0; j < 4; ++j) { const size_t i = i0 + j * GT; a[j] = x4[2 * i]; b[j] = x4[2 * i + 1]; }
#pragma unroll
            for (int j = 0; j < 4; ++j) { u32x4 o; o.x = pk_bf16(a[j].x, a[j].y); o.y = pk_bf16(a[j].z, a[j].w); o.z = pk_bf16(b[j].x, b[j].y); o.w = pk_bf16(b[j].z, b[j].w); xb[i0 + j * GT] = o; }
        }
    }
    P0_STAMP(2);
    {
        float* Wc = (float*)(ws + WS_WC);
        for (int idx = gw; idx < 8192; idx += NGW) {
            const int which = idx >> 12, i = (idx >> 3) & 511, gg = idx & 7, h = i >> 7, ii = i & 127;
            const float* wif = P.in[I_CD_WIF];
            float sacc = 0.f;
#pragma unroll
            for (int jj = 0; jj < 2; ++jj) {
                const int j = lane + 64 * jj;
                if (which == 0) sacc += P.in[I_CD_WQ][(size_t)(h * 128 + ii) * 128 + j] * wif[(h * 128 + j) * 8 + gg] + 0.08838834764831845f * P.in[I_CD_WK][(size_t)(h * 128 + ii) * 128 + j] * wif[(512 + h * 128 + j) * 8 + gg];
                else sacc += P.in[I_CD_WV][(size_t)(h * 128 + ii) * 128 + j] * wif[(1024 + h * 128 + j) * 8 + gg];
            }
            sacc = wave_sum(sacc);
            if (lane == 0) Wc[idx] = sacc;
        }
    }
    P0_STAMP(3);
    LAS float* scr = (LAS float*)(lds + wave * 16640);
    transpose_matrix(P.in[I_AB_WIN], 1024, 1536, (bf16_t*)(ws + WS_WABIN), 1024, RmId(), scr, gw, NGW, lane, 256);
    transpose_matrix(P.in[I_AB_GLUW], 512, 512, (bf16_t*)(ws + WS_WGLU), 512, RmId(), scr, gw, NGW, lane, 256 + 384);
    transpose_matrix(P.in[I_AB_WOUT], 1024, 1024, (bf16_t*)(ws + WS_WABOUT), 1024, RmId(), scr, gw, NGW, lane, 256 + 448);
    transpose_matrix(P.in[I_CD_WIN], 1024, 2560, (bf16_t*)(ws + WS_WCDIN), 1024, RmId(), scr, gw, NGW, lane, 256 + 704);
    transpose_matrix(P.in[I_CD_WOUT], 1024, 1024, (bf16_t*)(ws + WS_WCDOUT), 1024, RmId(), scr, gw, NGW, lane, 256 + 1344);
    { int it = gw - (256 + 1600); if (it < 0) it += NGW;
      for (; it < 16; it += NGW) {
        const int gate = it >> 3, h = it & 7;
        transpose_item(P.in[gate ? I_AB_GIW : I_AB_GRW] + h * 4096, 64, (bf16_t*)(ws + WS_WG) + h * 8192, 64, 0, 0, RmGate{gate}, scr, lane);
      } }
    { int it = gw - (256 + 1616); if (it < 0) it += NGW;
      for (; it < 48; it += NGW) {
        const int which = it >> 4, h = (it >> 2) & 3, kb = (it >> 1) & 1, nb = it & 1;
        transpose_item(P.in[I_CD_WQ + which] + h * 16384, 128, (bf16_t*)(ws + WS_WQKV) + (which * 4 + h) * 16384, 128, kb * 64, nb * 64, RmId(), scr, lane);
      } }
    P0_STAMP(4);
    convert_moe_weights(P, 0, 0, lds, (int)gridDim.x > 64 ? 32 : 0);
    P0_STAMP(5);
}

__device__ __forceinline__ void store_bf16x4(bf16_t* p, f32x4 v) { u32x2 o; o.x = pk_bf16(v[0], v[1]); o.y = pk_bf16(v[2], v[3]); *(u32x2*)p = o; }

__device__ __forceinline__ void ph_conv0(const Params& P) {
    const bf16_t* proj = (const bf16_t*)(P.ws + WS_PROJ); bf16_t* xc = (bf16_t*)(P.ws + WS_XC);
    const int lane = threadIdx.x & 63, gw = blockIdx.x * 8 + (threadIdx.x >> 6), NGW = gridDim.x * 8, c8 = lane * 8;
    float w[4][8], bias[8];
#pragma unroll
    for (int e = 0; e < 8; ++e) { bias[e] = P.in[I_AB_CONVB][c8 + e];
#pragma unroll
        for (int k = 0; k < 4; ++k) w[k][e] = P.in[I_AB_CONVW][k * 512 + c8 + e]; }
    for (int run = gw; run < T / 16; run += NGW) {
        const int tok0 = run * 16, p0 = tok0 & (SEQ - 1);
        u32x4 r[19];
#pragma unroll
        for (int i = 0; i < 19; ++i) { r[i] = (u32x4){0u, 0u, 0u, 0u}; if (p0 + i - 3 >= 0) r[i] = *(const u32x4*)(proj + (size_t)(tok0 + i - 3) * 1536 + c8); }
#pragma unroll
        for (int t = 0; t < 16; ++t) {
            float a[8];
#pragma unroll
            for (int e = 0; e < 8; ++e) a[e] = bias[e];
#pragma unroll
            for (int k = 0; k < 4; ++k) { float xv[8]; unpack8(r[t + k], xv);
#pragma unroll
                for (int e = 0; e < 8; ++e) a[e] += w[k][e] * xv[e]; }
            *(u32x4*)(xc + (size_t)(tok0 + t) * 512 + c8) = pack8(a);
        }
    }
}

__device__ __forceinline__ void ph_gates0(const Params& P, lds_t* lds) {
    const bf16_t* xc = (const bf16_t*)(P.ws + WS_XC); const bf16_t* Wg = (const bf16_t*)(P.ws + WS_WG);
    unsigned* lau = (unsigned*)(P.ws + WS_AF);
    const float* br = P.in[I_AB_GRB]; const float* bi = P.in[I_AB_GIB]; const float* lam = P.in[I_AB_LAMBDA];
    const int b0 = (int)blockIdx.x, G = (int)gridDim.x;
    {
        e1_stream<true>(lds, wg_tiles(1024), [](int) { return 1; },
            [=](int j, int, int r, int kp) { const int tile = b0 + j * G, h = tile & 7, rt = tile >> 3; return *(const u32x4*)(xc + (size_t)(rt * 256 + r) * 512 + h * 64 + kp * 8); },
            [=](int j, int, int n, int kp) { const int h = (b0 + j * G) & 7; return *(const u32x4*)(Wg + (size_t)h * 8192 + n * 64 + kp * 8); },
            [=](int j, f32x4 (&acc)[4][4], int wr, int wc, int fr, int fq) {
                const int tile = b0 + j * G, h = tile & 7, rt = tile >> 3;
#pragma unroll
                for (int n = 0; n < 2; ++n) {
                    const int ch = h * 64 + wc * 32 + n * 16 + fq * 4;
                    float sp[4], brv[4], biv[4];
#pragma unroll
                    for (int c = 0; c < 4; ++c) { const float l = -lam[ch + c]; sp[c] = fmaxf(l, 0.f) + flog(1.0f + fexp(-fabsf(l))); brv[c] = br[ch + c]; biv[c] = bi[ch + c]; }
#pragma unroll
                    for (int m = 0; m < 4; ++m) {
                        const size_t row = (size_t)(rt * 256 + wr * 64 + m * 16 + fr);
                        const u32x2 xr = *(const u32x2*)(xc + row * 512 + ch);
                        const float xv[4] = {__uint_as_float(xr.x << 16), __uint_as_float(xr.x & 0xffff0000u), __uint_as_float(xr.y << 16), __uint_as_float(xr.y & 0xffff0000u)};
                        f32x4 a4, u4;
#pragma unroll
                        for (int c = 0; c < 4; ++c) {
                            const float r = fsigmoid(acc[m][n][c] + brv[c]), ig = fsigmoid(acc[m][n + 2][c] + biv[c]);
                            const float la = -8.0f * r * sp[c], x2 = 2.0f * la;
                            const float om = (x2 > -0.01f) ? -x2 * (1.0f + 0.5f * x2 * (1.0f + x2 * (1.0f / 3.0f))) : 1.0f - fexp(x2);
                            a4[c] = la; u4[c] = sqrtf(om) * ig * xv[c];
                        }
                        { u32x4 o; o.x = pk_bf16(a4[0], u4[0]); o.y = pk_bf16(a4[1], u4[1]); o.z = pk_bf16(a4[2], u4[2]); o.w = pk_bf16(a4[3], u4[3]); *(u32x4*)(lau + row * 512 + ch) = o; }
                    }
                }
            });
    }
}

__device__ __forceinline__ void ph_lru_scan(const Params& P, lds_t* lds) {
    const unsigned* lau = (const unsigned*)(P.ws + WS_AF);
    const bf16_t* proj = (const bf16_t*)(P.ws + WS_PROJ); bf16_t* cat = (bf16_t*)(P.ws + WS_CAT);
    LAS float* lA = (LAS float*)lds; LAS float* lH = lA + 512;
    const int tid = threadIdx.x, seg = tid >> 4, c = tid & 15;
    for (int item = blockIdx.x; item < 256; item += gridDim.x) {
        const int b = item >> 5, ch = (item & 31) * 16 + c;
        const size_t base = (size_t)b * SEQ + seg * 128;
        float H = 0.f, sla = 0.f;
#pragma unroll 1
        for (int i0 = 0; i0 < 128; i0 += 64) {
            unsigned r[64];
#pragma unroll
            for (int j = 0; j < 64; ++j) r[j] = lau[(base + i0 + j) * 512 + ch];
#pragma unroll
            for (int j = 0; j < 64; ++j) { const float la = __uint_as_float(r[j] << 16), u = __uint_as_float(r[j] & 0xffff0000u); H = fexp(la) * H + u; sla += la; }
        }
        lA[tid] = fexp(sla); lH[tid] = H;
        __syncthreads();
        float carry = 0.f;
        for (int s2 = 0; s2 < seg; ++s2) carry = lA[s2 * 16 + c] * carry + lH[s2 * 16 + c];
        H = carry;
#pragma unroll 1
        for (int i0 = 0; i0 < 128; i0 += 32) {
            unsigned r[32]; unsigned short ga[32];
#pragma unroll
            for (int j = 0; j < 32; ++j) { r[j] = lau[(base + i0 + j) * 512 + ch]; ga[j] = proj[(base + i0 + j) * 1536 + 512 + ch]; }
#pragma unroll
            for (int j = 0; j < 32; ++j) {
                const float la = __uint_as_float(r[j] << 16), u = __uint_as_float(r[j] & 0xffff0000u); H = fexp(la) * H + u;
                cat[(base + i0 + j) * 1024 + ch] = (bf16_t)(pk_bf16(H * gelu_tanh(bf2f(ga[j])), 0.f) & 0xffffu);
            }
        }
        __syncthreads();
    }
}

__device__ __forceinline__ void ph_s5_state(const Params& P, lds_t* lds) {
    const bf16_t* proj = (const bf16_t*)(P.ws + WS_PROJ); const bf16_t* Wst = (const bf16_t*)(P.ws + WS_S5WST); float* S = (float*)(P.ws + WS_S5S);
    const int b0 = (int)blockIdx.x, G = (int)gridDim.x;
    {
        e1_stream<true>(lds, wg_tiles(128), [](int) { return 8; },
            [=](int j, int, int r, int kp) { const int tile = b0 + j * G, g = tile & 31, rt = tile >> 5; return *(const u32x4*)(proj + (size_t)((rt * 256 + r) * 32 + (kp >> 1)) * 1536 + 1024 + g * 16 + (kp & 1) * 8); },
            [=](int j, int, int n, int kp) { const int g = (b0 + j * G) & 31; return *(const u32x4*)(Wst + (size_t)g * 65536 + n * 512 + kp * 8); },
            [=](int j, f32x4 (&acc)[4][4], int wr, int wc, int fr, int fq) {
                const int tile = b0 + j * G, g = tile & 31, rt = tile >> 5;
#pragma unroll
                for (int m = 0; m < 4; ++m)
#pragma unroll
                    for (int n = 0; n < 4; ++n) *(f32x4*)(S + ((size_t)(rt * 256 + wr * 64 + m * 16 + fr) * 32 + g) * 128 + wc * 64 + n * 16 + fq * 4) = acc[m][n];
            });
    }
}

__device__ __forceinline__ void ph_s5_carry(const Params& P) {
    const float* S = (const float*)(P.ws + WS_S5S); bf16_t* X = (bf16_t*)(P.ws + WS_S5X);
    if (threadIdx.x >= 64) return;
    const int p = threadIdx.x;
    for (int it = blockIdx.x; it < 256; it += gridDim.x) {
        const int b = it >> 5, g = it & 31;
        const float lr = fminf(P.in[I_S5_LRE][g * 64 + p], -1e-4f), li = P.in[I_S5_LIM][g * 64 + p], step = expf(P.in[I_S5_STEP][g]);
        const float mag = expf((float)S5TC * lr * step); float sn, cs; sincosf((float)S5TC * li * step, &sn, &cs);
        const float cr = mag * cs, ci = mag * sn;
        float xr = 0.f, xi = 0.f;
        for (int c0 = 0; c0 < 128; c0 += 16) {
            float sr[16], si[16];
#pragma unroll
            for (int j = 0; j < 16; ++j) { const size_t o = ((size_t)(b * 128 + c0 + j) * 32 + g) * 128; sr[j] = S[o + p]; si[j] = S[o + 64 + p]; }
#pragma unroll
            for (int j = 0; j < 16; ++j) {
                const size_t o = ((size_t)(b * 128 + c0 + j) * 32 + g) * 128;
                X[o + p] = (bf16_t)(pk_bf16(xr, 0.f) & 0xffffu); X[o + 64 + p] = (bf16_t)(pk_bf16(xi, 0.f) & 0xffffu);
                const float nr = cr * xr - ci * xi + sr[j], ni = cr * xi + ci * xr + si[j];
                xr = nr; xi = ni;
            }
        }
    }
}

__device__ __forceinline__ void ph_s5_out(const Params& P, lds_t* lds) {
    const bf16_t* proj = (const bf16_t*)(P.ws + WS_PROJ); const bf16_t* Tm = (const bf16_t*)(P.ws + WS_S5TM); const bf16_t* X = (const bf16_t*)(P.ws + WS_S5X);
    bf16_t* sb = (bf16_t*)(P.ws + WS_SB);
    const int b0 = (int)blockIdx.x, G = (int)gridDim.x;
#define S5O_DECODE(J) const int tile = b0 + (J) * G, ct = (tile < 256) ? (tile & 3) : 3 - (tile & 3), g = (tile >> 2) & 31, rt = tile >> 7, nkl = 2 * ct + 2; (void)g; (void)rt;
    {
        e1_stream<true>(lds, wg_tiles(512), [=](int j) { S5O_DECODE(j) return nkl + 2; },
            [=](int j, int, int r, int kp0) {
                S5O_DECODE(j)
                const int kp = kp0 < nkl * 8 ? kp0 : kp0 - nkl * 8 + 64;
                if (kp < 64) return *(const u32x4*)(proj + (size_t)((rt * 256 + r) * 32 + (kp >> 1)) * 1536 + 1024 + g * 16 + (kp & 1) * 8);
                return *(const u32x4*)(X + ((size_t)(rt * 256 + r) * 32 + g) * 128 + (kp - 64) * 8); },
            [=](int j, int, int n, int kp0) { S5O_DECODE(j) const int kp = kp0 < nkl * 8 ? kp0 : kp0 - nkl * 8 + 64; return *(const u32x4*)(Tm + (size_t)g * 512 * S5K + (size_t)(ct * 128 + n) * S5K + kp * 8); },
            [=](int j, f32x4 (&acc)[4][4], int wr, int wc, int fr, int fq) {
                S5O_DECODE(j)
#pragma unroll
                for (int m = 0; m < 4; ++m)
#pragma unroll
                    for (int n = 0; n < 4; ++n) {
                        const int col = ct * 128 + wc * 64 + n * 16 + fq * 4, t = col >> 4, h0 = col & 15;
                        const size_t tok = (size_t)(rt * 256 + wr * 64 + m * 16 + fr) * 32 + t;
                        f32x4 y = acc[m][n];
#pragma unroll
                        for (int c = 0; c < 4; ++c) y[c] = gelu_tanh(y[c]);
                        store_bf16x4(sb + tok * 512 + g * 16 + h0, y);
                    }
            });
    }
}

#undef S5O_DECODE
__device__ __forceinline__ void ph_glu(const Params& P, lds_t* lds) {
    const bf16_t* sb = (const bf16_t*)(P.ws + WS_SB); const bf16_t* Wt = (const bf16_t*)(P.ws + WS_WGLU); bf16_t* cat = (bf16_t*)(P.ws + WS_CAT);
    const float* gb = P.in[I_AB_GLUB];
    const int b0 = (int)blockIdx.x, G = (int)gridDim.x;
    {
        e1_stream<true>(lds, wg_tiles(512), [](int) { return 8; },
            [=](int j, int, int r, int kp) { const int rt = (b0 + j * G) >> 2; return *(const u32x4*)(sb + (size_t)(rt * 256 + r) * 512 + kp * 8); },
            [=](int j, int, int n, int kp) { const int ct = (b0 + j * G) & 3; return *(const u32x4*)(Wt + (size_t)(ct * 128 + n) * 512 + kp * 8); },
            [=](int j, f32x4 (&acc)[4][4], int wr, int wc, int fr, int fq) {
                const int tile = b0 + j * G, rt = tile >> 2, ct = tile & 3;
#pragma unroll
                for (int n = 0; n < 4; ++n) {
                    const int col = ct * 128 + wc * 64 + n * 16 + fq * 4;
                    const f32x4 bv = *(const f32x4*)(gb + col);
#pragma unroll
                    for (int m = 0; m < 4; ++m) {
                        const size_t row = (size_t)(rt * 256 + wr * 64 + m * 16 + fr);
                        const u32x2 sr = *(const u32x2*)(sb + row * 512 + col);
                        const float sv[4] = {__uint_as_float(sr.x << 16), __uint_as_float(sr.x & 0xffff0000u), __uint_as_float(sr.y << 16), __uint_as_float(sr.y & 0xffff0000u)};
                        f32x4 y;
#pragma unroll
                        for (int c = 0; c < 4; ++c) y[c] = sv[c] * fsigmoid(acc[m][n][c] + bv[c]);
                        store_bf16x4(cat + row * 1024 + 512 + col, y);
                    }
                }
            });
    }
}

__device__ __forceinline__ void ph_ln_router(const Params& P, lds_t* lds, int layer, const float* xres  , int dummy = 0) {
    const bf16_t* mixb = (const bf16_t*)(P.ws + WS_ZF); bf16_t* xb = (bf16_t*)(P.ws + WS_XB); unsigned* xb8 = (unsigned*)(P.ws + WS_X1F);
    const float* lg = P.in[I_LNM_G] + layer * 1024; const float* lb = P.in[I_LNM_B] + layer * 1024;
    const float* rw = P.in[I_R_W] + (size_t)layer * 1024 * 32; const float* rbias = P.in[I_R_B] + layer * 32;
    int* gcount = (int*)(P.ws + WS_CTL) + 64 * layer + 32 * dummy;
    int* pair_e = (int*)(P.ws + WS_ROUTE); int* pair_rank = pair_e + T * 4; float* pair_gate = (float*)(pair_rank + T * 4);
    constexpr int XP = 2064;
    lds_t* Xh = lds; lds_t* Xl = lds + 16 * XP;
    LAS float* part = (LAS float*)(lds + 32 * XP);
    LAS int* hist = (LAS int*)(lds + 32 * XP + 16384); LAS int* basev = hist + 32; LAS int* pinfo = basev + 32;
    const int tid = threadIdx.x, lane = tid & 63, wave = tid >> 6, fr = lane & 15, fq = lane >> 4;
    bf16x8 wh[4][2], wl[4][2];
#pragma unroll
    for (int ks = 0; ks < 4; ++ks)
#pragma unroll
        for (int nt = 0; nt < 2; ++nt) {
            unsigned ph[4], pl[4];
#pragma unroll
            for (int j2 = 0; j2 < 4; ++j2) {
                const int k = wave * 128 + ks * 32 + fq * 8 + 2 * j2;
                const float w0 = rw[(size_t)k * 32 + nt * 16 + fr], w1 = rw[(size_t)(k + 1) * 32 + nt * 16 + fr];
                ph[j2] = pk_bf16(w0, w1);
                pl[j2] = pk_bf16(w0 - __uint_as_float(ph[j2] << 16), w1 - __uint_as_float(ph[j2] & 0xffff0000u));
            }
            const u32x4 uh = {ph[0], ph[1], ph[2], ph[3]}, ul = {pl[0], pl[1], pl[2], pl[3]};
            wh[ks][nt] = __builtin_bit_cast(bf16x8, uh); wl[ks][nt] = __builtin_bit_cast(bf16x8, ul);
        }
    const float myrb = rbias[lane & 31];
    for (int it = blockIdx.x; it < T / 16; it += gridDim.x) {
        if (tid < 32) hist[tid] = 0;
        f32x4 y[2][4];
#pragma unroll
        for (int rr = 0; rr < 2; ++rr)
#pragma unroll
            for (int j = 0; j < 4; ++j) {
                const size_t o = ((size_t)it * 16 + wave * 2 + rr) * 1024 + j * 256 + lane * 4;
                const u32x2 mr = *(const u32x2*)(mixb + o);
                f32x4 xr;
                if (xres) xr = *(const f32x4*)(xres + o);
                else { const u32x2 xq = *(const u32x2*)(xb + o); xr = (f32x4){__uint_as_float(xq.x << 16), __uint_as_float(xq.x & 0xffff0000u), __uint_as_float(xq.y << 16), __uint_as_float(xq.y & 0xffff0000u)}; }
                y[rr][j] = xr * ALPHA + (f32x4){__uint_as_float(mr.x << 16), __uint_as_float(mr.x & 0xffff0000u), __uint_as_float(mr.y << 16), __uint_as_float(mr.y & 0xffff0000u)};
            }
#pragma unroll
        for (int rr = 0; rr < 2; ++rr) {
            const int rl = wave * 2 + rr; const size_t row = (size_t)it * 16 + rl;
            float s = 0.f;
#pragma unroll
            for (int j = 0; j < 4; ++j) s += (y[rr][j][0] + y[rr][j][1]) + (y[rr][j][2] + y[rr][j][3]);
            const float mean = wave_sum(s) * (1.0f / 1024.0f); float s2 = 0.f;
#pragma unroll
            for (int j = 0; j < 4; ++j) { y[rr][j] = y[rr][j] - mean; s2 += (y[rr][j][0] * y[rr][j][0] + y[rr][j][1] * y[rr][j][1]) + (y[rr][j][2] * y[rr][j][2] + y[rr][j][3] * y[rr][j][3]); }
            const float rstd = rsqrtf(wave_sum(s2) * (1.0f / 1024.0f) + LN_EPS);
#pragma unroll
            for (int j = 0; j < 4; ++j) {
                const f32x4 v = y[rr][j] * rstd * *(const f32x4*)(lg + j * 256 + lane * 4) + *(const f32x4*)(lb + j * 256 + lane * 4);
                u32x2 hi; hi.x = pk_bf16(v[0], v[1]); hi.y = pk_bf16(v[2], v[3]);
                u32x2 lo; lo.x = pk_bf16(v[0] - __uint_as_float(hi.x << 16), v[1] - __uint_as_float(hi.x & 0xffff0000u)); lo.y = pk_bf16(v[2] - __uint_as_float(hi.y << 16), v[3] - __uint_as_float(hi.y & 0xffff0000u));
                *(u32x2*)(xb + row * 1024 + j * 256 + lane * 4) = hi;
                xb8[row * 256 + j * 64 + lane] = pk_fp8x4(v * FP8_SX);
                *(LAS u32x2*)(Xh + rl * XP + (j * 256 + lane * 4) * 2) = hi;
                *(LAS u32x2*)(Xl + rl * XP + (j * 256 + lane * 4) * 2) = lo;
            }
        }
        __syncthreads();
        f32x4 acc[2] = {(f32x4){0.f, 0.f, 0.f, 0.f}, (f32x4){0.f, 0.f, 0.f, 0.f}};
#pragma unroll
        for (int ks = 0; ks < 4; ++ks) {
            const int ko = (wave * 128 + ks * 32 + fq * 8) * 2;
            const bf16x8 ah = *(LAS bf16x8*)(Xh + fr * XP + ko), al = *(LAS bf16x8*)(Xl + fr * XP + ko);
#pragma unroll
            for (int nt = 0; nt < 2; ++nt) { acc[nt] = MFMA16(ah, wh[ks][nt], acc[nt]); acc[nt] = MFMA16(ah, wl[ks][nt], acc[nt]); acc[nt] = MFMA16(al, wh[ks][nt], acc[nt]); }
        }
#pragma unroll
        for (int nt = 0; nt < 2; ++nt)
#pragma unroll
            for (int r = 0; r < 4; ++r) part[(wave * 16 + fq * 4 + r) * 32 + nt * 16 + fr] = acc[nt][r];
        __syncthreads();
        {
            const int rl = wave * 2 + (lane >> 5), my = lane & 31;
            float val = myrb;
#pragma unroll
            for (int w2 = 0; w2 < 8; ++w2) val += part[(w2 * 16 + rl) * 32 + my];
            float topv[4]; int topi[4];
#pragma unroll
            for (int k = 0; k < 4; ++k) {
                float bv = val; int bi = my;
#pragma unroll
                for (int off = 16; off >= 1; off >>= 1) { const float ov = __shfl_xor(bv, off); const int oi = __shfl_xor(bi, off); if (ov > bv || (ov == bv && oi < bi)) { bv = ov; bi = oi; } }
                topv[k] = bv; topi[k] = bi; if (my == bi) val = -INFINITY;
            }
            if (my == 0) {
                const float e1 = expf(topv[1] - topv[0]), e2 = expf(topv[2] - topv[0]), e3 = expf(topv[3] - topv[0]);
                const float inv = 1.0f / (1.0f + e1 + e2 + e3);
                const float gt[4] = {inv, e1 * inv, e2 * inv, e3 * inv};
#pragma unroll
                for (int k = 0; k < 4; ++k) { const int lr = __hip_atomic_fetch_add(&hist[topi[k]], 1, __ATOMIC_RELAXED, __HIP_MEMORY_SCOPE_WORKGROUP); pinfo[(rl * 4 + k) * 3 + 0] = topi[k]; pinfo[(rl * 4 + k) * 3 + 1] = lr; pinfo[(rl * 4 + k) * 3 + 2] = __float_as_int(gt[k]); }
            }
        }
        __syncthreads();
        if (tid < 32) { const int c = hist[tid]; basev[tid] = c ? atomicAdd(gcount + tid, c) : 0; }
        __syncthreads();
        if (tid < 64) {
            const int e = pinfo[tid * 3 + 0]; const size_t pi = (size_t)it * 64 + tid;
            pair_e[pi] = e; pair_rank[pi] = basev[e] + pinfo[tid * 3 + 1]; pair_gate[pi] = __int_as_float(pinfo[tid * 3 + 2]);
        }
        __syncthreads();
    }
}

__device__ __forceinline__ void moe_pstart(const Params& P, lds_t* lds, int layer) {
    LAS int* ps = (LAS int*)(lds + PS_OFF);
    const int* gcount = (const int*)(P.ws + WS_CTL) + 64 * layer;
    if (threadIdx.x == 0) { int a = 0; for (int e = 0; e < 32; ++e) { const int c = gcount[e]; ps[e] = a; ps[40 + e] = c; a += ((c + 255) >> 8) << 8; } ps[32] = a; }
    __syncthreads();
}

__device__ __forceinline__ void ph_route_scatter(const Params& P, lds_t* lds, int layer) {
    moe_pstart(P, lds, layer);
    LAS int* ps = (LAS int*)(lds + PS_OFF);
    const int* pair_e = (const int*)(P.ws + WS_ROUTE); const int* pair_rank = pair_e + T * 4; const float* pair_gate = (const float*)(pair_rank + T * 4);
    int* dest = (int*)(pair_gate + T * 4); int* row_tok = dest + T * 4; float* row_gate = (float*)(row_tok + MOE_ROWS);
    const size_t gtid = (size_t)blockIdx.x * NTHREADS + threadIdx.x, GT = (size_t)gridDim.x * NTHREADS;
    for (size_t i = gtid; i < (size_t)T * 4; i += GT) {
        const int e = pair_e[i], pos = ps[e] + pair_rank[i];
        row_tok[pos] = (int)(i >> 2); row_gate[pos] = pair_gate[i]; dest[i] = pos;
    }
    for (size_t i = gtid; i < 32 * 256; i += GT) {
        const int e = (int)(i >> 8), pos = ps[e] + ps[40 + e] + (int)(i & 255);
        if (pos < ps[e + 1]) { row_tok[pos] = 0; row_gate[pos] = 0.f; }
    }
}

struct EpiInproj {
    bf16_t* proj; int N; const int* pos;
    __device__ __forceinline__ void operator()(f32x4 (&acc)[2][2][4][2], const g2::Unit& u, int wr, int wc, int fr, int fq) const {
#pragma unroll
        for (int bj = 0; bj < 2; ++bj) {
            const int ct = 2 * u.pn + bj;
            if (pos != nullptr && ct >= 8 && ct < 16 && wc == 0) {
                float invf[4];
#pragma unroll
                for (int c = 0; c < 4; ++c) invf[c] = exp2f(-(float)(fq * 4 + c) * (18.931568569324174f / 16.0f));
#pragma unroll
                for (int ai = 0; ai < 2; ++ai)
#pragma unroll
                    for (int m = 0; m < 4; ++m) {
                        const float pf = (float)pos[u.pm * 256 + ai * 128 + wr * 64 + m * 16 + fr];
#pragma unroll
                        for (int c = 0; c < 4; ++c) {
                            float sn, cs; fsincos(pf * invf[c], sn, cs);
                            const float a = acc[ai][bj][m][0][c], b = acc[ai][bj][m][1][c];
                            acc[ai][bj][m][0][c] = a * cs - b * sn; acc[ai][bj][m][1][c] = b * cs + a * sn;
                        }
                    }
            }
            const float sc = (pos != nullptr && ct >= 8 && ct < 12) ? 0.08838834764831845f : 1.0f;
#pragma unroll
            for (int ai = 0; ai < 2; ++ai)
#pragma unroll
                for (int m = 0; m < 4; ++m)
#pragma unroll
                    for (int n = 0; n < 2; ++n)
                        store_bf16x4(proj + (size_t)(u.pm * 256 + ai * 128 + wr * 64 + m * 16 + fr) * N + ct * 128 + wc * 32 + n * 16 + fq * 4, acc[ai][bj][m][n] * sc);
        }
    }
};
__device__ __forceinline__ void ph_inproj2(const Params& P, lds_t* lds, const bf16_t* Wt, int N, const int* pos) {
    g2::DenseSched S{(int)gridDim.x, (int)blockIdx.x, T / 256, N / 256, 1024, (const char*)Wt};
    EpiInproj E{(bf16_t*)(P.ws + WS_PROJ), N, pos};
    g2::gemm_phase<false>(lds, (const char*)(P.ws + WS_XB), 16, 2048u, S, E);
}
struct EpiOutproj {
    bf16_t* mixb;
    __device__ __forceinline__ void operator()(f32x4 (&acc)[2][2][4][2], const g2::Unit& u, int wr, int wc, int fr, int fq) const {
#pragma unroll
        for (int ai = 0; ai < 2; ++ai)
#pragma unroll
            for (int m = 0; m < 4; ++m)
#pragma unroll
                for (int bj = 0; bj < 2; ++bj)
#pragma unroll
                    for (int n = 0; n < 2; ++n) {
                        const size_t o = (size_t)(u.pm * 256 + ai * 128 + wr * 64 + m * 16 + fr) * 1024 + u.pn * 256 + bj * 128 + wc * 32 + n * 16 + fq * 4;
                        store_bf16x4(mixb + o, acc[ai][bj][m][n]);
                    }
    }
};
__device__ __forceinline__ void ph_outproj2(const Params& P, lds_t* lds, const bf16_t* Wt) {
    g2::DenseSched S{(int)gridDim.x, (int)blockIdx.x, T / 256, 4, 1024, (const char*)Wt};
    EpiOutproj E{(bf16_t*)(P.ws + WS_ZF)};
    g2::gemm_phase<false>(lds, (const char*)(P.ws + WS_CAT), 16, 2048u, S, E);
}
template <class RT> struct MoeSchedT {
    static constexpr bool CHEAP_AOFF = false;
    int G, c, nM, nN; const char* W; size_t wstride; const LAS RT* rt16; LAS int* ps; unsigned apitch, bpitch;
    __device__ __forceinline__ bool next(int i, g2::Unit& u) const { return g2::static_next(i, G, c, nM, nN, u); }
    __device__ __forceinline__ int expert(int pm) const { int e = 0; while (ps[e + 1] <= pm * 256) ++e; return e; }
    __device__ __forceinline__ void a_off(const g2::Unit& u, unsigned (&ao)[2][2]) const {
        int Rs[2], Cs[2];
#pragma unroll
        for (int i = 0; i < 2; ++i) g2::stage_rc((int)threadIdx.x * 16 + i * 8192, Rs[i], Cs[i]);
#pragma unroll
        for (int h = 0; h < 2; ++h)
#pragma unroll
            for (int i = 0; i < 2; ++i) {
                const unsigned row = (unsigned)rt16[u.idx * 256 + h * 128 + Rs[i]];
                ao[h][i] = row * apitch + (unsigned)Cs[i] * 2u;
            }
    }
    __device__ __forceinline__ const char* b_base(const g2::Unit& u) const { return W + (size_t)expert(u.pm) * wstride + (size_t)u.pn * 256 * bpitch; }
};
struct EpiMoeUp {
    unsigned* hact8; const LAS float* tb;
    __device__ __forceinline__ void operator()(f32x4 (&acc)[2][2][4][2], const g2::Unit& u, int wr, int wc, int fr, int fq) const {
#pragma unroll
        for (int n = 0; n < 2; ++n) {
            const int jl = wc * 32 + n * 16 + fq * 4, j = u.pn * 128 + jl;
            const f32x4 bg = *(const LAS f32x4*)(tb + u.idx * 256 + jl), bl = *(const LAS f32x4*)(tb + u.idx * 256 + 128 + jl);
#pragma unroll
            for (int ai = 0; ai < 2; ++ai)
#pragma unroll
                for (int m = 0; m < 4; ++m) {
                    f32x4 y;
#pragma unroll
                    for (int c = 0; c < 4; ++c) {
                        constexpr float us = 1.0f / (FP8_SX * FP8_SWIN);
                        const float gv = fminf(acc[ai][0][m][n][c] * us + bg[c], 7.0f), lv = fminf(fmaxf(acc[ai][1][m][n][c] * us + bl[c], -7.0f), 7.0f);
                        y[c] = gv * fsigmoid(1.702f * gv) * (lv + 1.0f);
                    }
                    hact8[((size_t)(u.pm * 256 + ai * 128 + wr * 64 + m * 16 + fr) * 1024 + j) >> 2] = pk_fp8x4(y * FP8_SH);
                }
        }
    }
};
__device__ __forceinline__ void ph_moe_up2(const Params& P, lds_t* lds, int layer) {
    moe_pstart(P, lds, layer);
    LAS int* ps = (LAS int*)(lds + PS_OFF);
    const int* row_tok = (const int*)(P.ws + WS_ROUTE) + 4 * T * 4;
    const float* b_in = P.in[I_M_BIN] + (size_t)layer * 32 * 2048;
    const int nM = ps[32] >> 8, G = (int)gridDim.x, c = (int)blockIdx.x;
    LAS float* tb = (LAS float*)(lds + MTAB_OFF);
    LAS unsigned short* rt16 = (LAS unsigned short*)(lds + MTAB_OFF + 17 * 1024);
    MoeSchedT<unsigned short> S{G, c, nM, 8, (const char*)(P.ws + (layer ? WS_MW1 : WS_MWIN)), (size_t)2048 * 1024, rt16, ps, 1024u, 1024u};
    { g2::Unit u; for (int i = 0; i < 17 && S.next(i, u); ++i) { const int e = S.expert(u.pm);
        if (threadIdx.x < 256) { const int t = threadIdx.x; tb[i * 256 + t] = b_in[e * 2048 + (t >> 7) * 1024 + u.pn * 128 + (t & 127)]; }
        else { const int t = threadIdx.x - 256; rt16[i * 256 + t] = (unsigned short)row_tok[u.pm * 256 + t]; } } }
    __syncthreads();
    EpiMoeUp E{(unsigned*)(P.ws + WS_HACT), tb};
    g2::gemm_phase<true>(lds, (const char*)(P.ws + WS_X1F), 8, 1024u, S, E);
    if (layer == 0) { const int r = (nM * 8) % G; if (r != 0 && c >= r) convert_range_wg(P, 1, (c - r) * TAIL_QUOTA, TAIL_QUOTA, lds); }
}
struct EpiMoeDown {
    static constexpr int NVMEM = 32;
    bf16_t* yb; const LAS float* tb;
    __device__ __forceinline__ void operator()(f32x4 (&acc)[2][2][4][2], const g2::Unit& u, int wr, int wc, int fr, int fq) const {
#pragma unroll
        for (int bj = 0; bj < 2; ++bj)
#pragma unroll
            for (int n = 0; n < 2; ++n) {
                const int cl = bj * 128 + wc * 32 + n * 16 + fq * 4;
                const f32x4 bv = *(const LAS f32x4*)(tb + u.idx * 512 + cl);
#pragma unroll
                for (int ai = 0; ai < 2; ++ai)
#pragma unroll
                    for (int m = 0; m < 4; ++m) {
                        const int rl = ai * 128 + wr * 64 + m * 16 + fr; const float gt = tb[u.idx * 512 + 256 + rl];
                        store_bf16x4(yb + (size_t)(u.pm * 256 + rl) * 1024 + u.pn * 256 + cl, (acc[ai][bj][m][n] * (1.0f / (FP8_SH * FP8_SWOUT)) + bv) * gt);
                    }
            }
    }
};
__device__ __forceinline__ void ph_moe_down2(const Params& P, lds_t* lds, int layer) {
    moe_pstart(P, lds, layer);
    LAS int* ps = (LAS int*)(lds + PS_OFF);
    const float* row_gate = (const float*)((const int*)(P.ws + WS_ROUTE) + 4 * T * 4 + MOE_ROWS);
    const float* b_out = P.in[I_M_BOUT] + (size_t)layer * 32 * 1024;
    const int nM = ps[32] >> 8, G = (int)gridDim.x, c = (int)blockIdx.x;
    LAS float* tb = (LAS float*)(lds + MTAB_OFF);
    LAS unsigned* rt32 = (LAS unsigned*)(lds + MTAB_OFF + 9 * 2048);
    MoeSchedT<unsigned> S{G, c, nM, 4, (const char*)(P.ws + (layer ? WS_MW1 : WS_MWIN) + (size_t)32 * 2048 * 1024), (size_t)1024 * 1024, rt32, ps, 1024u, 1024u};
    { g2::Unit u; for (int i = 0; i < 9 && S.next(i, u); ++i) { const int e = S.expert(u.pm);
        const int t = threadIdx.x; tb[i * 512 + t] = (t < 256) ? b_out[e * 1024 + u.pn * 256 + t] : row_gate[u.pm * 256 + (t - 256)]; if (t < 256) rt32[i * 256 + t] = (unsigned)(u.pm * 256 + t); } }
    __syncthreads();
    EpiMoeDown E{(bf16_t*)(P.ws + WS_YB), tb};
    g2::gemm_phase<true>(lds, (const char*)(P.ws + WS_HACT), 8, 1024u, S, E);
    if (layer == 0) { const int r = (nM * 4) % G; if (r != 0 && c >= r) convert_range_wg(P, 1, tail_done_up(nM, G) + (c - r) * TAIL_QUOTA, TAIL_QUOTA, lds); }
}

__device__ __forceinline__ void ph_combine_ln(const Params& P, int layer, float* outf  ) {
    const bf16_t* yb = (const bf16_t*)(P.ws + WS_YB); bf16_t* xb = (bf16_t*)(P.ws + WS_XB);
    const int* dest = (const int*)(P.ws + WS_ROUTE) + 3 * T * 4;
    const float* lg = P.in[I_LNF_G] + layer * 1024; const float* lb = P.in[I_LNF_B] + layer * 1024;
    const int lane = threadIdx.x & 63, gw = blockIdx.x * 8 + (threadIdx.x >> 6), NGW = gridDim.x * 8;
    int4 dnext[2];
#pragma unroll
    for (int rr = 0; rr < 2; ++rr) dnext[rr] = (gw * 2 + rr < T) ? *(const int4*)(dest + (gw * 2 + rr) * 4) : (int4){0, 0, 0, 0};
    for (int row0 = gw * 2; row0 < T; row0 += NGW * 2) {
        f32x4 v[2][4]; u32x2 yr[2][4][4];
        int4 dcur[2];
#pragma unroll
        for (int rr = 0; rr < 2; ++rr) { dcur[rr] = dnext[rr]; const int nr = row0 + NGW * 2 + rr; if (nr < T) dnext[rr] = *(const int4*)(dest + nr * 4); }
#pragma unroll
        for (int rr = 0; rr < 2; ++rr) {
            const int row = row0 + rr;
            const int4 d = dcur[rr];
            const int dd[4] = {d.x, d.y, d.z, d.w};
#pragma unroll
            for (int j = 0; j < 4; ++j) {
                { const u32x2 xq = *(const u32x2*)(xb + (size_t)row * 1024 + j * 256 + lane * 4); v[rr][j] = (f32x4){__uint_as_float(xq.x << 16), __uint_as_float(xq.x & 0xffff0000u), __uint_as_float(xq.y << 16), __uint_as_float(xq.y & 0xffff0000u)}; }
#pragma unroll
                for (int k = 0; k < 4; ++k) yr[rr][j][k] = *(const u32x2*)(yb + (size_t)dd[k] * 1024 + j * 256 + lane * 4);
            }
        }
#pragma unroll
        for (int rr = 0; rr < 2; ++rr) {
            const int row = row0 + rr; float s = 0.f;
#pragma unroll
            for (int j = 0; j < 4; ++j) {
                v[rr][j] = v[rr][j] * ALPHA;
#pragma unroll
                for (int k = 0; k < 4; ++k) {
                    const u32x2 r = yr[rr][j][k];
                    v[rr][j][0] += __uint_as_float(r.x << 16); v[rr][j][1] += __uint_as_float(r.x & 0xffff0000u); v[rr][j][2] += __uint_as_float(r.y << 16); v[rr][j][3] += __uint_as_float(r.y & 0xffff0000u);
                }
                s += (v[rr][j][0] + v[rr][j][1]) + (v[rr][j][2] + v[rr][j][3]);
            }
            const float mean = wave_sum(s) * (1.0f / 1024.0f); float s2 = 0.f;
#pragma unroll
            for (int j = 0; j < 4; ++j) { v[rr][j] = v[rr][j] - mean; s2 += (v[rr][j][0] * v[rr][j][0] + v[rr][j][1] * v[rr][j][1]) + (v[rr][j][2] * v[rr][j][2] + v[rr][j][3] * v[rr][j][3]); }
            const float rstd = rsqrtf(wave_sum(s2) * (1.0f / 1024.0f) + LN_EPS);
#pragma unroll
            for (int j = 0; j < 4; ++j) {
                const f32x4 o = v[rr][j] * rstd * *(const f32x4*)(lg + j * 256 + lane * 4) + *(const f32x4*)(lb + j * 256 + lane * 4);
                if (outf) *(f32x4*)(outf + (size_t)row * 1024 + j * 256 + lane * 4) = o;
                else store_bf16x4(xb + (size_t)row * 1024 + j * 256 + lane * 4, o);
            }
        }
    }
}

__device__ __forceinline__ void ph_conv1(const Params& P, lds_t* lds) {
    const bf16_t* proj = (const bf16_t*)(P.ws + WS_PROJ); bf16_t* xconv = (bf16_t*)(P.ws + WS_XCONV); float* gates = (float*)(P.ws + WS_GATES);
    LAS float* Wc = (LAS float*)lds;
    const float* Wcg = (const float*)(P.ws + WS_WC);
    for (int i = threadIdx.x; i < 8192; i += NTHREADS) {
        const int which = i >> 12, ch = (i >> 3) & 511, gg = i & 7;
        Wc[which * 4096 + (((ch & 7) * 2 + (gg >> 2)) * 64 + (ch >> 3)) * 4 + (gg & 3)] = Wcg[i];
    }
    __syncthreads();
    const int lane = threadIdx.x & 63, gw = blockIdx.x * 8 + (threadIdx.x >> 6), NGW = gridDim.x * 8, c8 = lane * 8;
    float w[4][8], bias[8];
#pragma unroll
    for (int e = 0; e < 8; ++e) { bias[e] = P.in[I_CD_CONVB][c8 + e];
#pragma unroll
        for (int k = 0; k < 4; ++k) w[k][e] = P.in[I_CD_CONVW][k * 512 + c8 + e]; }
    const float bif = P.in[I_CD_BIF][lane & 7];
    for (int run = gw; run < T / 8; run += NGW) {
        const int tok0 = run * 8, p0 = tok0 & (SEQ - 1);
        u32x4 r[11];
#pragma unroll
        for (int i = 0; i < 11; ++i) { r[i] = (u32x4){0u, 0u, 0u, 0u}; if (p0 + i - 3 >= 0) r[i] = *(const u32x4*)(proj + (size_t)(tok0 + i - 3) * 2560 + c8); }
#pragma unroll
        for (int t = 0; t < 8; ++t) {
            int woff = lane * 4; asm volatile("" : "+v"(woff));
            const int tok = tok0 + t;
            float a[8], xraw[8];
#pragma unroll
            for (int e = 0; e < 8; ++e) a[e] = bias[e];
#pragma unroll
            for (int k = 0; k < 4; ++k) { float xv[8]; unpack8(r[t + k], xv);
#pragma unroll
                for (int e = 0; e < 8; ++e) { a[e] += w[k][e] * xv[e]; if (k == 3) xraw[e] = xv[e]; } }
#pragma unroll
            for (int e = 0; e < 8; ++e) a[e] = a[e] * fsigmoid(a[e]);
            const u32x4 packed = pack8(a);
            *(u32x4*)(xconv + (size_t)tok * 512 + c8) = packed;
            float ar[8]; unpack8(packed, ar);
            float gs[8];
#pragma unroll
            for (int gg = 0; gg < 8; ++gg) gs[gg] = 0.f;
#pragma unroll
            for (int e = 0; e < 8; ++e) {
                const f32x4 w1a = *(LAS f32x4*)(Wc + woff + (e * 2) * 256), w1b = *(LAS f32x4*)(Wc + woff + (e * 2 + 1) * 256);
                const f32x4 w2a = *(LAS f32x4*)(Wc + 4096 + woff + (e * 2) * 256), w2b = *(LAS f32x4*)(Wc + 4096 + woff + (e * 2 + 1) * 256);
#pragma unroll
                for (int gg = 0; gg < 4; ++gg) { gs[gg] += ar[e] * w1a[gg] + xraw[e] * w2a[gg]; gs[gg + 4] += ar[e] * w1b[gg] + xraw[e] * w2b[gg]; }
            }
            float mine = 0.f;
#pragma unroll
            for (int gg = 0; gg < 8; ++gg) { const float tsum = wave_sum(gs[gg]); if ((lane & 7) == gg) mine = tsum; }
            if (lane < 8) gates[(size_t)tok * 8 + lane] = mine + bif;
        }
    }
}

__device__ __forceinline__ void ph_qkv(const Params& P, lds_t* lds) {
    const bf16_t* xconv = (const bf16_t*)(P.ws + WS_XCONV); const bf16_t* proj = (const bf16_t*)(P.ws + WS_PROJ); const bf16_t* Wt = (const bf16_t*)(P.ws + WS_WQKV);
    bf16_t* qb = (bf16_t*)(P.ws + WS_QB); static_assert(WS_KB == WS_QB + 32 * MiB && WS_VB == WS_QB + 64 * MiB, "q/k/v spacing");
    const int b0 = (int)blockIdx.x, G = (int)gridDim.x;
#define QKV_DECODE(J) const int tile = b0 + (J) * G, which = tile % 3, rt = (tile / 3) & 127, h = tile / 384; (void)rt;
    e1_stream<true>(lds, wg_tiles(1536), [](int) { return 2; },
        [=](int j, int, int r, int kp) { QKV_DECODE(j) const bf16_t* A = which < 2 ? xconv : proj; const int lda = which < 2 ? 512 : 2560; return *(const u32x4*)(A + (size_t)(rt * 256 + r) * lda + h * 128 + kp * 8); },
        [=](int j, int, int n, int kp) { QKV_DECODE(j) return *(const u32x4*)(Wt + (size_t)(which * 4 + h) * 16384 + n * 128 + kp * 8); },
        [=](int j, f32x4 (&acc)[4][4], int wr, int wc, int fr, int fq) {
            QKV_DECODE(j)
            bf16_t* out = (bf16_t*)((unsigned char*)qb + (size_t)which * (32 * MiB));
            const float sc = which == 1 ? 0.08838834764831845f : 1.0f;
#pragma unroll
            for (int m = 0; m < 4; ++m)
#pragma unroll
                for (int n = 0; n < 4; ++n)
                    store_bf16x4(out + (size_t)(rt * 256 + wr * 64 + m * 16 + fr) * 512 + h * 128 + wc * 64 + n * 16 + fq * 4, acc[m][n] * sc);
        });
#undef QKV_DECODE
}

constexpr int TP = 272;
__device__ __forceinline__ void ph_m1(const Params& P, lds_t* lds) {
    const bf16_t* kb = (const bf16_t*)(P.ws + WS_KB); const bf16_t* vb = (const bf16_t*)(P.ws + WS_VB); const float* gates = (const float*)(P.ws + WS_GATES);
    bf16_t* kvc = (bf16_t*)(P.ws + WS_KVC); float* nchunk = (float*)(P.ws + WS_MISC); float* scal = nchunk + 2 * 2048 * 128;
    lds_t* Kt = lds; lds_t* Vt = lds + 64 * TP; LAS float* wv = (LAS float*)(lds + 128 * TP);
    const int tid = threadIdx.x, lane = tid & 63, w = tid >> 6, fr = lane & 15, fq = lane >> 4, q = (lane & 15) >> 2, p4 = lane & 3;
    int item = blockIdx.x; if (item >= 2048) return;
    u32x4 rk[2], rv[2]; float pf_f, pf_i;
#define M1_LOAD(IT) do { const int bh_ = (IT) >> 6, n_ = (IT) & 63, b_ = bh_ >> 2, h_ = bh_ & 3; const size_t t0_ = (size_t)b_ * SEQ + n_ * 64; \
        _Pragma("unroll") for (int i_ = 0; i_ < 2; ++i_) { const int p_ = tid + i_ * NTHREADS; const size_t o_ = (t0_ + (p_ >> 4)) * 512 + h_ * 128 + (p_ & 15) * 8; rk[i_] = *(const u32x4*)(kb + o_); rv[i_] = *(const u32x4*)(vb + o_); } \
        pf_f = gates[(t0_ + lane) * 8 + 4 + h_]; pf_i = gates[(t0_ + lane) * 8 + h_]; } while (0)
    M1_LOAD(item);
    for (;;) {
#pragma unroll
        for (int i = 0; i < 2; ++i) { const int p = tid + i * NTHREADS; *(LAS u32x4*)(Kt + (p >> 4) * TP + (p & 15) * 16) = rk[i]; *(LAS u32x4*)(Vt + (p >> 4) * TP + (p & 15) * 16) = rv[i]; }
        if (w == 0) {
            float cum = logsigmoidf(pf_f);
#pragma unroll
            for (int off = 1; off < 64; off <<= 1) { const float t = __shfl_up(cum, off); if (lane >= off) cum += t; }
            const float cf = __shfl(cum, 63), te = cf - cum + pf_i, m = wave_max(te);
            wv[lane] = expf(te - m);
            if (lane == 0) { scal[item] = cf; scal[2048 + item] = m; }
        }
        __syncthreads();
        const int nitem = item + gridDim.x; const bool has_next = nitem < 2048;
        if (has_next) M1_LOAD(nitem);
        bf16x8 af[2]; float nsum = 0.f;
#pragma unroll
        for (int ks = 0; ks < 2; ++ks) {
            unsigned pk[4];
#pragma unroll
            for (int t = 0; t < 2; ++t) {
                const int s0 = 32 * ks + 8 * fq + 4 * t;
                const bf16x4 r = tr_read(Kt + (s0 + q) * TP + (16 * w + 4 * p4) * 2);
                const f32x4 ww = *(LAS f32x4*)(wv + s0);
                float x[4];
#pragma unroll
                for (int e = 0; e < 4; ++e) { x[e] = bf2f((unsigned short)r[e]) * ww[e]; nsum += x[e]; }
                pk[2 * t] = pk_bf16(x[0], x[1]); pk[2 * t + 1] = pk_bf16(x[2], x[3]);
            }
            u32x4 u = {pk[0], pk[1], pk[2], pk[3]}; af[ks] = __builtin_bit_cast(bf16x8, u);
        }
        nsum += __shfl_xor(nsum, 16); nsum += __shfl_xor(nsum, 32);
        if (fq == 0) nchunk[(size_t)item * 128 + 16 * w + fr] = nsum;
#pragma unroll
        for (int c = 0; c < 8; ++c) {
            f32x4 acc = {0.f, 0.f, 0.f, 0.f};
#pragma unroll
            for (int ks = 0; ks < 2; ++ks) {
                const int s0 = 32 * ks + 8 * fq;
                const bf16x8 bfv = cat44(tr_read(Vt + (s0 + q) * TP + (16 * c + 4 * p4) * 2), tr_read(Vt + (s0 + 4 + q) * TP + (16 * c + 4 * p4) * 2));
                acc = MFMA16(af[ks], bfv, acc);
            }
            store_bf16x4(kvc + ((size_t)item * 128 + c * 16 + fr) * 128 + 16 * w + fq * 4, acc);
        }
        __syncthreads();
        if (!has_next) break;
        item = nitem;
    }
#undef M1_LOAD
}

__device__ __forceinline__ void ph_m2(const Params& P) {
    const bf16_t* kvc = (const bf16_t*)(P.ws + WS_KVC); bf16_t* cprev = (bf16_t*)(P.ws + WS_CPREV);
    const float* nchunk = (const float*)(P.ws + WS_MISC); float* nprev = (float*)(P.ws + WS_MISC) + 2048 * 128; float* scal = (float*)(P.ws + WS_MISC) + 2 * 2048 * 128;
    const int tid = threadIdx.x;
    for (int it = blockIdx.x; it < 256; it += gridDim.x) {
        const int bh = it >> 3, sl = it & 7, idx = sl * 2048 + tid * 4;
        const bool donv = (sl == 0 && tid < 128);
        f32x4 C = {0.f, 0.f, 0.f, 0.f}; float nv = 0.f, m = -INFINITY;
        for (int n0 = 0; n0 < 64; n0 += 4) {
            f32x4 kv[4]; float nc[4], fc[4], mc[4];
#pragma unroll
            for (int j = 0; j < 4; ++j) {
                const int item = bh * 64 + n0 + j;
                { const u32x2 kq = *(const u32x2*)(kvc + (size_t)item * 16384 + idx); kv[j] = (f32x4){__uint_as_float(kq.x << 16), __uint_as_float(kq.x & 0xffff0000u), __uint_as_float(kq.y << 16), __uint_as_float(kq.y & 0xffff0000u)}; }
                nc[j] = donv ? nchunk[(size_t)item * 128 + tid] : 0.f;
                fc[j] = scal[item]; mc[j] = scal[2048 + item];
            }
#pragma unroll
            for (int j = 0; j < 4; ++j) {
                const int item = bh * 64 + n0 + j;
                store_bf16x4(cprev + (size_t)item * 16384 + idx, C);
                if (donv) nprev[(size_t)item * 128 + tid] = nv;
                if (sl == 0 && tid == 0) scal[4096 + item] = m;
                const float mn = fmaxf(fc[j] + m, mc[j]), so = expf(fc[j] + m - mn), sn = expf(mc[j] - mn);
                C = C * so + kv[j] * sn; nv = so * nv + sn * nc[j]; m = mn;
            }
        }
    }
}

__device__ __forceinline__ void ph_m3(const Params& P, lds_t* lds) {
    const bf16_t* qb = (const bf16_t*)(P.ws + WS_QB); const bf16_t* kb = (const bf16_t*)(P.ws + WS_KB); const bf16_t* vb = (const bf16_t*)(P.ws + WS_VB);
    const bf16_t* cprev = (const bf16_t*)(P.ws + WS_CPREV); const float* gates = (const float*)(P.ws + WS_GATES);
    const float* nprev = (const float*)(P.ws + WS_MISC) + 2048 * 128; const float* scal = (const float*)(P.ws + WS_MISC) + 2 * 2048 * 128;
    const bf16_t* proj = (const bf16_t*)(P.ws + WS_PROJ); bf16_t* cat = (bf16_t*)(P.ws + WS_CAT);
    lds_t* Qt = lds; lds_t* Kt = lds + 64 * TP; lds_t* Vt = lds + 128 * TP; lds_t* Ct = lds + 192 * TP;
    LAS float* cumf = (LAS float*)(lds + 320 * TP); LAS float* gv = cumf + 64; LAS float* msv = gv + 64; LAS float* npv = msv + 64; LAS float* ex = npv + 128;
    const int tid = threadIdx.x, lane = tid & 63, w = tid >> 6, fr = lane & 15, fq = lane >> 4, q = (lane & 15) >> 2, p4 = lane & 3;
    const int rt = w & 3, vh = w >> 2;
    int item = blockIdx.x; if (item >= 2048) return;
    u32x4 rq[2], rk[2], rv[2], rc[4]; float pf_f, pf_i, pf_n, pf_mp;
#define M3_LOAD(IT) do { const int bh_ = (IT) >> 6, n_ = (IT) & 63, b_ = bh_ >> 2, h_ = bh_ & 3; const size_t t0_ = (size_t)b_ * SEQ + n_ * 64; \
        _Pragma("unroll") for (int i_ = 0; i_ < 2; ++i_) { const int p_ = tid + i_ * NTHREADS; const size_t o_ = (t0_ + (p_ >> 4)) * 512 + h_ * 128 + (p_ & 15) * 8; rq[i_] = *(const u32x4*)(qb + o_); rk[i_] = *(const u32x4*)(kb + o_); rv[i_] = *(const u32x4*)(vb + o_); } \
        _Pragma("unroll") for (int i_ = 0; i_ < 4; ++i_) { const int p_ = tid + i_ * NTHREADS; rc[i_] = *(const u32x4*)(cprev + (size_t)(IT) * 16384 + (p_ >> 4) * 128 + (p_ & 15) * 8); } \
        pf_f = gates[(t0_ + lane) * 8 + 4 + h_]; pf_i = gates[(t0_ + lane) * 8 + h_]; pf_n = nprev[(size_t)(IT) * 128 + (tid & 127)]; pf_mp = scal[4096 + (IT)]; } while (0)
    M3_LOAD(item);
    for (;;) {
        const int bh = item >> 6, n = item & 63, b = bh >> 2, h = bh & 3; const size_t tok0 = (size_t)b * SEQ + n * 64;
#pragma unroll
        for (int i = 0; i < 2; ++i) { const int p = tid + i * NTHREADS; const int o = (p >> 4) * TP + (p & 15) * 16; *(LAS u32x4*)(Qt + o) = rq[i]; *(LAS u32x4*)(Kt + o) = rk[i]; *(LAS u32x4*)(Vt + o) = rv[i]; }
#pragma unroll
        for (int i = 0; i < 4; ++i) { const int p = tid + i * NTHREADS; *(LAS u32x4*)(Ct + (p >> 4) * TP + (p & 15) * 16) = rc[i]; }
        if (tid < 128) npv[tid] = pf_n;
        const float mp = pf_mp;
        if (w == 0) {
            float cum = logsigmoidf(pf_f);
#pragma unroll
            for (int off = 1; off < 64; off <<= 1) { const float t = __shfl_up(cum, off); if (lane >= off) cum += t; }
            const float gg = pf_i - cum; float pm = gg;
#pragma unroll
            for (int off = 1; off < 64; off <<= 1) { const float t = __shfl_up(pm, off); if (lane >= off) pm = fmaxf(pm, t); }
            cumf[lane] = cum; gv[lane] = gg; msv[lane] = cum + fmaxf(pm, mp);
        }
        __syncthreads();
        const int nitem = item + gridDim.x; const bool has_next = nitem < 2048;
        if (has_next) M3_LOAD(nitem);
        unsigned short opv[4][4];
#pragma unroll
        for (int c = 0; c < 4; ++c)
#pragma unroll
            for (int r = 0; r < 4; ++r) opv[c][r] = proj[(tok0 + rt * 16 + fq * 4 + r) * 2560 + 512 + h * 128 + vh * 64 + c * 16 + fr];
        bf16x8 qf[4];
#pragma unroll
        for (int ks = 0; ks < 4; ++ks) qf[ks] = *(LAS bf16x8*)(Qt + (rt * 16 + fr) * TP + ks * 64 + fq * 16);
        const int s = rt * 16 + fr; const float cs = cumf[s], mss = msv[s];
        float sp[4][4]; float rowsum = 0.f;
#pragma unroll
        for (int jt = 0; jt < 4; ++jt) {
            f32x4 st = {0.f, 0.f, 0.f, 0.f};
            if (jt <= rt) {
#pragma unroll
                for (int ks = 0; ks < 4; ++ks) st = MFMA16(*(LAS bf16x8*)(Kt + (jt * 16 + fr) * TP + ks * 64 + fq * 16), qf[ks], st);
            }
            const f32x4 g4 = *(LAS f32x4*)(gv + jt * 16 + fq * 4);
#pragma unroll
            for (int r = 0; r < 4; ++r) { const int j = jt * 16 + fq * 4 + r; const float wgt = (j <= s) ? fexp(cs + g4[r] - mss) : 0.f; sp[jt][r] = st[r] * wgt; rowsum += sp[jt][r]; }
        }
        rowsum += __shfl_xor(rowsum, 16); rowsum += __shfl_xor(rowsum, 32);
        float qn = 0.f;
#pragma unroll
        for (int ks = 0; ks < 4; ++ks) {
            const f32x4 n0 = *(LAS f32x4*)(npv + ks * 32 + fq * 8), n1 = *(LAS f32x4*)(npv + ks * 32 + fq * 8 + 4);
#pragma unroll
            for (int e = 0; e < 4; ++e) { qn += bf2f((unsigned short)qf[ks][e]) * n0[e]; qn += bf2f((unsigned short)qf[ks][4 + e]) * n1[e]; }
        }
        qn += __shfl_xor(qn, 16); qn += __shfl_xor(qn, 32);
        const float inter = expf(cs + mp - mss), den = rowsum + inter * qn, inv = 1.0f / fmaxf(fabsf(den), expf(-mss));
        if (fq == 0) { ex[w * 32 + fr] = inv; ex[w * 32 + 16 + fr] = inter; }
        __builtin_amdgcn_wave_barrier();
        const f32x4 inv4 = *(LAS f32x4*)(ex + w * 32 + fq * 4), int4 = *(LAS f32x4*)(ex + w * 32 + 16 + fq * 4);
        bf16x8 pa[2];
#pragma unroll
        for (int kk = 0; kk < 2; ++kk) { u32x4 u = {pk_bf16(sp[2 * kk][0], sp[2 * kk][1]), pk_bf16(sp[2 * kk][2], sp[2 * kk][3]), pk_bf16(sp[2 * kk + 1][0], sp[2 * kk + 1][1]), pk_bf16(sp[2 * kk + 1][2], sp[2 * kk + 1][3])}; pa[kk] = __builtin_bit_cast(bf16x8, u); }
#pragma unroll
        for (int c = 0; c < 4; ++c) {
            const int vcol = vh * 64 + c * 16;
            f32x4 acc = {0.f, 0.f, 0.f, 0.f};
#pragma unroll
            for (int ks = 0; ks < 4; ++ks) acc = MFMA16(qf[ks], *(LAS bf16x8*)(Ct + (vcol + fr) * TP + ks * 64 + fq * 16), acc);
#pragma unroll
            for (int r = 0; r < 4; ++r) acc[r] *= int4[r];
#pragma unroll
            for (int kk = 0; kk < 2; ++kk) {
                const bf16x8 vbf = cat44(tr_read(Vt + (32 * kk + 4 * fq + q) * TP + (vcol + 4 * p4) * 2), tr_read(Vt + (32 * kk + 16 + 4 * fq + q) * TP + (vcol + 4 * p4) * 2));
                acc = MFMA16(pa[kk], vbf, acc);
            }
#pragma unroll
            for (int r = 0; r < 4; ++r) {
                const size_t tok = tok0 + rt * 16 + fq * 4 + r; const int col = h * 128 + vcol + fr;
                cat[tok * 1024 + col] = (bf16_t)(pk_bf16(fsigmoid(bf2f(opv[c][r])) * acc[r] * inv4[r], 0.f) & 0xffffu);
            }
        }
        __syncthreads();
        if (!has_next) break;
        item = nitem;
    }
#undef M3_LOAD
}

__device__ __forceinline__ void ph_attn(const Params& P, lds_t* lds) {
    const bf16_t* proj = (const bf16_t*)(P.ws + WS_PROJ); bf16_t* atto = (bf16_t*)(P.ws + WS_ATTO); float* lse = (float*)(P.ws + WS_LSE);
    lds_t* Kt = lds; lds_t* Vt = lds + 256 * TP; LAS float* ex = (LAS float*)(lds + 512 * TP);
    const int tid = threadIdx.x, lane = tid & 63, w = tid >> 6, fr = lane & 15, fq = lane >> 4, q = (lane & 15) >> 2, p4 = lane & 3;
    const int per = (3072 + (int)gridDim.x - 1) / (int)gridDim.x;
    int item = (int)blockIdx.x * per; const int iend = (item + per < 3072) ? item + per : 3072;
    if (item >= iend) return;
    u32x4 rg[16]; bf16x8 qf[4], qn[4];
#define AT_DECODE(IT) const int g = (IT) >> 10, rem = (IT) & 1023, dsh = 2 * g, dil = 1 << dsh, nbsh = 5 - dsh, nb = rem & ((1 << nbsh) - 1), chain = rem >> nbsh, \
        h = chain & 3, br = chain >> 2, r = br & (dil - 1), b = br >> dsh; const size_t tokb = (size_t)b * SEQ + r;
#define AT_LOAD(IT, CHAINED, QF) do { AT_DECODE(IT) \
        _Pragma("unroll") for (int it8 = 0; it8 < 8; ++it8) { const int p = tid + it8 * NTHREADS, kr = p >> 4, pc = p & 15; const int i = nb * 128 + kr - 128; \
            rg[it8] = (u32x4){0u, 0u, 0u, 0u}; rg[8 + it8] = (u32x4){0u, 0u, 0u, 0u}; \
            if (i >= 0 && !((CHAINED) && it8 < 4)) { const bf16_t* src = proj + (tokb + (size_t)i * dil) * 2560 + h * 128 + pc * 8; rg[it8] = *(const u32x4*)(src + 1536); rg[8 + it8] = *(const u32x4*)(src + 2048); } } \
        const size_t tq_ = tokb + (size_t)(nb * 128 + w * 16 + fr) * dil; \
        _Pragma("unroll") for (int ks = 0; ks < 4; ++ks) QF[ks] = __builtin_bit_cast(bf16x8, *(const u32x4*)(proj + tq_ * 2560 + 1024 + h * 128 + ks * 32 + fq * 8)); } while (0)
    bool chained = false; int flip = 0;
    AT_LOAD(item, false, qf);
    for (;;) {
        if (!chained) {
            flip = 0;
#pragma unroll
            for (int it8 = 0; it8 < 8; ++it8) { const int p = tid + it8 * NTHREADS, kr = p >> 4, pc = p & 15; *(LAS u32x4*)(Kt + kr * TP + pc * 16) = rg[it8]; *(LAS u32x4*)(Vt + kr * TP + pc * 16) = rg[8 + it8]; }
        } else {
            flip ^= 1;
#pragma unroll
            for (int it8 = 4; it8 < 8; ++it8) { const int p = tid + it8 * NTHREADS, kr = (p >> 4) & 127, pc = p & 15; const int pr = ((1 ^ flip) << 7) + kr;
                *(LAS u32x4*)(Kt + pr * TP + pc * 16) = rg[it8]; *(LAS u32x4*)(Vt + pr * TP + pc * 16) = rg[8 + it8]; }
        }
        __syncthreads();
        const int nitem = item + 1; const bool has_next = nitem < iend;
        bool chained_next = false;
        if (has_next) { const int g2 = nitem >> 10, nbm = (1 << (5 - 2 * g2)) - 1; chained_next = (g2 == (item >> 10)) && ((nitem & 1023 & nbm) != 0); }
        if (has_next) { if (chained_next) AT_LOAD(nitem, true, qn); else AT_LOAD(nitem, false, qn); }
        AT_DECODE(item)
        const int qi = w * 16 + fr;
        const size_t tokq = tokb + (size_t)(nb * 128 + qi) * dil;
        float pv[9][4]; float mx = -INFINITY;
#pragma unroll
        for (int jj = 0; jj < 9; ++jj) {
            const int tw = w + jj, pt = ((((tw >> 3) ^ flip) & 1) << 3) + (tw & 7);
            f32x4 st = {0.f, 0.f, 0.f, 0.f};
#pragma unroll
            for (int ks = 0; ks < 4; ++ks) st = MFMA16(*(LAS bf16x8*)(Kt + (pt * 16 + fr) * TP + ks * 64 + fq * 16), qf[ks], st);
#pragma unroll
            for (int rr = 0; rr < 4; ++rr) {
                const int kj = tw * 16 + fq * 4 + rr;
                const bool valid = (kj >= qi) && (kj <= qi + 128) && (nb > 0 || kj >= 128);
                pv[jj][rr] = valid ? st[rr] : -INFINITY; mx = fmaxf(mx, pv[jj][rr]);
            }
        }
        mx = fmaxf(mx, __shfl_xor(mx, 16)); mx = fmaxf(mx, __shfl_xor(mx, 32));
        float l = 0.f;
#pragma unroll
        for (int jj = 0; jj < 9; ++jj)
#pragma unroll
            for (int rr = 0; rr < 4; ++rr) { pv[jj][rr] = fexp(pv[jj][rr] - mx); l += pv[jj][rr]; }
        l += __shfl_xor(l, 16); l += __shfl_xor(l, 32);
        if (fq == 0) { ex[w * 16 + fr] = 1.0f / l; lse[((size_t)g * T + tokq) * 4 + h] = mx + logf(l); }
        __builtin_amdgcn_wave_barrier();
        const f32x4 inv4 = *(LAS f32x4*)(ex + w * 16 + fq * 4);
        f32x4 acc[8];
#pragma unroll
        for (int c = 0; c < 8; ++c) acc[c] = (f32x4){0.f, 0.f, 0.f, 0.f};
#pragma unroll
        for (int kk = 0; kk < 5; ++kk) {
            const int ja = 2 * kk, jb = (2 * kk + 1 < 9) ? 2 * kk + 1 : 2 * kk;
            const int twa = w + ja, twb = w + jb;
            const int pa_t = ((((twa >> 3) ^ flip) & 1) << 3) + (twa & 7), pb_t = ((((twb >> 3) ^ flip) & 1) << 3) + (twb & 7);
            u32x4 u; u.x = pk_bf16(pv[ja][0], pv[ja][1]); u.y = pk_bf16(pv[ja][2], pv[ja][3]);
            if (2 * kk + 1 < 9) { u.z = pk_bf16(pv[jb][0], pv[jb][1]); u.w = pk_bf16(pv[jb][2], pv[jb][3]); } else { u.z = 0u; u.w = 0u; }
            const bf16x8 pa = __builtin_bit_cast(bf16x8, u);
#pragma unroll
            for (int c = 0; c < 8; ++c) {
                const bf16x8 vbf = cat44(tr_read(Vt + (pa_t * 16 + 4 * fq + q) * TP + (c * 16 + 4 * p4) * 2), tr_read(Vt + (pb_t * 16 + 4 * fq + q) * TP + (c * 16 + 4 * p4) * 2));
                acc[c] = MFMA16(pa, vbf, acc[c]);
            }
        }
#pragma unroll
        for (int rr = 0; rr < 4; ++rr) {
            const size_t tq = tokb + (size_t)(nb * 128 + w * 16 + fq * 4 + rr) * dil;
#pragma unroll
            for (int c = 0; c < 8; ++c) atto[((size_t)g * T + tq) * 512 + h * 128 + c * 16 + fr] = (bf16_t)(pk_bf16(acc[c][rr] * inv4[rr], 0.f) & 0xffffu);
        }
        __syncthreads();
        if (!has_next) break;
        item = nitem; chained = chained_next;
#pragma unroll
        for (int ks = 0; ks < 4; ++ks) qf[ks] = qn[ks];
    }
#undef AT_LOAD
#undef AT_DECODE
}

__device__ __forceinline__ void ph_attn_combine(const Params& P) {
    const bf16_t* atto = (const bf16_t*)(P.ws + WS_ATTO); const float* lse = (const float*)(P.ws + WS_LSE); bf16_t* cat = (bf16_t*)(P.ws + WS_CAT);
    const size_t gtid = (size_t)blockIdx.x * NTHREADS + threadIdx.x, GT = (size_t)gridDim.x * NTHREADS;
    for (size_t i0 = gtid; i0 < (size_t)T * 128; i0 += 4 * GT) {
        float l[4][3]; u32x2 o[4][3];
#pragma unroll
        for (int j = 0; j < 4; ++j) {
            const size_t i = i0 + j * GT, tok = i >> 7; const int c4 = (int)(i & 127) * 4, h = c4 >> 7;
#pragma unroll
            for (int g = 0; g < 3; ++g) { l[j][g] = lse[((size_t)g * T + tok) * 4 + h]; o[j][g] = *(const u32x2*)(atto + ((size_t)g * T + tok) * 512 + c4); }
        }
#pragma unroll
        for (int j = 0; j < 4; ++j) {
            const size_t i = i0 + j * GT, tok = i >> 7; const int c4 = (int)(i & 127) * 4;
            const float mx = fmaxf(l[j][0], fmaxf(l[j][1], l[j][2])), e0 = expf(l[j][0] - mx), e1 = expf(l[j][1] - mx), e2 = expf(l[j][2] - mx), inv = 1.0f / (e0 + e1 + e2);
            f32x4 of[3];
#pragma unroll
            for (int g = 0; g < 3; ++g) of[g] = (f32x4){__uint_as_float(o[j][g].x << 16), __uint_as_float(o[j][g].x & 0xffff0000u), __uint_as_float(o[j][g].y << 16), __uint_as_float(o[j][g].y & 0xffff0000u)};
            store_bf16x4(cat + tok * 1024 + 512 + c4, (of[0] * e0 + of[1] * e1 + of[2] * e2) * inv);
        }
    }
}

constexpr int NPHASES = 33;
__device__ __forceinline__ void grid_barrier_cg(cg::grid_group& grid) {
    asm volatile("s_waitcnt vmcnt(0)" ::: "memory");
    grid.sync();
    __builtin_amdgcn_fence(__ATOMIC_ACQUIRE, "agent");
    asm volatile("s_waitcnt vmcnt(0)" ::: "memory");
}
#define XB_TMO      128
#define XB_XCNT(j)  (256  + 64 * (j))
#define XB_XSUB(j)  (1280 + 64 * (j))
#define XB_XGEN(j)  (2304 + 64 * (j))
#define XB_TOP      3328
#define XB_TOPGEN   3392
#define XCD_BAR_WORDS 3456
#define XB_SPIN_CAP (1u << 22)
__device__ __forceinline__ unsigned xb_ld(unsigned* p)              { return __hip_atomic_load(p, __ATOMIC_RELAXED, __HIP_MEMORY_SCOPE_AGENT); }
__device__ __forceinline__ unsigned xb_add(unsigned* p, unsigned v) { return __hip_atomic_fetch_add(p, v, __ATOMIC_RELAXED, __HIP_MEMORY_SCOPE_AGENT); }
__device__ __forceinline__ unsigned xb_xcc_id() { return (unsigned)__builtin_amdgcn_s_getreg((3 << 11) | 20) & 0xFu; }
#define XB_SPIN(cond, bar) do { unsigned _sp = 0; while (cond) { __builtin_amdgcn_s_sleep(1); \
    if ((++_sp & 255u) == 0u) { if (xb_ld(&(bar)[XB_TMO])) break; if (_sp > XB_SPIN_CAP) { atomicAdd(&(bar)[XB_TMO], 1u); break; } } } } while (0)
struct XcdBarrier { unsigned* bar; unsigned x; volatile LAS unsigned* st; };
__device__ __forceinline__ XcdBarrier xcd_barrier_post(unsigned* bar, volatile LAS unsigned* st) {
    XcdBarrier b; b.bar = bar; b.x = xb_xcc_id(); b.st = st;
    if (threadIdx.x == 0) (void)xb_add(&bar[XB_XCNT(b.x)], 1u);
    return b;
}
__device__ __forceinline__ void xcd_barrier_complete(unsigned* bar, unsigned x, unsigned& nloc, unsigned& nx) {
    const unsigned G = gridDim.x * gridDim.y * gridDim.z;
    unsigned sum, cnt, mine, sp = 0u;
    for (;;) {
        sum = 0u; cnt = 0u; mine = 0u;
#pragma unroll
        for (unsigned j = 0; j < 16; ++j) { const unsigned c = xb_ld(&bar[XB_XCNT(j)]); sum += c; cnt += (c > 0u) ? 1u : 0u; mine = (j == x) ? c : mine; }
        if (sum == G) break;
        __builtin_amdgcn_s_sleep(1);
        if ((++sp & 255u) == 0u) { if (xb_ld(&bar[XB_TMO])) break; if (sp > XB_SPIN_CAP) { atomicAdd(&bar[XB_TMO], 1u); break; } }
    }
    nloc = mine > 0u ? mine : 1u; nx = cnt > 0u ? cnt : 1u;
}
__device__ __forceinline__ void xcd_barrier(const XcdBarrier& b) {
    asm volatile("s_waitcnt vmcnt(0)" ::: "memory");
    __syncthreads();
    if (threadIdx.x == 0) {
        unsigned* bar = b.bar;
        __builtin_amdgcn_s_waitcnt(0);
        unsigned nloc = b.st[0], nx = b.st[1];
        if (nloc == 0u) { xcd_barrier_complete(bar, b.x, nloc, nx); b.st[0] = nloc; b.st[1] = nx; }
        const unsigned old = xb_add(&bar[XB_XSUB(b.x)], 1u);
        const unsigned gen = old / nloc;
        if (old + 1u == (gen + 1u) * nloc) {
            __builtin_amdgcn_fence(__ATOMIC_RELEASE, "agent");
            asm volatile("s_waitcnt vmcnt(0)" ::: "memory");
            const unsigned og = xb_add(&bar[XB_TOP], 1u);
            const unsigned tg = og / nx;
            if (og + 1u == (tg + 1u) * nx) xb_add(&bar[XB_TOPGEN], 1u);
            else XB_SPIN(xb_ld(&bar[XB_TOPGEN]) == tg, bar);
            __builtin_amdgcn_fence(__ATOMIC_ACQUIRE, "agent");
            xb_add(&bar[XB_XGEN(b.x)], 1u);
            asm volatile("s_waitcnt vmcnt(0)" ::: "memory");
        } else {
            XB_SPIN(xb_ld(&bar[XB_XGEN(b.x)]) == gen, bar);
            __builtin_amdgcn_fence(__ATOMIC_ACQUIRE, "agent");
            asm volatile("s_waitcnt vmcnt(0)" ::: "memory");
        }
    }
    __syncthreads();
}
typedef __attribute__((address_space(4))) const Params* KP4;
__device__ __forceinline__ const Params& phase_params() { KP4 kp = (KP4)__builtin_amdgcn_kernarg_segment_ptr(); asm volatile("" : "+s"(kp)); return *(const Params*)kp; }
__global__ void __launch_bounds__(NTHREADS) fwd_megakernel(Params Pk) {
    extern __shared__ __attribute__((aligned(16))) unsigned char lds_raw[];
    lds_t* lds = (lds_t*)lds_raw;
    cg::grid_group grid = cg::this_grid();
    const int ph_lo = Pk.ph_lo, ph_hi = Pk.ph_hi;
#ifdef PROBE_BLK
    const unsigned long long t_k0 = __builtin_amdgcn_s_memrealtime();
#endif
    unsigned* barw = (unsigned*)(Pk.ws + WS_CTL) + 4096;
    volatile LAS unsigned* bst = (volatile LAS unsigned*)(lds + LDS_BYTES - 64);
    if (threadIdx.x == 0) { bst[0] = 0u; bst[1] = 0u; }
    if (ph_hi < 0) grid_barrier_cg(grid);
    (void)xcd_barrier_post(barw, bst);
#define SEAM(k) do { XcdBarrier xb_; xb_.bar = (unsigned*)(P.ws + WS_CTL) + 4096; xb_.x = xb_xcc_id(); xb_.st = bst; xcd_barrier(xb_); } while (0)
#ifdef ONLY_PHASE
#define PHASE(k, ...) if constexpr ((k) == ONLY_PHASE) { const Params& P = phase_params(); unsigned char* ws = P.ws; (void)ws; __VA_ARGS__; SEAM(k); }
#else
#ifndef PHASE_MASK
#define PHASE_MASK 0xffffffffu
#endif
#ifndef REPEAT_MASK
#define REPEAT_MASK 0u
#endif
#ifdef SPAN_LO
    unsigned long long t_span0 = 0, t_span1 = 0;
#define SPAN_T0(k) if ((k) == SPAN_LO) t_span0 = __builtin_amdgcn_s_memrealtime();
#define SPAN_T1(k) if ((k) == SPAN_HI) t_span1 = __builtin_amdgcn_s_memrealtime();
#else
#define SPAN_T0(k)
#define SPAN_T1(k)
#endif
#define PHASE(k, ...) if (((PHASE_MASK >> (k)) & 1u) && ph_lo <= (k) && (k) < ph_hi) { const Params& P = phase_params(); unsigned char* ws = P.ws; (void)ws; SPAN_T0(k) \
    if constexpr (((REPEAT_MASK >> (k)) & 1u) != 0u) { __VA_ARGS__; SEAM(k); } \
    __VA_ARGS__; if ((k) + 1 < ph_hi) SEAM(k); SPAN_T1(k) }
#endif
    PHASE(0, phase0(P, lds))
#ifdef PROBE_BLK
    if ((int)blockIdx.x == PROBE_BLK && threadIdx.x == 0 && PROBE_PT == 7) *(unsigned long long*)(Pk.ws + WS_CTL + 60000) = __builtin_amdgcn_s_memrealtime();
#endif
    PHASE(1, ph_inproj2(P, lds, (const bf16_t*)(ws + WS_WABIN), 1536, nullptr))
    PHASE(2, ph_conv0(P); ph_s5_state(P, lds))
    PHASE(3, ph_gates0(P, lds); ph_s5_carry(P))
    PHASE(4, ph_s5_out(P, lds))
    PHASE(5, ph_glu(P, lds); ph_lru_scan(P, lds))
    PHASE(6, ph_outproj2(P, lds, (const bf16_t*)(ws + WS_WABOUT)))
#ifdef PROBE_LN7
    PHASE(7, ph_ln_router(P, lds, 0, P.in[I_X], 1); SEAM(7); ph_ln_router(P, lds, 0, P.in[I_X]))
#else
    PHASE(7, ph_ln_router(P, lds, 0, P.in[I_X]))
#endif
    PHASE(8, ph_route_scatter(P, lds, 0))
    PHASE(9, ph_moe_up2(P, lds, 0))
    PHASE(10, ph_moe_down2(P, lds, 0))
#ifdef PROBE_LN11
    PHASE(11, ph_combine_ln(P, 0, nullptr))
#else
    PHASE(11, ph_combine_ln(P, 0, nullptr))
#endif
    PHASE(12, ph_inproj2(P, lds, (const bf16_t*)(ws + WS_WCDIN), 2560, (const int*)P.in[I_POS]); moe_pstart(P, lds, 0); convert_moe_weights(P, 1, tail_done_all(((LAS int*)(lds + PS_OFF))[32] >> 8, (int)gridDim.x), lds))
    PHASE(13, ph_conv1(P, lds))
    PHASE(14, ph_qkv(P, lds))
    PHASE(15, ph_m1(P, lds); ph_attn(P, lds))
    PHASE(16, ph_m2(P); ph_attn_combine(P))
    PHASE(17, ph_m3(P, lds))
    PHASE(18, ph_outproj2(P, lds, (const bf16_t*)(ws + WS_WCDOUT)))
    PHASE(19, ph_ln_router(P, lds, 1, nullptr))
    PHASE(20, ph_route_scatter(P, lds, 1))
    PHASE(21, ph_moe_up2(P, lds, 1))
    PHASE(22, ph_moe_down2(P, lds, 1))
#ifdef EXTRA_BARRIERS
    { const Params& P = phase_params(); for (int xb2_ = 0; xb2_ < EXTRA_BARRIERS; ++xb2_) SEAM(0); }
#endif
    PHASE(23, ph_combine_ln(P, 1, P.out))
#undef PHASE
#ifdef PROBE_BLK
    if (blockIdx.x == 0 && threadIdx.x == 0) {
        const unsigned long long st = __hip_atomic_load((unsigned long long*)(Pk.ws + WS_CTL + 60000), __ATOMIC_RELAXED, __HIP_MEMORY_SCOPE_AGENT);
        const unsigned long long d = (st > t_k0 ? st - t_k0 : 0ull) * 4ull, t0 = __builtin_amdgcn_s_memrealtime();
        while (__builtin_amdgcn_s_memrealtime() - t0 < d) __builtin_amdgcn_s_sleep(8);
    }
#endif
#ifdef SPAN_LO
    if (blockIdx.x == 0 && threadIdx.x == 0) {
        const unsigned long long d = (t_span1 - t_span0) * 4ull, t0 = __builtin_amdgcn_s_memrealtime();
        while (__builtin_amdgcn_s_memrealtime() - t0 < d) __builtin_amdgcn_s_sleep(8);
    }
#endif
}

extern "C" void kernel_launch(void* const* d_in, const int* in_sizes, int n_in, void* d_out, int out_size, void* d_ws, size_t ws_size, hipStream_t stream) {
    static int grid_blocks = 0;
    if (grid_blocks == 0) {
        if (n_in != N_IN || out_size != T * D || ws_size < WS_END) { fprintf(stderr, "kernel_launch: unexpected shapes (n_in %d out %d ws %zu need %zu)\n", n_in, out_size, ws_size, (size_t)WS_END); grid_blocks = -1; return; }
        int dev = 0, cus = 0, per_cu = 0;
        (void)hipGetDevice(&dev);
        (void)hipDeviceGetAttribute(&cus, hipDeviceAttributeMultiprocessorCount, dev);
        if (hipFuncSetAttribute((const void*)fwd_megakernel, hipFuncAttributeMaxDynamicSharedMemorySize, LDS_BYTES) != hipSuccess) { fprintf(stderr, "kernel_launch: hipFuncSetAttribute failed\n"); grid_blocks = -1; return; }
        (void)hipOccupancyMaxActiveBlocksPerMultiprocessor(&per_cu, (const void*)fwd_megakernel, NTHREADS, LDS_BYTES);
        if (per_cu < 1) { fprintf(stderr, "kernel_launch: occupancy query returned %d\n", per_cu); grid_blocks = -1; return; }
        grid_blocks = cus * per_cu;
        if (grid_blocks != 256) { fprintf(stderr, "kernel_launch: built for a 256-workgroup resident grid (256 CUs x 1), got %d x %d; nothing launched\n", cus, per_cu); grid_blocks = -1; return; }
    }
    if (grid_blocks < 0) return;
    (void)hipMemsetAsync((unsigned char*)d_ws + WS_CTL, 0, 65536, stream);
    Params p{};
    for (int i = 0; i < N_IN; ++i) p.in[i] = (const float*)d_in[i];
    p.out = (float*)d_out; p.ws = (unsigned char*)d_ws;
    p.ph_lo = 0; p.ph_hi = 24;
    void* args[] = {&p};
    hipError_t e = hipLaunchCooperativeKernel((const void*)fwd_megakernel, dim3(grid_blocks), dim3(NTHREADS), args, LDS_BYTES, stream);
    if (e != hipSuccess) fprintf(stderr, "cooperative launch failed: %s (grid %d)\n", hipGetErrorString(e), grid_blocks);
}
```

```cpp
#include <hip/hip_runtime.h>
#include <hip/hip_cooperative_groups.h>
#include <cstdio>
#include <cstdint>
namespace cg = cooperative_groups;

#define LAS __attribute__((address_space(3)))
typedef unsigned short bf16_t;
typedef short bf16x8 __attribute__((ext_vector_type(8)));
typedef short bf16x4 __attribute__((ext_vector_type(4)));
typedef float f32x4 __attribute__((ext_vector_type(4)));
typedef unsigned u32x4 __attribute__((ext_vector_type(4)));
typedef unsigned u32x2 __attribute__((ext_vector_type(2)));
typedef LAS unsigned char lds_t;

constexpr int T = 32768, D = 1024, SEQ = 4096;
constexpr int NTHREADS = 512;
constexpr int LDS_BYTES = 160 * 1024;
constexpr int PS_OFF = LDS_BYTES - 1024;
constexpr int MTAB_OFF = 128 * 1024;
constexpr float ALPHA = 1.4142135623730951f;
constexpr float LN_EPS = 1e-5f;
constexpr int MOE_ROWS = 139264;
constexpr int S5TC = 32;
constexpr int S5K = S5TC * 16 + 128;

enum { I_X = 0, I_POS, I_AB_WIN, I_AB_CONVW, I_AB_CONVB, I_AB_GRW, I_AB_GRB, I_AB_GIW, I_AB_GIB, I_AB_LAMBDA,
       I_S5_LRE, I_S5_LIM, I_S5_STEP, I_S5_BRE, I_S5_BIM, I_S5_CRE, I_S5_CIM, I_S5_D, I_AB_GLUW, I_AB_GLUB, I_AB_WOUT,
       I_CD_WIN, I_CD_CONVW, I_CD_CONVB, I_CD_WQ, I_CD_WK, I_CD_WV, I_CD_WIF, I_CD_BIF, I_CD_WOUT,
       I_LNM_G, I_LNM_B, I_LNF_G, I_LNF_B, I_R_W, I_R_B, I_M_WIN, I_M_BIN, I_M_WOUT, I_M_BOUT, N_IN };

constexpr size_t MiB = 1ull << 20;
constexpr size_t WS_CTL = 0;
constexpr size_t WS_XB = 1 * MiB;
constexpr size_t WS_WABIN = 65 * MiB;
constexpr size_t WS_WGLU = 68 * MiB;
constexpr size_t WS_WABOUT = 69 * MiB;
constexpr size_t WS_WCDIN = 71 * MiB;
constexpr size_t WS_WCDOUT = 76 * MiB;
constexpr size_t WS_WG = 78 * MiB;
constexpr size_t WS_WQKV = 78 * MiB + 256 * 1024;
constexpr size_t WS_WC = 79 * MiB;
constexpr size_t WS_S5TM = 80 * MiB;
constexpr size_t WS_S5WST = 100 * MiB;
constexpr size_t WS_MWIN = 104 * MiB;
constexpr size_t WS_MWOUT = 232 * MiB;
constexpr size_t WS_PROJ = 296 * MiB;
constexpr size_t WS_CAT = 456 * MiB;
constexpr size_t WS_X1F = 520 * MiB;
constexpr size_t WS_ZF = 648 * MiB;
constexpr size_t WS_HACT = 776 * MiB;
constexpr size_t WS_YB = 1048 * MiB;
constexpr size_t WS_ROUTE = 1320 * MiB;
constexpr size_t WS_SCR = 1328 * MiB;
constexpr size_t WS_XC = WS_SCR;
constexpr size_t WS_AF = WS_SCR + 32 * MiB;
constexpr size_t WS_UF = WS_SCR + 96 * MiB;
constexpr size_t WS_SB = WS_SCR + 160 * MiB;
constexpr size_t WS_S5S = WS_SCR + 192 * MiB;
constexpr size_t WS_S5X = WS_SCR + 208 * MiB;
constexpr size_t WS_XCONV = WS_SCR;
constexpr size_t WS_QB = WS_SCR + 32 * MiB;
constexpr size_t WS_KB = WS_SCR + 64 * MiB;
constexpr size_t WS_VB = WS_SCR + 96 * MiB;
constexpr size_t WS_GATES = WS_SCR + 128 * MiB;
constexpr size_t WS_KVC = WS_SCR + 130 * MiB;
constexpr size_t WS_CPREV = WS_SCR + 258 * MiB;
constexpr size_t WS_MISC = WS_SCR + 322 * MiB;
constexpr size_t WS_ATTO = WS_SCR + 326 * MiB;
constexpr size_t WS_LSE = WS_SCR + 518 * MiB;
constexpr size_t WS_MW1 = WS_SCR + 520 * MiB;
constexpr size_t WS_END = WS_MW1 + 192 * MiB;

struct Params { const float* in[N_IN]; float* out; unsigned char* ws; int ph_lo, ph_hi; };

__device__ __forceinline__ float bf2f(unsigned short b) { return __uint_as_float(((unsigned)b) << 16); }
typedef __bf16 bf16v2_t __attribute__((ext_vector_type(2)));
typedef float f32x2 __attribute__((ext_vector_type(2)));
__device__ __forceinline__ unsigned pk_bf16(float lo, float hi) { const f32x2 v = {lo, hi}; return __builtin_bit_cast(unsigned, __builtin_convertvector(v, bf16v2_t)); }
__device__ __forceinline__ float wave_sum(float v) {
#pragma unroll
    for (int o = 1; o < 64; o <<= 1) v += __shfl_xor(v, o);
    return v;
}
__device__ __forceinline__ float wave_max(float v) {
#pragma unroll
    for (int o = 1; o < 64; o <<= 1) v = fmaxf(v, __shfl_xor(v, o));
    return v;
}
__device__ __forceinline__ float fsigmoid(float x) { return __builtin_amdgcn_rcpf(1.0f + __builtin_amdgcn_exp2f(-1.4426950408889634f * x)); }
__device__ __forceinline__ float fexp(float x) { return __builtin_amdgcn_exp2f(1.4426950408889634f * x); }
__device__ __forceinline__ float flog(float x) { return 0.6931471805599453f * __builtin_amdgcn_logf(x); }
__device__ __forceinline__ void fsincos(float x, float& sn, float& cs) {
    const float n = rintf(x * 0.15915494309189535f);
    float r = fmaf(-n, 6.28125f, x); r = fmaf(-n, 0.0019353071795864769f, r);
    const float rev = r * 0.15915494309189535f;
    sn = __builtin_amdgcn_sinf(rev); cs = __builtin_amdgcn_cosf(rev);
}
__device__ __forceinline__ float gelu_tanh(float x) { return x * fsigmoid(1.5957691216057308f * (x + 0.044715f * x * x * x)); }
__device__ __forceinline__ float logsigmoidf(float x) { return fminf(x, 0.f) - log1pf(expf(-fabsf(x))); }
__device__ __forceinline__ void unpack8(u32x4 v, float (&f)[8]) {
    f[0] = __uint_as_float(v.x << 16); f[1] = __uint_as_float(v.x & 0xffff0000u);
    f[2] = __uint_as_float(v.y << 16); f[3] = __uint_as_float(v.y & 0xffff0000u);
    f[4] = __uint_as_float(v.z << 16); f[5] = __uint_as_float(v.z & 0xffff0000u);
    f[6] = __uint_as_float(v.w << 16); f[7] = __uint_as_float(v.w & 0xffff0000u);
}
__device__ __forceinline__ u32x4 pack8(const float (&f)[8]) { u32x4 o; o.x = pk_bf16(f[0], f[1]); o.y = pk_bf16(f[2], f[3]); o.z = pk_bf16(f[4], f[5]); o.w = pk_bf16(f[6], f[7]); return o; }
__device__ __forceinline__ bf16x4 tr_read(lds_t* p) { return __builtin_amdgcn_ds_read_tr16_b64_v4i16((LAS bf16x4*)p); }
__device__ __forceinline__ bf16x8 cat44(bf16x4 a, bf16x4 b) { bf16x8 r = {a[0], a[1], a[2], a[3], b[0], b[1], b[2], b[3]}; return r; }
#define MFMA16(a, b, c) __builtin_amdgcn_mfma_f32_16x16x32_bf16((a), (b), (c), 0, 0, 0)
typedef int i32x8 __attribute__((ext_vector_type(8)));
__device__ __forceinline__ f32x4 mfma_fp8(i32x8 a, i32x8 b, f32x4 c) { return __builtin_amdgcn_mfma_scale_f32_16x16x128_f8f6f4(a, b, c, 0, 0, 0, 0x7f7f7f7f, 0, 0x7f7f7f7f); }
typedef int i32x4 __attribute__((ext_vector_type(4)));
__device__ __forceinline__ i32x8 ld_frag8(lds_t* p) { const i32x4 lo = *(const LAS i32x4*)p, hi = *(const LAS i32x4*)(p + 1024); return __builtin_shufflevector(lo, hi, 0, 1, 2, 3, 4, 5, 6, 7); }
__device__ __forceinline__ unsigned pk_fp8x4(f32x4 v) {
    unsigned w = 0;
    w = __builtin_amdgcn_cvt_pk_fp8_f32(fminf(fmaxf(v[0], -448.f), 448.f), fminf(fmaxf(v[1], -448.f), 448.f), w, false);
    w = __builtin_amdgcn_cvt_pk_fp8_f32(fminf(fmaxf(v[2], -448.f), 448.f), fminf(fmaxf(v[3], -448.f), 448.f), w, true);
    return w;
}
constexpr float FP8_SX = 4.0f, FP8_SWIN = 32.0f, FP8_SH = 8.0f, FP8_SWOUT = 64.0f;

constexpr int E1_PITCH = 144;
constexpr int E1_A = 256 * E1_PITCH;
constexpr int E1_B = 128 * E1_PITCH;
constexpr int E1_BUF = E1_A + E1_B;

template <bool TRANS, class NK, class AL, class BL, class EP>
__device__ __forceinline__ void e1_stream(lds_t* lds, int ntiles, NK nkf, AL aload, BL bload, EP epi) {
    if (ntiles <= 0) return;
    const int tid = threadIdx.x, lane = tid & 63, wave = tid >> 6, wr = wave >> 1, wc = wave & 1, fr = lane & 15, fq = lane >> 4;
    const int prow = tid >> 3, pc = tid & 7;
    f32x4 acc[4][4];
#pragma unroll
    for (int m = 0; m < 4; ++m)
#pragma unroll
        for (int n = 0; n < 4; ++n) acc[m][n] = (f32x4){0.f, 0.f, 0.f, 0.f};
    u32x4 ra0[4], rb0[2], ra1[4], rb1[2];
#define E1S_LOAD(RA, RB, J, TT) do { _Pragma("unroll") for (int i = 0; i < 4; ++i) RA[i] = aload((J), i, prow + 64 * i, (TT) * 8 + pc); \
        _Pragma("unroll") for (int i = 0; i < 2; ++i) RB[i] = bload((J), i, prow + 64 * i, (TT) * 8 + pc); } while (0)
#define E1S_WRITE(RA, RB, BUF) do { lds_t* nb_ = lds + (BUF) * E1_BUF; \
        _Pragma("unroll") for (int i = 0; i < 4; ++i) *(LAS u32x4*)(nb_ + (prow + 64 * i) * E1_PITCH + pc * 16) = RA[i]; \
        _Pragma("unroll") for (int i = 0; i < 2; ++i) *(LAS u32x4*)(nb_ + E1_A + (prow + 64 * i) * E1_PITCH + pc * 16) = RB[i]; } while (0)
#define E1S_ADV(J, TT, V) do { if ((TT) + 1 < nkf(J)) { ++(TT); } else { ++(J); (TT) = 0; } (V) = (J) < ntiles; } while (0)
#define E1S_COMPUTE(BUF) do { lds_t* Ab = lds + (BUF) * E1_BUF + (wr * 64 + fr) * E1_PITCH + fq * 16; lds_t* Bb = lds + (BUF) * E1_BUF + E1_A + (wc * 64 + fr) * E1_PITCH + fq * 16; \
        _Pragma("unroll") for (int kk = 0; kk < 2; ++kk) { bf16x8 af[4], bfr[4]; \
            _Pragma("unroll") for (int m = 0; m < 4; ++m) af[m] = *(LAS bf16x8*)(Ab + m * 16 * E1_PITCH + kk * 64); \
            _Pragma("unroll") for (int n = 0; n < 4; ++n) bfr[n] = *(LAS bf16x8*)(Bb + n * 16 * E1_PITCH + kk * 64); \
            _Pragma("unroll") for (int m = 0; m < 4; ++m) _Pragma("unroll") for (int n = 0; n < 4; ++n) acc[m][n] = TRANS ? MFMA16(bfr[n], af[m], acc[m][n]) : MFMA16(af[m], bfr[n], acc[m][n]); } \
        if (t0 + 1 == nkf(j0)) { epi(j0, acc, wr, wc, fr, fq); \
            _Pragma("unroll") for (int m = 0; m < 4; ++m) _Pragma("unroll") for (int n = 0; n < 4; ++n) acc[m][n] = (f32x4){0.f, 0.f, 0.f, 0.f}; } } while (0)
    int j0 = 0, t0 = 0, j1 = 0, t1 = 0, j2, t2; bool v1, v2;
    E1S_ADV(j1, t1, v1); j2 = j1; t2 = t1; v2 = v1; if (v1) E1S_ADV(j2, t2, v2);
    E1S_LOAD(ra0, rb0, 0, 0);
    if (v1) E1S_LOAD(ra1, rb1, j1, t1);
    E1S_WRITE(ra0, rb0, 0);
    __syncthreads();
    int cb = 0;
    for (;;) {
        if (v2) E1S_LOAD(ra0, rb0, j2, t2);
        E1S_COMPUTE(cb);
        if (v1) E1S_WRITE(ra1, rb1, cb ^ 1);
        __syncthreads();
        if (!v1) break;
        j0 = j1; t0 = t1; j1 = j2; t1 = t2; v1 = v2; if (v2) E1S_ADV(j2, t2, v2); cb ^= 1;
        if (v2) E1S_LOAD(ra1, rb1, j2, t2);
        E1S_COMPUTE(cb);
        if (v1) E1S_WRITE(ra0, rb0, cb ^ 1);
        __syncthreads();
        if (!v1) break;
        j0 = j1; t0 = t1; j1 = j2; t1 = t2; v1 = v2; if (v2) E1S_ADV(j2, t2, v2); cb ^= 1;
    }
#undef E1S_LOAD
#undef E1S_WRITE
#undef E1S_ADV
#undef E1S_COMPUTE
}
__device__ __forceinline__ int wg_tiles(int total) { const int b = (int)blockIdx.x, G = (int)gridDim.x; return b < total ? (total - b + G - 1) / G : 0; }

namespace g2 {
constexpr int HTB = 16384;
__device__ __forceinline__ int lds_byte(int r, int c) { const int st = (r >> 4) * 2 + (c >> 5), rr = r & 15, cc = c & 31, ob = rr * 64 + cc * 2; return st * 1024 + (ob ^ (((ob >> 9) & 1) << 5)); }
__device__ __forceinline__ void stage_rc(int b, int& R, int& C) { const int st = b / 1024, sb = b % 1024, swz = sb ^ (((sb >> 9) & 1) << 5); R = (st >> 1) * 16 + swz / 64; C = (st & 1) * 32 + (swz % 64) / 2; }
struct Unit { int pm, pn, idx; };
__device__ __forceinline__ bool static_next(int i, int G, int c, int nM, int nN, Unit& u) {
    const int nwg = nM * nN; const long L = (long)i * G + c; if (L >= nwg) return false;
    int wgid = (int)L; { const int q = nwg / 8, r = nwg % 8, xcd = wgid % 8, off = wgid / 8; wgid = (xcd < r ? xcd * (q + 1) : r * (q + 1) + (xcd - r) * q) + off; }
    const int nig = 8 * nN, gid = wgid / nig, fm = gid * 8, gsz = (nM - fm) < 8 ? (nM - fm) : 8;
    u.pm = fm + ((wgid % nig) % gsz); u.pn = (wgid % nig) / gsz; u.idx = i; return true;
}
template <bool FP8, class Sched, class Epi>
__device__ __forceinline__ void gemm_phase(lds_t* lds, const char* Abase, int nt  , unsigned ldb_bytes, const Sched& S, const Epi& E) {
    const int tid = threadIdx.x, wid = __builtin_amdgcn_readfirstlane(tid >> 6), lane = tid & 63, wr = wid >> 2, wc = wid & 3, fr = lane & 15, fq = lane >> 4;
    unsigned voffB0; { int R0, C0; stage_rc(tid * 16, R0, C0); voffB0 = (unsigned)R0 * ldb_bytes + (unsigned)C0 * 2u; }
    const size_t hstepB = (size_t)128 * ldb_bytes;
    const unsigned ldsw = (unsigned)wid * 1024u;
    const int aoff = lds_byte(wr * 64 + fr, fq * 8), boff = lds_byte(wc * 32 + fr, fq * 8);
#define G2_SA(b, h) (((b) * 2 + (h)) * g2::HTB)
#define G2_SB(b, h) ((4 + (b) * 2 + (h)) * g2::HTB)
#define G2_STAGE_A(bufoff, offs, kb) do { _Pragma("unroll") for (int _i = 0; _i < 2; ++_i) \
        __builtin_amdgcn_global_load_lds((const unsigned*)((Abase + (kb)) + (offs)[_i]), (LAS unsigned*)(lds + (bufoff) + ldsw + _i * 8192), 16, 0, 0); } while (0)
#define G2_STAGE_B(bufoff, gbase) do { _Pragma("unroll") for (int _i = 0; _i < 2; ++_i) \
        __builtin_amdgcn_global_load_lds((const unsigned*)(((const char*)(gbase) + (size_t)_i * 64 * ldb_bytes) + voffB0), (LAS unsigned*)(lds + (bufoff) + ldsw + _i * 8192), 16, 0, 0); } while (0)
#define G2_LDA(dst, b, h) do { _Pragma("unroll") for (int m = 0; m < 4; ++m) { if constexpr (FP8) { if (m < 2) dst##8[m] = ld_frag8(lds + G2_SA(b, h) + aoff + m * 2048); } \
        else { _Pragma("unroll") for (int k = 0; k < 2; ++k) dst[m][k] = *(const LAS bf16x8*)(lds + G2_SA(b, h) + aoff + m * 2048 + k * 1024); } } } while (0)
#define G2_LDB(dst, b, h) do { _Pragma("unroll") for (int n = 0; n < 2; ++n) { if constexpr (FP8) dst##8[n] = ld_frag8(lds + G2_SB(b, h) + boff + n * 2048); \
        else { _Pragma("unroll") for (int k = 0; k < 2; ++k) dst[n][k] = *(const LAS bf16x8*)(lds + G2_SB(b, h) + boff + n * 2048 + k * 1024); } } } while (0)
#define G2_MMA(ai, bj, At, Bt) do { __builtin_amdgcn_s_setprio(1); _Pragma("unroll") for (int m = 0; m < 4; ++m) _Pragma("unroll") for (int n = 0; n < 2; ++n) { \
        if constexpr (FP8) acc[ai][bj][m][n] = mfma_fp8(Bt##8[n], At##8[m], acc[ai][bj][m][n]); \
        else { _Pragma("unroll") for (int k = 0; k < 2; ++k) acc[ai][bj][m][n] = __builtin_amdgcn_mfma_f32_16x16x32_bf16(Bt[n][k], At[m][k], acc[ai][bj][m][n], 0, 0, 0); } } \
        __builtin_amdgcn_s_setprio(0); } while (0)
#define G2_MMAP(ai, b, h) do { if constexpr (!FP8) { G2_MMA(ai, 0, At, B0); G2_MMA(ai, 1, At, B1); } else { __builtin_amdgcn_s_setprio(1); \
        _Pragma("unroll") for (int m = 0; m < 2; ++m) _Pragma("unroll") for (int n = 0; n < 2; ++n) { acc[ai][0][m][n] = mfma_fp8(B08[n], At8[m], acc[ai][0][m][n]); acc[ai][1][m][n] = mfma_fp8(B18[n], At8[m], acc[ai][1][m][n]); } \
        At8[0] = ld_frag8(lds + G2_SA(b, h) + aoff + 2 * 2048); At8[1] = ld_frag8(lds + G2_SA(b, h) + aoff + 3 * 2048); \
        _Pragma("unroll") for (int m = 0; m < 2; ++m) _Pragma("unroll") for (int n = 0; n < 2; ++n) { acc[ai][0][m + 2][n] = mfma_fp8(B08[n], At8[m], acc[ai][0][m + 2][n]); acc[ai][1][m + 2][n] = mfma_fp8(B18[n], At8[m], acc[ai][1][m + 2][n]); } \
        __builtin_amdgcn_s_setprio(0); } } while (0)
#define G2_WAIT_V(n) asm volatile("s_waitcnt vmcnt(" #n ")" ::: "memory")
#define G2_WAIT_L(n) asm volatile("s_waitcnt lgkmcnt(" #n ")" ::: "memory")
#define G2_BAR __builtin_amdgcn_s_barrier()
#define G2_SCHED __builtin_amdgcn_sched_barrier(0)
#define G2_SCHED8 do { if constexpr (FP8) __builtin_amdgcn_sched_barrier(0); } while (0)
    Unit cur, nxt; int ui = 0;
    if (!S.next(0, cur)) return;
    f32x4 acc[2][2][4][2];
#pragma unroll
    for (int a = 0; a < 2; ++a)
#pragma unroll
        for (int b = 0; b < 2; ++b)
#pragma unroll
            for (int m = 0; m < 4; ++m)
#pragma unroll
                for (int n = 0; n < 2; ++n) acc[a][b][m][n] = (f32x4){0.f, 0.f, 0.f, 0.f};
    bf16x8 At[4][2], B0[2][2], B1[2][2]; i32x8 At8[2], B08[2], B18[2];
    unsigned aoC[2][2], aoN[2][2];
    S.a_off(cur, aoC);
    const char* cB = S.b_base(cur);
    G2_STAGE_B(G2_SB(0, 0), cB); G2_STAGE_B(G2_SB(0, 1), cB + hstepB); G2_STAGE_A(G2_SA(0, 0), aoC[0], 0); G2_STAGE_A(G2_SA(0, 1), aoC[1], 0);
    if (wr == 1) G2_BAR;
    G2_WAIT_V(2); G2_BAR;
    G2_STAGE_B(G2_SB(1, 0), cB + 128); G2_STAGE_A(G2_SA(1, 0), aoC[0], 128); G2_STAGE_B(G2_SB(1, 1), cB + hstepB + 128);
    G2_WAIT_V(6); G2_BAR;
    for (;;) {
        const bool has_next = S.next(ui + 1, nxt);
        const char* nB = cB;
        if constexpr (!Sched::CHEAP_AOFF) {
#pragma unroll
            for (int h = 0; h < 2; ++h)
#pragma unroll
                for (int i = 0; i < 2; ++i) aoN[h][i] = aoC[h][i];
            if (has_next) S.a_off(nxt, aoN);
        }
        if (has_next) nB = S.b_base(nxt);
#pragma unroll 1
        for (int t = 0; t < nt; t += 2) {
            const bool last = (t == nt - 2);
            const unsigned k1 = (unsigned)(t + 1) * 128u, k2 = last ? 0u : (unsigned)(t + 2) * 128u, k3 = k2 + 128u;
            unsigned a2o[2][2];
#pragma unroll
            for (int h = 0; h < 2; ++h)
#pragma unroll
                for (int i = 0; i < 2; ++i) a2o[h][i] = (!Sched::CHEAP_AOFF && last) ? aoN[h][i] : aoC[h][i];
            if constexpr (Sched::CHEAP_AOFF) { if (last && has_next) S.a_off(nxt, a2o); }
            const char* b2 = last ? nB : cB + (size_t)(t + 2) * 128; const char* b3 = b2 + 128;
            G2_LDB(B0, 0, 0); G2_LDB(B1, 0, 1); G2_SCHED; G2_LDA(At, 0, 0); G2_STAGE_A(G2_SA(1, 1), aoC[1], k1);
            G2_WAIT_V(8); G2_WAIT_L(0); G2_BAR; G2_MMAP(0, 0, 0); G2_BAR; G2_SCHED;
            G2_LDA(At, 0, 1); G2_STAGE_B(G2_SB(0, 0), b2); G2_STAGE_B(G2_SB(0, 1), b2 + hstepB); G2_STAGE_A(G2_SA(0, 0), a2o[0], k2);
            G2_WAIT_V(8); G2_WAIT_L(0); G2_BAR; G2_MMAP(1, 0, 1); G2_BAR; G2_SCHED;
            G2_LDB(B0, 1, 0); G2_LDB(B1, 1, 1); G2_SCHED; G2_LDA(At, 1, 0); G2_STAGE_A(G2_SA(0, 1), a2o[1], k2);
            G2_WAIT_V(8); G2_WAIT_L(0); G2_BAR; G2_MMAP(0, 1, 0); G2_BAR; G2_SCHED;
            G2_LDA(At, 1, 1); G2_STAGE_B(G2_SB(1, 0), b3); G2_STAGE_B(G2_SB(1, 1), b3 + hstepB); G2_STAGE_A(G2_SA(1, 0), a2o[0], k3);
            G2_WAIT_V(8); G2_WAIT_L(0); G2_BAR; G2_MMAP(1, 1, 1); G2_BAR; G2_SCHED;
        }
        if (wr == 0) G2_BAR;
        { int lane_e = (int)(threadIdx.x & 63); asm volatile("" : "+v"(lane_e));
          E(acc, cur, wr, wc, lane_e & 15, lane_e >> 4); }
        if (!has_next) break;
#pragma unroll
        for (int a = 0; a < 2; ++a)
#pragma unroll
            for (int b = 0; b < 2; ++b)
#pragma unroll
                for (int m = 0; m < 4; ++m)
#pragma unroll
                    for (int n = 0; n < 2; ++n) acc[a][b][m][n] = (f32x4){0.f, 0.f, 0.f, 0.f};
        cur = nxt; cB = nB; ++ui;
        if constexpr (Sched::CHEAP_AOFF) S.a_off(cur, aoC);
        else {
#pragma unroll
            for (int h = 0; h < 2; ++h)
#pragma unroll
                for (int i = 0; i < 2; ++i) aoC[h][i] = aoN[h][i];
        }
        if (wr == 1) G2_BAR;
    }
    G2_WAIT_V(0);
    G2_BAR;
#undef G2_SA
#undef G2_SB
#undef G2_STAGE_A
#undef G2_STAGE_B
#undef G2_LDA
#undef G2_LDB
#undef G2_MMA
#undef G2_MMAP
#undef G2_WAIT_V
#undef G2_WAIT_L
#undef G2_BAR
#undef G2_SCHED
#undef G2_SCHED8
}
struct DenseSched {
    static constexpr bool CHEAP_AOFF = false;
    int G, c, nM, nN, K; const char* Bt;
    __device__ __forceinline__ bool next(int i, Unit& u) const { return static_next(i, G, c, nM, nN, u); }
    __device__ __forceinline__ void a_off(const Unit& u, unsigned (&ao)[2][2]) const {
        int Rs[2], Cs[2];
#pragma unroll
        for (int i = 0; i < 2; ++i) stage_rc((int)threadIdx.x * 16 + i * 8192, Rs[i], Cs[i]);
#pragma unroll
        for (int h = 0; h < 2; ++h)
#pragma unroll
            for (int i = 0; i < 2; ++i) ao[h][i] = ((unsigned)(u.pm * 256 + h * 128 + Rs[i]) * (unsigned)K + (unsigned)Cs[i]) * 2u;
    }
    __device__ __forceinline__ const char* b_base(const Unit& u) const { return Bt + (size_t)u.pn * 256 * K * 2; }
};
}

template <class RM>
__device__ __forceinline__ void transpose_item(const float* __restrict__ W, int N, bf16_t* __restrict__ WT, int ldwt, int k0, int n0, RM rowmap, LAS float* scr, int lane) {
#pragma unroll 16
    for (int i = 0; i < 64; ++i) scr[i * 65 + lane] = W[(size_t)(k0 + i) * N + n0 + lane];
    __builtin_amdgcn_wave_barrier();
    const int c = lane & 7;
#pragma unroll
    for (int j = 0; j < 8; ++j) {
        const int n = (lane >> 3) + 8 * j;
        const LAS float* s = scr + (8 * c) * 65 + n;
        u32x4 o; o.x = pk_bf16(s[0], s[65]); o.y = pk_bf16(s[2 * 65], s[3 * 65]); o.z = pk_bf16(s[4 * 65], s[5 * 65]); o.w = pk_bf16(s[6 * 65], s[7 * 65]);
        *(u32x4*)(WT + (size_t)rowmap(n0 + n) * ldwt + k0 + 8 * c) = o;
    }
    __builtin_amdgcn_wave_barrier();
}
template <class RM>
__device__ __forceinline__ void transpose_item_fp8(const float* __restrict__ W, int N, unsigned char* __restrict__ WT, int ldwt, int k0, int n0, RM rowmap, float scale, LAS float* scr, int lane) {
#pragma unroll 16
    for (int i = 0; i < 64; ++i) scr[i * 65 + lane] = W[(size_t)(k0 + i) * N + n0 + lane];
    __builtin_amdgcn_wave_barrier();
    const int c = lane & 7;
#pragma unroll
    for (int j = 0; j < 8; ++j) {
        const int n = (lane >> 3) + 8 * j;
        const LAS float* sp = scr + (8 * c) * 65 + n;
        u32x2 o; o.x = pk_fp8x4((f32x4){sp[0], sp[65], sp[2 * 65], sp[3 * 65]} * scale); o.y = pk_fp8x4((f32x4){sp[4 * 65], sp[5 * 65], sp[6 * 65], sp[7 * 65]} * scale);
        *(u32x2*)(WT + (size_t)rowmap(n0 + n) * ldwt + k0 + 8 * c) = o;
    }
    __builtin_amdgcn_wave_barrier();
}
struct RmId { __device__ __forceinline__ int operator()(int n) const { return n; } };
struct RmMoeIn { __device__ __forceinline__ int operator()(int n) const { const int half = n >> 10, j = n & 1023; return (j >> 7) * 256 + half * 128 + (j & 127); } };
struct RmGate { int gate; __device__ __forceinline__ int operator()(int j) const { return (j >> 5) * 64 + gate * 32 + (j & 31); } };

template <class RM>
__device__ __forceinline__ void transpose_matrix(const float* W, int K, int N, bf16_t* WT, int ldwt, RM rm, LAS float* scr, int gw, int NGW, int lane, int first_wave) {
    const int nkb = K / 64, nnb = N / 64;
    int it = gw - first_wave; if (it < 0) it += NGW;
    for (; it < nkb * nnb; it += NGW) transpose_item(W, N, WT, ldwt, (it / nnb) * 64, (it % nnb) * 64, rm, scr, lane);
}

constexpr int CONV_ITEMS = 24576, TAIL_QUOTA = 48;
__device__ __forceinline__ void convert_item(const Params& P, int layer, int r, LAS float* scr, int lane) {
    unsigned char* dst = P.ws + (layer ? WS_MW1 : WS_MWIN);
    if (r < 16384) {
        const int e = r >> 9, rr = r & 511, kb = rr >> 5, nb = rr & 31;
        transpose_item_fp8(P.in[I_M_WIN] + ((size_t)layer * 32 + e) * 1024 * 2048, 2048, dst + (size_t)e * 2048 * 1024, 1024, kb * 64, nb * 64, RmMoeIn(), FP8_SWIN, scr, lane);
    } else {
        const int r2 = r - 16384, e = r2 >> 8, rr = r2 & 255, kb = rr >> 4, nb = rr & 15;
        transpose_item_fp8(P.in[I_M_WOUT] + ((size_t)layer * 32 + e) * 1024 * 1024, 1024, dst + (size_t)32 * 2048 * 1024 + (size_t)e * 1024 * 1024, 1024, kb * 64, nb * 64, RmId(), FP8_SWOUT, scr, lane);
    }
}
__device__ __forceinline__ void convert_range_wg(const Params& P, int layer, int first, int count, lds_t* lds) {
    const int lane = threadIdx.x & 63, wave = threadIdx.x >> 6;
    LAS float* scr = (LAS float*)(lds + wave * 16640);
    const int end = (first + count < CONV_ITEMS) ? first + count : CONV_ITEMS;
    for (int r = first + wave; r < end; r += 8) convert_item(P, layer, r, scr, lane);
}
__device__ __forceinline__ void convert_moe_weights(const Params& P, int layer, int first, lds_t* lds, int skip_wgs = 0) {
    if ((int)blockIdx.x < skip_wgs) return;
    const int lane = threadIdx.x & 63, wave = threadIdx.x >> 6, gw = ((int)blockIdx.x - skip_wgs) * 8 + wave, NGW = ((int)gridDim.x - skip_wgs) * 8;
    LAS float* scr = (LAS float*)(lds + wave * 16640);
    for (int r = first + gw; r < CONV_ITEMS; r += NGW) convert_item(P, layer, r, scr, lane);
}
__device__ __forceinline__ int tail_idle(int nunits, int G) { const int r = nunits % G; return r ? G - r : 0; }
__device__ __forceinline__ int tail_done_up(int nM, int G) { const int d = tail_idle(nM * 8, G) * TAIL_QUOTA; return d < CONV_ITEMS ? d : CONV_ITEMS; }
__device__ __forceinline__ int tail_done_all(int nM, int G) { const int d = tail_done_up(nM, G) + tail_idle(nM * 4, G) * TAIL_QUOTA; return d < CONV_ITEMS ? d : CONV_ITEMS; }

__device__ __forceinline__ void s5_precompute(const Params& P, int g, lds_t* lds) {
    const int tid = threadIdx.x;
    LAS float* Bbr = (LAS float*)lds;
    LAS float* Bbi = Bbr + 1024;
    LAS float* Cr = Bbi + 1024;
    LAS float* Ci = Cr + 1024;
    LAS float* ApR = Ci + 1024;
    LAS float* ApI = ApR + 33 * 64;
    LAS float* KJ = ApI + 33 * 64;
    const float* lre = P.in[I_S5_LRE] + g * 64; const float* lim = P.in[I_S5_LIM] + g * 64;
    const float step = expf(P.in[I_S5_STEP][g]);
    for (int idx = tid; idx < 1024; idx += NTHREADS) {
        const int p = idx >> 4;
        const float lr = fminf(lre[p], -1e-4f), li = lim[p];
        const float mag = expf(lr * step); float sn, cs; sincosf(li * step, &sn, &cs);
        const float ar = mag * cs, ai = mag * sn, inv = 1.0f / (lr * lr + li * li);
        const float zr = ((ar - 1.0f) * lr + ai * li) * inv, zi = (ai * lr - (ar - 1.0f) * li) * inv;
        const float br = P.in[I_S5_BRE][g * 1024 + idx], bi = P.in[I_S5_BIM][g * 1024 + idx];
        Bbr[idx] = zr * br - zi * bi; Bbi[idx] = zr * bi + zi * br;
        Cr[idx] = P.in[I_S5_CRE][g * 1024 + idx]; Ci[idx] = P.in[I_S5_CIM][g * 1024 + idx];
    }
    for (int idx = tid; idx < 33 * 64; idx += NTHREADS) {
        const int j = idx >> 6, p = idx & 63;
        const float lr = fminf(lre[p], -1e-4f), li = lim[p];
        const float mag = fexp((float)j * lr * step); float sn, cs; fsincos((float)j * li * step, sn, cs);
        ApR[idx] = mag * cs; ApI[idx] = mag * sn;
    }
    __syncthreads();
    {
        const int h = (tid >> 4) & 15, h2 = tid & 15, jh = tid >> 8;
        float gr[64], gi[64];
#pragma unroll
        for (int p = 0; p < 64; ++p) { const float cr = Cr[h * 64 + p], ci = Ci[h * 64 + p], br = Bbr[p * 16 + h2], bi = Bbi[p * 16 + h2]; gr[p] = cr * br - ci * bi; gi[p] = cr * bi + ci * br; }
        for (int j = jh * 16; j < jh * 16 + 16; ++j) {
            float s0 = 0.f, s1 = 0.f;
#pragma unroll
            for (int p = 0; p < 64; p += 2) { s0 += gr[p] * ApR[j * 64 + p] - gi[p] * ApI[j * 64 + p]; s1 += gr[p + 1] * ApR[j * 64 + p + 1] - gi[p + 1] * ApI[j * 64 + p + 1]; }
            float sres = s0 + s1;
            if (j == 0 && h == h2) sres += P.in[I_S5_D][g * 16 + h];
            KJ[(j * 16 + h) * 16 + h2] = sres;
        }
    }
    __syncthreads();
    bf16_t* Tm = (bf16_t*)(P.ws + WS_S5TM) + (size_t)g * 512 * S5K;
    for (int pi = tid; pi < 512 * (S5K / 8); pi += NTHREADS) {
        const int row = pi / (S5K / 8), c8 = (pi % (S5K / 8)) * 8, t = row >> 4, h = row & 15;
        float v[8];
#pragma unroll
        for (int e = 0; e < 8; ++e) {
            const int col = c8 + e;
            if (col < 512) { const int s = col >> 4, h2 = col & 15; v[e] = (s <= t) ? KJ[((t - s) * 16 + h) * 16 + h2] : 0.f; }
            else { const int p = (col - 512) & 63, im = (col - 512) >> 6;
                const float cr = Cr[h * 64 + p], ci = Ci[h * 64 + p], ar = ApR[(t + 1) * 64 + p], ai = ApI[(t + 1) * 64 + p];
                v[e] = im ? -(cr * ai + ci * ar) : (cr * ar - ci * ai); }
        }
        *(u32x4*)(Tm + (size_t)row * S5K + c8) = pack8(v);
    }
    bf16_t* Wst = (bf16_t*)(P.ws + WS_S5WST) + (size_t)g * 128 * 512;
    for (int pi = tid; pi < 128 * 64; pi += NTHREADS) {
        const int row = pi >> 6, c8 = (pi & 63) * 8, p = row & 63, im = row >> 6;
        float v[8];
#pragma unroll
        for (int e = 0; e < 8; ++e) {
            const int col = c8 + e, s = col >> 4, h2 = col & 15;
            const float ar = ApR[(S5TC - 1 - s) * 64 + p], ai = ApI[(S5TC - 1 - s) * 64 + p], br = Bbr[p * 16 + h2], bi = Bbi[p * 16 + h2];
            v[e] = im ? (ar * bi + ai * br) : (ar * br - ai * bi);
        }
        *(u32x4*)(Wst + (size_t)row * 512 + c8) = pack8(v);
    }
    __syncthreads();
}

__device__ __forceinline__ void phase0(const Params& P, lds_t* lds) {
    const int tid = threadIdx.x, lane = tid & 63, wave = tid >> 6, gw = blockIdx.x * 8 + wave, NGW = gridDim.x * 8;
    const size_t gtid = (size_t)blockIdx.x * NTHREADS + tid, GT = (size_t)gridDim.x * NTHREADS;
    unsigned char* ws = P.ws;
    for (int g = blockIdx.x; g < 32; g += gridDim.x) s5_precompute(P, g, lds);
    {
        const f32x4* x4 = (const f32x4*)P.in[I_X]; u32x4* xb = (u32x4*)(ws + WS_XB);
        for (size_t i0 = gtid; i0 < (size_t)T * D / 8; i0 += 4 * GT) {
            f32x4 a[4], b[4];
#pragma unroll
            for (int j = 0; j < 4; ++j) { const size_t i = i0 + j * GT; a[j] = x4[2 * i]; b[j] = x4[2 * i + 1]; }
#pragma unroll
            for (int j = 0; j < 4; ++j) { u32x4 o; o.x = pk_bf16(a[j].x, a[j].y); o.y = pk_bf16(a[j].z, a[j].w); o.z = pk_bf16(b[j].x, b[j].y); o.w = pk_bf16(b[j].z, b[j].w); xb[i0 + j * GT] = o; }
        }
    }
    {
        float* Wc = (float*)(ws + WS_WC);
        for (int idx = gw; idx < 8192; idx += NGW) {
            const int which = idx >> 12, i = (idx >> 3) & 511, gg = idx & 7, h = i >> 7, ii = i & 127;
            const float* wif = P.in[I_CD_WIF];
            float sacc = 0.f;
#pragma unroll
            for (int jj = 0; jj < 2; ++jj) {
                const int j = lane + 64 * jj;
                if (which == 0) sacc += P.in[I_CD_WQ][(size_t)(h * 128 + ii) * 128 + j] * wif[(h * 128 + j) * 8 + gg] + 0.08838834764831845f * P.in[I_CD_WK][(size_t)(h * 128 + ii) * 128 + j] * wif[(512 + h * 128 + j) * 8 + gg];
                else sacc += P.in[I_CD_WV][(size_t)(h * 128 + ii) * 128 + j] * wif[(1024 + h * 128 + j) * 8 + gg];
            }
            sacc = wave_sum(sacc);
            if (lane == 0) Wc[idx] = sacc;
        }
    }
    LAS float* scr = (LAS float*)(lds + wave * 16640);
    transpose_matrix(P.in[I_AB_WIN], 1024, 1536, (bf16_t*)(ws + WS_WABIN), 1024, RmId(), scr, gw, NGW, lane, 256);
    transpose_matrix(P.in[I_AB_GLUW], 512, 512, (bf16_t*)(ws + WS_WGLU), 512, RmId(), scr, gw, NGW, lane, 256 + 384);
    transpose_matrix(P.in[I_AB_WOUT], 1024, 1024, (bf16_t*)(ws + WS_WABOUT), 1024, RmId(), scr, gw, NGW, lane, 256 + 448);
    transpose_matrix(P.in[I_CD_WIN], 1024, 2560, (bf16_t*)(ws + WS_WCDIN), 1024, RmId(), scr, gw, NGW, lane, 256 + 704);
    transpose_matrix(P.in[I_CD_WOUT], 1024, 1024, (bf16_t*)(ws + WS_WCDOUT), 1024, RmId(), scr, gw, NGW, lane, 256 + 1344);
    { int it = gw - (256 + 1600); if (it < 0) it += NGW;
      for (; it < 16; it += NGW) {
        const int gate = it >> 3, h = it & 7;
        transpose_item(P.in[gate ? I_AB_GIW : I_AB_GRW] + h * 4096, 64, (bf16_t*)(ws + WS_WG) + h * 8192, 64, 0, 0, RmGate{gate}, scr, lane);
      } }
    { int it = gw - (256 + 1616); if (it < 0) it += NGW;
      for (; it < 48; it += NGW) {
        const int which = it >> 4, h = (it >> 2) & 3, kb = (it >> 1) & 1, nb = it & 1;
        transpose_item(P.in[I_CD_WQ + which] + h * 16384, 128, (bf16_t*)(ws + WS_WQKV) + (which * 4 + h) * 16384, 128, kb * 64, nb * 64, RmId(), scr, lane);
      } }
    convert_moe_weights(P, 0, 0, lds, (int)gridDim.x > 64 ? 32 : 0);
}

__device__ __forceinline__ void store_bf16x4(bf16_t* p, f32x4 v) { u32x2 o; o.x = pk_bf16(v[0], v[1]); o.y = pk_bf16(v[2], v[3]); *(u32x2*)p = o; }

__device__ __forceinline__ void ph_conv0(const Params& P) {
    const bf16_t* proj = (const bf16_t*)(P.ws + WS_PROJ); bf16_t* xc = (bf16_t*)(P.ws + WS_XC);
    const int lane = threadIdx.x & 63, gw = blockIdx.x * 8 + (threadIdx.x >> 6), NGW = gridDim.x * 8, c8 = lane * 8;
    float w[4][8], bias[8];
#pragma unroll
    for (int e = 0; e < 8; ++e) { bias[e] = P.in[I_AB_CONVB][c8 + e];
#pragma unroll
        for (int k = 0; k < 4; ++k) w[k][e] = P.in[I_AB_CONVW][k * 512 + c8 + e]; }
    for (int run = gw; run < T / 16; run += NGW) {
        const int tok0 = run * 16, p0 = tok0 & (SEQ - 1);
        u32x4 r[19];
#pragma unroll
        for (int i = 0; i < 19; ++i) { r[i] = (u32x4){0u, 0u, 0u, 0u}; if (p0 + i - 3 >= 0) r[i] = *(const u32x4*)(proj + (size_t)(tok0 + i - 3) * 1536 + c8); }
#pragma unroll
        for (int t = 0; t < 16; ++t) {
            float a[8];
#pragma unroll
            for (int e = 0; e < 8; ++e) a[e] = bias[e];
#pragma unroll
            for (int k = 0; k < 4; ++k) { float xv[8]; unpack8(r[t + k], xv);
#pragma unroll
                for (int e = 0; e < 8; ++e) a[e] += w[k][e] * xv[e]; }
            *(u32x4*)(xc + (size_t)(tok0 + t) * 512 + c8) = pack8(a);
        }
    }
}

__device__ __forceinline__ void ph_gates0(const Params& P, lds_t* lds) {
    const bf16_t* xc = (const bf16_t*)(P.ws + WS_XC); const bf16_t* Wg = (const bf16_t*)(P.ws + WS_WG);
    unsigned* lau = (unsigned*)(P.ws + WS_AF);
    const float* br = P.in[I_AB_GRB]; const float* bi = P.in[I_AB_GIB]; const float* lam = P.in[I_AB_LAMBDA];
    const int b0 = (int)blockIdx.x, G = (int)gridDim.x;
    {
        e1_stream<true>(lds, wg_tiles(1024), [](int) { return 1; },
            [=](int j, int, int r, int kp) { const int tile = b0 + j * G, h = tile & 7, rt = tile >> 3; return *(const u32x4*)(xc + (size_t)(rt * 256 + r) * 512 + h * 64 + kp * 8); },
            [=](int j, int, int n, int kp) { const int h = (b0 + j * G) & 7; return *(const u32x4*)(Wg + (size_t)h * 8192 + n * 64 + kp * 8); },
            [=](int j, f32x4 (&acc)[4][4], int wr, int wc, int fr, int fq) {
                const int tile = b0 + j * G, h = tile & 7, rt = tile >> 3;
#pragma unroll
                for (int n = 0; n < 2; ++n) {
                    const int ch = h * 64 + wc * 32 + n * 16 + fq * 4;
                    float sp[4], brv[4], biv[4];
#pragma unroll
                    for (int c = 0; c < 4; ++c) { const float l = -lam[ch + c]; sp[c] = fmaxf(l, 0.f) + flog(1.0f + fexp(-fabsf(l))); brv[c] = br[ch + c]; biv[c] = bi[ch + c]; }
#pragma unroll
                    for (int m = 0; m < 4; ++m) {
                        const size_t row = (size_t)(rt * 256 + wr * 64 + m * 16 + fr);
                        const u32x2 xr = *(const u32x2*)(xc + row * 512 + ch);
                        const float xv[4] = {__uint_as_float(xr.x << 16), __uint_as_float(xr.x & 0xffff0000u), __uint_as_float(xr.y << 16), __uint_as_float(xr.y & 0xffff0000u)};
                        f32x4 a4, u4;
#pragma unroll
                        for (int c = 0; c < 4; ++c) {
                            const float r = fsigmoid(acc[m][n][c] + brv[c]), ig = fsigmoid(acc[m][n + 2][c] + biv[c]);
                            const float la = -8.0f * r * sp[c], x2 = 2.0f * la;
                            const float om = (x2 > -0.01f) ? -x2 * (1.0f + 0.5f * x2 * (1.0f + x2 * (1.0f / 3.0f))) : 1.0f - fexp(x2);
                            a4[c] = la; u4[c] = sqrtf(om) * ig * xv[c];
                        }
                        { u32x4 o; o.x = pk_bf16(a4[0], u4[0]); o.y = pk_bf16(a4[1], u4[1]); o.z = pk_bf16(a4[2], u4[2]); o.w = pk_bf16(a4[3], u4[3]); *(u32x4*)(lau + row * 512 + ch) = o; }
                    }
                }
            });
    }
}

__device__ __forceinline__ void ph_lru_scan(const Params& P, lds_t* lds) {
    const unsigned* lau = (const unsigned*)(P.ws + WS_AF);
    const bf16_t* proj = (const bf16_t*)(P.ws + WS_PROJ); bf16_t* cat = (bf16_t*)(P.ws + WS_CAT);
    LAS float* lA = (LAS float*)lds; LAS float* lH = lA + 512;
    const int tid = threadIdx.x, seg = tid >> 4, c = tid & 15;
    for (int item = blockIdx.x; item < 256; item += gridDim.x) {
        const int b = item >> 5, ch = (item & 31) * 16 + c;
        const size_t base = (size_t)b * SEQ + seg * 128;
        float H = 0.f, sla = 0.f;
#pragma unroll 1
        for (int i0 = 0; i0 < 128; i0 += 64) {
            unsigned r[64];
#pragma unroll
            for (int j = 0; j < 64; ++j) r[j] = lau[(base + i0 + j) * 512 + ch];
#pragma unroll
            for (int j = 0; j < 64; ++j) { const float la = __uint_as_float(r[j] << 16), u = __uint_as_float(r[j] & 0xffff0000u); H = fexp(la) * H + u; sla += la; }
        }
        lA[tid] = fexp(sla); lH[tid] = H;
        __syncthreads();
        float carry = 0.f;
        for (int s2 = 0; s2 < seg; ++s2) carry = lA[s2 * 16 + c] * carry + lH[s2 * 16 + c];
        H = carry;
#pragma unroll 1
        for (int i0 = 0; i0 < 128; i0 += 32) {
            unsigned r[32]; unsigned short ga[32];
#pragma unroll
            for (int j = 0; j < 32; ++j) { r[j] = lau[(base + i0 + j) * 512 + ch]; ga[j] = proj[(base + i0 + j) * 1536 + 512 + ch]; }
#pragma unroll
            for (int j = 0; j < 32; ++j) {
                const float la = __uint_as_float(r[j] << 16), u = __uint_as_float(r[j] & 0xffff0000u); H = fexp(la) * H + u;
                cat[(base + i0 + j) * 1024 + ch] = (bf16_t)(pk_bf16(H * gelu_tanh(bf2f(ga[j])), 0.f) & 0xffffu);
            }
        }
        __syncthreads();
    }
}

__device__ __forceinline__ void ph_s5_state(const Params& P, lds_t* lds) {
    const bf16_t* proj = (const bf16_t*)(P.ws + WS_PROJ); const bf16_t* Wst = (const bf16_t*)(P.ws + WS_S5WST); float* S = (float*)(P.ws + WS_S5S);
    const int b0 = (int)blockIdx.x, G = (int)gridDim.x;
    {
        e1_stream<true>(lds, wg_tiles(128), [](int) { return 8; },
            [=](int j, int, int r, int kp) { const int tile = b0 + j * G, g = tile & 31, rt = tile >> 5; return *(const u32x4*)(proj + (size_t)((rt * 256 + r) * 32 + (kp >> 1)) * 1536 + 1024 + g * 16 + (kp & 1) * 8); },
            [=](int j, int, int n, int kp) { const int g = (b0 + j * G) & 31; return *(const u32x4*)(Wst + (size_t)g * 65536 + n * 512 + kp * 8); },
            [=](int j, f32x4 (&acc)[4][4], int wr, int wc, int fr, int fq) {
                const int tile = b0 + j * G, g = tile & 31, rt = tile >> 5;
#pragma unroll
                for (int m = 0; m < 4; ++m)
#pragma unroll
                    for (int n = 0; n < 4; ++n) *(f32x4*)(S + ((size_t)(rt * 256 + wr * 64 + m * 16 + fr) * 32 + g) * 128 + wc * 64 + n * 16 + fq * 4) = acc[m][n];
            });
    }
}

__device__ __forceinline__ void ph_s5_carry(const Params& P) {
    const float* S = (const float*)(P.ws + WS_S5S); bf16_t* X = (bf16_t*)(P.ws + WS_S5X);
    if (threadIdx.x >= 64) return;
    const int p = threadIdx.x;
    for (int it = blockIdx.x; it < 256; it += gridDim.x) {
        const int b = it >> 5, g = it & 31;
        const float lr = fminf(P.in[I_S5_LRE][g * 64 + p], -1e-4f), li = P.in[I_S5_LIM][g * 64 + p], step = expf(P.in[I_S5_STEP][g]);
        const float mag = expf((float)S5TC * lr * step); float sn, cs; sincosf((float)S5TC * li * step, &sn, &cs);
        const float cr = mag * cs, ci = mag * sn;
        float xr = 0.f, xi = 0.f;
        for (int c0 = 0; c0 < 128; c0 += 16) {
            float sr[16], si[16];
#pragma unroll
            for (int j = 0; j < 16; ++j) { const size_t o = ((size_t)(b * 128 + c0 + j) * 32 + g) * 128; sr[j] = S[o + p]; si[j] = S[o + 64 + p]; }
#pragma unroll
            for (int j = 0; j < 16; ++j) {
                const size_t o = ((size_t)(b * 128 + c0 + j) * 32 + g) * 128;
                X[o + p] = (bf16_t)(pk_bf16(xr, 0.f) & 0xffffu); X[o + 64 + p] = (bf16_t)(pk_bf16(xi, 0.f) & 0xffffu);
                const float nr = cr * xr - ci * xi + sr[j], ni = cr * xi + ci * xr + si[j];
                xr = nr; xi = ni;
            }
        }
    }
}

__device__ __forceinline__ void ph_s5_out(const Params& P, lds_t* lds) {
    const bf16_t* proj = (const bf16_t*)(P.ws + WS_PROJ); const bf16_t* Tm = (const bf16_t*)(P.ws + WS_S5TM); const bf16_t* X = (const bf16_t*)(P.ws + WS_S5X);
    bf16_t* sb = (bf16_t*)(P.ws + WS_SB);
    const int b0 = (int)blockIdx.x, G = (int)gridDim.x;
#define S5O_DECODE(J) const int tile = b0 + (J) * G, ct = (tile < 256) ? (tile & 3) : 3 - (tile & 3), g = (tile >> 2) & 31, rt = tile >> 7, nkl = 2 * ct + 2; (void)g; (void)rt;
    {
        e1_stream<true>(lds, wg_tiles(512), [=](int j) { S5O_DECODE(j) return nkl + 2; },
            [=](int j, int, int r, int kp0) {
                S5O_DECODE(j)
                const int kp = kp0 < nkl * 8 ? kp0 : kp0 - nkl * 8 + 64;
                if (kp < 64) return *(const u32x4*)(proj + (size_t)((rt * 256 + r) * 32 + (kp >> 1)) * 1536 + 1024 + g * 16 + (kp & 1) * 8);
                return *(const u32x4*)(X + ((size_t)(rt * 256 + r) * 32 + g) * 128 + (kp - 64) * 8); },
            [=](int j, int, int n, int kp0) { S5O_DECODE(j) const int kp = kp0 < nkl * 8 ? kp0 : kp0 - nkl * 8 + 64; return *(const u32x4*)(Tm + (size_t)g * 512 * S5K + (size_t)(ct * 128 + n) * S5K + kp * 8); },
            [=](int j, f32x4 (&acc)[4][4], int wr, int wc, int fr, int fq) {
                S5O_DECODE(j)
#pragma unroll
                for (int m = 0; m < 4; ++m)
#pragma unroll
                    for (int n = 0; n < 4; ++n) {
                        const int col = ct * 128 + wc * 64 + n * 16 + fq * 4, t = col >> 4, h0 = col & 15;
                        const size_t tok = (size_t)(rt * 256 + wr * 64 + m * 16 + fr) * 32 + t;
                        f32x4 y = acc[m][n];
#pragma unroll
                        for (int c = 0; c < 4; ++c) y[c] = gelu_tanh(y[c]);
                        store_bf16x4(sb + tok * 512 + g * 16 + h0, y);
                    }
            });
    }
}

#undef S5O_DECODE
__device__ __forceinline__ void ph_glu(const Params& P, lds_t* lds) {
    const bf16_t* sb = (const bf16_t*)(P.ws + WS_SB); const bf16_t* Wt = (const bf16_t*)(P.ws + WS_WGLU); bf16_t* cat = (bf16_t*)(P.ws + WS_CAT);
    const float* gb = P.in[I_AB_GLUB];
    const int b0 = (int)blockIdx.x, G = (int)gridDim.x;
    {
        e1_stream<true>(lds, wg_tiles(512), [](int) { return 8; },
            [=](int j, int, int r, int kp) { const int rt = (b0 + j * G) >> 2; return *(const u32x4*)(sb + (size_t)(rt * 256 + r) * 512 + kp * 8); },
            [=](int j, int, int n, int kp) { const int ct = (b0 + j * G) & 3; return *(const u32x4*)(Wt + (size_t)(ct * 128 + n) * 512 + kp * 8); },
            [=](int j, f32x4 (&acc)[4][4], int wr, int wc, int fr, int fq) {
                const int tile = b0 + j * G, rt = tile >> 2, ct = tile & 3;
#pragma unroll
                for (int n = 0; n < 4; ++n) {
                    const int col = ct * 128 + wc * 64 + n * 16 + fq * 4;
                    const f32x4 bv = *(const f32x4*)(gb + col);
#pragma unroll
                    for (int m = 0; m < 4; ++m) {
                        const size_t row = (size_t)(rt * 256 + wr * 64 + m * 16 + fr);
                        const u32x2 sr = *(const u32x2*)(sb + row * 512 + col);
                        const float sv[4] = {__uint_as_float(sr.x << 16), __uint_as_float(sr.x & 0xffff0000u), __uint_as_float(sr.y << 16), __uint_as_float(sr.y & 0xffff0000u)};
                        f32x4 y;
#pragma unroll
                        for (int c = 0; c < 4; ++c) y[c] = sv[c] * fsigmoid(acc[m][n][c] + bv[c]);
                        store_bf16x4(cat + row * 1024 + 512 + col, y);
                    }
                }
            });
    }
}

__device__ __forceinline__ void ph_ln_router(const Params& P, lds_t* lds, int layer, const float* xres  , int dummy = 0) {
    const bf16_t* mixb = (const bf16_t*)(P.ws + WS_ZF); bf16_t* xb = (bf16_t*)(P.ws + WS_XB); unsigned* xb8 = (unsigned*)(P.ws + WS_X1F);
    const float* lg = P.in[I_LNM_G] + layer * 1024; const float* lb = P.in[I_LNM_B] + layer * 1024;
    const float* rw = P.in[I_R_W] + (size_t)layer * 1024 * 32; const float* rbias = P.in[I_R_B] + layer * 32;
    int* gcount = (int*)(P.ws + WS_CTL) + 64 * layer + 32 * dummy;
    int* pair_e = (int*)(P.ws + WS_ROUTE); int* pair_rank = pair_e + T * 4; float* pair_gate = (float*)(pair_rank + T * 4);
    constexpr int XP = 2064;
    lds_t* Xh = lds; lds_t* Xl = lds + 16 * XP;
    LAS float* part = (LAS float*)(lds + 32 * XP);
    LAS int* hist = (LAS int*)(lds + 32 * XP + 16384); LAS int* basev = hist + 32; LAS int* pinfo = basev + 32;
    const int tid = threadIdx.x, lane = tid & 63, wave = tid >> 6, fr = lane & 15, fq = lane >> 4;
    bf16x8 wh[4][2], wl[4][2];
#pragma unroll
    for (int ks = 0; ks < 4; ++ks)
#pragma unroll
        for (int nt = 0; nt < 2; ++nt) {
            unsigned ph[4], pl[4];
#pragma unroll
            for (int j2 = 0; j2 < 4; ++j2) {
                const int k = wave * 128 + ks * 32 + fq * 8 + 2 * j2;
                const float w0 = rw[(size_t)k * 32 + nt * 16 + fr], w1 = rw[(size_t)(k + 1) * 32 + nt * 16 + fr];
                ph[j2] = pk_bf16(w0, w1);
                pl[j2] = pk_bf16(w0 - __uint_as_float(ph[j2] << 16), w1 - __uint_as_float(ph[j2] & 0xffff0000u));
            }
            const u32x4 uh = {ph[0], ph[1], ph[2], ph[3]}, ul = {pl[0], pl[1], pl[2], pl[3]};
            wh[ks][nt] = __builtin_bit_cast(bf16x8, uh); wl[ks][nt] = __builtin_bit_cast(bf16x8, ul);
        }
    const float myrb = rbias[lane & 31];
    for (int it = blockIdx.x; it < T / 16; it += gridDim.x) {
        if (tid < 32) hist[tid] = 0;
        f32x4 y[2][4];
#pragma unroll
        for (int rr = 0; rr < 2; ++rr)
#pragma unroll
            for (int j = 0; j < 4; ++j) {
                const size_t o = ((size_t)it * 16 + wave * 2 + rr) * 1024 + j * 256 + lane * 4;
                const u32x2 mr = *(const u32x2*)(mixb + o);
                f32x4 xr;
                if (xres) xr = *(const f32x4*)(xres + o);
                else { const u32x2 xq = *(const u32x2*)(xb + o); xr = (f32x4){__uint_as_float(xq.x << 16), __uint_as_float(xq.x & 0xffff0000u), __uint_as_float(xq.y << 16), __uint_as_float(xq.y & 0xffff0000u)}; }
                y[rr][j] = xr * ALPHA + (f32x4){__uint_as_float(mr.x << 16), __uint_as_float(mr.x & 0xffff0000u), __uint_as_float(mr.y << 16), __uint_as_float(mr.y & 0xffff0000u)};
            }
#pragma unroll
        for (int rr = 0; rr < 2; ++rr) {
            const int rl = wave * 2 + rr; const size_t row = (size_t)it * 16 + rl;
            float s = 0.f;
#pragma unroll
            for (int j = 0; j < 4; ++j) s += (y[rr][j][0] + y[rr][j][1]) + (y[rr][j][2] + y[rr][j][3]);
            const float mean = wave_sum(s) * (1.0f / 1024.0f); float s2 = 0.f;
#pragma unroll
            for (int j = 0; j < 4; ++j) { y[rr][j] = y[rr][j] - mean; s2 += (y[rr][j][0] * y[rr][j][0] + y[rr][j][1] * y[rr][j][1]) + (y[rr][j][2] * y[rr][j][2] + y[rr][j][3] * y[rr][j][3]); }
            const float rstd = rsqrtf(wave_sum(s2) * (1.0f / 1024.0f) + LN_EPS);
#pragma unroll
            for (int j = 0; j < 4; ++j) {
                const f32x4 v = y[rr][j] * rstd * *(const f32x4*)(lg + j * 256 + lane * 4) + *(const f32x4*)(lb + j * 256 + lane * 4);
                u32x2 hi; hi.x = pk_bf16(v[0], v[1]); hi.y = pk_bf16(v[2], v[3]);
                u32x2 lo; lo.x = pk_bf16(v[0] - __uint_as_float(hi.x << 16), v[1] - __uint_as_float(hi.x & 0xffff0000u)); lo.y = pk_bf16(v[2] - __uint_as_float(hi.y << 16), v[3] - __uint_as_float(hi.y & 0xffff0000u));
                *(u32x2*)(xb + row * 1024 + j * 256 + lane * 4) = hi;
                xb8[row * 256 + j * 64 + lane] = pk_fp8x4(v * FP8_SX);
                *(LAS u32x2*)(Xh + rl * XP + (j * 256 + lane * 4) * 2) = hi;
                *(LAS u32x2*)(Xl + rl * XP + (j * 256 + lane * 4) * 2) = lo;
            }
        }
        __syncthreads();
        f32x4 acc[2] = {(f32x4){0.f, 0.f, 0.f, 0.f}, (f32x4){0.f, 0.f, 0.f, 0.f}};
#pragma unroll
        for (int ks = 0; ks < 4; ++ks) {
            const int ko = (wave * 128 + ks * 32 + fq * 8) * 2;
            const bf16x8 ah = *(LAS bf16x8*)(Xh + fr * XP + ko), al = *(LAS bf16x8*)(Xl + fr * XP + ko);
#pragma unroll
            for (int nt = 0; nt < 2; ++nt) { acc[nt] = MFMA16(ah, wh[ks][nt], acc[nt]); acc[nt] = MFMA16(ah, wl[ks][nt], acc[nt]); acc[nt] = MFMA16(al, wh[ks][nt], acc[nt]); }
        }
#pragma unroll
        for (int nt = 0; nt < 2; ++nt)
#pragma unroll
            for (int r = 0; r < 4; ++r) part[(wave * 16 + fq * 4 + r) * 32 + nt * 16 + fr] = acc[nt][r];
        __syncthreads();
        {
            const int rl = wave * 2 + (lane >> 5), my = lane & 31;
            float val = myrb;
#pragma unroll
            for (int w2 = 0; w2 < 8; ++w2) val += part[(w2 * 16 + rl) * 32 + my];
            float topv[4]; int topi[4];
#pragma unroll
            for (int k = 0; k < 4; ++k) {
                float bv = val; int bi = my;
#pragma unroll
                for (int off = 16; off >= 1; off >>= 1) { const float ov = __shfl_xor(bv, off); const int oi = __shfl_xor(bi, off); if (ov > bv || (ov == bv && oi < bi)) { bv = ov; bi = oi; } }
                topv[k] = bv; topi[k] = bi; if (my == bi) val = -INFINITY;
            }
            if (my == 0) {
                const float e1 = expf(topv[1] - topv[0]), e2 = expf(topv[2] - topv[0]), e3 = expf(topv[3] - topv[0]);
                const float inv = 1.0f / (1.0f + e1 + e2 + e3);
                const float gt[4] = {inv, e1 * inv, e2 * inv, e3 * inv};
#pragma unroll
                for (int k = 0; k < 4; ++k) { const int lr = __hip_atomic_fetch_add(&hist[topi[k]], 1, __ATOMIC_RELAXED, __HIP_MEMORY_SCOPE_WORKGROUP); pinfo[(rl * 4 + k) * 3 + 0] = topi[k]; pinfo[(rl * 4 + k) * 3 + 1] = lr; pinfo[(rl * 4 + k) * 3 + 2] = __float_as_int(gt[k]); }
            }
        }
        __syncthreads();
        if (tid < 32) { const int c = hist[tid]; basev[tid] = c ? atomicAdd(gcount + tid, c) : 0; }
        __syncthreads();
        if (tid < 64) {
            const int e = pinfo[tid * 3 + 0]; const size_t pi = (size_t)it * 64 + tid;
            pair_e[pi] = e; pair_rank[pi] = basev[e] + pinfo[tid * 3 + 1]; pair_gate[pi] = __int_as_float(pinfo[tid * 3 + 2]);
        }
        __syncthreads();
    }
}

__device__ __forceinline__ void moe_pstart(const Params& P, lds_t* lds, int layer) {
    LAS int* ps = (LAS int*)(lds + PS_OFF);
    const int* gcount = (const int*)(P.ws + WS_CTL) + 64 * layer;
    if (threadIdx.x == 0) { int a = 0; for (int e = 0; e < 32; ++e) { const int c = gcount[e]; ps[e] = a; ps[40 + e] = c; a += ((c + 255) >> 8) << 8; } ps[32] = a; }
    __syncthreads();
}

__device__ __forceinline__ void ph_route_scatter(const Params& P, lds_t* lds, int layer) {
    moe_pstart(P, lds, layer);
    LAS int* ps = (LAS int*)(lds + PS_OFF);
    const int* pair_e = (const int*)(P.ws + WS_ROUTE); const int* pair_rank = pair_e + T * 4; const float* pair_gate = (const float*)(pair_rank + T * 4);
    int* dest = (int*)(pair_gate + T * 4); int* row_tok = dest + T * 4; float* row_gate = (float*)(row_tok + MOE_ROWS);
    const size_t gtid = (size_t)blockIdx.x * NTHREADS + threadIdx.x, GT = (size_t)gridDim.x * NTHREADS;
    for (size_t i = gtid; i < (size_t)T * 4; i += GT) {
        const int e = pair_e[i], pos = ps[e] + pair_rank[i];
        row_tok[pos] = (int)(i >> 2); row_gate[pos] = pair_gate[i]; dest[i] = pos;
    }
    for (size_t i = gtid; i < 32 * 256; i += GT) {
        const int e = (int)(i >> 8), pos = ps[e] + ps[40 + e] + (int)(i & 255);
        if (pos < ps[e + 1]) { row_tok[pos] = 0; row_gate[pos] = 0.f; }
    }
}

struct EpiInproj {
    bf16_t* proj; int N; const int* pos;
    __device__ __forceinline__ void operator()(f32x4 (&acc)[2][2][4][2], const g2::Unit& u, int wr, int wc, int fr, int fq) const {
#pragma unroll
        for (int bj = 0; bj < 2; ++bj) {
            const int ct = 2 * u.pn + bj;
            if (pos != nullptr && ct >= 8 && ct < 16 && wc == 0) {
                float invf[4];
#pragma unroll
                for (int c = 0; c < 4; ++c) invf[c] = exp2f(-(float)(fq * 4 + c) * (18.931568569324174f / 16.0f));
#pragma unroll
                for (int ai = 0; ai < 2; ++ai)
#pragma unroll
                    for (int m = 0; m < 4; ++m) {
                        const float pf = (float)pos[u.pm * 256 + ai * 128 + wr * 64 + m * 16 + fr];
#pragma unroll
                        for (int c = 0; c < 4; ++c) {
                            float sn, cs; fsincos(pf * invf[c], sn, cs);
                            const float a = acc[ai][bj][m][0][c], b = acc[ai][bj][m][1][c];
                            acc[ai][bj][m][0][c] = a * cs - b * sn; acc[ai][bj][m][1][c] = b * cs + a * sn;
                        }
                    }
            }
            const float sc = (pos != nullptr && ct >= 8 && ct < 12) ? 0.08838834764831845f : 1.0f;
#pragma unroll
            for (int ai = 0; ai < 2; ++ai)
#pragma unroll
                for (int m = 0; m < 4; ++m)
#pragma unroll
                    for (int n = 0; n < 2; ++n)
                        store_bf16x4(proj + (size_t)(u.pm * 256 + ai * 128 + wr * 64 + m * 16 + fr) * N + ct * 128 + wc * 32 + n * 16 + fq * 4, acc[ai][bj][m][n] * sc);
        }
    }
};
__device__ __forceinline__ void ph_inproj2(const Params& P, lds_t* lds, const bf16_t* Wt, int N, const int* pos) {
    g2::DenseSched S{(int)gridDim.x, (int)blockIdx.x, T / 256, N / 256, 1024, (const char*)Wt};
    EpiInproj E{(bf16_t*)(P.ws + WS_PROJ), N, pos};
    g2::gemm_phase<false>(lds, (const char*)(P.ws + WS_XB), 16, 2048u, S, E);
}
struct EpiOutproj {
    bf16_t* mixb;
    __device__ __forceinline__ void operator()(f32x4 (&acc)[2][2][4][2], const g2::Unit& u, int wr, int wc, int fr, int fq) const {
#pragma unroll
        for (int ai = 0; ai < 2; ++ai)
#pragma unroll
            for (int m = 0; m < 4; ++m)
#pragma unroll
                for (int bj = 0; bj < 2; ++bj)
#pragma unroll
                    for (int n = 0; n < 2; ++n) {
                        const size_t o = (size_t)(u.pm * 256 + ai * 128 + wr * 64 + m * 16 + fr) * 1024 + u.pn * 256 + bj * 128 + wc * 32 + n * 16 + fq * 4;
                        store_bf16x4(mixb + o, acc[ai][bj][m][n]);
                    }
    }
};
__device__ __forceinline__ void ph_outproj2(const Params& P, lds_t* lds, const bf16_t* Wt) {
    g2::DenseSched S{(int)gridDim.x, (int)blockIdx.x, T / 256, 4, 1024, (const char*)Wt};
    EpiOutproj E{(bf16_t*)(P.ws + WS_ZF)};
    g2::gemm_phase<false>(lds, (const char*)(P.ws + WS_CAT), 16, 2048u, S, E);
}
template <class RT> struct MoeSchedT {
    static constexpr bool CHEAP_AOFF = false;
    int G, c, nM, nN; const char* W; size_t wstride; const LAS RT* rt16; LAS int* ps; unsigned apitch, bpitch;
    __device__ __forceinline__ bool next(int i, g2::Unit& u) const { return g2::static_next(i, G, c, nM, nN, u); }
    __device__ __forceinline__ int expert(int pm) const { int e = 0; while (ps[e + 1] <= pm * 256) ++e; return e; }
    __device__ __forceinline__ void a_off(const g2::Unit& u, unsigned (&ao)[2][2]) const {
        int Rs[2], Cs[2];
#pragma unroll
        for (int i = 0; i < 2; ++i) g2::stage_rc((int)threadIdx.x * 16 + i * 8192, Rs[i], Cs[i]);
#pragma unroll
        for (int h = 0; h < 2; ++h)
#pragma unroll
            for (int i = 0; i < 2; ++i) {
                const unsigned row = (unsigned)rt16[u.idx * 256 + h * 128 + Rs[i]];
                ao[h][i] = row * apitch + (unsigned)Cs[i] * 2u;
            }
    }
    __device__ __forceinline__ const char* b_base(const g2::Unit& u) const { return W + (size_t)expert(u.pm) * wstride + (size_t)u.pn * 256 * bpitch; }
};
struct EpiMoeUp {
    unsigned* hact8; const LAS float* tb;
    __device__ __forceinline__ void operator()(f32x4 (&acc)[2][2][4][2], const g2::Unit& u, int wr, int wc, int fr, int fq) const {
#pragma unroll
        for (int n = 0; n < 2; ++n) {
            const int jl = wc * 32 + n * 16 + fq * 4, j = u.pn * 128 + jl;
            const f32x4 bg = *(const LAS f32x4*)(tb + u.idx * 256 + jl), bl = *(const LAS f32x4*)(tb + u.idx * 256 + 128 + jl);
#pragma unroll
            for (int ai = 0; ai < 2; ++ai)
#pragma unroll
                for (int m = 0; m < 4; ++m) {
                    f32x4 y;
#pragma unroll
                    for (int c = 0; c < 4; ++c) {
                        constexpr float us = 1.0f / (FP8_SX * FP8_SWIN);
                        const float gv = fminf(acc[ai][0][m][n][c] * us + bg[c], 7.0f), lv = fminf(fmaxf(acc[ai][1][m][n][c] * us + bl[c], -7.0f), 7.0f);
                        y[c] = gv * fsigmoid(1.702f * gv) * (lv + 1.0f);
                    }
                    hact8[((size_t)(u.pm * 256 + ai * 128 + wr * 64 + m * 16 + fr) * 1024 + j) >> 2] = pk_fp8x4(y * FP8_SH);
                }
        }
    }
};
__device__ __forceinline__ void ph_moe_up2(const Params& P, lds_t* lds, int layer) {
    moe_pstart(P, lds, layer);
    LAS int* ps = (LAS int*)(lds + PS_OFF);
    const int* row_tok = (const int*)(P.ws + WS_ROUTE) + 4 * T * 4;
    const float* b_in = P.in[I_M_BIN] + (size_t)layer * 32 * 2048;
    const int nM = ps[32] >> 8, G = (int)gridDim.x, c = (int)blockIdx.x;
    LAS float* tb = (LAS float*)(lds + MTAB_OFF);
    LAS unsigned short* rt16 = (LAS unsigned short*)(lds + MTAB_OFF + 17 * 1024);
    MoeSchedT<unsigned short> S{G, c, nM, 8, (const char*)(P.ws + (layer ? WS_MW1 : WS_MWIN)), (size_t)2048 * 1024, rt16, ps, 1024u, 1024u};
    { g2::Unit u; for (int i = 0; i < 17 && S.next(i, u); ++i) { const int e = S.expert(u.pm);
        if (threadIdx.x < 256) { const int t = threadIdx.x; tb[i * 256 + t] = b_in[e * 2048 + (t >> 7) * 1024 + u.pn * 128 + (t & 127)]; }
        else { const int t = threadIdx.x - 256; rt16[i * 256 + t] = (unsigned short)row_tok[u.pm * 256 + t]; } } }
    __syncthreads();
    EpiMoeUp E{(unsigned*)(P.ws + WS_HACT), tb};
    g2::gemm_phase<true>(lds, (const char*)(P.ws + WS_X1F), 8, 1024u, S, E);
    if (layer == 0) { const int r = (nM * 8) % G; if (r != 0 && c >= r) convert_range_wg(P, 1, (c - r) * TAIL_QUOTA, TAIL_QUOTA, lds); }
}
struct EpiMoeDown {
    static constexpr int NVMEM = 32;
    bf16_t* yb; const LAS float* tb;
    __device__ __forceinline__ void operator()(f32x4 (&acc)[2][2][4][2], const g2::Unit& u, int wr, int wc, int fr, int fq) const {
#pragma unroll
        for (int bj = 0; bj < 2; ++bj)
#pragma unroll
            for (int n = 0; n < 2; ++n) {
                const int cl = bj * 128 + wc * 32 + n * 16 + fq * 4;
                const f32x4 bv = *(const LAS f32x4*)(tb + u.idx * 512 + cl);
#pragma unroll
                for (int ai = 0; ai < 2; ++ai)
#pragma unroll
                    for (int m = 0; m < 4; ++m) {
                        const int rl = ai * 128 + wr * 64 + m * 16 + fr; const float gt = tb[u.idx * 512 + 256 + rl];
                        store_bf16x4(yb + (size_t)(u.pm * 256 + rl) * 1024 + u.pn * 256 + cl, (acc[ai][bj][m][n] * (1.0f / (FP8_SH * FP8_SWOUT)) + bv) * gt);
                    }
            }
    }
};
__device__ __forceinline__ void ph_moe_down2(const Params& P, lds_t* lds, int layer) {
    moe_pstart(P, lds, layer);
    LAS int* ps = (LAS int*)(lds + PS_OFF);
    const float* row_gate = (const float*)((const int*)(P.ws + WS_ROUTE) + 4 * T * 4 + MOE_ROWS);
    const float* b_out = P.in[I_M_BOUT] + (size_t)layer * 32 * 1024;
    const int nM = ps[32] >> 8, G = (int)gridDim.x, c = (int)blockIdx.x;
    LAS float* tb = (LAS float*)(lds + MTAB_OFF);
    LAS unsigned* rt32 = (LAS unsigned*)(lds + MTAB_OFF + 9 * 2048);
    MoeSchedT<unsigned> S{G, c, nM, 4, (const char*)(P.ws + (layer ? WS_MW1 : WS_MWIN) + (size_t)32 * 2048 * 1024), (size_t)1024 * 1024, rt32, ps, 1024u, 1024u};
    { g2::Unit u; for (int i = 0; i < 9 && S.next(i, u); ++i) { const int e = S.expert(u.pm);
        const int t = threadIdx.x; tb[i * 512 + t] = (t < 256) ? b_out[e * 1024 + u.pn * 256 + t] : row_gate[u.pm * 256 + (t - 256)]; if (t < 256) rt32[i * 256 + t] = (unsigned)(u.pm * 256 + t); } }
    __syncthreads();
    EpiMoeDown E{(bf16_t*)(P.ws + WS_YB), tb};
    g2::gemm_phase<true>(lds, (const char*)(P.ws + WS_HACT), 8, 1024u, S, E);
    if (layer == 0) { const int r = (nM * 4) % G; if (r != 0 && c >= r) convert_range_wg(P, 1, tail_done_up(nM, G) + (c - r) * TAIL_QUOTA, TAIL_QUOTA, lds); }
}

__device__ __forceinline__ void ph_combine_ln(const Params& P, int layer, float* outf  ) {
    const bf16_t* yb = (const bf16_t*)(P.ws + WS_YB); bf16_t* xb = (bf16_t*)(P.ws + WS_XB);
    const int* dest = (const int*)(P.ws + WS_ROUTE) + 3 * T * 4;
    const float* lg = P.in[I_LNF_G] + layer * 1024; const float* lb = P.in[I_LNF_B] + layer * 1024;
    const int lane = threadIdx.x & 63, gw = blockIdx.x * 8 + (threadIdx.x >> 6), NGW = gridDim.x * 8;
    int4 dnext[2];
#pragma unroll
    for (int rr = 0; rr < 2; ++rr) dnext[rr] = (gw * 2 + rr < T) ? *(const int4*)(dest + (gw * 2 + rr) * 4) : (int4){0, 0, 0, 0};
    for (int row0 = gw * 2; row0 < T; row0 += NGW * 2) {
        f32x4 v[2][4]; u32x2 yr[2][4][4];
        int4 dcur[2];
#pragma unroll
        for (int rr = 0; rr < 2; ++rr) { dcur[rr] = dnext[rr]; const int nr = row0 + NGW * 2 + rr; if (nr < T) dnext[rr] = *(const int4*)(dest + nr * 4); }
#pragma unroll
        for (int rr = 0; rr < 2; ++rr) {
            const int row = row0 + rr;
            const int4 d = dcur[rr];
            const int dd[4] = {d.x, d.y, d.z, d.w};
#pragma unroll
            for (int j = 0; j < 4; ++j) {
                { const u32x2 xq = *(const u32x2*)(xb + (size_t)row * 1024 + j * 256 + lane * 4); v[rr][j] = (f32x4){__uint_as_float(xq.x << 16), __uint_as_float(xq.x & 0xffff0000u), __uint_as_float(xq.y << 16), __uint_as_float(xq.y & 0xffff0000u)}; }
#pragma unroll
                for (int k = 0; k < 4; ++k) yr[rr][j][k] = *(const u32x2*)(yb + (size_t)dd[k] * 1024 + j * 256 + lane * 4);
            }
        }
#pragma unroll
        for (int rr = 0; rr < 2; ++rr) {
            const int row = row0 + rr; float s = 0.f;
#pragma unroll
            for (int j = 0; j < 4; ++j) {
                v[rr][j] = v[rr][j] * ALPHA;
#pragma unroll
                for (int k = 0; k < 4; ++k) {
                    const u32x2 r = yr[rr][j][k];
                    v[rr][j][0] += __uint_as_float(r.x << 16); v[rr][j][1] += __uint_as_float(r.x & 0xffff0000u); v[rr][j][2] += __uint_as_float(r.y << 16); v[rr][j][3] += __uint_as_float(r.y & 0xffff0000u);
                }
                s += (v[rr][j][0] + v[rr][j][1]) + (v[rr][j][2] + v[rr][j][3]);
            }
            const float mean = wave_sum(s) * (1.0f / 1024.0f); float s2 = 0.f;
#pragma unroll
            for (int j = 0; j < 4; ++j) { v[rr][j] = v[rr][j] - mean; s2 += (v[rr][j][0] * v[rr][j][0] + v[rr][j][1] * v[rr][j][1]) + (v[rr][j][2] * v[rr][j][2] + v[rr][j][3] * v[rr][j][3]); }
            const float rstd = rsqrtf(wave_sum(s2) * (1.0f / 1024.0f) + LN_EPS);
#pragma unroll
            for (int j = 0; j < 4; ++j) {
                const f32x4 o = v[rr][j] * rstd * *(const f32x4*)(lg + j * 256 + lane * 4) + *(const f32x4*)(lb + j * 256 + lane * 4);
                if (outf) *(f32x4*)(outf + (size_t)row * 1024 + j * 256 + lane * 4) = o;
                else store_bf16x4(xb + (size_t)row * 1024 + j * 256 + lane * 4, o);
            }
        }
    }
}

__device__ __forceinline__ void ph_conv1(const Params& P, lds_t* lds) {
    const bf16_t* proj = (const bf16_t*)(P.ws + WS_PROJ); bf16_t* xconv = (bf16_t*)(P.ws + WS_XCONV); float* gates = (float*)(P.ws + WS_GATES);
    LAS float* Wc = (LAS float*)lds;
    const float* Wcg = (const float*)(P.ws + WS_WC);
    for (int i = threadIdx.x; i < 8192; i += NTHREADS) {
        const int which = i >> 12, ch = (i >> 3) & 511, gg = i & 7;
        Wc[which * 4096 + (((ch & 7) * 2 + (gg >> 2)) * 64 + (ch >> 3)) * 4 + (gg & 3)] = Wcg[i];
    }
    __syncthreads();
    const int lane = threadIdx.x & 63, gw = blockIdx.x * 8 + (threadIdx.x >> 6), NGW = gridDim.x * 8, c8 = lane * 8;
    float w[4][8], bias[8];
#pragma unroll
    for (int e = 0; e < 8; ++e) { bias[e] = P.in[I_CD_CONVB][c8 + e];
#pragma unroll
        for (int k = 0; k < 4; ++k) w[k][e] = P.in[I_CD_CONVW][k * 512 + c8 + e]; }
    const float bif = P.in[I_CD_BIF][lane & 7];
    for (int run = gw; run < T / 8; run += NGW) {
        const int tok0 = run * 8, p0 = tok0 & (SEQ - 1);
        u32x4 r[11];
#pragma unroll
        for (int i = 0; i < 11; ++i) { r[i] = (u32x4){0u, 0u, 0u, 0u}; if (p0 + i - 3 >= 0) r[i] = *(const u32x4*)(proj + (size_t)(tok0 + i - 3) * 2560 + c8); }
#pragma unroll
        for (int t = 0; t < 8; ++t) {
            int woff = lane * 4; asm volatile("" : "+v"(woff));
            const int tok = tok0 + t;
            float a[8], xraw[8];
#pragma unroll
            for (int e = 0; e < 8; ++e) a[e] = bias[e];
#pragma unroll
            for (int k = 0; k < 4; ++k) { float xv[8]; unpack8(r[t + k], xv);
#pragma unroll
                for (int e = 0; e < 8; ++e) { a[e] += w[k][e] * xv[e]; if (k == 3) xraw[e] = xv[e]; } }
#pragma unroll
            for (int e = 0; e < 8; ++e) a[e] = a[e] * fsigmoid(a[e]);
            const u32x4 packed = pack8(a);
            *(u32x4*)(xconv + (size_t)tok * 512 + c8) = packed;
            float ar[8]; unpack8(packed, ar);
            float gs[8];
#pragma unroll
            for (int gg = 0; gg < 8; ++gg) gs[gg] = 0.f;
#pragma unroll
            for (int e = 0; e < 8; ++e) {
                const f32x4 w1a = *(LAS f32x4*)(Wc + woff + (e * 2) * 256), w1b = *(LAS f32x4*)(Wc + woff + (e * 2 + 1) * 256);
                const f32x4 w2a = *(LAS f32x4*)(Wc + 4096 + woff + (e * 2) * 256), w2b = *(LAS f32x4*)(Wc + 4096 + woff + (e * 2 + 1) * 256);
#pragma unroll
                for (int gg = 0; gg < 4; ++gg) { gs[gg] += ar[e] * w1a[gg] + xraw[e] * w2a[gg]; gs[gg + 4] += ar[e] * w1b[gg] + xraw[e] * w2b[gg]; }
            }
            float mine = 0.f;
#pragma unroll
            for (int gg = 0; gg < 8; ++gg) { const float tsum = wave_sum(gs[gg]); if ((lane & 7) == gg) mine = tsum; }
            if (lane < 8) gates[(size_t)tok * 8 + lane] = mine + bif;
        }
    }
}

__device__ __forceinline__ void ph_qkv(const Params& P, lds_t* lds) {
    const bf16_t* xconv = (const bf16_t*)(P.ws + WS_XCONV); const bf16_t* proj = (const bf16_t*)(P.ws + WS_PROJ); const bf16_t* Wt = (const bf16_t*)(P.ws + WS_WQKV);
    bf16_t* qb = (bf16_t*)(P.ws + WS_QB); static_assert(WS_KB == WS_QB + 32 * MiB && WS_VB == WS_QB + 64 * MiB, "q/k/v spacing");
    const int b0 = (int)blockIdx.x, G = (int)gridDim.x;
#define QKV_DECODE(J) const int tile = b0 + (J) * G, which = tile % 3, rt = (tile / 3) & 127, h = tile / 384; (void)rt;
    e1_stream<true>(lds, wg_tiles(1536), [](int) { return 2; },
        [=](int j, int, int r, int kp) { QKV_DECODE(j) const bf16_t* A = which < 2 ? xconv : proj; const int lda = which < 2 ? 512 : 2560; return *(const u32x4*)(A + (size_t)(rt * 256 + r) * lda + h * 128 + kp * 8); },
        [=](int j, int, int n, int kp) { QKV_DECODE(j) return *(const u32x4*)(Wt + (size_t)(which * 4 + h) * 16384 + n * 128 + kp * 8); },
        [=](int j, f32x4 (&acc)[4][4], int wr, int wc, int fr, int fq) {
            QKV_DECODE(j)
            bf16_t* out = (bf16_t*)((unsigned char*)qb + (size_t)which * (32 * MiB));
            const float sc = which == 1 ? 0.08838834764831845f : 1.0f;
#pragma unroll
            for (int m = 0; m < 4; ++m)
#pragma unroll
                for (int n = 0; n < 4; ++n)
                    store_bf16x4(out + (size_t)(rt * 256 + wr * 64 + m * 16 + fr) * 512 + h * 128 + wc * 64 + n * 16 + fq * 4, acc[m][n] * sc);
        });
#undef QKV_DECODE
}

constexpr int TP = 272;
__device__ __forceinline__ void ph_m1(const Params& P, lds_t* lds) {
    const bf16_t* kb = (const bf16_t*)(P.ws + WS_KB); const bf16_t* vb = (const bf16_t*)(P.ws + WS_VB); const float* gates = (const float*)(P.ws + WS_GATES);
    bf16_t* kvc = (bf16_t*)(P.ws + WS_KVC); float* nchunk = (float*)(P.ws + WS_MISC); float* scal = nchunk + 2 * 2048 * 128;
    lds_t* Kt = lds; lds_t* Vt = lds + 64 * TP; LAS float* wv = (LAS float*)(lds + 128 * TP);
    const int tid = threadIdx.x, lane = tid & 63, w = tid >> 6, fr = lane & 15, fq = lane >> 4, q = (lane & 15) >> 2, p4 = lane & 3;
    int item = blockIdx.x; if (item >= 2048) return;
    u32x4 rk[2], rv[2]; float pf_f, pf_i;
#define M1_LOAD(IT) do { const int bh_ = (IT) >> 6, n_ = (IT) & 63, b_ = bh_ >> 2, h_ = bh_ & 3; const size_t t0_ = (size_t)b_ * SEQ + n_ * 64; \
        _Pragma("unroll") for (int i_ = 0; i_ < 2; ++i_) { const int p_ = tid + i_ * NTHREADS; const size_t o_ = (t0_ + (p_ >> 4)) * 512 + h_ * 128 + (p_ & 15) * 8; rk[i_] = *(const u32x4*)(kb + o_); rv[i_] = *(const u32x4*)(vb + o_); } \
        pf_f = gates[(t0_ + lane) * 8 + 4 + h_]; pf_i = gates[(t0_ + lane) * 8 + h_]; } while (0)
    M1_LOAD(item);
    for (;;) {
#pragma unroll
        for (int i = 0; i < 2; ++i) { const int p = tid + i * NTHREADS; *(LAS u32x4*)(Kt + (p >> 4) * TP + (p & 15) * 16) = rk[i]; *(LAS u32x4*)(Vt + (p >> 4) * TP + (p & 15) * 16) = rv[i]; }
        if (w == 0) {
            float cum = logsigmoidf(pf_f);
#pragma unroll
            for (int off = 1; off < 64; off <<= 1) { const float t = __shfl_up(cum, off); if (lane >= off) cum += t; }
            const float cf = __shfl(cum, 63), te = cf - cum + pf_i, m = wave_max(te);
            wv[lane] = expf(te - m);
            if (lane == 0) { scal[item] = cf; scal[2048 + item] = m; }
        }
        __syncthreads();
        const int nitem = item + gridDim.x; const bool has_next = nitem < 2048;
        if (has_next) M1_LOAD(nitem);
        bf16x8 af[2]; float nsum = 0.f;
#pragma unroll
        for (int ks = 0; ks < 2; ++ks) {
            unsigned pk[4];
#pragma unroll
            for (int t = 0; t < 2; ++t) {
                const int s0 = 32 * ks + 8 * fq + 4 * t;
                const bf16x4 r = tr_read(Kt + (s0 + q) * TP + (16 * w + 4 * p4) * 2);
                const f32x4 ww = *(LAS f32x4*)(wv + s0);
                float x[4];
#pragma unroll
                for (int e = 0; e < 4; ++e) { x[e] = bf2f((unsigned short)r[e]) * ww[e]; nsum += x[e]; }
                pk[2 * t] = pk_bf16(x[0], x[1]); pk[2 * t + 1] = pk_bf16(x[2], x[3]);
            }
            u32x4 u = {pk[0], pk[1], pk[2], pk[3]}; af[ks] = __builtin_bit_cast(bf16x8, u);
        }
        nsum += __shfl_xor(nsum, 16); nsum += __shfl_xor(nsum, 32);
        if (fq == 0) nchunk[(size_t)item * 128 + 16 * w + fr] = nsum;
#pragma unroll
        for (int c = 0; c < 8; ++c) {
            f32x4 acc = {0.f, 0.f, 0.f, 0.f};
#pragma unroll
            for (int ks = 0; ks < 2; ++ks) {
                const int s0 = 32 * ks + 8 * fq;
                const bf16x8 bfv = cat44(tr_read(Vt + (s0 + q) * TP + (16 * c + 4 * p4) * 2), tr_read(Vt + (s0 + 4 + q) * TP + (16 * c + 4 * p4) * 2));
                acc = MFMA16(af[ks], bfv, acc);
            }
            store_bf16x4(kvc + ((size_t)item * 128 + c * 16 + fr) * 128 + 16 * w + fq * 4, acc);
        }
        __syncthreads();
        if (!has_next) break;
        item = nitem;
    }
#undef M1_LOAD
}

__device__ __forceinline__ void ph_m2(const Params& P) {
    const bf16_t* kvc = (const bf16_t*)(P.ws + WS_KVC); bf16_t* cprev = (bf16_t*)(P.ws + WS_CPREV);
    const float* nchunk = (const float*)(P.ws + WS_MISC); float* nprev = (float*)(P.ws + WS_MISC) + 2048 * 128; float* scal = (float*)(P.ws + WS_MISC) + 2 * 2048 * 128;
    const int tid = threadIdx.x;
    for (int it = blockIdx.x; it < 256; it += gridDim.x) {
        const int bh = it >> 3, sl = it & 7, idx = sl * 2048 + tid * 4;
        const bool donv = (sl == 0 && tid < 128);
        f32x4 C = {0.f, 0.f, 0.f, 0.f}; float nv = 0.f, m = -INFINITY;
        for (int n0 = 0; n0 < 64; n0 += 4) {
            f32x4 kv[4]; float nc[4], fc[4], mc[4];
#pragma unroll
            for (int j = 0; j < 4; ++j) {
                const int item = bh * 64 + n0 + j;
                { const u32x2 kq = *(const u32x2*)(kvc + (size_t)item * 16384 + idx); kv[j] = (f32x4){__uint_as_float(kq.x << 16), __uint_as_float(kq.x & 0xffff0000u), __uint_as_float(kq.y << 16), __uint_as_float(kq.y & 0xffff0000u)}; }
                nc[j] = donv ? nchunk[(size_t)item * 128 + tid] : 0.f;
                fc[j] = scal[item]; mc[j] = scal[2048 + item];
            }
#pragma unroll
            for (int j = 0; j < 4; ++j) {
                const int item = bh * 64 + n0 + j;
                store_bf16x4(cprev + (size_t)item * 16384 + idx, C);
                if (donv) nprev[(size_t)item * 128 + tid] = nv;
                if (sl == 0 && tid == 0) scal[4096 + item] = m;
                const float mn = fmaxf(fc[j] + m, mc[j]), so = expf(fc[j] + m - mn), sn = expf(mc[j] - mn);
                C = C * so + kv[j] * sn; nv = so * nv + sn * nc[j]; m = mn;
            }
        }
    }
}

__device__ __forceinline__ void ph_m3(const Params& P, lds_t* lds) {
    const bf16_t* qb = (const bf16_t*)(P.ws + WS_QB); const bf16_t* kb = (const bf16_t*)(P.ws + WS_KB); const bf16_t* vb = (const bf16_t*)(P.ws + WS_VB);
    const bf16_t* cprev = (const bf16_t*)(P.ws + WS_CPREV); const float* gates = (const float*)(P.ws + WS_GATES);
    const float* nprev = (const float*)(P.ws + WS_MISC) + 2048 * 128; const float* scal = (const float*)(P.ws + WS_MISC) + 2 * 2048 * 128;
    const bf16_t* proj = (const bf16_t*)(P.ws + WS_PROJ); bf16_t* cat = (bf16_t*)(P.ws + WS_CAT);
    lds_t* Qt = lds; lds_t* Kt = lds + 64 * TP; lds_t* Vt = lds + 128 * TP; lds_t* Ct = lds + 192 * TP;
    LAS float* cumf = (LAS float*)(lds + 320 * TP); LAS float* gv = cumf + 64; LAS float* msv = gv + 64; LAS float* npv = msv + 64; LAS float* ex = npv + 128;
    const int tid = threadIdx.x, lane = tid & 63, w = tid >> 6, fr = lane & 15, fq = lane >> 4, q = (lane & 15) >> 2, p4 = lane & 3;
    const int rt = w & 3, vh = w >> 2;
    int item = blockIdx.x; if (item >= 2048) return;
    u32x4 rq[2], rk[2], rv[2], rc[4]; float pf_f, pf_i, pf_n, pf_mp;
#define M3_LOAD(IT) do { const int bh_ = (IT) >> 6, n_ = (IT) & 63, b_ = bh_ >> 2, h_ = bh_ & 3; const size_t t0_ = (size_t)b_ * SEQ + n_ * 64; \
        _Pragma("unroll") for (int i_ = 0; i_ < 2; ++i_) { const int p_ = tid + i_ * NTHREADS; const size_t o_ = (t0_ + (p_ >> 4)) * 512 + h_ * 128 + (p_ & 15) * 8; rq[i_] = *(const u32x4*)(qb + o_); rk[i_] = *(const u32x4*)(kb + o_); rv[i_] = *(const u32x4*)(vb + o_); } \
        _Pragma("unroll") for (int i_ = 0; i_ < 4; ++i_) { const int p_ = tid + i_ * NTHREADS; rc[i_] = *(const u32x4*)(cprev + (size_t)(IT) * 16384 + (p_ >> 4) * 128 + (p_ & 15) * 8); } \
        pf_f = gates[(t0_ + lane) * 8 + 4 + h_]; pf_i = gates[(t0_ + lane) * 8 + h_]; pf_n = nprev[(size_t)(IT) * 128 + (tid & 127)]; pf_mp = scal[4096 + (IT)]; } while (0)
    M3_LOAD(item);
    for (;;) {
        const int bh = item >> 6, n = item & 63, b = bh >> 2, h = bh & 3; const size_t tok0 = (size_t)b * SEQ + n * 64;
#pragma unroll
        for (int i = 0; i < 2; ++i) { const int p = tid + i * NTHREADS; const int o = (p >> 4) * TP + (p & 15) * 16; *(LAS u32x4*)(Qt + o) = rq[i]; *(LAS u32x4*)(Kt + o) = rk[i]; *(LAS u32x4*)(Vt + o) = rv[i]; }
#pragma unroll
        for (int i = 0; i < 4; ++i) { const int p = tid + i * NTHREADS; *(LAS u32x4*)(Ct + (p >> 4) * TP + (p & 15) * 16) = rc[i]; }
        if (tid < 128) npv[tid] = pf_n;
        const float mp = pf_mp;
        if (w == 0) {
            float cum = logsigmoidf(pf_f);
#pragma unroll
            for (int off = 1; off < 64; off <<= 1) { const float t = __shfl_up(cum, off); if (lane >= off) cum += t; }
            const float gg = pf_i - cum; float pm = gg;
#pragma unroll
            for (int off = 1; off < 64; off <<= 1) { const float t = __shfl_up(pm, off); if (lane >= off) pm = fmaxf(pm, t); }
            cumf[lane] = cum; gv[lane] = gg; msv[lane] = cum + fmaxf(pm, mp);
        }
        __syncthreads();
        const int nitem = item + gridDim.x; const bool has_next = nitem < 2048;
        if (has_next) M3_LOAD(nitem);
        unsigned short opv[4][4];
#pragma unroll
        for (int c = 0; c < 4; ++c)
#pragma unroll
            for (int r = 0; r < 4; ++r) opv[c][r] = proj[(tok0 + rt * 16 + fq * 4 + r) * 2560 + 512 + h * 128 + vh * 64 + c * 16 + fr];
        bf16x8 qf[4];
#pragma unroll
        for (int ks = 0; ks < 4; ++ks) qf[ks] = *(LAS bf16x8*)(Qt + (rt * 16 + fr) * TP + ks * 64 + fq * 16);
        const int s = rt * 16 + fr; const float cs = cumf[s], mss = msv[s];
        float sp[4][4]; float rowsum = 0.f;
#pragma unroll
        for (int jt = 0; jt < 4; ++jt) {
            f32x4 st = {0.f, 0.f, 0.f, 0.f};
            if (jt <= rt) {
#pragma unroll
                for (int ks = 0; ks < 4; ++ks) st = MFMA16(*(LAS bf16x8*)(Kt + (jt * 16 + fr) * TP + ks * 64 + fq * 16), qf[ks], st);
            }
            const f32x4 g4 = *(LAS f32x4*)(gv + jt * 16 + fq * 4);
#pragma unroll
            for (int r = 0; r < 4; ++r) { const int j = jt * 16 + fq * 4 + r; const float wgt = (j <= s) ? fexp(cs + g4[r] - mss) : 0.f; sp[jt][r] = st[r] * wgt; rowsum += sp[jt][r]; }
        }
        rowsum += __shfl_xor(rowsum, 16); rowsum += __shfl_xor(rowsum, 32);
        float qn = 0.f;
#pragma unroll
        for (int ks = 0; ks < 4; ++ks) {
            const f32x4 n0 = *(LAS f32x4*)(npv + ks * 32 + fq * 8), n1 = *(LAS f32x4*)(npv + ks * 32 + fq * 8 + 4);
#pragma unroll
            for (int e = 0; e < 4; ++e) { qn += bf2f((unsigned short)qf[ks][e]) * n0[e]; qn += bf2f((unsigned short)qf[ks][4 + e]) * n1[e]; }
        }
        qn += __shfl_xor(qn, 16); qn += __shfl_xor(qn, 32);
        const float inter = expf(cs + mp - mss), den = rowsum + inter * qn, inv = 1.0f / fmaxf(fabsf(den), expf(-mss));
        if (fq == 0) { ex[w * 32 + fr] = inv; ex[w * 32 + 16 + fr] = inter; }
        __builtin_amdgcn_wave_barrier();
        const f32x4 inv4 = *(LAS f32x4*)(ex + w * 32 + fq * 4), int4 = *(LAS f32x4*)(ex + w * 32 + 16 + fq * 4);
        bf16x8 pa[2];
#pragma unroll
        for (int kk = 0; kk < 2; ++kk) { u32x4 u = {pk_bf16(sp[2 * kk][0], sp[2 * kk][1]), pk_bf16(sp[2 * kk][2], sp[2 * kk][3]), pk_bf16(sp[2 * kk + 1][0], sp[2 * kk + 1][1]), pk_bf16(sp[2 * kk + 1][2], sp[2 * kk + 1][3])}; pa[kk] = __builtin_bit_cast(bf16x8, u); }
#pragma unroll
        for (int c = 0; c < 4; ++c) {
            const int vcol = vh * 64 + c * 16;
            f32x4 acc = {0.f, 0.f, 0.f, 0.f};
#pragma unroll
            for (int ks = 0; ks < 4; ++ks) acc = MFMA16(qf[ks], *(LAS bf16x8*)(Ct + (vcol + fr) * TP + ks * 64 + fq * 16), acc);
#pragma unroll
            for (int r = 0; r < 4; ++r) acc[r] *= int4[r];
#pragma unroll
            for (int kk = 0; kk < 2; ++kk) {
                const bf16x8 vbf = cat44(tr_read(Vt + (32 * kk + 4 * fq + q) * TP + (vcol + 4 * p4) * 2), tr_read(Vt + (32 * kk + 16 + 4 * fq + q) * TP + (vcol + 4 * p4) * 2));
                acc = MFMA16(pa[kk], vbf, acc);
            }
#pragma unroll
            for (int r = 0; r < 4; ++r) {
                const size_t tok = tok0 + rt * 16 + fq * 4 + r; const int col = h * 128 + vcol + fr;
                cat[tok * 1024 + col] = (bf16_t)(pk_bf16(fsigmoid(bf2f(opv[c][r])) * acc[r] * inv4[r], 0.f) & 0xffffu);
            }
        }
        __syncthreads();
        if (!has_next) break;
        item = nitem;
    }
#undef M3_LOAD
}

__device__ __forceinline__ void ph_attn(const Params& P, lds_t* lds) {
    const bf16_t* proj = (const bf16_t*)(P.ws + WS_PROJ); bf16_t* atto = (bf16_t*)(P.ws + WS_ATTO); float* lse = (float*)(P.ws + WS_LSE);
    lds_t* Kt = lds; lds_t* Vt = lds + 256 * TP; LAS float* ex = (LAS float*)(lds + 512 * TP);
    const int tid = threadIdx.x, lane = tid & 63, w = tid >> 6, fr = lane & 15, fq = lane >> 4, q = (lane & 15) >> 2, p4 = lane & 3;
    const int per = (3072 + (int)gridDim.x - 1) / (int)gridDim.x;
    int item = (int)blockIdx.x * per; const int iend = (item + per < 3072) ? item + per : 3072;
    if (item >= iend) return;
    u32x4 rg[16]; bf16x8 qf[4], qn[4];
#define AT_DECODE(IT) const int g = (IT) >> 10, rem = (IT) & 1023, dsh = 2 * g, dil = 1 << dsh, nbsh = 5 - dsh, nb = rem & ((1 << nbsh) - 1), chain = rem >> nbsh, \
        h = chain & 3, br = chain >> 2, r = br & (dil - 1), b = br >> dsh; const size_t tokb = (size_t)b * SEQ + r;
#define AT_LOAD(IT, CHAINED, QF) do { AT_DECODE(IT) \
        _Pragma("unroll") for (int it8 = 0; it8 < 8; ++it8) { const int p = tid + it8 * NTHREADS, kr = p >> 4, pc = p & 15; const int i = nb * 128 + kr - 128; \
            rg[it8] = (u32x4){0u, 0u, 0u, 0u}; rg[8 + it8] = (u32x4){0u, 0u, 0u, 0u}; \
            if (i >= 0 && !((CHAINED) && it8 < 4)) { const bf16_t* src = proj + (tokb + (size_t)i * dil) * 2560 + h * 128 + pc * 8; rg[it8] = *(const u32x4*)(src + 1536); rg[8 + it8] = *(const u32x4*)(src + 2048); } } \
        const size_t tq_ = tokb + (size_t)(nb * 128 + w * 16 + fr) * dil; \
        _Pragma("unroll") for (int ks = 0; ks < 4; ++ks) QF[ks] = __builtin_bit_cast(bf16x8, *(const u32x4*)(proj + tq_ * 2560 + 1024 + h * 128 + ks * 32 + fq * 8)); } while (0)
    bool chained = false; int flip = 0;
    AT_LOAD(item, false, qf);
    for (;;) {
        if (!chained) {
            flip = 0;
#pragma unroll
            for (int it8 = 0; it8 < 8; ++it8) { const int p = tid + it8 * NTHREADS, kr = p >> 4, pc = p & 15; *(LAS u32x4*)(Kt + kr * TP + pc * 16) = rg[it8]; *(LAS u32x4*)(Vt + kr * TP + pc * 16) = rg[8 + it8]; }
        } else {
            flip ^= 1;
#pragma unroll
            for (int it8 = 4; it8 < 8; ++it8) { const int p = tid + it8 * NTHREADS, kr = (p >> 4) & 127, pc = p & 15; const int pr = ((1 ^ flip) << 7) + kr;
                *(LAS u32x4*)(Kt + pr * TP + pc * 16) = rg[it8]; *(LAS u32x4*)(Vt + pr * TP + pc * 16) = rg[8 + it8]; }
        }
        __syncthreads();
        const int nitem = item + 1; const bool has_next = nitem < iend;
        bool chained_next = false;
        if (has_next) { const int g2 = nitem >> 10, nbm = (1 << (5 - 2 * g2)) - 1; chained_next = (g2 == (item >> 10)) && ((nitem & 1023 & nbm) != 0); }
        if (has_next) { if (chained_next) AT_LOAD(nitem, true, qn); else AT_LOAD(nitem, false, qn); }
        AT_DECODE(item)
        const int qi = w * 16 + fr;
        const size_t tokq = tokb + (size_t)(nb * 128 + qi) * dil;
        float pv[9][4]; float mx = -INFINITY;
#pragma unroll
        for (int jj = 0; jj < 9; ++jj) {
            const int tw = w + jj, pt = ((((tw >> 3) ^ flip) & 1) << 3) + (tw & 7);
            f32x4 st = {0.f, 0.f, 0.f, 0.f};
#pragma unroll
            for (int ks = 0; ks < 4; ++ks) st = MFMA16(*(LAS bf16x8*)(Kt + (pt * 16 + fr) * TP + ks * 64 + fq * 16), qf[ks], st);
#pragma unroll
            for (int rr = 0; rr < 4; ++rr) {
                const int kj = tw * 16 + fq * 4 + rr;
                const bool valid = (kj >= qi) && (kj <= qi + 128) && (nb > 0 || kj >= 128);
                pv[jj][rr] = valid ? st[rr] : -INFINITY; mx = fmaxf(mx, pv[jj][rr]);
            }
        }
        mx = fmaxf(mx, __shfl_xor(mx, 16)); mx = fmaxf(mx, __shfl_xor(mx, 32));
        float l = 0.f;
#pragma unroll
        for (int jj = 0; jj < 9; ++jj)
#pragma unroll
            for (int rr = 0; rr < 4; ++rr) { pv[jj][rr] = fexp(pv[jj][rr] - mx); l += pv[jj][rr]; }
        l += __shfl_xor(l, 16); l += __shfl_xor(l, 32);
        if (fq == 0) { ex[w * 16 + fr] = 1.0f / l; lse[((size_t)g * T + tokq) * 4 + h] = mx + logf(l); }
        __builtin_amdgcn_wave_barrier();
        const f32x4 inv4 = *(LAS f32x4*)(ex + w * 16 + fq * 4);
        f32x4 acc[8];
#pragma unroll
        for (int c = 0; c < 8; ++c) acc[c] = (f32x4){0.f, 0.f, 0.f, 0.f};
#pragma unroll
        for (int kk = 0; kk < 5; ++kk) {
            const int ja = 2 * kk, jb = (2 * kk + 1 < 9) ? 2 * kk + 1 : 2 * kk;
            const int twa = w + ja, twb = w + jb;
            const int pa_t = ((((twa >> 3) ^ flip) & 1) << 3) + (twa & 7), pb_t = ((((twb >> 3) ^ flip) & 1) << 3) + (twb & 7);
            u32x4 u; u.x = pk_bf16(pv[ja][0], pv[ja][1]); u.y = pk_bf16(pv[ja][2], pv[ja][3]);
            if (2 * kk + 1 < 9) { u.z = pk_bf16(pv[jb][0], pv[jb][1]); u.w = pk_bf16(pv[jb][2], pv[jb][3]); } else { u.z = 0u; u.w = 0u; }
            const bf16x8 pa = __builtin_bit_cast(bf16x8, u);
#pragma unroll
            for (int c = 0; c < 8; ++c) {
                const bf16x8 vbf = cat44(tr_read(Vt + (pa_t * 16 + 4 * fq + q) * TP + (c * 16 + 4 * p4) * 2), tr_read(Vt + (pb_t * 16 + 4 * fq + q) * TP + (c * 16 + 4 * p4) * 2));
                acc[c] = MFMA16(pa, vbf, acc[c]);
            }
        }
#pragma unroll
        for (int rr = 0; rr < 4; ++rr) {
            const size_t tq = tokb + (size_t)(nb * 128 + w * 16 + fq * 4 + rr) * dil;
#pragma unroll
            for (int c = 0; c < 8; ++c) atto[((size_t)g * T + tq) * 512 + h * 128 + c * 16 + fr] = (bf16_t)(pk_bf16(acc[c][rr] * inv4[rr], 0.f) & 0xffffu);
        }
        __syncthreads();
        if (!has_next) break;
        item = nitem; chained = chained_next;
#pragma unroll
        for (int ks = 0; ks < 4; ++ks) qf[ks] = qn[ks];
    }
#undef AT_LOAD
#undef AT_DECODE
}

__device__ __forceinline__ void ph_attn_combine(const Params& P) {
    const bf16_t* atto = (const bf16_t*)(P.ws + WS_ATTO); const float* lse = (const float*)(P.ws + WS_LSE); bf16_t* cat = (bf16_t*)(P.ws + WS_CAT);
    const size_t gtid = (size_t)blockIdx.x * NTHREADS + threadIdx.x, GT = (size_t)gridDim.x * NTHREADS;
    for (size_t i0 = gtid; i0 < (size_t)T * 128; i0 += 4 * GT) {
        float l[4][3]; u32x2 o[4][3];
#pragma unroll
        for (int j = 0; j < 4; ++j) {
            const size_t i = i0 + j * GT, tok = i >> 7; const int c4 = (int)(i & 127) * 4, h = c4 >> 7;
#pragma unroll
            for (int g = 0; g < 3; ++g) { l[j][g] = lse[((size_t)g * T + tok) * 4 + h]; o[j][g] = *(const u32x2*)(atto + ((size_t)g * T + tok) * 512 + c4); }
        }
#pragma unroll
        for (int j = 0; j < 4; ++j) {
            const size_t i = i0 + j * GT, tok = i >> 7; const int c4 = (int)(i & 127) * 4;
            const float mx = fmaxf(l[j][0], fmaxf(l[j][1], l[j][2])), e0 = expf(l[j][0] - mx), e1 = expf(l[j][1] - mx), e2 = expf(l[j][2] - mx), inv = 1.0f / (e0 + e1 + e2);
            f32x4 of[3];
#pragma unroll
            for (int g = 0; g < 3; ++g) of[g] = (f32x4){__uint_as_float(o[j][g].x << 16), __uint_as_float(o[j][g].x & 0xffff0000u), __uint_as_float(o[j][g].y << 16), __uint_as_float(o[j][g].y & 0xffff0000u)};
            store_bf16x4(cat + tok * 1024 + 512 + c4, (of[0] * e0 + of[1] * e1 + of[2] * e2) * inv);
        }
    }
}

constexpr int NPHASES = 33;
__device__ __forceinline__ void grid_barrier_cg(cg::grid_group& grid) {
    asm volatile("s_waitcnt vmcnt(0)" ::: "memory");
    grid.sync();
    __builtin_amdgcn_fence(__ATOMIC_ACQUIRE, "agent");
    asm volatile("s_waitcnt vmcnt(0)" ::: "memory");
}
#define XB_TMO      128
#define XB_XCNT(j)  (256  + 64 * (j))
#define XB_XSUB(j)  (1280 + 64 * (j))
#define XB_XGEN(j)  (2304 + 64 * (j))
#define XB_TOP      3328
#define XB_TOPGEN   3392
#define XCD_BAR_WORDS 3456
#define XB_SPIN_CAP (1u << 22)
__device__ __forceinline__ unsigned xb_ld(unsigned* p)              { return __hip_atomic_load(p, __ATOMIC_RELAXED, __HIP_MEMORY_SCOPE_AGENT); }
__device__ __forceinline__ unsigned xb_add(unsigned* p, unsigned v) { return __hip_atomic_fetch_add(p, v, __ATOMIC_RELAXED, __HIP_MEMORY_SCOPE_AGENT); }
__device__ __forceinline__ unsigned xb_xcc_id() { return (unsigned)__builtin_amdgcn_s_getreg((3 << 11) | 20) & 0xFu; }
#define XB_SPIN(cond, bar) do { unsigned _sp = 0; while (cond) { __builtin_amdgcn_s_sleep(1); \
    if ((++_sp & 255u) == 0u) { if (xb_ld(&(bar)[XB_TMO])) break; if (_sp > XB_SPIN_CAP) { atomicAdd(&(bar)[XB_TMO], 1u); break; } } } } while (0)
struct XcdBarrier { unsigned* bar; unsigned x; volatile LAS unsigned* st; };
__device__ __forceinline__ XcdBarrier xcd_barrier_post(unsigned* bar, volatile LAS unsigned* st) {
    XcdBarrier b; b.bar = bar; b.x = xb_xcc_id(); b.st = st;
    if (threadIdx.x == 0) (void)xb_add(&bar[XB_XCNT(b.x)], 1u);
    return b;
}
__device__ __forceinline__ void xcd_barrier_complete(unsigned* bar, unsigned x, unsigned& nloc, unsigned& nx) {
    const unsigned G = gridDim.x * gridDim.y * gridDim.z;
    unsigned sum, cnt, mine, sp = 0u;
    for (;;) {
        sum = 0u; cnt = 0u; mine = 0u;
#pragma unroll
        for (unsigned j = 0; j < 16; ++j) { const unsigned c = xb_ld(&bar[XB_XCNT(j)]); sum += c; cnt += (c > 0u) ? 1u : 0u; mine = (j == x) ? c : mine; }
        if (sum == G) break;
        __builtin_amdgcn_s_sleep(1);
        if ((++sp & 255u) == 0u) { if (xb_ld(&bar[XB_TMO])) break; if (sp > XB_SPIN_CAP) { atomicAdd(&bar[XB_TMO], 1u); break; } }
    }
    nloc = mine > 0u ? mine : 1u; nx = cnt > 0u ? cnt : 1u;
}
__device__ __forceinline__ void xcd_barrier(const XcdBarrier& b) {
    asm volatile("s_waitcnt vmcnt(0)" ::: "memory");
    __syncthreads();
    if (threadIdx.x == 0) {
        unsigned* bar = b.bar;
        __builtin_amdgcn_s_waitcnt(0);
        unsigned nloc = b.st[0], nx = b.st[1];
        if (nloc == 0u) { xcd_barrier_complete(bar, b.x, nloc, nx); b.st[0] = nloc; b.st[1] = nx; }
        const unsigned old = xb_add(&bar[XB_XSUB(b.x)], 1u);
        const unsigned gen = old / nloc;
        if (old + 1u == (gen + 1u) * nloc) {
            __builtin_amdgcn_fence(__ATOMIC_RELEASE, "agent");
            asm volatile("s_waitcnt vmcnt(0)" ::: "memory");
            const unsigned og = xb_add(&bar[XB_TOP], 1u);
            const unsigned tg = og / nx;
            if (og + 1u == (tg + 1u) * nx) xb_add(&bar[XB_TOPGEN], 1u);
            else XB_SPIN(xb_ld(&bar[XB_TOPGEN]) == tg, bar);
            __builtin_amdgcn_fence(__ATOMIC_ACQUIRE, "agent");
            xb_add(&bar[XB_XGEN(b.x)], 1u);
            asm volatile("s_waitcnt vmcnt(0)" ::: "memory");
        } else {
            XB_SPIN(xb_ld(&bar[XB_XGEN(b.x)]) == gen, bar);
            __builtin_amdgcn_fence(__ATOMIC_ACQUIRE, "agent");
            asm volatile("s_waitcnt vmcnt(0)" ::: "memory");
        }
    }
    __syncthreads();
}
typedef __attribute__((address_space(4))) const Params* KP4;
__device__ __forceinline__ const Params& phase_params() { KP4 kp = (KP4)__builtin_amdgcn_kernarg_segment_ptr(); asm volatile("" : "+s"(kp)); return *(const Params*)kp; }
__global__ void __launch_bounds__(NTHREADS) fwd_megakernel(Params Pk) {
    extern __shared__ __attribute__((aligned(16))) unsigned char lds_raw[];
    lds_t* lds = (lds_t*)lds_raw;
    cg::grid_group grid = cg::this_grid();
    const int ph_lo = Pk.ph_lo, ph_hi = Pk.ph_hi;
    unsigned* barw = (unsigned*)(Pk.ws + WS_CTL) + 4096;
    volatile LAS unsigned* bst = (volatile LAS unsigned*)(lds + LDS_BYTES - 64);
    if (threadIdx.x == 0) { bst[0] = 0u; bst[1] = 0u; }
    if (ph_hi < 0) grid_barrier_cg(grid);
    (void)xcd_barrier_post(barw, bst);
#define SEAM(k) do { XcdBarrier xb_; xb_.bar = (unsigned*)(P.ws + WS_CTL) + 4096; xb_.x = xb_xcc_id(); xb_.st = bst; xcd_barrier(xb_); } while (0)
#define PHASE(k, ...) if (ph_lo <= (k) && (k) < ph_hi) { const Params& P = phase_params(); unsigned char* ws = P.ws; (void)ws; __VA_ARGS__; if ((k) + 1 < ph_hi) SEAM(k); }
    PHASE(0, phase0(P, lds))
    PHASE(1, ph_inproj2(P, lds, (const bf16_t*)(ws + WS_WABIN), 1536, nullptr))
    PHASE(2, ph_conv0(P); ph_s5_state(P, lds))
    PHASE(3, ph_gates0(P, lds); ph_s5_carry(P))
    PHASE(4, ph_s5_out(P, lds))
    PHASE(5, ph_glu(P, lds); ph_lru_scan(P, lds))
    PHASE(6, ph_outproj2(P, lds, (const bf16_t*)(ws + WS_WABOUT)))
    PHASE(7, ph_ln_router(P, lds, 0, P.in[I_X]))
    PHASE(8, ph_route_scatter(P, lds, 0))
    PHASE(9, ph_moe_up2(P, lds, 0))
    PHASE(10, ph_moe_down2(P, lds, 0))
    PHASE(11, ph_combine_ln(P, 0, nullptr))
    PHASE(12, ph_inproj2(P, lds, (const bf16_t*)(ws + WS_WCDIN), 2560, (const int*)P.in[I_POS]); moe_pstart(P, lds, 0); convert_moe_weights(P, 1, tail_done_all(((LAS int*)(lds + PS_OFF))[32] >> 8, (int)gridDim.x), lds))
    PHASE(13, ph_conv1(P, lds))
    PHASE(14, ph_qkv(P, lds))
    PHASE(15, ph_m1(P, lds); ph_attn(P, lds))
    PHASE(16, ph_m2(P); ph_attn_combine(P))
    PHASE(17, ph_m3(P, lds))
    PHASE(18, ph_outproj2(P, lds, (const bf16_t*)(ws + WS_WCDOUT)))
    PHASE(19, ph_ln_router(P, lds, 1, nullptr))
    PHASE(20, ph_route_scatter(P, lds, 1))
    PHASE(21, ph_moe_up2(P, lds, 1))
    PHASE(22, ph_moe_down2(P, lds, 1))
    PHASE(23, ph_combine_ln(P, 1, P.out))
#undef PHASE
}

extern "C" void kernel_launch(void* const* d_in, const int* in_sizes, int n_in, void* d_out, int out_size, void* d_ws, size_t ws_size, hipStream_t stream) {
    static int grid_blocks = 0;
    if (grid_blocks == 0) {
        if (n_in != N_IN || out_size != T * D || ws_size < WS_END) { fprintf(stderr, "kernel_launch: unexpected shapes (n_in %d out %d ws %zu need %zu)\n", n_in, out_size, ws_size, (size_t)WS_END); grid_blocks = -1; return; }
        int dev = 0, cus = 0, per_cu = 0;
        (void)hipGetDevice(&dev);
        (void)hipDeviceGetAttribute(&cus, hipDeviceAttributeMultiprocessorCount, dev);
        if (hipFuncSetAttribute((const void*)fwd_megakernel, hipFuncAttributeMaxDynamicSharedMemorySize, LDS_BYTES) != hipSuccess) { fprintf(stderr, "kernel_launch: hipFuncSetAttribute failed\n"); grid_blocks = -1; return; }
        (void)hipOccupancyMaxActiveBlocksPerMultiprocessor(&per_cu, (const void*)fwd_megakernel, NTHREADS, LDS_BYTES);
        if (per_cu < 1) { fprintf(stderr, "kernel_launch: occupancy query returned %d\n", per_cu); grid_blocks = -1; return; }
        grid_blocks = cus * per_cu;
        if (grid_blocks != 256) { fprintf(stderr, "kernel_launch: built for a 256-workgroup resident grid (256 CUs x 1), got %d x %d; nothing launched\n", cus, per_cu); grid_blocks = -1; return; }
    }
    if (grid_blocks < 0) return;
    (void)hipMemsetAsync((unsigned char*)d_ws + WS_CTL, 0, 65536, stream);
    Params p{};
    for (int i = 0; i < N_IN; ++i) p.in[i] = (const float*)d_in[i];
    p.out = (float*)d_out; p.ws = (unsigned char*)d_ws;
    p.ph_lo = 0; p.ph_hi = 24;
    void* args[] = {&p};
    hipError_t e = hipLaunchCooperativeKernel((const void*)fwd_megakernel, dim3(grid_blocks), dim3(NTHREADS), args, LDS_BYTES, stream);
    if (e != hipSuccess) fprintf(stderr, "cooperative launch failed: %s (grid %d)\n", hipGetErrorString(e), grid_blocks);
}
```

```cpp
#include <hip/hip_runtime.h>
#include <hip/hip_cooperative_groups.h>
#include <cstdio>
#include <cstdint>
namespace cg = cooperative_groups;

#define LAS __attribute__((address_space(3)))
typedef unsigned short bf16_t;
typedef short bf16x8 __attribute__((ext_vector_type(8)));
typedef short bf16x4 __attribute__((ext_vector_type(4)));
typedef float f32x4 __attribute__((ext_vector_type(4)));
typedef unsigned u32x4 __attribute__((ext_vector_type(4)));
typedef unsigned u32x2 __attribute__((ext_vector_type(2)));
typedef LAS unsigned char lds_t;

constexpr int T = 32768, D = 1024, SEQ = 4096;
constexpr int NTHREADS = 512;
constexpr int LDS_BYTES = 160 * 1024;
constexpr int PS_OFF = LDS_BYTES - 1024;
constexpr int MTAB_OFF = 128 * 1024;
constexpr float ALPHA = 1.4142135623730951f;
constexpr float LN_EPS = 1e-5f;
constexpr int MOE_ROWS = 139264;
constexpr int S5TC = 32;
constexpr int S5K = S5TC * 16 + 128;

enum { I_X = 0, I_POS, I_AB_WIN, I_AB_CONVW, I_AB_CONVB, I_AB_GRW, I_AB_GRB, I_AB_GIW, I_AB_GIB, I_AB_LAMBDA,
       I_S5_LRE, I_S5_LIM, I_S5_STEP, I_S5_BRE, I_S5_BIM, I_S5_CRE, I_S5_CIM, I_S5_D, I_AB_GLUW, I_AB_GLUB, I_AB_WOUT,
       I_CD_WIN, I_CD_CONVW, I_CD_CONVB, I_CD_WQ, I_CD_WK, I_CD_WV, I_CD_WIF, I_CD_BIF, I_CD_WOUT,
       I_LNM_G, I_LNM_B, I_LNF_G, I_LNF_B, I_R_W, I_R_B, I_M_WIN, I_M_BIN, I_M_WOUT, I_M_BOUT, N_IN };

constexpr size_t MiB = 1ull << 20;
constexpr size_t WS_CTL = 0;
constexpr size_t WS_XB = 1 * MiB;
constexpr size_t WS_WABIN = 65 * MiB;
constexpr size_t WS_WGLU = 68 * MiB;
constexpr size_t WS_WABOUT = 69 * MiB;
constexpr size_t WS_WCDIN = 71 * MiB;
constexpr size_t WS_WCDOUT = 76 * MiB;
constexpr size_t WS_WG = 78 * MiB;
constexpr size_t WS_WQKV = 78 * MiB + 256 * 1024;
constexpr size_t WS_WC = 79 * MiB;
constexpr size_t WS_S5TM = 80 * MiB;
constexpr size_t WS_S5WST = 100 * MiB;
constexpr size_t WS_MWIN = 104 * MiB;
constexpr size_t WS_MWOUT = 232 * MiB;
constexpr size_t WS_PROJ = 296 * MiB;
constexpr size_t WS_CAT = 456 * MiB;
constexpr size_t WS_X1F = 520 * MiB;
constexpr size_t WS_ZF = 648 * MiB;
constexpr size_t WS_HACT = 776 * MiB;
constexpr size_t WS_YB = 1048 * MiB;
constexpr size_t WS_ROUTE = 1320 * MiB;
constexpr size_t WS_SCR = 1328 * MiB;
constexpr size_t WS_XC = WS_SCR;
constexpr size_t WS_AF = WS_SCR + 32 * MiB;
constexpr size_t WS_UF = WS_SCR + 96 * MiB;
constexpr size_t WS_SB = WS_SCR + 160 * MiB;
constexpr size_t WS_S5S = WS_SCR + 192 * MiB;
constexpr size_t WS_S5X = WS_SCR + 208 * MiB;
constexpr size_t WS_XCONV = WS_SCR;
constexpr size_t WS_QB = WS_SCR + 32 * MiB;
constexpr size_t WS_KB = WS_SCR + 64 * MiB;
constexpr size_t WS_VB = WS_SCR + 96 * MiB;
constexpr size_t WS_GATES = WS_SCR + 128 * MiB;
constexpr size_t WS_KVC = WS_SCR + 130 * MiB;
constexpr size_t WS_CPREV = WS_SCR + 258 * MiB;
constexpr size_t WS_MISC = WS_SCR + 322 * MiB;
constexpr size_t WS_ATTO = WS_SCR + 326 * MiB;
constexpr size_t WS_LSE = WS_SCR + 518 * MiB;
constexpr size_t WS_MW1 = WS_SCR + 520 * MiB;
constexpr size_t WS_END = WS_MW1 + 192 * MiB;

struct Params { const float* in[N_IN]; float* out; unsigned char* ws; int ph_lo, ph_hi; };

__device__ __forceinline__ float bf2f(unsigned short b) { return __uint_as_float(((unsigned)b) << 16); }
typedef __bf16 bf16v2_t __attribute__((ext_vector_type(2)));
typedef float f32x2 __attribute__((ext_vector_type(2)));
__device__ __forceinline__ unsigned pk_bf16(float lo, float hi) { const f32x2 v = {lo, hi}; return __builtin_bit_cast(unsigned, __builtin_convertvector(v, bf16v2_t)); }
__device__ __forceinline__ float wave_sum(float v) {
#pragma unroll
    for (int o = 1; o < 64; o <<= 1) v += __shfl_xor(v, o);
    return v;
}
__device__ __forceinline__ float wave_max(float v) {
#pragma unroll
    for (int o = 1; o < 64; o <<= 1) v = fmaxf(v, __shfl_xor(v, o));
    return v;
}
__device__ __forceinline__ float fsigmoid(float x) { return __builtin_amdgcn_rcpf(1.0f + __builtin_amdgcn_exp2f(-1.4426950408889634f * x)); }
__device__ __forceinline__ float fexp(float x) { return __builtin_amdgcn_exp2f(1.4426950408889634f * x); }
__device__ __forceinline__ float flog(float x) { return 0.6931471805599453f * __builtin_amdgcn_logf(x); }
__device__ __forceinline__ void fsincos(float x, float& sn, float& cs) {
    const float n = rintf(x * 0.15915494309189535f);
    float r = fmaf(-n, 6.28125f, x); r = fmaf(-n, 0.0019353071795864769f, r);
    const float rev = r * 0.15915494309189535f;
    sn = __builtin_amdgcn_sinf(rev); cs = __builtin_amdgcn_cosf(rev);
}
__device__ __forceinline__ float gelu_tanh(float x) { return x * fsigmoid(1.5957691216057308f * (x + 0.044715f * x * x * x)); }
__device__ __forceinline__ float logsigmoidf(float x) { return fminf(x, 0.f) - log1pf(expf(-fabsf(x))); }
__device__ __forceinline__ void unpack8(u32x4 v, float (&f)[8]) {
    f[0] = __uint_as_float(v.x << 16); f[1] = __uint_as_float(v.x & 0xffff0000u);
    f[2] = __uint_as_float(v.y << 16); f[3] = __uint_as_float(v.y & 0xffff0000u);
    f[4] = __uint_as_float(v.z << 16); f[5] = __uint_as_float(v.z & 0xffff0000u);
    f[6] = __uint_as_float(v.w << 16); f[7] = __uint_as_float(v.w & 0xffff0000u);
}
__device__ __forceinline__ u32x4 pack8(const float (&f)[8]) { u32x4 o; o.x = pk_bf16(f[0], f[1]); o.y = pk_bf16(f[2], f[3]); o.z = pk_bf16(f[4], f[5]); o.w = pk_bf16(f[6], f[7]); return o; }
__device__ __forceinline__ bf16x4 tr_read(lds_t* p) { return __builtin_amdgcn_ds_read_tr16_b64_v4i16((LAS bf16x4*)p); }
__device__ __forceinline__ bf16x8 cat44(bf16x4 a, bf16x4 b) { bf16x8 r = {a[0], a[1], a[2], a[3], b[0], b[1], b[2], b[3]}; return r; }
#define MFMA16(a, b, c) __builtin_amdgcn_mfma_f32_16x16x32_bf16((a), (b), (c), 0, 0, 0)
typedef int i32x8 __attribute__((ext_vector_type(8)));
__device__ __forceinline__ f32x4 mfma_fp8(i32x8 a, i32x8 b, f32x4 c) { return __builtin_amdgcn_mfma_scale_f32_16x16x128_f8f6f4(a, b, c, 0, 0, 0, 0x7f7f7f7f, 0, 0x7f7f7f7f); }
typedef int i32x4 __attribute__((ext_vector_type(4)));
__device__ __forceinline__ i32x8 ld_frag8(lds_t* p) { const i32x4 lo = *(const LAS i32x4*)p, hi = *(const LAS i32x4*)(p + 1024); return __builtin_shufflevector(lo, hi, 0, 1, 2, 3, 4, 5, 6, 7); }
__device__ __forceinline__ unsigned pk_fp8x4(f32x4 v) {
    unsigned w = 0;
    w = __builtin_amdgcn_cvt_pk_fp8_f32(fminf(fmaxf(v[0], -448.f), 448.f), fminf(fmaxf(v[1], -448.f), 448.f), w, false);
    w = __builtin_amdgcn_cvt_pk_fp8_f32(fminf(fmaxf(v[2], -448.f), 448.f), fminf(fmaxf(v[3], -448.f), 448.f), w, true);
    return w;
}
constexpr float FP8_SX = 4.0f, FP8_SWIN = 32.0f, FP8_SH = 8.0f, FP8_SWOUT = 64.0f;

constexpr int E1_PITCH = 144;
constexpr int E1_A = 256 * E1_PITCH;
constexpr int E1_B = 128 * E1_PITCH;
constexpr int E1_BUF = E1_A + E1_B;

template <bool TRANS, class NK, class AL, class BL, class EP>
__device__ __forceinline__ void e1_stream(lds_t* lds, int ntiles, NK nkf, AL aload, BL bload, EP epi) {
    if (ntiles <= 0) return;
    const int tid = threadIdx.x, lane = tid & 63, wave = tid >> 6, wr = wave >> 1, wc = wave & 1, fr = lane & 15, fq = lane >> 4;
    const int prow = tid >> 3, pc = tid & 7;
    f32x4 acc[4][4];
#pragma unroll
    for (int m = 0; m < 4; ++m)
#pragma unroll
        for (int n = 0; n < 4; ++n) acc[m][n] = (f32x4){0.f, 0.f, 0.f, 0.f};
    u32x4 ra0[4], rb0[2], ra1[4], rb1[2];
#define E1S_LOAD(RA, RB, J, TT) do { _Pragma("unroll") for (int i = 0; i < 4; ++i) RA[i] = aload((J), i, prow + 64 * i, (TT) * 8 + pc); \
        _Pragma("unroll") for (int i = 0; i < 2; ++i) RB[i] = bload((J), i, prow + 64 * i, (TT) * 8 + pc); } while (0)
#define E1S_WRITE(RA, RB, BUF) do { lds_t* nb_ = lds + (BUF) * E1_BUF; \
        _Pragma("unroll") for (int i = 0; i < 4; ++i) *(LAS u32x4*)(nb_ + (prow + 64 * i) * E1_PITCH + pc * 16) = RA[i]; \
        _Pragma("unroll") for (int i = 0; i < 2; ++i) *(LAS u32x4*)(nb_ + E1_A + (prow + 64 * i) * E1_PITCH + pc * 16) = RB[i]; } while (0)
#define E1S_ADV(J, TT, V) do { if ((TT) + 1 < nkf(J)) { ++(TT); } else { ++(J); (TT) = 0; } (V) = (J) < ntiles; } while (0)
#define E1S_COMPUTE(BUF) do { lds_t* Ab = lds + (BUF) * E1_BUF + (wr * 64 + fr) * E1_PITCH + fq * 16; lds_t* Bb = lds + (BUF) * E1_BUF + E1_A + (wc * 64 + fr) * E1_PITCH + fq * 16; \
        _Pragma("unroll") for (int kk = 0; kk < 2; ++kk) { bf16x8 af[4], bfr[4]; \
            _Pragma("unroll") for (int m = 0; m < 4; ++m) af[m] = *(LAS bf16x8*)(Ab + m * 16 * E1_PITCH + kk * 64); \
            _Pragma("unroll") for (int n = 0; n < 4; ++n) bfr[n] = *(LAS bf16x8*)(Bb + n * 16 * E1_PITCH + kk * 64); \
            _Pragma("unroll") for (int m = 0; m < 4; ++m) _Pragma("unroll") for (int n = 0; n < 4; ++n) acc[m][n] = TRANS ? MFMA16(bfr[n], af[m], acc[m][n]) : MFMA16(af[m], bfr[n], acc[m][n]); } \
        if (t0 + 1 == nkf(j0)) { epi(j0, acc, wr, wc, fr, fq); \
            _Pragma("unroll") for (int m = 0; m < 4; ++m) _Pragma("unroll") for (int n = 0; n < 4; ++n) acc[m][n] = (f32x4){0.f, 0.f, 0.f, 0.f}; } } while (0)
    int j0 = 0, t0 = 0, j1 = 0, t1 = 0, j2, t2; bool v1, v2;
    E1S_ADV(j1, t1, v1); j2 = j1; t2 = t1; v2 = v1; if (v1) E1S_ADV(j2, t2, v2);
    E1S_LOAD(ra0, rb0, 0, 0);
    if (v1) E1S_LOAD(ra1, rb1, j1, t1);
    E1S_WRITE(ra0, rb0, 0);
    __syncthreads();
    int cb = 0;
    for (;;) {
        if (v2) E1S_LOAD(ra0, rb0, j2, t2);
        E1S_COMPUTE(cb);
        if (v1) E1S_WRITE(ra1, rb1, cb ^ 1);
        __syncthreads();
        if (!v1) break;
        j0 = j1; t0 = t1; j1 = j2; t1 = t2; v1 = v2; if (v2) E1S_ADV(j2, t2, v2); cb ^= 1;
        if (v2) E1S_LOAD(ra1, rb1, j2, t2);
        E1S_COMPUTE(cb);
        if (v1) E1S_WRITE(ra0, rb0, cb ^ 1);
        __syncthreads();
        if (!v1) break;
        j0 = j1; t0 = t1; j1 = j2; t1 = t2; v1 = v2; if (v2) E1S_ADV(j2, t2, v2); cb ^= 1;
    }
#undef E1S_LOAD
#undef E1S_WRITE
#undef E1S_ADV
#undef E1S_COMPUTE
}
__device__ __forceinline__ int wg_tiles(int total) { const int b = (int)blockIdx.x, G = (int)gridDim.x; return b < total ? (total - b + G - 1) / G : 0; }

namespace g2 {
constexpr int HTB = 16384;
__device__ __forceinline__ int lds_byte(int r, int c) { const int st = (r >> 4) * 2 + (c >> 5), rr = r & 15, cc = c & 31, ob = rr * 64 + cc * 2; return st * 1024 + (ob ^ (((ob >> 9) & 1) << 5)); }
__device__ __forceinline__ void stage_rc(int b, int& R, int& C) { const int st = b / 1024, sb = b % 1024, swz = sb ^ (((sb >> 9) & 1) << 5); R = (st >> 1) * 16 + swz / 64; C = (st & 1) * 32 + (swz % 64) / 2; }
struct Unit { int pm, pn, idx; };
__device__ __forceinline__ bool static_next(int i, int G, int c, int nM, int nN, Unit& u) {
    const int nwg = nM * nN; const long L = (long)i * G + c; if (L >= nwg) return false;
    int wgid = (int)L; { const int q = nwg / 8, r = nwg % 8, xcd = wgid % 8, off = wgid / 8; wgid = (xcd < r ? xcd * (q + 1) : r * (q + 1) + (xcd - r) * q) + off; }
    const int nig = 8 * nN, gid = wgid / nig, fm = gid * 8, gsz = (nM - fm) < 8 ? (nM - fm) : 8;
    u.pm = fm + ((wgid % nig) % gsz); u.pn = (wgid % nig) / gsz; u.idx = i; return true;
}
template <bool FP8, class Sched, class Epi>
__device__ __forceinline__ void gemm_phase(lds_t* lds, const char* Abase, int nt  , unsigned ldb_bytes, const Sched& S, const Epi& E) {
    const int tid = threadIdx.x, wid = __builtin_amdgcn_readfirstlane(tid >> 6), lane = tid & 63, wr = wid >> 2, wc = wid & 3, fr = lane & 15, fq = lane >> 4;
    unsigned voffB0; { int R0, C0; stage_rc(tid * 16, R0, C0); voffB0 = (unsigned)R0 * ldb_bytes + (unsigned)C0 * 2u; }
    const size_t hstepB = (size_t)128 * ldb_bytes;
    const unsigned ldsw = (unsigned)wid * 1024u;
    const int aoff = lds_byte(wr * 64 + fr, fq * 8), boff = lds_byte(wc * 32 + fr, fq * 8);
#define G2_SA(b, h) (((b) * 2 + (h)) * g2::HTB)
#define G2_SB(b, h) ((4 + (b) * 2 + (h)) * g2::HTB)
#define G2_STAGE_A(bufoff, offs, kb) do { _Pragma("unroll") for (int _i = 0; _i < 2; ++_i) \
        __builtin_amdgcn_global_load_lds((const unsigned*)((Abase + (kb)) + (offs)[_i]), (LAS unsigned*)(lds + (bufoff) + ldsw + _i * 8192), 16, 0, 0); } while (0)
#define G2_STAGE_B(bufoff, gbase) do { _Pragma("unroll") for (int _i = 0; _i < 2; ++_i) \
        __builtin_amdgcn_global_load_lds((const unsigned*)(((const char*)(gbase) + (size_t)_i * 64 * ldb_bytes) + voffB0), (LAS unsigned*)(lds + (bufoff) + ldsw + _i * 8192), 16, 0, 0); } while (0)
#define G2_LDA(dst, b, h) do { _Pragma("unroll") for (int m = 0; m < 4; ++m) { if constexpr (FP8) { if (m < 2) dst##8[m] = ld_frag8(lds + G2_SA(b, h) + aoff + m * 2048); } \
        else { _Pragma("unroll") for (int k = 0; k < 2; ++k) dst[m][k] = *(const LAS bf16x8*)(lds + G2_SA(b, h) + aoff + m * 2048 + k * 1024); } } } while (0)
#define G2_LDB(dst, b, h) do { _Pragma("unroll") for (int n = 0; n < 2; ++n) { if constexpr (FP8) dst##8[n] = ld_frag8(lds + G2_SB(b, h) + boff + n * 2048); \
        else { _Pragma("unroll") for (int k = 0; k < 2; ++k) dst[n][k] = *(const LAS bf16x8*)(lds + G2_SB(b, h) + boff + n * 2048 + k * 1024); } } } while (0)
#define G2_MMA(ai, bj, At, Bt) do { __builtin_amdgcn_s_setprio(1); _Pragma("unroll") for (int m = 0; m < 4; ++m) _Pragma("unroll") for (int n = 0; n < 2; ++n) { \
        if constexpr (FP8) acc[ai][bj][m][n] = mfma_fp8(Bt##8[n], At##8[m], acc[ai][bj][m][n]); \
        else { _Pragma("unroll") for (int k = 0; k < 2; ++k) acc[ai][bj][m][n] = __builtin_amdgcn_mfma_f32_16x16x32_bf16(Bt[n][k], At[m][k], acc[ai][bj][m][n], 0, 0, 0); } } \
        __builtin_amdgcn_s_setprio(0); } while (0)
#define G2_MMAP(ai, b, h) do { if constexpr (!FP8) { G2_MMA(ai, 0, At, B0); G2_MMA(ai, 1, At, B1); } else { __builtin_amdgcn_s_setprio(1); \
        _Pragma("unroll") for (int m = 0; m < 2; ++m) _Pragma("unroll") for (int n = 0; n < 2; ++n) { acc[ai][0][m][n] = mfma_fp8(B08[n], At8[m], acc[ai][0][m][n]); acc[ai][1][m][n] = mfma_fp8(B18[n], At8[m], acc[ai][1][m][n]); } \
        At8[0] = ld_frag8(lds + G2_SA(b, h) + aoff + 2 * 2048); At8[1] = ld_frag8(lds + G2_SA(b, h) + aoff + 3 * 2048); \
        _Pragma("unroll") for (int m = 0; m < 2; ++m) _Pragma("unroll") for (int n = 0; n < 2; ++n) { acc[ai][0][m + 2][n] = mfma_fp8(B08[n], At8[m], acc[ai][0][m + 2][n]); acc[ai][1][m + 2][n] = mfma_fp8(B18[n], At8[m], acc[ai][1][m + 2][n]); } \
        __builtin_amdgcn_s_setprio(0); } } while (0)
#define G2_WAIT_V(n) asm volatile("s_waitcnt vmcnt(" #n ")" ::: "memory")
#define G2_WAIT_L(n) asm volatile("s_waitcnt lgkmcnt(" #n ")" ::: "memory")
#define G2_BAR __builtin_amdgcn_s_barrier()
#define G2_SCHED __builtin_amdgcn_sched_barrier(0)
#define G2_SCHED8 do { if constexpr (FP8) __builtin_amdgcn_sched_barrier(0); } while (0)
    Unit cur, nxt; int ui = 0;
    if (!S.next(0, cur)) return;
    f32x4 acc[2][2][4][2];
#pragma unroll
    for (int a = 0; a < 2; ++a)
#pragma unroll
        for (int b = 0; b < 2; ++b)
#pragma unroll
            for (int m = 0; m < 4; ++m)
#pragma unroll
                for (int n = 0; n < 2; ++n) acc[a][b][m][n] = (f32x4){0.f, 0.f, 0.f, 0.f};
    bf16x8 At[4][2], B0[2][2], B1[2][2]; i32x8 At8[2], B08[2], B18[2];
    unsigned aoC[2][2], aoN[2][2];
    S.a_off(cur, aoC);
    const char* cB = S.b_base(cur);
    G2_STAGE_B(G2_SB(0, 0), cB); G2_STAGE_B(G2_SB(0, 1), cB + hstepB); G2_STAGE_A(G2_SA(0, 0), aoC[0], 0); G2_STAGE_A(G2_SA(0, 1), aoC[1], 0);
    if (wr == 1) G2_BAR;
    G2_WAIT_V(2); G2_BAR;
    G2_STAGE_B(G2_SB(1, 0), cB + 128); G2_STAGE_A(G2_SA(1, 0), aoC[0], 128); G2_STAGE_B(G2_SB(1, 1), cB + hstepB + 128);
    G2_WAIT_V(6); G2_BAR;
    for (;;) {
        const bool has_next = S.next(ui + 1, nxt);
        const char* nB = cB;
        if constexpr (!Sched::CHEAP_AOFF) {
#pragma unroll
            for (int h = 0; h < 2; ++h)
#pragma unroll
                for (int i = 0; i < 2; ++i) aoN[h][i] = aoC[h][i];
            if (has_next) S.a_off(nxt, aoN);
        }
        if (has_next) nB = S.b_base(nxt);
#pragma unroll 1
        for (int t = 0; t < nt; t += 2) {
            const bool last = (t == nt - 2);
            const unsigned k1 = (unsigned)(t + 1) * 128u, k2 = last ? 0u : (unsigned)(t + 2) * 128u, k3 = k2 + 128u;
            unsigned a2o[2][2];
#pragma unroll
            for (int h = 0; h < 2; ++h)
#pragma unroll
                for (int i = 0; i < 2; ++i) a2o[h][i] = (!Sched::CHEAP_AOFF && last) ? aoN[h][i] : aoC[h][i];
            if constexpr (Sched::CHEAP_AOFF) { if (last && has_next) S.a_off(nxt, a2o); }
            const char* b2 = last ? nB : cB + (size_t)(t + 2) * 128; const char* b3 = b2 + 128;
            G2_LDB(B0, 0, 0); G2_LDB(B1, 0, 1); G2_SCHED; G2_LDA(At, 0, 0); G2_STAGE_A(G2_SA(1, 1), aoC[1], k1);
            G2_WAIT_V(8); G2_WAIT_L(0); G2_BAR; G2_MMAP(0, 0, 0); G2_BAR; G2_SCHED;
            G2_LDA(At, 0, 1); G2_STAGE_B(G2_SB(0, 0), b2); G2_STAGE_B(G2_SB(0, 1), b2 + hstepB); G2_STAGE_A(G2_SA(0, 0), a2o[0], k2);
            G2_WAIT_V(8); G2_WAIT_L(0); G2_BAR; G2_MMAP(1, 0, 1); G2_BAR; G2_SCHED;
            G2_LDB(B0, 1, 0); G2_LDB(B1, 1, 1); G2_SCHED; G2_LDA(At, 1, 0); G2_STAGE_A(G2_SA(0, 1), a2o[1], k2);
            G2_WAIT_V(8); G2_WAIT_L(0); G2_BAR; G2_MMAP(0, 1, 0); G2_BAR; G2_SCHED;
            G2_LDA(At, 1, 1); G2_STAGE_B(G2_SB(1, 0), b3); G2_STAGE_B(G2_SB(1, 1), b3 + hstepB); G2_STAGE_A(G2_SA(1, 0), a2o[0], k3);
            G2_WAIT_V(8); G2_WAIT_L(0); G2_BAR; G2_MMAP(1, 1, 1); G2_BAR; G2_SCHED;
        }
        if (wr == 0) G2_BAR;
        { int lane_e = (int)(threadIdx.x & 63); asm volatile("" : "+v"(lane_e));
          E(acc, cur, wr, wc, lane_e & 15, lane_e >> 4); }
        if (!has_next) break;
#pragma unroll
        for (int a = 0; a < 2; ++a)
#pragma unroll
            for (int b = 0; b < 2; ++b)
#pragma unroll
                for (int m = 0; m < 4; ++m)
#pragma unroll
                    for (int n = 0; n < 2; ++n) acc[a][b][m][n] = (f32x4){0.f, 0.f, 0.f, 0.f};
        cur = nxt; cB = nB; ++ui;
        if constexpr (Sched::CHEAP_AOFF) S.a_off(cur, aoC);
        else {
#pragma unroll
            for (int h = 0; h < 2; ++h)
#pragma unroll
                for (int i = 0; i < 2; ++i) aoC[h][i] = aoN[h][i];
        }
        if (wr == 1) G2_BAR;
    }
    G2_WAIT_V(0);
    G2_BAR;
#undef G2_SA
#undef G2_SB
#undef G2_STAGE_A
#undef G2_STAGE_B
#undef G2_LDA
#undef G2_LDB
#undef G2_MMA
#undef G2_MMAP
#undef G2_WAIT_V
#undef G2_WAIT_L
#undef G2_BAR
#undef G2_SCHED
#undef G2_SCHED8
}
struct DenseSched {
    static constexpr bool CHEAP_AOFF = false;
    int G, c, nM, nN, K; const char* Bt;
    __device__ __forceinline__ bool next(int i, Unit& u) const { return static_next(i, G, c, nM, nN, u); }
    __device__ __forceinline__ void a_off(const Unit& u, unsigned (&ao)[2][2]) const {
        int Rs[2], Cs[2];
#pragma unroll
        for (int i = 0; i < 2; ++i) stage_rc((int)threadIdx.x * 16 + i * 8192, Rs[i], Cs[i]);
#pragma unroll
        for (int h = 0; h < 2; ++h)
#pragma unroll
            for (int i = 0; i < 2; ++i) ao[h][i] = ((unsigned)(u.pm * 256 + h * 128 + Rs[i]) * (unsigned)K + (unsigned)Cs[i]) * 2u;
    }
    __device__ __forceinline__ const char* b_base(const Unit& u) const { return Bt + (size_t)u.pn * 256 * K * 2; }
};
}

template <class RM>
__device__ __forceinline__ void transpose_item(const float* __restrict__ W, int N, bf16_t* __restrict__ WT, int ldwt, int k0, int n0, RM rowmap, LAS float* scr, int lane) {
#pragma unroll 16
    for (int i = 0; i < 64; ++i) scr[i * 65 + lane] = W[(size_t)(k0 + i) * N + n0 + lane];
    __builtin_amdgcn_wave_barrier();
    const int c = lane & 7;
#pragma unroll
    for (int j = 0; j < 8; ++j) {
        const int n = (lane >> 3) + 8 * j;
        const LAS float* s = scr + (8 * c) * 65 + n;
        u32x4 o; o.x = pk_bf16(s[0], s[65]); o.y = pk_bf16(s[2 * 65], s[3 * 65]); o.z = pk_bf16(s[4 * 65], s[5 * 65]); o.w = pk_bf16(s[6 * 65], s[7 * 65]);
        *(u32x4*)(WT + (size_t)rowmap(n0 + n) * ldwt + k0 + 8 * c) = o;
    }
    __builtin_amdgcn_wave_barrier();
}
template <class RM>
__device__ __forceinline__ void transpose_item_fp8(const float* __restrict__ W, int N, unsigned char* __restrict__ WT, int ldwt, int k0, int n0, RM rowmap, float scale, LAS float* scr, int lane) {
#pragma unroll 16
    for (int i = 0; i < 64; ++i) scr[i * 65 + lane] = W[(size_t)(k0 + i) * N + n0 + lane];
    __builtin_amdgcn_wave_barrier();
    const int c = lane & 7;
#pragma unroll
    for (int j = 0; j < 8; ++j) {
        const int n = (lane >> 3) + 8 * j;
        const LAS float* sp = scr + (8 * c) * 65 + n;
        u32x2 o; o.x = pk_fp8x4((f32x4){sp[0], sp[65], sp[2 * 65], sp[3 * 65]} * scale); o.y = pk_fp8x4((f32x4){sp[4 * 65], sp[5 * 65], sp[6 * 65], sp[7 * 65]} * scale);
        *(u32x2*)(WT + (size_t)rowmap(n0 + n) * ldwt + k0 + 8 * c) = o;
    }
    __builtin_amdgcn_wave_barrier();
}
struct RmId { __device__ __forceinline__ int operator()(int n) const { return n; } };
struct RmMoeIn { __device__ __forceinline__ int operator()(int n) const { const int half = n >> 10, j = n & 1023; return (j >> 7) * 256 + half * 128 + (j & 127); } };
struct RmGate { int gate; __device__ __forceinline__ int operator()(int j) const { return (j >> 5) * 64 + gate * 32 + (j & 31); } };

template <class RM>
__device__ __forceinline__ void transpose_matrix(const float* W, int K, int N, bf16_t* WT, int ldwt, RM rm, LAS float* scr, int gw, int NGW, int lane, int first_wave) {
    const int nkb = K / 64, nnb = N / 64;
    int it = gw - first_wave; if (it < 0) it += NGW;
    for (; it < nkb * nnb; it += NGW) transpose_item(W, N, WT, ldwt, (it / nnb) * 64, (it % nnb) * 64, rm, scr, lane);
}

constexpr int CONV_ITEMS = 24576, TAIL_QUOTA = 48;
__device__ __forceinline__ void convert_item(const Params& P, int layer, int r, LAS float* scr, int lane) {
    unsigned char* dst = P.ws + (layer ? WS_MW1 : WS_MWIN);
    if (r < 16384) {
        const int e = r >> 9, rr = r & 511, kb = rr >> 5, nb = rr & 31;
        transpose_item_fp8(P.in[I_M_WIN] + ((size_t)layer * 32 + e) * 1024 * 2048, 2048, dst + (size_t)e * 2048 * 1024, 1024, kb * 64, nb * 64, RmMoeIn(), FP8_SWIN, scr, lane);
    } else {
        const int r2 = r - 16384, e = r2 >> 8, rr = r2 & 255, kb = rr >> 4, nb = rr & 15;
        transpose_item_fp8(P.in[I_M_WOUT] + ((size_t)layer * 32 + e) * 1024 * 1024, 1024, dst + (size_t)32 * 2048 * 1024 + (size_t)e * 1024 * 1024, 1024, kb * 64, nb * 64, RmId(), FP8_SWOUT, scr, lane);
    }
}
__device__ __forceinline__ void convert_range_wg(const Params& P, int layer, int first, int count, lds_t* lds) {
    const int lane = threadIdx.x & 63, wave = threadIdx.x >> 6;
    LAS float* scr = (LAS float*)(lds + wave * 16640);
    const int end = (first + count < CONV_ITEMS) ? first + count : CONV_ITEMS;
    for (int r = first + wave; r < end; r += 8) convert_item(P, layer, r, scr, lane);
}
__device__ __forceinline__ void convert_moe_weights(const Params& P, int layer, int first, lds_t* lds, int skip_wgs = 0) {
    if ((int)blockIdx.x < skip_wgs) return;
    const int lane = threadIdx.x & 63, wave = threadIdx.x >> 6, gw = ((int)blockIdx.x - skip_wgs) * 8 + wave, NGW = ((int)gridDim.x - skip_wgs) * 8;
    LAS float* scr = (LAS float*)(lds + wave * 16640);
    for (int r = first + gw; r < CONV_ITEMS; r += NGW) convert_item(P, layer, r, scr, lane);
}
__device__ __forceinline__ int tail_idle(int nunits, int G) { const int r = nunits % G; return r ? G - r : 0; }
__device__ __forceinline__ int tail_done_up(int nM, int G) { const int d = tail_idle(nM * 8, G) * TAIL_QUOTA; return d < CONV_ITEMS ? d : CONV_ITEMS; }
__device__ __forceinline__ int tail_done_all(int nM, int G) { const int d = tail_done_up(nM, G) + tail_idle(nM * 4, G) * TAIL_QUOTA; return d < CONV_ITEMS ? d : CONV_ITEMS; }

__device__ __forceinline__ void s5_precompute(const Params& P, int g, lds_t* lds) {
    const int tid = threadIdx.x;
    LAS float* Bbr = (LAS float*)lds;
    LAS float* Bbi = Bbr + 1024;
    LAS float* Cr = Bbi + 1024;
    LAS float* Ci = Cr + 1024;
    LAS float* ApR = Ci + 1024;
    LAS float* ApI = ApR + 33 * 64;
    LAS float* KJ = ApI + 33 * 64;
    const float* lre = P.in[I_S5_LRE] + g * 64; const float* lim = P.in[I_S5_LIM] + g * 64;
    const float step = expf(P.in[I_S5_STEP][g]);
    for (int idx = tid; idx < 1024; idx += NTHREADS) {
        const int p = idx >> 4;
        const float lr = fminf(lre[p], -1e-4f), li = lim[p];
        const float mag = expf(lr * step); float sn, cs; sincosf(li * step, &sn, &cs);
        const float ar = mag * cs, ai = mag * sn, inv = 1.0f / (lr * lr + li * li);
        const float zr = ((ar - 1.0f) * lr + ai * li) * inv, zi = (ai * lr - (ar - 1.0f) * li) * inv;
        const float br = P.in[I_S5_BRE][g * 1024 + idx], bi = P.in[I_S5_BIM][g * 1024 + idx];
        Bbr[idx] = zr * br - zi * bi; Bbi[idx] = zr * bi + zi * br;
        Cr[idx] = P.in[I_S5_CRE][g * 1024 + idx]; Ci[idx] = P.in[I_S5_CIM][g * 1024 + idx];
    }
    for (int idx = tid; idx < 33 * 64; idx += NTHREADS) {
        const int j = idx >> 6, p = idx & 63;
        const float lr = fminf(lre[p], -1e-4f), li = lim[p];
        const float mag = fexp((float)j * lr * step); float sn, cs; fsincos((float)j * li * step, sn, cs);
        ApR[idx] = mag * cs; ApI[idx] = mag * sn;
    }
    __syncthreads();
    {
        const int h = (tid >> 4) & 15, h2 = tid & 15, jh = tid >> 8;
        float gr[64], gi[64];
#pragma unroll
        for (int p = 0; p < 64; ++p) { const float cr = Cr[h * 64 + p], ci = Ci[h * 64 + p], br = Bbr[p * 16 + h2], bi = Bbi[p * 16 + h2]; gr[p] = cr * br - ci * bi; gi[p] = cr * bi + ci * br; }
        for (int j = jh * 16; j < jh * 16 + 16; ++j) {
            float s0 = 0.f, s1 = 0.f;
#pragma unroll
            for (int p = 0; p < 64; p += 2) { s0 += gr[p] * ApR[j * 64 + p] - gi[p] * ApI[j * 64 + p]; s1 += gr[p + 1] * ApR[j * 64 + p + 1] - gi[p + 1] * ApI[j * 64 + p + 1]; }
            float sres = s0 + s1;
            if (j == 0 && h == h2) sres += P.in[I_S5_D][g * 16 + h];
            KJ[(j * 16 + h) * 16 + h2] = sres;
        }
    }
    __syncthreads();
    bf16_t* Tm = (bf16_t*)(P.ws + WS_S5TM) + (size_t)g * 512 * S5K;
    for (int pi = tid; pi < 512 * (S5K / 8); pi += NTHREADS) {
        const int row = pi / (S5K / 8), c8 = (pi % (S5K / 8)) * 8, t = row >> 4, h = row & 15;
        float v[8];
#pragma unroll
        for (int e = 0; e < 8; ++e) {
            const int col = c8 + e;
            if (col < 512) { const int s = col >> 4, h2 = col & 15; v[e] = (s <= t) ? KJ[((t - s) * 16 + h) * 16 + h2] : 0.f; }
            else { const int p = (col - 512) & 63, im = (col - 512) >> 6;
                const float cr = Cr[h * 64 + p], ci = Ci[h * 64 + p], ar = ApR[(t + 1) * 64 + p], ai = ApI[(t + 1) * 64 + p];
                v[e] = im ? -(cr * ai + ci * ar) : (cr * ar - ci * ai); }
        }
        *(u32x4*)(Tm + (size_t)row * S5K + c8) = pack8(v);
    }
    bf16_t* Wst = (bf16_t*)(P.ws + WS_S5WST) + (size_t)g * 128 * 512;
    for (int pi = tid; pi < 128 * 64; pi += NTHREADS) {
        const int row = pi >> 6, c8 = (pi & 63) * 8, p = row & 63, im = row >> 6;
        float v[8];
#pragma unroll
        for (int e = 0; e < 8; ++e) {
            const int col = c8 + e, s = col >> 4, h2 = col & 15;
            const float ar = ApR[(S5TC - 1 - s) * 64 + p], ai = ApI[(S5TC - 1 - s) * 64 + p], br = Bbr[p * 16 + h2], bi = Bbi[p * 16 + h2];
            v[e] = im ? (ar * bi + ai * br) : (ar * br - ai * bi);
        }
        *(u32x4*)(Wst + (size_t)row * 512 + c8) = pack8(v);
    }
    __syncthreads();
}

__device__ __forceinline__ void phase0(const Params& P, lds_t* lds) {
    const int tid = threadIdx.x, lane = tid & 63, wave = tid >> 6, gw = blockIdx.x * 8 + wave, NGW = gridDim.x * 8;
    const size_t gtid = (size_t)blockIdx.x * NTHREADS + tid, GT = (size_t)gridDim.x * NTHREADS;
    unsigned char* ws = P.ws;
    for (int g = blockIdx.x; g < 32; g += gridDim.x) s5_precompute(P, g, lds);
    {
        const f32x4* x4 = (const f32x4*)P.in[I_X]; u32x4* xb = (u32x4*)(ws + WS_XB);
        for (size_t i0 = gtid; i0 < (size_t)T * D / 8; i0 += 4 * GT) {
            f32x4 a[4], b[4];
#pragma unroll
            for (int j = 0; j < 4; ++j) { const size_t i = i0 + j * GT; a[j] = x4[2 * i]; b[j] = x4[2 * i + 1]; }
#pragma unroll
            for (int j = 0; j < 4; ++j) { u32x4 o; o.x = pk_bf16(a[j].x, a[j].y); o.y = pk_bf16(a[j].z, a[j].w); o.z = pk_bf16(b[j].x, b[j].y); o.w = pk_bf16(b[j].z, b[j].w); xb[i0 + j * GT] = o; }
        }
    }
    {
        float* Wc = (float*)(ws + WS_WC);
        for (int idx = gw; idx < 8192; idx += NGW) {
            const int which = idx >> 12, i = (idx >> 3) & 511, gg = idx & 7, h = i >> 7, ii = i & 127;
            const float* wif = P.in[I_CD_WIF];
            float sacc = 0.f;
#pragma unroll
            for (int jj = 0; jj < 2; ++jj) {
                const int j = lane + 64 * jj;
                if (which == 0) sacc += P.in[I_CD_WQ][(size_t)(h * 128 + ii) * 128 + j] * wif[(h * 128 + j) * 8 + gg] + 0.08838834764831845f * P.in[I_CD_WK][(size_t)(h * 128 + ii) * 128 + j] * wif[(512 + h * 128 + j) * 8 + gg];
                else sacc += P.in[I_CD_WV][(size_t)(h * 128 + ii) * 128 + j] * wif[(1024 + h * 128 + j) * 8 + gg];
            }
            sacc = wave_sum(sacc);
            if (lane == 0) Wc[idx] = sacc;
        }
    }
    LAS float* scr = (LAS float*)(lds + wave * 16640);
    transpose_matrix(P.in[I_AB_WIN], 1024, 1536, (bf16_t*)(ws + WS_WABIN), 1024, RmId(), scr, gw, NGW, lane, 256);
    transpose_matrix(P.in[I_AB_GLUW], 512, 512, (bf16_t*)(ws + WS_WGLU), 512, RmId(), scr, gw, NGW, lane, 256 + 384);
    transpose_matrix(P.in[I_AB_WOUT], 1024, 1024, (bf16_t*)(ws + WS_WABOUT), 1024, RmId(), scr, gw, NGW, lane, 256 + 448);
    transpose_matrix(P.in[I_CD_WIN], 1024, 2560, (bf16_t*)(ws + WS_WCDIN), 1024, RmId(), scr, gw, NGW, lane, 256 + 704);
    transpose_matrix(P.in[I_CD_WOUT], 1024, 1024, (bf16_t*)(ws + WS_WCDOUT), 1024, RmId(), scr, gw, NGW, lane, 256 + 1344);
    { int it = gw - (256 + 1600); if (it < 0) it += NGW;
      for (; it < 16; it += NGW) {
        const int gate = it >> 3, h = it & 7;
        transpose_item(P.in[gate ? I_AB_GIW : I_AB_GRW] + h * 4096, 64, (bf16_t*)(ws + WS_WG) + h * 8192, 64, 0, 0, RmGate{gate}, scr, lane);
      } }
    { int it = gw - (256 + 1616); if (it < 0) it += NGW;
      for (; it < 48; it += NGW) {
        const int which = it >> 4, h = (it >> 2) & 3, kb = (it >> 1) & 1, nb = it & 1;
        transpose_item(P.in[I_CD_WQ + which] + h * 16384, 128, (bf16_t*)(ws + WS_WQKV) + (which * 4 + h) * 16384, 128, kb * 64, nb * 64, RmId(), scr, lane);
      } }
    convert_moe_weights(P, 0, 0, lds, (int)gridDim.x > 64 ? 32 : 0);
}

__device__ __forceinline__ void store_bf16x4(bf16_t* p, f32x4 v) { u32x2 o; o.x = pk_bf16(v[0], v[1]); o.y = pk_bf16(v[2], v[3]); *(u32x2*)p = o; }

__device__ __forceinline__ void ph_conv0(const Params& P) {
    const bf16_t* proj = (const bf16_t*)(P.ws + WS_PROJ); bf16_t* xc = (bf16_t*)(P.ws + WS_XC);
    const int lane = threadIdx.x & 63, gw = blockIdx.x * 8 + (threadIdx.x >> 6), NGW = gridDim.x * 8, c8 = lane * 8;
    float w[4][8], bias[8];
#pragma unroll
    for (int e = 0; e < 8; ++e) { bias[e] = P.in[I_AB_CONVB][c8 + e];
#pragma unroll
        for (int k = 0; k < 4; ++k) w[k][e] = P.in[I_AB_CONVW][k * 512 + c8 + e]; }
    for (int run = gw; run < T / 16; run += NGW) {
        const int tok0 = run * 16, p0 = tok0 & (SEQ - 1);
        u32x4 r[19];
#pragma unroll
        for (int i = 0; i < 19; ++i) { r[i] = (u32x4){0u, 0u, 0u, 0u}; if (p0 + i - 3 >= 0) r[i] = *(const u32x4*)(proj + (size_t)(tok0 + i - 3) * 1536 + c8); }
#pragma unroll
        for (int t = 0; t < 16; ++t) {
            float a[8];
#pragma unroll
            for (int e = 0; e < 8; ++e) a[e] = bias[e];
#pragma unroll
            for (int k = 0; k < 4; ++k) { float xv[8]; unpack8(r[t + k], xv);
#pragma unroll
                for (int e = 0; e < 8; ++e) a[e] += w[k][e] * xv[e]; }
            *(u32x4*)(xc + (size_t)(tok0 + t) * 512 + c8) = pack8(a);
        }
    }
}

__device__ __forceinline__ void ph_gates0(const Params& P, lds_t* lds) {
    const bf16_t* xc = (const bf16_t*)(P.ws + WS_XC); const bf16_t* Wg = (const bf16_t*)(P.ws + WS_WG);
    unsigned* lau = (unsigned*)(P.ws + WS_AF);
    const float* br = P.in[I_AB_GRB]; const float* bi = P.in[I_AB_GIB]; const float* lam = P.in[I_AB_LAMBDA];
    const int b0 = (int)blockIdx.x, G = (int)gridDim.x;
    {
        e1_stream<true>(lds, wg_tiles(1024), [](int) { return 1; },
            [=](int j, int, int r, int kp) { const int tile = b0 + j * G, h = tile & 7, rt = tile >> 3; return *(const u32x4*)(xc + (size_t)(rt * 256 + r) * 512 + h * 64 + kp * 8); },
            [=](int j, int, int n, int kp) { const int h = (b0 + j * G) & 7; return *(const u32x4*)(Wg + (size_t)h * 8192 + n * 64 + kp * 8); },
            [=](int j, f32x4 (&acc)[4][4], int wr, int wc, int fr, int fq) {
                const int tile = b0 + j * G, h = tile & 7, rt = tile >> 3;
#pragma unroll
                for (int n = 0; n < 2; ++n) {
                    const int ch = h * 64 + wc * 32 + n * 16 + fq * 4;
                    float sp[4], brv[4], biv[4];
#pragma unroll
                    for (int c = 0; c < 4; ++c) { const float l = -lam[ch + c]; sp[c] = fmaxf(l, 0.f) + flog(1.0f + fexp(-fabsf(l))); brv[c] = br[ch + c]; biv[c] = bi[ch + c]; }
#pragma unroll
                    for (int m = 0; m < 4; ++m) {
                        const size_t row = (size_t)(rt * 256 + wr * 64 + m * 16 + fr);
                        const u32x2 xr = *(const u32x2*)(xc + row * 512 + ch);
                        const float xv[4] = {__uint_as_float(xr.x << 16), __uint_as_float(xr.x & 0xffff0000u), __uint_as_float(xr.y << 16), __uint_as_float(xr.y & 0xffff0000u)};
                        f32x4 a4, u4;
#pragma unroll
                        for (int c = 0; c < 4; ++c) {
                            const float r = fsigmoid(acc[m][n][c] + brv[c]), ig = fsigmoid(acc[m][n + 2][c] + biv[c]);
                            const float la = -8.0f * r * sp[c], x2 = 2.0f * la;
                            const float om = (x2 > -0.01f) ? -x2 * (1.0f + 0.5f * x2 * (1.0f + x2 * (1.0f / 3.0f))) : 1.0f - fexp(x2);
                            a4[c] = la; u4[c] = sqrtf(om) * ig * xv[c];
                        }
                        { u32x4 o; o.x = pk_bf16(a4[0], u4[0]); o.y = pk_bf16(a4[1], u4[1]); o.z = pk_bf16(a4[2], u4[2]); o.w = pk_bf16(a4[3], u4[3]); *(u32x4*)(lau + row * 512 + ch) = o; }
                    }
                }
            });
    }
}

__device__ __forceinline__ void ph_lru_scan(const Params& P, lds_t* lds) {
    const unsigned* lau = (const unsigned*)(P.ws + WS_AF);
    const bf16_t* proj = (const bf16_t*)(P.ws + WS_PROJ); bf16_t* cat = (bf16_t*)(P.ws + WS_CAT);
    LAS float* lA = (LAS float*)lds; LAS float* lH = lA + 512;
    const int tid = threadIdx.x, seg = tid >> 4, c = tid & 15;
    for (int item = blockIdx.x; item < 256; item += gridDim.x) {
        const int b = item >> 5, ch = (item & 31) * 16 + c;
        const size_t base = (size_t)b * SEQ + seg * 128;
        float H = 0.f, sla = 0.f;
#pragma unroll 1
        for (int i0 = 0; i0 < 128; i0 += 64) {
            unsigned r[64];
#pragma unroll
            for (int j = 0; j < 64; ++j) r[j] = lau[(base + i0 + j) * 512 + ch];
#pragma unroll
            for (int j = 0; j < 64; ++j) { const float la = __uint_as_float(r[j] << 16), u = __uint_as_float(r[j] & 0xffff0000u); H = fexp(la) * H + u; sla += la; }
        }
        lA[tid] = fexp(sla); lH[tid] = H;
        __syncthreads();
        float carry = 0.f;
        for (int s2 = 0; s2 < seg; ++s2) carry = lA[s2 * 16 + c] * carry + lH[s2 * 16 + c];
        H = carry;
#pragma unroll 1
        for (int i0 = 0; i0 < 128; i0 += 32) {
            unsigned r[32]; unsigned short ga[32];
#pragma unroll
            for (int j = 0; j < 32; ++j) { r[j] = lau[(base + i0 + j) * 512 + ch]; ga[j] = proj[(base + i0 + j) * 1536 + 512 + ch]; }
#pragma unroll
            for (int j = 0; j < 32; ++j) {
                const float la = __uint_as_float(r[j] << 16), u = __uint_as_float(r[j] & 0xffff0000u); H = fexp(la) * H + u;
                cat[(base + i0 + j) * 1024 + ch] = (bf16_t)(pk_bf16(H * gelu_tanh(bf2f(ga[j])), 0.f) & 0xffffu);
            }
        }
        __syncthreads();
    }
}

__device__ __forceinline__ void ph_s5_state(const Params& P, lds_t* lds) {
    const bf16_t* proj = (const bf16_t*)(P.ws + WS_PROJ); const bf16_t* Wst = (const bf16_t*)(P.ws + WS_S5WST); float* S = (float*)(P.ws + WS_S5S);
    const int b0 = (int)blockIdx.x, G = (int)gridDim.x;
    {
        e1_stream<true>(lds, wg_tiles(128), [](int) { return 8; },
            [=](int j, int, int r, int kp) { const int tile = b0 + j * G, g = tile & 31, rt = tile >> 5; return *(const u32x4*)(proj + (size_t)((rt * 256 + r) * 32 + (kp >> 1)) * 1536 + 1024 + g * 16 + (kp & 1) * 8); },
            [=](int j, int, int n, int kp) { const int g = (b0 + j * G) & 31; return *(const u32x4*)(Wst + (size_t)g * 65536 + n * 512 + kp * 8); },
            [=](int j, f32x4 (&acc)[4][4], int wr, int wc, int fr, int fq) {
                const int tile = b0 + j * G, g = tile & 31, rt = tile >> 5;
#pragma unroll
                for (int m = 0; m < 4; ++m)
#pragma unroll
                    for (int n = 0; n < 4; ++n) *(f32x4*)(S + ((size_t)(rt * 256 + wr * 64 + m * 16 + fr) * 32 + g) * 128 + wc * 64 + n * 16 + fq * 4) = acc[m][n];
            });
    }
}

__device__ __forceinline__ void ph_s5_carry(const Params& P) {
    const float* S = (const float*)(P.ws + WS_S5S); bf16_t* X = (bf16_t*)(P.ws + WS_S5X);
    if (threadIdx.x >= 64) return;
    const int p = threadIdx.x;
    for (int it = blockIdx.x; it < 256; it += gridDim.x) {
        const int b = it >> 5, g = it & 31;
        const float lr = fminf(P.in[I_S5_LRE][g * 64 + p], -1e-4f), li = P.in[I_S5_LIM][g * 64 + p], step = expf(P.in[I_S5_STEP][g]);
        const float mag = expf((float)S5TC * lr * step); float sn, cs; sincosf((float)S5TC * li * step, &sn, &cs);
        const float cr = mag * cs, ci = mag * sn;
        float xr = 0.f, xi = 0.f;
        for (int c0 = 0; c0 < 128; c0 += 16) {
            float sr[16], si[16];
#pragma unroll
            for (int j = 0; j < 16; ++j) { const size_t o = ((size_t)(b * 128 + c0 + j) * 32 + g) * 128; sr[j] = S[o + p]; si[j] = S[o + 64 + p]; }
#pragma unroll
            for (int j = 0; j < 16; ++j) {
                const size_t o = ((size_t)(b * 128 + c0 + j) * 32 + g) * 128;
                X[o + p] = (bf16_t)(pk_bf16(xr, 0.f) & 0xffffu); X[o + 64 + p] = (bf16_t)(pk_bf16(xi, 0.f) & 0xffffu);
                const float nr = cr * xr - ci * xi + sr[j], ni = cr * xi + ci * xr + si[j];
                xr = nr; xi = ni;
            }
        }
    }
}

__device__ __forceinline__ void ph_s5_out(const Params& P, lds_t* lds) {
    const bf16_t* proj = (const bf16_t*)(P.ws + WS_PROJ); const bf16_t* Tm = (const bf16_t*)(P.ws + WS_S5TM); const bf16_t* X = (const bf16_t*)(P.ws + WS_S5X);
    bf16_t* sb = (bf16_t*)(P.ws + WS_SB);
    const int b0 = (int)blockIdx.x, G = (int)gridDim.x;
#define S5O_DECODE(J) const int tile = b0 + (J) * G, ct = (tile < 256) ? (tile & 3) : 3 - (tile & 3), g = (tile >> 2) & 31, rt = tile >> 7, nkl = 2 * ct + 2; (void)g; (void)rt;
    {
        e1_stream<true>(lds, wg_tiles(512), [=](int j) { S5O_DECODE(j) return nkl + 2; },
            [=](int j, int, int r, int kp0) {
                S5O_DECODE(j)
                const int kp = kp0 < nkl * 8 ? kp0 : kp0 - nkl * 8 + 64;
                if (kp < 64) return *(const u32x4*)(proj + (size_t)((rt * 256 + r) * 32 + (kp >> 1)) * 1536 + 1024 + g * 16 + (kp & 1) * 8);
                return *(const u32x4*)(X + ((size_t)(rt * 256 + r) * 32 + g) * 128 + (kp - 64) * 8); },
            [=](int j, int, int n, int kp0) { S5O_DECODE(j) const int kp = kp0 < nkl * 8 ? kp0 : kp0 - nkl * 8 + 64; return *(const u32x4*)(Tm + (size_t)g * 512 * S5K + (size_t)(ct * 128 + n) * S5K + kp * 8); },
            [=](int j, f32x4 (&acc)[4][4], int wr, int wc, int fr, int fq) {
                S5O_DECODE(j)
#pragma unroll
                for (int m = 0; m < 4; ++m)
#pragma unroll
                    for (int n = 0; n < 4; ++n) {
                        const int col = ct * 128 + wc * 64 + n * 16 + fq * 4, t = col >> 4, h0 = col & 15;
                        const size_t tok = (size_t)(rt * 256 + wr * 64 + m * 16 + fr) * 32 + t;
                        f32x4 y = acc[m][n];
#pragma unroll
                        for (int c = 0; c < 4; ++c) y[c] = gelu_tanh(y[c]);
                        store_bf16x4(sb + tok * 512 + g * 16 + h0, y);
                    }
            });
    }
}

#undef S5O_DECODE
__device__ __forceinline__ void ph_glu(const Params& P, lds_t* lds) {
    const bf16_t* sb = (const bf16_t*)(P.ws + WS_SB); const bf16_t* Wt = (const bf16_t*)(P.ws + WS_WGLU); bf16_t* cat = (bf16_t*)(P.ws + WS_CAT);
    const float* gb = P.in[I_AB_GLUB];
    const int b0 = (int)blockIdx.x, G = (int)gridDim.x;
    {
        e1_stream<true>(lds, wg_tiles(512), [](int) { return 8; },
            [=](int j, int, int r, int kp) { const int rt = (b0 + j * G) >> 2; return *(const u32x4*)(sb + (size_t)(rt * 256 + r) * 512 + kp * 8); },
            [=](int j, int, int n, int kp) { const int ct = (b0 + j * G) & 3; return *(const u32x4*)(Wt + (size_t)(ct * 128 + n) * 512 + kp * 8); },
            [=](int j, f32x4 (&acc)[4][4], int wr, int wc, int fr, int fq) {
                const int tile = b0 + j * G, rt = tile >> 2, ct = tile & 3;
#pragma unroll
                for (int n = 0; n < 4; ++n) {
                    const int col = ct * 128 + wc * 64 + n * 16 + fq * 4;
                    const f32x4 bv = *(const f32x4*)(gb + col);
#pragma unroll
                    for (int m = 0; m < 4; ++m) {
                        const size_t row = (size_t)(rt * 256 + wr * 64 + m * 16 + fr);
                        const u32x2 sr = *(const u32x2*)(sb + row * 512 + col);
                        const float sv[4] = {__uint_as_float(sr.x << 16), __uint_as_float(sr.x & 0xffff0000u), __uint_as_float(sr.y << 16), __uint_as_float(sr.y & 0xffff0000u)};
                        f32x4 y;
#pragma unroll
                        for (int c = 0; c < 4; ++c) y[c] = sv[c] * fsigmoid(acc[m][n][c] + bv[c]);
                        store_bf16x4(cat + row * 1024 + 512 + col, y);
                    }
                }
            });
    }
}

__device__ __forceinline__ void ph_ln_router(const Params& P, lds_t* lds, int layer, const float* xres  , int dummy = 0) {
    const bf16_t* mixb = (const bf16_t*)(P.ws + WS_ZF); bf16_t* xb = (bf16_t*)(P.ws + WS_XB); unsigned* xb8 = (unsigned*)(P.ws + WS_X1F);
    const float* lg = P.in[I_LNM_G] + layer * 1024; const float* lb = P.in[I_LNM_B] + layer * 1024;
    const float* rw = P.in[I_R_W] + (size_t)layer * 1024 * 32; const float* rbias = P.in[I_R_B] + layer * 32;
    int* gcount = (int*)(P.ws + WS_CTL) + 64 * layer + 32 * dummy;
    int* pair_e = (int*)(P.ws + WS_ROUTE); int* pair_rank = pair_e + T * 4; float* pair_gate = (float*)(pair_rank + T * 4);
    constexpr int XP = 2064;
    lds_t* Xh = lds; lds_t* Xl = lds + 16 * XP;
    LAS float* part = (LAS float*)(lds + 32 * XP);
    LAS int* hist = (LAS int*)(lds + 32 * XP + 16384); LAS int* basev = hist + 32; LAS int* pinfo = basev + 32;
    const int tid = threadIdx.x, lane = tid & 63, wave = tid >> 6, fr = lane & 15, fq = lane >> 4;
    bf16x8 wh[4][2], wl[4][2];
#pragma unroll
    for (int ks = 0; ks < 4; ++ks)
#pragma unroll
        for (int nt = 0; nt < 2; ++nt) {
            unsigned ph[4], pl[4];
#pragma unroll
            for (int j2 = 0; j2 < 4; ++j2) {
                const int k = wave * 128 + ks * 32 + fq * 8 + 2 * j2;
                const float w0 = rw[(size_t)k * 32 + nt * 16 + fr], w1 = rw[(size_t)(k + 1) * 32 + nt * 16 + fr];
                ph[j2] = pk_bf16(w0, w1);
                pl[j2] = pk_bf16(w0 - __uint_as_float(ph[j2] << 16), w1 - __uint_as_float(ph[j2] & 0xffff0000u));
            }
            const u32x4 uh = {ph[0], ph[1], ph[2], ph[3]}, ul = {pl[0], pl[1], pl[2], pl[3]};
            wh[ks][nt] = __builtin_bit_cast(bf16x8, uh); wl[ks][nt] = __builtin_bit_cast(bf16x8, ul);
        }
    const float myrb = rbias[lane & 31];
    for (int it = blockIdx.x; it < T / 16; it += gridDim.x) {
        if (tid < 32) hist[tid] = 0;
        f32x4 y[2][4];
#pragma unroll
        for (int rr = 0; rr < 2; ++rr)
#pragma unroll
            for (int j = 0; j < 4; ++j) {
                const size_t o = ((size_t)it * 16 + wave * 2 + rr) * 1024 + j * 256 + lane * 4;
                const u32x2 mr = *(const u32x2*)(mixb + o);
                f32x4 xr;
                if (xres) xr = *(const f32x4*)(xres + o);
                else { const u32x2 xq = *(const u32x2*)(xb + o); xr = (f32x4){__uint_as_float(xq.x << 16), __uint_as_float(xq.x & 0xffff0000u), __uint_as_float(xq.y << 16), __uint_as_float(xq.y & 0xffff0000u)}; }
                y[rr][j] = xr * ALPHA + (f32x4){__uint_as_float(mr.x << 16), __uint_as_float(mr.x & 0xffff0000u), __uint_as_float(mr.y << 16), __uint_as_float(mr.y & 0xffff0000u)};
            }
#pragma unroll
        for (int rr = 0; rr < 2; ++rr) {
            const int rl = wave * 2 + rr; const size_t row = (size_t)it * 16 + rl;
            float s = 0.f;
#pragma unroll
            for (int j = 0; j < 4; ++j) s += (y[rr][j][0] + y[rr][j][1]) + (y[rr][j][2] + y[rr][j][3]);
            const float mean = wave_sum(s) * (1.0f / 1024.0f); float s2 = 0.f;
#pragma unroll
            for (int j = 0; j < 4; ++j) { y[rr][j] = y[rr][j] - mean; s2 += (y[rr][j][0] * y[rr][j][0] + y[rr][j][1] * y[rr][j][1]) + (y[rr][j][2] * y[rr][j][2] + y[rr][j][3] * y[rr][j][3]); }
            const float rstd = rsqrtf(wave_sum(s2) * (1.0f / 1024.0f) + LN_EPS);
#pragma unroll
            for (int j = 0; j < 4; ++j) {
                const f32x4 v = y[rr][j] * rstd * *(const f32x4*)(lg + j * 256 + lane * 4) + *(const f32x4*)(lb + j * 256 + lane * 4);
                u32x2 hi; hi.x = pk_bf16(v[0], v[1]); hi.y = pk_bf16(v[2], v[3]);
                u32x2 lo; lo.x = pk_bf16(v[0] - __uint_as_float(hi.x << 16), v[1] - __uint_as_float(hi.x & 0xffff0000u)); lo.y = pk_bf16(v[2] - __uint_as_float(hi.y << 16), v[3] - __uint_as_float(hi.y & 0xffff0000u));
                *(u32x2*)(xb + row * 1024 + j * 256 + lane * 4) = hi;
                xb8[row * 256 + j * 64 + lane] = pk_fp8x4(v * FP8_SX);
                *(LAS u32x2*)(Xh + rl * XP + (j * 256 + lane * 4) * 2) = hi;
                *(LAS u32x2*)(Xl + rl * XP + (j * 256 + lane * 4) * 2) = lo;
            }
        }
        __syncthreads();
        f32x4 acc[2] = {(f32x4){0.f, 0.f, 0.f, 0.f}, (f32x4){0.f, 0.f, 0.f, 0.f}};
#pragma unroll
        for (int ks = 0; ks < 4; ++ks) {
            const int ko = (wave * 128 + ks * 32 + fq * 8) * 2;
            const bf16x8 ah = *(LAS bf16x8*)(Xh + fr * XP + ko), al = *(LAS bf16x8*)(Xl + fr * XP + ko);
#pragma unroll
            for (int nt = 0; nt < 2; ++nt) { acc[nt] = MFMA16(ah, wh[ks][nt], acc[nt]); acc[nt] = MFMA16(ah, wl[ks][nt], acc[nt]); acc[nt] = MFMA16(al, wh[ks][nt], acc[nt]); }
        }
#pragma unroll
        for (int nt = 0; nt < 2; ++nt)
#pragma unroll
            for (int r = 0; r < 4; ++r) part[(wave * 16 + fq * 4 + r) * 32 + nt * 16 + fr] = acc[nt][r];
        __syncthreads();
        {
            const int rl = wave * 2 + (lane >> 5), my = lane & 31;
            float val = myrb;
#pragma unroll
            for (int w2 = 0; w2 < 8; ++w2) val += part[(w2 * 16 + rl) * 32 + my];
            float topv[4]; int topi[4];
#pragma unroll
            for (int k = 0; k < 4; ++k) {
                float bv = val; int bi = my;
#pragma unroll
                for (int off = 16; off >= 1; off >>= 1) { const float ov = __shfl_xor(bv, off); const int oi = __shfl_xor(bi, off); if (ov > bv || (ov == bv && oi < bi)) { bv = ov; bi = oi; } }
                topv[k] = bv; topi[k] = bi; if (my == bi) val = -INFINITY;
            }
            if (my == 0) {
                const float e1 = expf(topv[1] - topv[0]), e2 = expf(topv[2] - topv[0]), e3 = expf(topv[3] - topv[0]);
                const float inv = 1.0f / (1.0f + e1 + e2 + e3);
                const float gt[4] = {inv, e1 * inv, e2 * inv, e3 * inv};
#pragma unroll
                for (int k = 0; k < 4; ++k) { const int lr = __hip_atomic_fetch_add(&hist[topi[k]], 1, __ATOMIC_RELAXED, __HIP_MEMORY_SCOPE_WORKGROUP); pinfo[(rl * 4 + k) * 3 + 0] = topi[k]; pinfo[(rl * 4 + k) * 3 + 1] = lr; pinfo[(rl * 4 + k) * 3 + 2] = __float_as_int(gt[k]); }
            }
        }
        __syncthreads();
        if (tid < 32) { const int c = hist[tid]; basev[tid] = c ? atomicAdd(gcount + tid, c) : 0; }
        __syncthreads();
        if (tid < 64) {
            const int e = pinfo[tid * 3 + 0]; const size_t pi = (size_t)it * 64 + tid;
            pair_e[pi] = e; pair_rank[pi] = basev[e] + pinfo[tid * 3 + 1]; pair_gate[pi] = __int_as_float(pinfo[tid * 3 + 2]);
        }
        __syncthreads();
    }
}

__device__ __forceinline__ void moe_pstart(const Params& P, lds_t* lds, int layer) {
    LAS int* ps = (LAS int*)(lds + PS_OFF);
    const int* gcount = (const int*)(P.ws + WS_CTL) + 64 * layer;
    if (threadIdx.x == 0) { int a = 0; for (int e = 0; e < 32; ++e) { const int c = gcount[e]; ps[e] = a; ps[40 + e] = c; a += ((c + 255) >> 8) << 8; } ps[32] = a; }
    __syncthreads();
}

__device__ __forceinline__ void ph_route_scatter(const Params& P, lds_t* lds, int layer) {
    moe_pstart(P, lds, layer);
    LAS int* ps = (LAS int*)(lds + PS_OFF);
    const int* pair_e = (const int*)(P.ws + WS_ROUTE); const int* pair_rank = pair_e + T * 4; const float* pair_gate = (const float*)(pair_rank + T * 4);
    int* dest = (int*)(pair_gate + T * 4); int* row_tok = dest + T * 4; float* row_gate = (float*)(row_tok + MOE_ROWS);
    const size_t gtid = (size_t)blockIdx.x * NTHREADS + threadIdx.x, GT = (size_t)gridDim.x * NTHREADS;
    for (size_t i = gtid; i < (size_t)T * 4; i += GT) {
        const int e = pair_e[i], pos = ps[e] + pair_rank[i];
        row_tok[pos] = (int)(i >> 2); row_gate[pos] = pair_gate[i]; dest[i] = pos;
    }
    for (size_t i = gtid; i < 32 * 256; i += GT) {
        const int e = (int)(i >> 8), pos = ps[e] + ps[40 + e] + (int)(i & 255);
        if (pos < ps[e + 1]) { row_tok[pos] = 0; row_gate[pos] = 0.f; }
    }
}

struct EpiInproj {
    bf16_t* proj; int N; const int* pos;
    __device__ __forceinline__ void operator()(f32x4 (&acc)[2][2][4][2], const g2::Unit& u, int wr, int wc, int fr, int fq) const {
#pragma unroll
        for (int bj = 0; bj < 2; ++bj) {
            const int ct = 2 * u.pn + bj;
            if (pos != nullptr && ct >= 8 && ct < 16 && wc == 0) {
                float invf[4];
#pragma unroll
                for (int c = 0; c < 4; ++c) invf[c] = exp2f(-(float)(fq * 4 + c) * (18.931568569324174f / 16.0f));
#pragma unroll
                for (int ai = 0; ai < 2; ++ai)
#pragma unroll
                    for (int m = 0; m < 4; ++m) {
                        const float pf = (float)pos[u.pm * 256 + ai * 128 + wr * 64 + m * 16 + fr];
#pragma unroll
                        for (int c = 0; c < 4; ++c) {
                            float sn, cs; fsincos(pf * invf[c], sn, cs);
                            const float a = acc[ai][bj][m][0][c], b = acc[ai][bj][m][1][c];
                            acc[ai][bj][m][0][c] = a * cs - b * sn; acc[ai][bj][m][1][c] = b * cs + a * sn;
                        }
                    }
            }
            const float sc = (pos != nullptr && ct >= 8 && ct < 12) ? 0.08838834764831845f : 1.0f;
#pragma unroll
            for (int ai = 0; ai < 2; ++ai)
#pragma unroll
                for (int m = 0; m < 4; ++m)
#pragma unroll
                    for (int n = 0; n < 2; ++n)
                        store_bf16x4(proj + (size_t)(u.pm * 256 + ai * 128 + wr * 64 + m * 16 + fr) * N + ct * 128 + wc * 32 + n * 16 + fq * 4, acc[ai][bj][m][n] * sc);
        }
    }
};
__device__ __forceinline__ void ph_inproj2(const Params& P, lds_t* lds, const bf16_t* Wt, int N, const int* pos) {
    g2::DenseSched S{(int)gridDim.x, (int)blockIdx.x, T / 256, N / 256, 1024, (const char*)Wt};
    EpiInproj E{(bf16_t*)(P.ws + WS_PROJ), N, pos};
    g2::gemm_phase<false>(lds, (const char*)(P.ws + WS_XB), 16, 2048u, S, E);
}
struct EpiOutproj {
    bf16_t* mixb;
    __device__ __forceinline__ void operator()(f32x4 (&acc)[2][2][4][2], const g2::Unit& u, int wr, int wc, int fr, int fq) const {
#pragma unroll
        for (int ai = 0; ai < 2; ++ai)
#pragma unroll
            for (int m = 0; m < 4; ++m)
#pragma unroll
                for (int bj = 0; bj < 2; ++bj)
#pragma unroll
                    for (int n = 0; n < 2; ++n) {
                        const size_t o = (size_t)(u.pm * 256 + ai * 128 + wr * 64 + m * 16 + fr) * 1024 + u.pn * 256 + bj * 128 + wc * 32 + n * 16 + fq * 4;
                        store_bf16x4(mixb + o, acc[ai][bj][m][n]);
                    }
    }
};
__device__ __forceinline__ void ph_outproj2(const Params& P, lds_t* lds, const bf16_t* Wt) {
    g2::DenseSched S{(int)gridDim.x, (int)blockIdx.x, T / 256, 4, 1024, (const char*)Wt};
    EpiOutproj E{(bf16_t*)(P.ws + WS_ZF)};
    g2::gemm_phase<false>(lds, (const char*)(P.ws + WS_CAT), 16, 2048u, S, E);
}
template <class RT> struct MoeSchedT {
    static constexpr bool CHEAP_AOFF = false;
    int G, c, nM, nN; const char* W; size_t wstride; const LAS RT* rt16; LAS int* ps; unsigned apitch, bpitch;
    __device__ __forceinline__ bool next(int i, g2::Unit& u) const { return g2::static_next(i, G, c, nM, nN, u); }
    __device__ __forceinline__ int expert(int pm) const { int e = 0; while (ps[e + 1] <= pm * 256) ++e; return e; }
    __device__ __forceinline__ void a_off(const g2::Unit& u, unsigned (&ao)[2][2]) const {
        int Rs[2], Cs[2];
#pragma unroll
        for (int i = 0; i < 2; ++i) g2::stage_rc((int)threadIdx.x * 16 + i * 8192, Rs[i], Cs[i]);
#pragma unroll
        for (int h = 0; h < 2; ++h)
#pragma unroll
            for (int i = 0; i < 2; ++i) {
                const unsigned row = (unsigned)rt16[u.idx * 256 + h * 128 + Rs[i]];
                ao[h][i] = row * apitch + (unsigned)Cs[i] * 2u;
            }
    }
    __device__ __forceinline__ const char* b_base(const g2::Unit& u) const { return W + (size_t)expert(u.pm) * wstride + (size_t)u.pn * 256 * bpitch; }
};
struct EpiMoeUp {
    unsigned* hact8; const LAS float* tb;
    __device__ __forceinline__ void operator()(f32x4 (&acc)[2][2][4][2], const g2::Unit& u, int wr, int wc, int fr, int fq) const {
#pragma unroll
        for (int n = 0; n < 2; ++n) {
            const int jl = wc * 32 + n * 16 + fq * 4, j = u.pn * 128 + jl;
            const f32x4 bg = *(const LAS f32x4*)(tb + u.idx * 256 + jl), bl = *(const LAS f32x4*)(tb + u.idx * 256 + 128 + jl);
#pragma unroll
            for (int ai = 0; ai < 2; ++ai)
#pragma unroll
                for (int m = 0; m < 4; ++m) {
                    f32x4 y;
#pragma unroll
                    for (int c = 0; c < 4; ++c) {
                        constexpr float us = 1.0f / (FP8_SX * FP8_SWIN);
                        const float gv = fminf(acc[ai][0][m][n][c] * us + bg[c], 7.0f), lv = fminf(fmaxf(acc[ai][1][m][n][c] * us + bl[c], -7.0f), 7.0f);
                        y[c] = gv * fsigmoid(1.702f * gv) * (lv + 1.0f);
                    }
                    { unsigned wv = 0; const f32x4 ys = y * FP8_SH;
                      wv = __builtin_amdgcn_cvt_pk_fp8_f32(ys[0], ys[1], wv, false); wv = __builtin_amdgcn_cvt_pk_fp8_f32(ys[2], ys[3], wv, true);
                      hact8[((size_t)(u.pm * 256 + ai * 128 + wr * 64 + m * 16 + fr) * 1024 + j) >> 2] = wv; }
                }
        }
    }
};
__device__ __forceinline__ void ph_moe_up2(const Params& P, lds_t* lds, int layer) {
    moe_pstart(P, lds, layer);
    LAS int* ps = (LAS int*)(lds + PS_OFF);
    const int* row_tok = (const int*)(P.ws + WS_ROUTE) + 4 * T * 4;
    const float* b_in = P.in[I_M_BIN] + (size_t)layer * 32 * 2048;
    const int nM = ps[32] >> 8, G = (int)gridDim.x, c = (int)blockIdx.x;
    LAS float* tb = (LAS float*)(lds + MTAB_OFF);
    LAS unsigned short* rt16 = (LAS unsigned short*)(lds + MTAB_OFF + 17 * 1024);
    MoeSchedT<unsigned short> S{G, c, nM, 8, (const char*)(P.ws + (layer ? WS_MW1 : WS_MWIN)), (size_t)2048 * 1024, rt16, ps, 1024u, 1024u};
    { g2::Unit u; for (int i = 0; i < 17 && S.next(i, u); ++i) { const int e = S.expert(u.pm);
        if (threadIdx.x < 256) { const int t = threadIdx.x; tb[i * 256 + t] = b_in[e * 2048 + (t >> 7) * 1024 + u.pn * 128 + (t & 127)]; }
        else { const int t = threadIdx.x - 256; rt16[i * 256 + t] = (unsigned short)row_tok[u.pm * 256 + t]; } } }
    __syncthreads();
    EpiMoeUp E{(unsigned*)(P.ws + WS_HACT), tb};
    g2::gemm_phase<true>(lds, (const char*)(P.ws + WS_X1F), 8, 1024u, S, E);
    if (layer == 0) { const int r = (nM * 8) % G; if (r != 0 && c >= r) convert_range_wg(P, 1, (c - r) * TAIL_QUOTA, TAIL_QUOTA, lds); }
}
struct EpiMoeDown {
    static constexpr int NVMEM = 32;
    bf16_t* yb; const LAS float* tb;
    __device__ __forceinline__ void operator()(f32x4 (&acc)[2][2][4][2], const g2::Unit& u, int wr, int wc, int fr, int fq) const {
#pragma unroll
        for (int bj = 0; bj < 2; ++bj)
#pragma unroll
            for (int n = 0; n < 2; ++n) {
                const int cl = bj * 128 + wc * 32 + n * 16 + fq * 4;
                const f32x4 bv = *(const LAS f32x4*)(tb + u.idx * 512 + cl);
#pragma unroll
                for (int ai = 0; ai < 2; ++ai)
#pragma unroll
                    for (int m = 0; m < 4; ++m) {
                        const int rl = ai * 128 + wr * 64 + m * 16 + fr; const float gt = tb[u.idx * 512 + 256 + rl];
                        store_bf16x4(yb + (size_t)(u.pm * 256 + rl) * 1024 + u.pn * 256 + cl, (acc[ai][bj][m][n] * (1.0f / (FP8_SH * FP8_SWOUT)) + bv) * gt);
                    }
            }
    }
};
__device__ __forceinline__ void ph_moe_down2(const Params& P, lds_t* lds, int layer) {
    moe_pstart(P, lds, layer);
    LAS int* ps = (LAS int*)(lds + PS_OFF);
    const float* row_gate = (const float*)((const int*)(P.ws + WS_ROUTE) + 4 * T * 4 + MOE_ROWS);
    const float* b_out = P.in[I_M_BOUT] + (size_t)layer * 32 * 1024;
    const int nM = ps[32] >> 8, G = (int)gridDim.x, c = (int)blockIdx.x;
    LAS float* tb = (LAS float*)(lds + MTAB_OFF);
    LAS unsigned* rt32 = (LAS unsigned*)(lds + MTAB_OFF + 9 * 2048);
    MoeSchedT<unsigned> S{G, c, nM, 4, (const char*)(P.ws + (layer ? WS_MW1 : WS_MWIN) + (size_t)32 * 2048 * 1024), (size_t)1024 * 1024, rt32, ps, 1024u, 1024u};
    { g2::Unit u; for (int i = 0; i < 9 && S.next(i, u); ++i) { const int e = S.expert(u.pm);
        const int t = threadIdx.x; tb[i * 512 + t] = (t < 256) ? b_out[e * 1024 + u.pn * 256 + t] : row_gate[u.pm * 256 + (t - 256)]; if (t < 256) rt32[i * 256 + t] = (unsigned)(u.pm * 256 + t); } }
    __syncthreads();
    EpiMoeDown E{(bf16_t*)(P.ws + WS_YB), tb};
    g2::gemm_phase<true>(lds, (const char*)(P.ws + WS_HACT), 8, 1024u, S, E);
    if (layer == 0) { const int r = (nM * 4) % G; if (r != 0 && c >= r) convert_range_wg(P, 1, tail_done_up(nM, G) + (c - r) * TAIL_QUOTA, TAIL_QUOTA, lds); }
}

__device__ __forceinline__ void ph_combine_ln(const Params& P, int layer, float* outf  ) {
    const bf16_t* yb = (const bf16_t*)(P.ws + WS_YB); bf16_t* xb = (bf16_t*)(P.ws + WS_XB);
    const int* dest = (const int*)(P.ws + WS_ROUTE) + 3 * T * 4;
    const float* lg = P.in[I_LNF_G] + layer * 1024; const float* lb = P.in[I_LNF_B] + layer * 1024;
    const int lane = threadIdx.x & 63, gw = blockIdx.x * 8 + (threadIdx.x >> 6), NGW = gridDim.x * 8;
    int4 dnext[2];
#pragma unroll
    for (int rr = 0; rr < 2; ++rr) dnext[rr] = (gw * 2 + rr < T) ? *(const int4*)(dest + (gw * 2 + rr) * 4) : (int4){0, 0, 0, 0};
    for (int row0 = gw * 2; row0 < T; row0 += NGW * 2) {
        f32x4 v[2][4]; u32x2 yr[2][4][4];
        int4 dcur[2];
#pragma unroll
        for (int rr = 0; rr < 2; ++rr) { dcur[rr] = dnext[rr]; const int nr = row0 + NGW * 2 + rr; if (nr < T) dnext[rr] = *(const int4*)(dest + nr * 4); }
#pragma unroll
        for (int rr = 0; rr < 2; ++rr) {
            const int row = row0 + rr;
            const int4 d = dcur[rr];
            const int dd[4] = {d.x, d.y, d.z, d.w};
#pragma unroll
            for (int j = 0; j < 4; ++j) {
                { const u32x2 xq = *(const u32x2*)(xb + (size_t)row * 1024 + j * 256 + lane * 4); v[rr][j] = (f32x4){__uint_as_float(xq.x << 16), __uint_as_float(xq.x & 0xffff0000u), __uint_as_float(xq.y << 16), __uint_as_float(xq.y & 0xffff0000u)}; }
#pragma unroll
                for (int k = 0; k < 4; ++k) yr[rr][j][k] = *(const u32x2*)(yb + (size_t)dd[k] * 1024 + j * 256 + lane * 4);
            }
        }
#pragma unroll
        for (int rr = 0; rr < 2; ++rr) {
            const int row = row0 + rr; float s = 0.f;
#pragma unroll
            for (int j = 0; j < 4; ++j) {
                v[rr][j] = v[rr][j] * ALPHA;
#pragma unroll
                for (int k = 0; k < 4; ++k) {
                    const u32x2 r = yr[rr][j][k];
                    v[rr][j][0] += __uint_as_float(r.x << 16); v[rr][j][1] += __uint_as_float(r.x & 0xffff0000u); v[rr][j][2] += __uint_as_float(r.y << 16); v[rr][j][3] += __uint_as_float(r.y & 0xffff0000u);
                }
                s += (v[rr][j][0] + v[rr][j][1]) + (v[rr][j][2] + v[rr][j][3]);
            }
            const float mean = wave_sum(s) * (1.0f / 1024.0f); float s2 = 0.f;
#pragma unroll
            for (int j = 0; j < 4; ++j) { v[rr][j] = v[rr][j] - mean; s2 += (v[rr][j][0] * v[rr][j][0] + v[rr][j][1] * v[rr][j][1]) + (v[rr][j][2] * v[rr][j][2] + v[rr][j][3] * v[rr][j][3]); }
            const float rstd = rsqrtf(wave_sum(s2) * (1.0f / 1024.0f) + LN_EPS);
#pragma unroll
            for (int j = 0; j < 4; ++j) {
                const f32x4 o = v[rr][j] * rstd * *(const f32x4*)(lg + j * 256 + lane * 4) + *(const f32x4*)(lb + j * 256 + lane * 4);
                if (outf) *(f32x4*)(outf + (size_t)row * 1024 + j * 256 + lane * 4) = o;
                else store_bf16x4(xb + (size_t)row * 1024 + j * 256 + lane * 4, o);
            }
        }
    }
}

__device__ __forceinline__ void ph_conv1(const Params& P, lds_t* lds) {
    const bf16_t* proj = (const bf16_t*)(P.ws + WS_PROJ); bf16_t* xconv = (bf16_t*)(P.ws + WS_XCONV); float* gates = (float*)(P.ws + WS_GATES);
    LAS float* Wc = (LAS float*)lds;
    const float* Wcg = (const float*)(P.ws + WS_WC);
    for (int i = threadIdx.x; i < 8192; i += NTHREADS) {
        const int which = i >> 12, ch = (i >> 3) & 511, gg = i & 7;
        Wc[which * 4096 + (((ch & 7) * 2 + (gg >> 2)) * 64 + (ch >> 3)) * 4 + (gg & 3)] = Wcg[i];
    }
    __syncthreads();
    const int lane = threadIdx.x & 63, gw = blockIdx.x * 8 + (threadIdx.x >> 6), NGW = gridDim.x * 8, c8 = lane * 8;
    float w[4][8], bias[8];
#pragma unroll
    for (int e = 0; e < 8; ++e) { bias[e] = P.in[I_CD_CONVB][c8 + e];
#pragma unroll
        for (int k = 0; k < 4; ++k) w[k][e] = P.in[I_CD_CONVW][k * 512 + c8 + e]; }
    const float bif = P.in[I_CD_BIF][lane & 7];
    for (int run = gw; run < T / 8; run += NGW) {
        const int tok0 = run * 8, p0 = tok0 & (SEQ - 1);
        u32x4 r[11];
#pragma unroll
        for (int i = 0; i < 11; ++i) { r[i] = (u32x4){0u, 0u, 0u, 0u}; if (p0 + i - 3 >= 0) r[i] = *(const u32x4*)(proj + (size_t)(tok0 + i - 3) * 2560 + c8); }
#pragma unroll
        for (int t = 0; t < 8; ++t) {
            int woff = lane * 4; asm volatile("" : "+v"(woff));
            const int tok = tok0 + t;
            float a[8], xraw[8];
#pragma unroll
            for (int e = 0; e < 8; ++e) a[e] = bias[e];
#pragma unroll
            for (int k = 0; k < 4; ++k) { float xv[8]; unpack8(r[t + k], xv);
#pragma unroll
                for (int e = 0; e < 8; ++e) { a[e] += w[k][e] * xv[e]; if (k == 3) xraw[e] = xv[e]; } }
#pragma unroll
            for (int e = 0; e < 8; ++e) a[e] = a[e] * fsigmoid(a[e]);
            const u32x4 packed = pack8(a);
            *(u32x4*)(xconv + (size_t)tok * 512 + c8) = packed;
            float ar[8]; unpack8(packed, ar);
            float gs[8];
#pragma unroll
            for (int gg = 0; gg < 8; ++gg) gs[gg] = 0.f;
#pragma unroll
            for (int e = 0; e < 8; ++e) {
                const f32x4 w1a = *(LAS f32x4*)(Wc + woff + (e * 2) * 256), w1b = *(LAS f32x4*)(Wc + woff + (e * 2 + 1) * 256);
                const f32x4 w2a = *(LAS f32x4*)(Wc + 4096 + woff + (e * 2) * 256), w2b = *(LAS f32x4*)(Wc + 4096 + woff + (e * 2 + 1) * 256);
#pragma unroll
                for (int gg = 0; gg < 4; ++gg) { gs[gg] += ar[e] * w1a[gg] + xraw[e] * w2a[gg]; gs[gg + 4] += ar[e] * w1b[gg] + xraw[e] * w2b[gg]; }
            }
            float mine = 0.f;
#pragma unroll
            for (int gg = 0; gg < 8; ++gg) { const float tsum = wave_sum(gs[gg]); if ((lane & 7) == gg) mine = tsum; }
            if (lane < 8) gates[(size_t)tok * 8 + lane] = mine + bif;
        }
    }
}

__device__ __forceinline__ void ph_qkv(const Params& P, lds_t* lds) {
    const bf16_t* xconv = (const bf16_t*)(P.ws + WS_XCONV); const bf16_t* proj = (const bf16_t*)(P.ws + WS_PROJ); const bf16_t* Wt = (const bf16_t*)(P.ws + WS_WQKV);
    bf16_t* qb = (bf16_t*)(P.ws + WS_QB); static_assert(WS_KB == WS_QB + 32 * MiB && WS_VB == WS_QB + 64 * MiB, "q/k/v spacing");
    const int b0 = (int)blockIdx.x, G = (int)gridDim.x;
#define QKV_DECODE(J) const int tile = b0 + (J) * G, which = tile % 3, rt = (tile / 3) & 127, h = tile / 384; (void)rt;
    e1_stream<true>(lds, wg_tiles(1536), [](int) { return 2; },
        [=](int j, int, int r, int kp) { QKV_DECODE(j) const bf16_t* A = which < 2 ? xconv : proj; const int lda = which < 2 ? 512 : 2560; return *(const u32x4*)(A + (size_t)(rt * 256 + r) * lda + h * 128 + kp * 8); },
        [=](int j, int, int n, int kp) { QKV_DECODE(j) return *(const u32x4*)(Wt + (size_t)(which * 4 + h) * 16384 + n * 128 + kp * 8); },
        [=](int j, f32x4 (&acc)[4][4], int wr, int wc, int fr, int fq) {
            QKV_DECODE(j)
            bf16_t* out = (bf16_t*)((unsigned char*)qb + (size_t)which * (32 * MiB));
            const float sc = which == 1 ? 0.08838834764831845f : 1.0f;
#pragma unroll
            for (int m = 0; m < 4; ++m)
#pragma unroll
                for (int n = 0; n < 4; ++n)
                    store_bf16x4(out + (size_t)(rt * 256 + wr * 64 + m * 16 + fr) * 512 + h * 128 + wc * 64 + n * 16 + fq * 4, acc[m][n] * sc);
        });
#undef QKV_DECODE
}

constexpr int TP = 272;
__device__ __forceinline__ void ph_m1(const Params& P, lds_t* lds) {
    const bf16_t* kb = (const bf16_t*)(P.ws + WS_KB); const bf16_t* vb = (const bf16_t*)(P.ws + WS_VB); const float* gates = (const float*)(P.ws + WS_GATES);
    bf16_t* kvc = (bf16_t*)(P.ws + WS_KVC); float* nchunk = (float*)(P.ws + WS_MISC); float* scal = nchunk + 2 * 2048 * 128;
    lds_t* Kt = lds; lds_t* Vt = lds + 64 * TP; LAS float* wv = (LAS float*)(lds + 128 * TP);
    const int tid = threadIdx.x, lane = tid & 63, w = tid >> 6, fr = lane & 15, fq = lane >> 4, q = (lane & 15) >> 2, p4 = lane & 3;
    int item = blockIdx.x; if (item >= 2048) return;
    u32x4 rk[2], rv[2]; float pf_f, pf_i;
#define M1_LOAD(IT) do { const int bh_ = (IT) >> 6, n_ = (IT) & 63, b_ = bh_ >> 2, h_ = bh_ & 3; const size_t t0_ = (size_t)b_ * SEQ + n_ * 64; \
        _Pragma("unroll") for (int i_ = 0; i_ < 2; ++i_) { const int p_ = tid + i_ * NTHREADS; const size_t o_ = (t0_ + (p_ >> 4)) * 512 + h_ * 128 + (p_ & 15) * 8; rk[i_] = *(const u32x4*)(kb + o_); rv[i_] = *(const u32x4*)(vb + o_); } \
        pf_f = gates[(t0_ + lane) * 8 + 4 + h_]; pf_i = gates[(t0_ + lane) * 8 + h_]; } while (0)
    M1_LOAD(item);
    for (;;) {
#pragma unroll
        for (int i = 0; i < 2; ++i) { const int p = tid + i * NTHREADS; *(LAS u32x4*)(Kt + (p >> 4) * TP + (p & 15) * 16) = rk[i]; *(LAS u32x4*)(Vt + (p >> 4) * TP + (p & 15) * 16) = rv[i]; }
        if (w == 0) {
            float cum = logsigmoidf(pf_f);
#pragma unroll
            for (int off = 1; off < 64; off <<= 1) { const float t = __shfl_up(cum, off); if (lane >= off) cum += t; }
            const float cf = __shfl(cum, 63), te = cf - cum + pf_i, m = wave_max(te);
            wv[lane] = expf(te - m);
            if (lane == 0) { scal[item] = cf; scal[2048 + item] = m; }
        }
        __syncthreads();
        const int nitem = item + gridDim.x; const bool has_next = nitem < 2048;
        if (has_next) M1_LOAD(nitem);
        bf16x8 af[2]; float nsum = 0.f;
#pragma unroll
        for (int ks = 0; ks < 2; ++ks) {
            unsigned pk[4];
#pragma unroll
            for (int t = 0; t < 2; ++t) {
                const int s0 = 32 * ks + 8 * fq + 4 * t;
                const bf16x4 r = tr_read(Kt + (s0 + q) * TP + (16 * w + 4 * p4) * 2);
                const f32x4 ww = *(LAS f32x4*)(wv + s0);
                float x[4];
#pragma unroll
                for (int e = 0; e < 4; ++e) { x[e] = bf2f((unsigned short)r[e]) * ww[e]; nsum += x[e]; }
                pk[2 * t] = pk_bf16(x[0], x[1]); pk[2 * t + 1] = pk_bf16(x[2], x[3]);
            }
            u32x4 u = {pk[0], pk[1], pk[2], pk[3]}; af[ks] = __builtin_bit_cast(bf16x8, u);
        }
        nsum += __shfl_xor(nsum, 16); nsum += __shfl_xor(nsum, 32);
        if (fq == 0) nchunk[(size_t)item * 128 + 16 * w + fr] = nsum;
#pragma unroll
        for (int c = 0; c < 8; ++c) {
            f32x4 acc = {0.f, 0.f, 0.f, 0.f};
#pragma unroll
            for (int ks = 0; ks < 2; ++ks) {
                const int s0 = 32 * ks + 8 * fq;
                const bf16x8 bfv = cat44(tr_read(Vt + (s0 + q) * TP + (16 * c + 4 * p4) * 2), tr_read(Vt + (s0 + 4 + q) * TP + (16 * c + 4 * p4) * 2));
                acc = MFMA16(af[ks], bfv, acc);
            }
            store_bf16x4(kvc + ((size_t)item * 128 + c * 16 + fr) * 128 + 16 * w + fq * 4, acc);
        }
        __syncthreads();
        if (!has_next) break;
        item = nitem;
    }
#undef M1_LOAD
}

__device__ __forceinline__ void ph_m2(const Params& P) {
    const bf16_t* kvc = (const bf16_t*)(P.ws + WS_KVC); bf16_t* cprev = (bf16_t*)(P.ws + WS_CPREV);
    const float* nchunk = (const float*)(P.ws + WS_MISC); float* nprev = (float*)(P.ws + WS_MISC) + 2048 * 128; float* scal = (float*)(P.ws + WS_MISC) + 2 * 2048 * 128;
    const int tid = threadIdx.x;
    for (int it = blockIdx.x; it < 256; it += gridDim.x) {
        const int bh = it >> 3, sl = it & 7, idx = sl * 2048 + tid * 4;
        const bool donv = (sl == 0 && tid < 128);
        f32x4 C = {0.f, 0.f, 0.f, 0.f}; float nv = 0.f, m = -INFINITY;
        for (int n0 = 0; n0 < 64; n0 += 4) {
            f32x4 kv[4]; float nc[4], fc[4], mc[4];
#pragma unroll
            for (int j = 0; j < 4; ++j) {
                const int item = bh * 64 + n0 + j;
                { const u32x2 kq = *(const u32x2*)(kvc + (size_t)item * 16384 + idx); kv[j] = (f32x4){__uint_as_float(kq.x << 16), __uint_as_float(kq.x & 0xffff0000u), __uint_as_float(kq.y << 16), __uint_as_float(kq.y & 0xffff0000u)}; }
                nc[j] = donv ? nchunk[(size_t)item * 128 + tid] : 0.f;
                fc[j] = scal[item]; mc[j] = scal[2048 + item];
            }
#pragma unroll
            for (int j = 0; j < 4; ++j) {
                const int item = bh * 64 + n0 + j;
                store_bf16x4(cprev + (size_t)item * 16384 + idx, C);
                if (donv) nprev[(size_t)item * 128 + tid] = nv;
                if (sl == 0 && tid == 0) scal[4096 + item] = m;
                const float mn = fmaxf(fc[j] + m, mc[j]), so = expf(fc[j] + m - mn), sn = expf(mc[j] - mn);
                C = C * so + kv[j] * sn; nv = so * nv + sn * nc[j]; m = mn;
            }
        }
    }
}

__device__ __forceinline__ void ph_m3(const Params& P, lds_t* lds) {
    const bf16_t* qb = (const bf16_t*)(P.ws + WS_QB); const bf16_t* kb = (const bf16_t*)(P.ws + WS_KB); const bf16_t* vb = (const bf16_t*)(P.ws + WS_VB);
    const bf16_t* cprev = (const bf16_t*)(P.ws + WS_CPREV); const float* gates = (const float*)(P.ws + WS_GATES);
    const float* nprev = (const float*)(P.ws + WS_MISC) + 2048 * 128; const float* scal = (const float*)(P.ws + WS_MISC) + 2 * 2048 * 128;
    const bf16_t* proj = (const bf16_t*)(P.ws + WS_PROJ); bf16_t* cat = (bf16_t*)(P.ws + WS_CAT);
    lds_t* Qt = lds; lds_t* Kt = lds + 64 * TP; lds_t* Vt = lds + 128 * TP; lds_t* Ct = lds + 192 * TP;
    LAS float* cumf = (LAS float*)(lds + 320 * TP); LAS float* gv = cumf + 64; LAS float* msv = gv + 64; LAS float* npv = msv + 64; LAS float* ex = npv + 128;
    const int tid = threadIdx.x, lane = tid & 63, w = tid >> 6, fr = lane & 15, fq = lane >> 4, q = (lane & 15) >> 2, p4 = lane & 3;
    const int rt = w & 3, vh = w >> 2;
    int item = blockIdx.x; if (item >= 2048) return;
    u32x4 rq[2], rk[2], rv[2], rc[4]; float pf_f, pf_i, pf_n, pf_mp;
#define M3_LOAD(IT) do { const int bh_ = (IT) >> 6, n_ = (IT) & 63, b_ = bh_ >> 2, h_ = bh_ & 3; const size_t t0_ = (size_t)b_ * SEQ + n_ * 64; \
        _Pragma("unroll") for (int i_ = 0; i_ < 2; ++i_) { const int p_ = tid + i_ * NTHREADS; const size_t o_ = (t0_ + (p_ >> 4)) * 512 + h_ * 128 + (p_ & 15) * 8; rq[i_] = *(const u32x4*)(qb + o_); rk[i_] = *(const u32x4*)(kb + o_); rv[i_] = *(const u32x4*)(vb + o_); } \
        _Pragma("unroll") for (int i_ = 0; i_ < 4; ++i_) { const int p_ = tid + i_ * NTHREADS; rc[i_] = *(const u32x4*)(cprev + (size_t)(IT) * 16384 + (p_ >> 4) * 128 + (p_ & 15) * 8); } \
        pf_f = gates[(t0_ + lane) * 8 + 4 + h_]; pf_i = gates[(t0_ + lane) * 8 + h_]; pf_n = nprev[(size_t)(IT) * 128 + (tid & 127)]; pf_mp = scal[4096 + (IT)]; } while (0)
    M3_LOAD(item);
    for (;;) {
        const int bh = item >> 6, n = item & 63, b = bh >> 2, h = bh & 3; const size_t tok0 = (size_t)b * SEQ + n * 64;
#pragma unroll
        for (int i = 0; i < 2; ++i) { const int p = tid + i * NTHREADS; const int o = (p >> 4) * TP + (p & 15) * 16; *(LAS u32x4*)(Qt + o) = rq[i]; *(LAS u32x4*)(Kt + o) = rk[i]; *(LAS u32x4*)(Vt + o) = rv[i]; }
#pragma unroll
        for (int i = 0; i < 4; ++i) { const int p = tid + i * NTHREADS; *(LAS u32x4*)(Ct + (p >> 4) * TP + (p & 15) * 16) = rc[i]; }
        if (tid < 128) npv[tid] = pf_n;
        const float mp = pf_mp;
        if (w == 0) {
            float cum = logsigmoidf(pf_f);
#pragma unroll
            for (int off = 1; off < 64; off <<= 1) { const float t = __shfl_up(cum, off); if (lane >= off) cum += t; }
            const float gg = pf_i - cum; float pm = gg;
#pragma unroll
            for (int off = 1; off < 64; off <<= 1) { const float t = __shfl_up(pm, off); if (lane >= off) pm = fmaxf(pm, t); }
            cumf[lane] = cum; gv[lane] = gg; msv[lane] = cum + fmaxf(pm, mp);
        }
        __syncthreads();
        const int nitem = item + gridDim.x; const bool has_next = nitem < 2048;
        if (has_next) M3_LOAD(nitem);
        unsigned short opv[4][4];
#pragma unroll
        for (int c = 0; c < 4; ++c)
#pragma unroll
            for (int r = 0; r < 4; ++r) opv[c][r] = proj[(tok0 + rt * 16 + fq * 4 + r) * 2560 + 512 + h * 128 + vh * 64 + c * 16 + fr];
        bf16x8 qf[4];
#pragma unroll
        for (int ks = 0; ks < 4; ++ks) qf[ks] = *(LAS bf16x8*)(Qt + (rt * 16 + fr) * TP + ks * 64 + fq * 16);
        const int s = rt * 16 + fr; const float cs = cumf[s], mss = msv[s];
        float sp[4][4]; float rowsum = 0.f;
#pragma unroll
        for (int jt = 0; jt < 4; ++jt) {
            f32x4 st = {0.f, 0.f, 0.f, 0.f};
            if (jt <= rt) {
#pragma unroll
                for (int ks = 0; ks < 4; ++ks) st = MFMA16(*(LAS bf16x8*)(Kt + (jt * 16 + fr) * TP + ks * 64 + fq * 16), qf[ks], st);
            }
            const f32x4 g4 = *(LAS f32x4*)(gv + jt * 16 + fq * 4);
#pragma unroll
            for (int r = 0; r < 4; ++r) { const int j = jt * 16 + fq * 4 + r; const float wgt = (j <= s) ? fexp(cs + g4[r] - mss) : 0.f; sp[jt][r] = st[r] * wgt; rowsum += sp[jt][r]; }
        }
        rowsum += __shfl_xor(rowsum, 16); rowsum += __shfl_xor(rowsum, 32);
        float qn = 0.f;
#pragma unroll
        for (int ks = 0; ks < 4; ++ks) {
            const f32x4 n0 = *(LAS f32x4*)(npv + ks * 32 + fq * 8), n1 = *(LAS f32x4*)(npv + ks * 32 + fq * 8 + 4);
#pragma unroll
            for (int e = 0; e < 4; ++e) { qn += bf2f((unsigned short)qf[ks][e]) * n0[e]; qn += bf2f((unsigned short)qf[ks][4 + e]) * n1[e]; }
        }
        qn += __shfl_xor(qn, 16); qn += __shfl_xor(qn, 32);
        const float inter = expf(cs + mp - mss), den = rowsum + inter * qn, inv = 1.0f / fmaxf(fabsf(den), expf(-mss));
        if (fq == 0) { ex[w * 32 + fr] = inv; ex[w * 32 + 16 + fr] = inter; }
        __builtin_amdgcn_wave_barrier();
        const f32x4 inv4 = *(LAS f32x4*)(ex + w * 32 + fq * 4), int4 = *(LAS f32x4*)(ex + w * 32 + 16 + fq * 4);
        bf16x8 pa[2];
#pragma unroll
        for (int kk = 0; kk < 2; ++kk) { u32x4 u = {pk_bf16(sp[2 * kk][0], sp[2 * kk][1]), pk_bf16(sp[2 * kk][2], sp[2 * kk][3]), pk_bf16(sp[2 * kk + 1][0], sp[2 * kk + 1][1]), pk_bf16(sp[2 * kk + 1][2], sp[2 * kk + 1][3])}; pa[kk] = __builtin_bit_cast(bf16x8, u); }
#pragma unroll
        for (int c = 0; c < 4; ++c) {
            const int vcol = vh * 64 + c * 16;
            f32x4 acc = {0.f, 0.f, 0.f, 0.f};
#pragma unroll
            for (int ks = 0; ks < 4; ++ks) acc = MFMA16(qf[ks], *(LAS bf16x8*)(Ct + (vcol + fr) * TP + ks * 64 + fq * 16), acc);
#pragma unroll
            for (int r = 0; r < 4; ++r) acc[r] *= int4[r];
#pragma unroll
            for (int kk = 0; kk < 2; ++kk) {
                const bf16x8 vbf = cat44(tr_read(Vt + (32 * kk + 4 * fq + q) * TP + (vcol + 4 * p4) * 2), tr_read(Vt + (32 * kk + 16 + 4 * fq + q) * TP + (vcol + 4 * p4) * 2));
                acc = MFMA16(pa[kk], vbf, acc);
            }
#pragma unroll
            for (int r = 0; r < 4; ++r) {
                const size_t tok = tok0 + rt * 16 + fq * 4 + r; const int col = h * 128 + vcol + fr;
                cat[tok * 1024 + col] = (bf16_t)(pk_bf16(fsigmoid(bf2f(opv[c][r])) * acc[r] * inv4[r], 0.f) & 0xffffu);
            }
        }
        __syncthreads();
        if (!has_next) break;
        item = nitem;
    }
#undef M3_LOAD
}

__device__ __forceinline__ void ph_attn(const Params& P, lds_t* lds) {
    const bf16_t* proj = (const bf16_t*)(P.ws + WS_PROJ); bf16_t* atto = (bf16_t*)(P.ws + WS_ATTO); float* lse = (float*)(P.ws + WS_LSE);
    lds_t* Kt = lds; lds_t* Vt = lds + 256 * TP; LAS float* ex = (LAS float*)(lds + 512 * TP);
    const int tid = threadIdx.x, lane = tid & 63, w = tid >> 6, fr = lane & 15, fq = lane >> 4, q = (lane & 15) >> 2, p4 = lane & 3;
    const int per = (3072 + (int)gridDim.x - 1) / (int)gridDim.x;
    int item = (int)blockIdx.x * per; const int iend = (item + per < 3072) ? item + per : 3072;
    if (item >= iend) return;
    u32x4 rg[16]; bf16x8 qf[4], qn[4];
#define AT_DECODE(IT) const int g = (IT) >> 10, rem = (IT) & 1023, dsh = 2 * g, dil = 1 << dsh, nbsh = 5 - dsh, nb = rem & ((1 << nbsh) - 1), chain = rem >> nbsh, \
        h = chain & 3, br = chain >> 2, r = br & (dil - 1), b = br >> dsh; const size_t tokb = (size_t)b * SEQ + r;
#define AT_LOAD(IT, CHAINED, QF) do { AT_DECODE(IT) \
        _Pragma("unroll") for (int it8 = 0; it8 < 8; ++it8) { const int p = tid + it8 * NTHREADS, kr = p >> 4, pc = p & 15; const int i = nb * 128 + kr - 128; \
            rg[it8] = (u32x4){0u, 0u, 0u, 0u}; rg[8 + it8] = (u32x4){0u, 0u, 0u, 0u}; \
            if (i >= 0 && !((CHAINED) && it8 < 4)) { const bf16_t* src = proj + (tokb + (size_t)i * dil) * 2560 + h * 128 + pc * 8; rg[it8] = *(const u32x4*)(src + 1536); rg[8 + it8] = *(const u32x4*)(src + 2048); } } \
        const size_t tq_ = tokb + (size_t)(nb * 128 + w * 16 + fr) * dil; \
        _Pragma("unroll") for (int ks = 0; ks < 4; ++ks) QF[ks] = __builtin_bit_cast(bf16x8, *(const u32x4*)(proj + tq_ * 2560 + 1024 + h * 128 + ks * 32 + fq * 8)); } while (0)
    bool chained = false; int flip = 0;
    AT_LOAD(item, false, qf);
    for (;;) {
        if (!chained) {
            flip = 0;
#pragma unroll
            for (int it8 = 0; it8 < 8; ++it8) { const int p = tid + it8 * NTHREADS, kr = p >> 4, pc = p & 15; *(LAS u32x4*)(Kt + kr * TP + pc * 16) = rg[it8]; *(LAS u32x4*)(Vt + kr * TP + pc * 16) = rg[8 + it8]; }
        } else {
            flip ^= 1;
#pragma unroll
            for (int it8 = 4; it8 < 8; ++it8) { const int p = tid + it8 * NTHREADS, kr = (p >> 4) & 127, pc = p & 15; const int pr = ((1 ^ flip) << 7) + kr;
                *(LAS u32x4*)(Kt + pr * TP + pc * 16) = rg[it8]; *(LAS u32x4*)(Vt + pr * TP + pc * 16) = rg[8 + it8]; }
        }
        __syncthreads();
        const int nitem = item + 1; const bool has_next = nitem < iend;
        bool chained_next = false;
        if (has_next) { const int g2 = nitem >> 10, nbm = (1 << (5 - 2 * g2)) - 1; chained_next = (g2 == (item >> 10)) && ((nitem & 1023 & nbm) != 0); }
        if (has_next) { if (chained_next) AT_LOAD(nitem, true, qn); else AT_LOAD(nitem, false, qn); }
        AT_DECODE(item)
        const int qi = w * 16 + fr;
        const size_t tokq = tokb + (size_t)(nb * 128 + qi) * dil;
        float pv[9][4]; float mx = -INFINITY;
#pragma unroll
        for (int jj = 0; jj < 9; ++jj) {
            const int tw = w + jj, pt = ((((tw >> 3) ^ flip) & 1) << 3) + (tw & 7);
            f32x4 st = {0.f, 0.f, 0.f, 0.f};
#pragma unroll
            for (int ks = 0; ks < 4; ++ks) st = MFMA16(*(LAS bf16x8*)(Kt + (pt * 16 + fr) * TP + ks * 64 + fq * 16), qf[ks], st);
#pragma unroll
            for (int rr = 0; rr < 4; ++rr) {
                const int kj = tw * 16 + fq * 4 + rr;
                const bool valid = (kj >= qi) && (kj <= qi + 128) && (nb > 0 || kj >= 128);
                pv[jj][rr] = valid ? st[rr] : -INFINITY; mx = fmaxf(mx, pv[jj][rr]);
            }
        }
        mx = fmaxf(mx, __shfl_xor(mx, 16)); mx = fmaxf(mx, __shfl_xor(mx, 32));
        float l = 0.f;
#pragma unroll
        for (int jj = 0; jj < 9; ++jj)
#pragma unroll
            for (int rr = 0; rr < 4; ++rr) { pv[jj][rr] = fexp(pv[jj][rr] - mx); l += pv[jj][rr]; }
        l += __shfl_xor(l, 16); l += __shfl_xor(l, 32);
        if (fq == 0) { ex[w * 16 + fr] = 1.0f / l; lse[((size_t)g * T + tokq) * 4 + h] = mx + logf(l); }
        __builtin_amdgcn_wave_barrier();
        const f32x4 inv4 = *(LAS f32x4*)(ex + w * 16 + fq * 4);
        f32x4 acc[8];
#pragma unroll
        for (int c = 0; c < 8; ++c) acc[c] = (f32x4){0.f, 0.f, 0.f, 0.f};
#pragma unroll
        for (int kk = 0; kk < 5; ++kk) {
            const int ja = 2 * kk, jb = (2 * kk + 1 < 9) ? 2 * kk + 1 : 2 * kk;
            const int twa = w + ja, twb = w + jb;
            const int pa_t = ((((twa >> 3) ^ flip) & 1) << 3) + (twa & 7), pb_t = ((((twb >> 3) ^ flip) & 1) << 3) + (twb & 7);
            u32x4 u; u.x = pk_bf16(pv[ja][0], pv[ja][1]); u.y = pk_bf16(pv[ja][2], pv[ja][3]);
            if (2 * kk + 1 < 9) { u.z = pk_bf16(pv[jb][0], pv[jb][1]); u.w = pk_bf16(pv[jb][2], pv[jb][3]); } else { u.z = 0u; u.w = 0u; }
            const bf16x8 pa = __builtin_bit_cast(bf16x8, u);
#pragma unroll
            for (int c = 0; c < 8; ++c) {
                const bf16x8 vbf = cat44(tr_read(Vt + (pa_t * 16 + 4 * fq + q) * TP + (c * 16 + 4 * p4) * 2), tr_read(Vt + (pb_t * 16 + 4 * fq + q) * TP + (c * 16 + 4 * p4) * 2));
                acc[c] = MFMA16(pa, vbf, acc[c]);
            }
        }
#pragma unroll
        for (int rr = 0; rr < 4; ++rr) {
            const size_t tq = tokb + (size_t)(nb * 128 + w * 16 + fq * 4 + rr) * dil;
#pragma unroll
            for (int c = 0; c < 8; ++c) atto[((size_t)g * T + tq) * 512 + h * 128 + c * 16 + fr] = (bf16_t)(pk_bf16(acc[c][rr] * inv4[rr], 0.f) & 0xffffu);
        }
        __syncthreads();
        if (!has_next) break;
        item = nitem; chained = chained_next;
#pragma unroll
        for (int ks = 0; ks < 4; ++ks) qf[ks] = qn[ks];
    }
#undef AT_LOAD
#undef AT_DECODE
}

__device__ __forceinline__ void ph_attn_combine(const Params& P) {
    const bf16_t* atto = (const bf16_t*)(P.ws + WS_ATTO); const float* lse = (const float*)(P.ws + WS_LSE); bf16_t* cat = (bf16_t*)(P.ws + WS_CAT);
    const size_t gtid = (size_t)blockIdx.x * NTHREADS + threadIdx.x, GT = (size_t)gridDim.x * NTHREADS;
    for (size_t i0 = gtid; i0 < (size_t)T * 128; i0 += 4 * GT) {
        float l[4][3]; u32x2 o[4][3];
#pragma unroll
        for (int j = 0; j < 4; ++j) {
            const size_t i = i0 + j * GT, tok = i >> 7; const int c4 = (int)(i & 127) * 4, h = c4 >> 7;
#pragma unroll
            for (int g = 0; g < 3; ++g) { l[j][g] = lse[((size_t)g * T + tok) * 4 + h]; o[j][g] = *(const u32x2*)(atto + ((size_t)g * T + tok) * 512 + c4); }
        }
#pragma unroll
        for (int j = 0; j < 4; ++j) {
            const size_t i = i0 + j * GT, tok = i >> 7; const int c4 = (int)(i & 127) * 4;
            const float mx = fmaxf(l[j][0], fmaxf(l[j][1], l[j][2])), e0 = expf(l[j][0] - mx), e1 = expf(l[j][1] - mx), e2 = expf(l[j][2] - mx), inv = 1.0f / (e0 + e1 + e2);
            f32x4 of[3];
#pragma unroll
            for (int g = 0; g < 3; ++g) of[g] = (f32x4){__uint_as_float(o[j][g].x << 16), __uint_as_float(o[j][g].x & 0xffff0000u), __uint_as_float(o[j][g].y << 16), __uint_as_float(o[j][g].y & 0xffff0000u)};
            store_bf16x4(cat + tok * 1024 + 512 + c4, (of[0] * e0 + of[1] * e1 + of[2] * e2) * inv);
        }
    }
}

constexpr int NPHASES = 33;
__device__ __forceinline__ void grid_barrier_cg(cg::grid_group& grid) {
    asm volatile("s_waitcnt vmcnt(0)" ::: "memory");
    grid.sync();
    __builtin_amdgcn_fence(__ATOMIC_ACQUIRE, "agent");
    asm volatile("s_waitcnt vmcnt(0)" ::: "memory");
}
#define XB_TMO      128
#define XB_XCNT(j)  (256  + 64 * (j))
#define XB_XSUB(j)  (1280 + 64 * (j))
#define XB_XGEN(j)  (2304 + 64 * (j))
#define XB_TOP      3328
#define XB_TOPGEN   3392
#define XCD_BAR_WORDS 3456
#define XB_SPIN_CAP (1u << 22)
__device__ __forceinline__ unsigned xb_ld(unsigned* p)              { return __hip_atomic_load(p, __ATOMIC_RELAXED, __HIP_MEMORY_SCOPE_AGENT); }
__device__ __forceinline__ unsigned xb_add(unsigned* p, unsigned v) { return __hip_atomic_fetch_add(p, v, __ATOMIC_RELAXED, __HIP_MEMORY_SCOPE_AGENT); }
__device__ __forceinline__ unsigned xb_xcc_id() { return (unsigned)__builtin_amdgcn_s_getreg((3 << 11) | 20) & 0xFu; }
#define XB_SPIN(cond, bar) do { unsigned _sp = 0; while (cond) { __builtin_amdgcn_s_sleep(1); \
    if ((++_sp & 255u) == 0u) { if (xb_ld(&(bar)[XB_TMO])) break; if (_sp > XB_SPIN_CAP) { atomicAdd(&(bar)[XB_TMO], 1u); break; } } } } while (0)
struct XcdBarrier { unsigned* bar; unsigned x; volatile LAS unsigned* st; };
__device__ __forceinline__ XcdBarrier xcd_barrier_post(unsigned* bar, volatile LAS unsigned* st) {
    XcdBarrier b; b.bar = bar; b.x = xb_xcc_id(); b.st = st;
    if (threadIdx.x == 0) (void)xb_add(&bar[XB_XCNT(b.x)], 1u);
    return b;
}
__device__ __forceinline__ void xcd_barrier_complete(unsigned* bar, unsigned x, unsigned& nloc, unsigned& nx) {
    const unsigned G = gridDim.x * gridDim.y * gridDim.z;
    unsigned sum, cnt, mine, sp = 0u;
    for (;;) {
        sum = 0u; cnt = 0u; mine = 0u;
#pragma unroll
        for (unsigned j = 0; j < 16; ++j) { const unsigned c = xb_ld(&bar[XB_XCNT(j)]); sum += c; cnt += (c > 0u) ? 1u : 0u; mine = (j == x) ? c : mine; }
        if (sum == G) break;
        __builtin_amdgcn_s_sleep(1);
        if ((++sp & 255u) == 0u) { if (xb_ld(&bar[XB_TMO])) break; if (sp > XB_SPIN_CAP) { atomicAdd(&bar[XB_TMO], 1u); break; } }
    }
    nloc = mine > 0u ? mine : 1u; nx = cnt > 0u ? cnt : 1u;
}
__device__ __forceinline__ void xcd_barrier(const XcdBarrier& b) {
    asm volatile("s_waitcnt vmcnt(0)" ::: "memory");
    __syncthreads();
    if (threadIdx.x == 0) {
        unsigned* bar = b.bar;
        __builtin_amdgcn_s_waitcnt(0);
        unsigned nloc = b.st[0], nx = b.st[1];
        if (nloc == 0u) { xcd_barrier_complete(bar, b.x, nloc, nx); b.st[0] = nloc; b.st[1] = nx; }
        const unsigned old = xb_add(&bar[XB_XSUB(b.x)], 1u);
        const unsigned gen = old / nloc;
        if (old + 1u == (gen + 1u) * nloc) {
            __builtin_amdgcn_fence(__ATOMIC_RELEASE, "agent");
            asm volatile("s_waitcnt vmcnt(0)" ::: "memory");
            const unsigned og = xb_add(&bar[XB_TOP], 1u);
            const unsigned tg = og / nx;
            if (og + 1u == (tg + 1u) * nx) xb_add(&bar[XB_TOPGEN], 1u);
            else XB_SPIN(xb_ld(&bar[XB_TOPGEN]) == tg, bar);
            __builtin_amdgcn_fence(__ATOMIC_ACQUIRE, "agent");
            xb_add(&bar[XB_XGEN(b.x)], 1u);
            asm volatile("s_waitcnt vmcnt(0)" ::: "memory");
        } else {
            XB_SPIN(xb_ld(&bar[XB_XGEN(b.x)]) == gen, bar);
            __builtin_amdgcn_fence(__ATOMIC_ACQUIRE, "agent");
            asm volatile("s_waitcnt vmcnt(0)" ::: "memory");
        }
    }
    __syncthreads();
}
typedef __attribute__((address_space(4))) const Params* KP4;
__device__ __forceinline__ const Params& phase_params() { KP4 kp = (KP4)__builtin_amdgcn_kernarg_segment_ptr(); asm volatile("" : "+s"(kp)); return *(const Params*)kp; }
__global__ void __launch_bounds__(NTHREADS) fwd_megakernel(Params Pk) {
    extern __shared__ __attribute__((aligned(16))) unsigned char lds_raw[];
    lds_t* lds = (lds_t*)lds_raw;
    cg::grid_group grid = cg::this_grid();
    const int ph_lo = Pk.ph_lo, ph_hi = Pk.ph_hi;
    unsigned* barw = (unsigned*)(Pk.ws + WS_CTL) + 4096;
    volatile LAS unsigned* bst = (volatile LAS unsigned*)(lds + LDS_BYTES - 64);
    if (threadIdx.x == 0) { bst[0] = 0u; bst[1] = 0u; }
    if (ph_hi < 0) grid_barrier_cg(grid);
    (void)xcd_barrier_post(barw, bst);
#define SEAM(k) do { XcdBarrier xb_; xb_.bar = (unsigned*)(P.ws + WS_CTL) + 4096; xb_.x = xb_xcc_id(); xb_.st = bst; xcd_barrier(xb_); } while (0)
#define PHASE(k, ...) if (ph_lo <= (k) && (k) < ph_hi) { const Params& P = phase_params(); unsigned char* ws = P.ws; (void)ws; __VA_ARGS__; if ((k) + 1 < ph_hi) SEAM(k); }
    PHASE(0, phase0(P, lds))
    PHASE(1, ph_inproj2(P, lds, (const bf16_t*)(ws + WS_WABIN), 1536, nullptr))
    PHASE(2, ph_conv0(P); ph_s5_state(P, lds))
    PHASE(3, ph_gates0(P, lds); ph_s5_carry(P))
    PHASE(4, ph_s5_out(P, lds))
    PHASE(5, ph_glu(P, lds); ph_lru_scan(P, lds))
    PHASE(6, ph_outproj2(P, lds, (const bf16_t*)(ws + WS_WABOUT)))
    PHASE(7, ph_ln_router(P, lds, 0, P.in[I_X]))
    PHASE(8, ph_route_scatter(P, lds, 0))
    PHASE(9, ph_moe_up2(P, lds, 0))
    PHASE(10, ph_moe_down2(P, lds, 0))
    PHASE(11, ph_combine_ln(P, 0, nullptr))
    PHASE(12, ph_inproj2(P, lds, (const bf16_t*)(ws + WS_WCDIN), 2560, (const int*)P.in[I_POS]); moe_pstart(P, lds, 0); convert_moe_weights(P, 1, tail_done_all(((LAS int*)(lds + PS_OFF))[32] >> 8, (int)gridDim.x), lds))
    PHASE(13, ph_conv1(P, lds))
    PHASE(14, ph_qkv(P, lds))
    PHASE(15, ph_m1(P, lds); ph_attn(P, lds))
    PHASE(16, ph_m2(P); ph_attn_combine(P))
    PHASE(17, ph_m3(P, lds))
    PHASE(18, ph_outproj2(P, lds, (const bf16_t*)(ws + WS_WCDOUT)))
    PHASE(19, ph_ln_router(P, lds, 1, nullptr))
    PHASE(20, ph_route_scatter(P, lds, 1))
    PHASE(21, ph_moe_up2(P, lds, 1))
    PHASE(22, ph_moe_down2(P, lds, 1))
    PHASE(23, ph_combine_ln(P, 1, P.out))
#undef PHASE
}

extern "C" void kernel_launch(void* const* d_in, const int* in_sizes, int n_in, void* d_out, int out_size, void* d_ws, size_t ws_size, hipStream_t stream) {
    static int grid_blocks = 0;
    if (grid_blocks == 0) {
        if (n_in != N_IN || out_size != T * D || ws_size < WS_END) { fprintf(stderr, "kernel_launch: unexpected shapes (n_in %d out %d ws %zu need %zu)\n", n_in, out_size, ws_size, (size_t)WS_END); grid_blocks = -1; return; }
        int dev = 0, cus = 0, per_cu = 0;
        (void)hipGetDevice(&dev);
        (void)hipDeviceGetAttribute(&cus, hipDeviceAttributeMultiprocessorCount, dev);
        if (hipFuncSetAttribute((const void*)fwd_megakernel, hipFuncAttributeMaxDynamicSharedMemorySize, LDS_BYTES) != hipSuccess) { fprintf(stderr, "kernel_launch: hipFuncSetAttribute failed\n"); grid_blocks = -1; return; }
        (void)hipOccupancyMaxActiveBlocksPerMultiprocessor(&per_cu, (const void*)fwd_megakernel, NTHREADS, LDS_BYTES);
        if (per_cu < 1) { fprintf(stderr, "kernel_launch: occupancy query returned %d\n", per_cu); grid_blocks = -1; return; }
        grid_blocks = cus * per_cu;
        if (grid_blocks != 256) { fprintf(stderr, "kernel_launch: built for a 256-workgroup resident grid (256 CUs x 1), got %d x %d; nothing launched\n", cus, per_cu); grid_blocks = -1; return; }
    }
    if (grid_blocks < 0) return;
    (void)hipMemsetAsync((unsigned char*)d_ws + WS_CTL, 0, 65536, stream);
    Params p{};
    for (int i = 0; i < N_IN; ++i) p.in[i] = (const float*)d_in[i];
    p.out = (float*)d_out; p.ws = (unsigned char*)d_ws;
    p.ph_lo = 0; p.ph_hi = 24;
    void* args[] = {&p};
    hipError_t e = hipLaunchCooperativeKernel((const void*)fwd_megakernel, dim3(grid_blocks), dim3(NTHREADS), args, LDS_BYTES, stream);
    if (e != hipSuccess) fprintf(stderr, "cooperative launch failed: %s (grid %d)\n", hipGetErrorString(e), grid_blocks);
}
```

```cpp
#include <hip/hip_runtime.h>
#include <hip/hip_cooperative_groups.h>
#include <cstdio>
#include <cstdint>
namespace cg = cooperative_groups;

#define LAS __attribute__((address_space(3)))
typedef unsigned short bf16_t;
typedef short bf16x8 __attribute__((ext_vector_type(8)));
typedef short bf16x4 __attribute__((ext_vector_type(4)));
typedef float f32x4 __attribute__((ext_vector_type(4)));
typedef unsigned u32x4 __attribute__((ext_vector_type(4)));
typedef unsigned u32x2 __attribute__((ext_vector_type(2)));
typedef LAS unsigned char lds_t;

constexpr int T = 32768, D = 1024, SEQ = 4096;
constexpr int NTHREADS = 512;
constexpr int LDS_BYTES = 160 * 1024;
constexpr int PS_OFF = LDS_BYTES - 1024;
constexpr int UEXP_OFF = PS_OFF - 128;
constexpr int MTAB_OFF = 128 * 1024;
constexpr float ALPHA = 1.4142135623730951f;
constexpr float LN_EPS = 1e-5f;
constexpr int MOE_ROWS = 139264;
constexpr int S5TC = 32;
constexpr int S5K = S5TC * 16 + 128;

enum { I_X = 0, I_POS, I_AB_WIN, I_AB_CONVW, I_AB_CONVB, I_AB_GRW, I_AB_GRB, I_AB_GIW, I_AB_GIB, I_AB_LAMBDA,
       I_S5_LRE, I_S5_LIM, I_S5_STEP, I_S5_BRE, I_S5_BIM, I_S5_CRE, I_S5_CIM, I_S5_D, I_AB_GLUW, I_AB_GLUB, I_AB_WOUT,
       I_CD_WIN, I_CD_CONVW, I_CD_CONVB, I_CD_WQ, I_CD_WK, I_CD_WV, I_CD_WIF, I_CD_BIF, I_CD_WOUT,
       I_LNM_G, I_LNM_B, I_LNF_G, I_LNF_B, I_R_W, I_R_B, I_M_WIN, I_M_BIN, I_M_WOUT, I_M_BOUT, N_IN };

constexpr size_t MiB = 1ull << 20;
constexpr size_t WS_CTL = 0;
constexpr size_t WS_XB = 1 * MiB;
constexpr size_t WS_WABIN = 65 * MiB;
constexpr size_t WS_WGLU = 68 * MiB;
constexpr size_t WS_WABOUT = 69 * MiB;
constexpr size_t WS_WCDIN = 71 * MiB;
constexpr size_t WS_WCDOUT = 76 * MiB;
constexpr size_t WS_WG = 78 * MiB;
constexpr size_t WS_WQKV = 78 * MiB + 256 * 1024;
constexpr size_t WS_WC = 79 * MiB;
constexpr size_t WS_S5TM = 80 * MiB;
constexpr size_t WS_S5WST = 100 * MiB;
constexpr size_t WS_MWIN = 104 * MiB;
constexpr size_t WS_MWOUT = 232 * MiB;
constexpr size_t WS_PROJ = 296 * MiB;
constexpr size_t WS_CAT = 456 * MiB;
constexpr size_t WS_X1F = 520 * MiB;
constexpr size_t WS_ZF = 648 * MiB;
constexpr size_t WS_HACT = 776 * MiB;
constexpr size_t WS_YB = 1048 * MiB;
constexpr size_t WS_ROUTE = 1320 * MiB;
constexpr size_t WS_ELIST = 648 * MiB + 64 * MiB;
constexpr size_t WS_SCR = 1328 * MiB;
constexpr size_t WS_XC = WS_SCR;
constexpr size_t WS_AF = WS_SCR + 32 * MiB;
constexpr size_t WS_UF = WS_SCR + 96 * MiB;
constexpr size_t WS_SB = WS_SCR + 160 * MiB;
constexpr size_t WS_S5S = WS_SCR + 192 * MiB;
constexpr size_t WS_S5X = WS_SCR + 208 * MiB;
constexpr size_t WS_XCONV = WS_SCR;
constexpr size_t WS_QB = WS_SCR + 32 * MiB;
constexpr size_t WS_KB = WS_SCR + 64 * MiB;
constexpr size_t WS_VB = WS_SCR + 96 * MiB;
constexpr size_t WS_GATES = WS_SCR + 128 * MiB;
constexpr size_t WS_KVC = WS_SCR + 130 * MiB;
constexpr size_t WS_CPREV = WS_SCR + 258 * MiB;
constexpr size_t WS_MISC = WS_SCR + 322 * MiB;
constexpr size_t WS_ATTO = WS_SCR + 326 * MiB;
constexpr size_t WS_LSE = WS_SCR + 518 * MiB;
constexpr size_t WS_MW1 = WS_SCR + 520 * MiB;
constexpr size_t WS_END = WS_MW1 + 192 * MiB;

struct Params { const float* in[N_IN]; float* out; unsigned char* ws; int ph_lo, ph_hi; };

__device__ __forceinline__ float bf2f(unsigned short b) { return __uint_as_float(((unsigned)b) << 16); }
typedef __bf16 bf16v2_t __attribute__((ext_vector_type(2)));
typedef float f32x2 __attribute__((ext_vector_type(2)));
__device__ __forceinline__ unsigned pk_bf16(float lo, float hi) { const f32x2 v = {lo, hi}; return __builtin_bit_cast(unsigned, __builtin_convertvector(v, bf16v2_t)); }
__device__ __forceinline__ float wave_sum(float v) {
#pragma unroll
    for (int o = 1; o < 64; o <<= 1) v += __shfl_xor(v, o);
    return v;
}
__device__ __forceinline__ float wave_max(float v) {
#pragma unroll
    for (int o = 1; o < 64; o <<= 1) v = fmaxf(v, __shfl_xor(v, o));
    return v;
}
__device__ __forceinline__ float fsigmoid(float x) { return __builtin_amdgcn_rcpf(1.0f + __builtin_amdgcn_exp2f(-1.4426950408889634f * x)); }
__device__ __forceinline__ float fexp(float x) { return __builtin_amdgcn_exp2f(1.4426950408889634f * x); }
__device__ __forceinline__ float flog(float x) { return 0.6931471805599453f * __builtin_amdgcn_logf(x); }
__device__ __forceinline__ void fsincos(float x, float& sn, float& cs) {
    const float n = rintf(x * 0.15915494309189535f);
    float r = fmaf(-n, 6.28125f, x); r = fmaf(-n, 0.0019353071795864769f, r);
    const float rev = r * 0.15915494309189535f;
    sn = __builtin_amdgcn_sinf(rev); cs = __builtin_amdgcn_cosf(rev);
}
__device__ __forceinline__ float gelu_tanh(float x) { return x * fsigmoid(1.5957691216057308f * (x + 0.044715f * x * x * x)); }
__device__ __forceinline__ float logsigmoidf(float x) { return fminf(x, 0.f) - log1pf(expf(-fabsf(x))); }
__device__ __forceinline__ void unpack8(u32x4 v, float (&f)[8]) {
    f[0] = __uint_as_float(v.x << 16); f[1] = __uint_as_float(v.x & 0xffff0000u);
    f[2] = __uint_as_float(v.y << 16); f[3] = __uint_as_float(v.y & 0xffff0000u);
    f[4] = __uint_as_float(v.z << 16); f[5] = __uint_as_float(v.z & 0xffff0000u);
    f[6] = __uint_as_float(v.w << 16); f[7] = __uint_as_float(v.w & 0xffff0000u);
}
__device__ __forceinline__ u32x4 pack8(const float (&f)[8]) { u32x4 o; o.x = pk_bf16(f[0], f[1]); o.y = pk_bf16(f[2], f[3]); o.z = pk_bf16(f[4], f[5]); o.w = pk_bf16(f[6], f[7]); return o; }
__device__ __forceinline__ bf16x4 tr_read(lds_t* p) { return __builtin_amdgcn_ds_read_tr16_b64_v4i16((LAS bf16x4*)p); }
__device__ __forceinline__ bf16x8 cat44(bf16x4 a, bf16x4 b) { bf16x8 r = {a[0], a[1], a[2], a[3], b[0], b[1], b[2], b[3]}; return r; }
#define MFMA16(a, b, c) __builtin_amdgcn_mfma_f32_16x16x32_bf16((a), (b), (c), 0, 0, 0)
typedef int i32x8 __attribute__((ext_vector_type(8)));
__device__ __forceinline__ f32x4 mfma_fp8(i32x8 a, i32x8 b, f32x4 c) { return __builtin_amdgcn_mfma_scale_f32_16x16x128_f8f6f4(a, b, c, 0, 0, 0, 0x7f7f7f7f, 0, 0x7f7f7f7f); }
typedef int i32x4 __attribute__((ext_vector_type(4)));
__device__ __forceinline__ i32x8 ld_frag8(lds_t* p) { const i32x4 lo = *(const LAS i32x4*)p, hi = *(const LAS i32x4*)(p + 1024); return __builtin_shufflevector(lo, hi, 0, 1, 2, 3, 4, 5, 6, 7); }
__device__ __forceinline__ unsigned pk_fp8x4(f32x4 v) {
    unsigned w = 0;
    w = __builtin_amdgcn_cvt_pk_fp8_f32(fminf(fmaxf(v[0], -448.f), 448.f), fminf(fmaxf(v[1], -448.f), 448.f), w, false);
    w = __builtin_amdgcn_cvt_pk_fp8_f32(fminf(fmaxf(v[2], -448.f), 448.f), fminf(fmaxf(v[3], -448.f), 448.f), w, true);
    return w;
}
constexpr float FP8_SX = 4.0f, FP8_SWIN = 32.0f, FP8_SH = 8.0f, FP8_SWOUT = 64.0f, FP8_SY = 16.0f;

constexpr int E1_PITCH = 144;
constexpr int E1_A = 256 * E1_PITCH;
constexpr int E1_B = 128 * E1_PITCH;
constexpr int E1_BUF = E1_A + E1_B;

template <bool TRANS, class NK, class AL, class BL, class EP>
__device__ __forceinline__ void e1_stream(lds_t* lds, int ntiles, NK nkf, AL aload, BL bload, EP epi) {
    if (ntiles <= 0) return;
    const int tid = threadIdx.x, lane = tid & 63, wave = tid >> 6, wr = wave >> 1, wc = wave & 1, fr = lane & 15, fq = lane >> 4;
    const int prow = tid >> 3, pc = tid & 7;
    f32x4 acc[4][4];
#pragma unroll
    for (int m = 0; m < 4; ++m)
#pragma unroll
        for (int n = 0; n < 4; ++n) acc[m][n] = (f32x4){0.f, 0.f, 0.f, 0.f};
    u32x4 ra0[4], rb0[2], ra1[4], rb1[2];
#define E1S_LOAD(RA, RB, J, TT) do { _Pragma("unroll") for (int i = 0; i < 4; ++i) RA[i] = aload((J), i, prow + 64 * i, (TT) * 8 + pc); \
        _Pragma("unroll") for (int i = 0; i < 2; ++i) RB[i] = bload((J), i, prow + 64 * i, (TT) * 8 + pc); } while (0)
#define E1S_WRITE(RA, RB, BUF) do { lds_t* nb_ = lds + (BUF) * E1_BUF; \
        _Pragma("unroll") for (int i = 0; i < 4; ++i) *(LAS u32x4*)(nb_ + (prow + 64 * i) * E1_PITCH + pc * 16) = RA[i]; \
        _Pragma("unroll") for (int i = 0; i < 2; ++i) *(LAS u32x4*)(nb_ + E1_A + (prow + 64 * i) * E1_PITCH + pc * 16) = RB[i]; } while (0)
#define E1S_ADV(J, TT, V) do { if ((TT) + 1 < nkf(J)) { ++(TT); } else { ++(J); (TT) = 0; } (V) = (J) < ntiles; } while (0)
#define E1S_COMPUTE(BUF) do { lds_t* Ab = lds + (BUF) * E1_BUF + (wr * 64 + fr) * E1_PITCH + fq * 16; lds_t* Bb = lds + (BUF) * E1_BUF + E1_A + (wc * 64 + fr) * E1_PITCH + fq * 16; \
        _Pragma("unroll") for (int kk = 0; kk < 2; ++kk) { bf16x8 af[4], bfr[4]; \
            _Pragma("unroll") for (int m = 0; m < 4; ++m) af[m] = *(LAS bf16x8*)(Ab + m * 16 * E1_PITCH + kk * 64); \
            _Pragma("unroll") for (int n = 0; n < 4; ++n) bfr[n] = *(LAS bf16x8*)(Bb + n * 16 * E1_PITCH + kk * 64); \
            _Pragma("unroll") for (int m = 0; m < 4; ++m) _Pragma("unroll") for (int n = 0; n < 4; ++n) acc[m][n] = TRANS ? MFMA16(bfr[n], af[m], acc[m][n]) : MFMA16(af[m], bfr[n], acc[m][n]); } \
        if (t0 + 1 == nkf(j0)) { epi(j0, acc, wr, wc, fr, fq); \
            _Pragma("unroll") for (int m = 0; m < 4; ++m) _Pragma("unroll") for (int n = 0; n < 4; ++n) acc[m][n] = (f32x4){0.f, 0.f, 0.f, 0.f}; } } while (0)
    int j0 = 0, t0 = 0, j1 = 0, t1 = 0, j2, t2; bool v1, v2;
    E1S_ADV(j1, t1, v1); j2 = j1; t2 = t1; v2 = v1; if (v1) E1S_ADV(j2, t2, v2);
    E1S_LOAD(ra0, rb0, 0, 0);
    if (v1) E1S_LOAD(ra1, rb1, j1, t1);
    E1S_WRITE(ra0, rb0, 0);
    __syncthreads();
    int cb = 0;
    for (;;) {
        if (v2) E1S_LOAD(ra0, rb0, j2, t2);
        E1S_COMPUTE(cb);
        if (v1) E1S_WRITE(ra1, rb1, cb ^ 1);
        __syncthreads();
        if (!v1) break;
        j0 = j1; t0 = t1; j1 = j2; t1 = t2; v1 = v2; if (v2) E1S_ADV(j2, t2, v2); cb ^= 1;
        if (v2) E1S_LOAD(ra1, rb1, j2, t2);
        E1S_COMPUTE(cb);
        if (v1) E1S_WRITE(ra0, rb0, cb ^ 1);
        __syncthreads();
        if (!v1) break;
        j0 = j1; t0 = t1; j1 = j2; t1 = t2; v1 = v2; if (v2) E1S_ADV(j2, t2, v2); cb ^= 1;
    }
#undef E1S_LOAD
#undef E1S_WRITE
#undef E1S_ADV
#undef E1S_COMPUTE
}
__device__ __forceinline__ int wg_tiles(int total) { const int b = (int)blockIdx.x, G = (int)gridDim.x; return b < total ? (total - b + G - 1) / G : 0; }
__device__ __forceinline__ int xcd_group_id(int lg) { const int b = (int)blockIdx.x; if ((int)gridDim.x != 256) return b; const int x = b & 7, y = b >> 3; return (((y >> lg) * 8 + x) << lg) + (y & ((1 << lg) - 1)); }

namespace g2 {
constexpr int HTB = 16384;
__device__ __forceinline__ int lds_byte(int r, int c) { const int st = (r >> 4) * 2 + (c >> 5), rr = r & 15, cc = c & 31, ob = rr * 64 + cc * 2; return st * 1024 + (ob ^ (((ob >> 9) & 1) << 5)); }
__device__ __forceinline__ void stage_rc(int b, int& R, int& C) { const int st = b / 1024, sb = b % 1024, swz = sb ^ (((sb >> 9) & 1) << 5); R = (st >> 1) * 16 + swz / 64; C = (st & 1) * 32 + (swz % 64) / 2; }
struct Unit { int pm, pn, idx; };
__device__ __forceinline__ bool static_next(int i, int G, int c, int nM, int nN, Unit& u) {
    const int nwg = nM * nN; const long L = (long)i * G + c; if (L >= nwg) return false;
    int wgid = (int)L; { const int q = nwg / 8, r = nwg % 8, xcd = wgid % 8, off = wgid / 8; wgid = (xcd < r ? xcd * (q + 1) : r * (q + 1) + (xcd - r) * q) + off; }
    const int nig = 8 * nN, gid = wgid / nig, fm = gid * 8, gsz = (nM - fm) < 8 ? (nM - fm) : 8;
    u.pm = fm + ((wgid % nig) % gsz); u.pn = (wgid % nig) / gsz; u.idx = i; return true;
}
template <bool FP8, class Sched, class Epi>
__device__ __forceinline__ void gemm_phase(lds_t* lds, const char* Abase, int nt  , unsigned ldb_bytes, const Sched& S, const Epi& E) {
    const int tid = threadIdx.x, wid = __builtin_amdgcn_readfirstlane(tid >> 6), lane = tid & 63, wr = wid >> 2, wc = wid & 3, fr = lane & 15, fq = lane >> 4;
    unsigned voffB0; { int R0, C0; stage_rc(tid * 16, R0, C0); voffB0 = (unsigned)R0 * ldb_bytes + (unsigned)C0 * 2u; }
    const size_t hstepB = (size_t)128 * ldb_bytes;
    const unsigned ldsw = (unsigned)wid * 1024u;
    const int aoff = lds_byte(wr * 64 + fr, fq * 8), boff = lds_byte(wc * 32 + fr, fq * 8);
#define G2_SA(b, h) (((b) * 2 + (h)) * g2::HTB)
#define G2_SB(b, h) ((4 + (b) * 2 + (h)) * g2::HTB)
#define G2_STAGE_A(bufoff, offs, kb) do { _Pragma("unroll") for (int _i = 0; _i < 2; ++_i) \
        __builtin_amdgcn_global_load_lds((const unsigned*)((Abase + (kb)) + (offs)[_i]), (LAS unsigned*)(lds + (bufoff) + ldsw + _i * 8192), 16, 0, 0); } while (0)
#define G2_STAGE_B(bufoff, gbase) do { _Pragma("unroll") for (int _i = 0; _i < 2; ++_i) \
        __builtin_amdgcn_global_load_lds((const unsigned*)(((const char*)(gbase) + (size_t)_i * 64 * ldb_bytes) + voffB0), (LAS unsigned*)(lds + (bufoff) + ldsw + _i * 8192), 16, 0, 0); } while (0)
#define G2_LDA(dst, b, h) do { _Pragma("unroll") for (int m = 0; m < 4; ++m) { if constexpr (FP8) { if (m < 2) dst##8[m] = ld_frag8(lds + G2_SA(b, h) + aoff + m * 2048); } \
        else { _Pragma("unroll") for (int k = 0; k < 2; ++k) dst[m][k] = *(const LAS bf16x8*)(lds + G2_SA(b, h) + aoff + m * 2048 + k * 1024); } } } while (0)
#define G2_LDB(dst, b, h) do { _Pragma("unroll") for (int n = 0; n < 2; ++n) { if constexpr (FP8) dst##8[n] = ld_frag8(lds + G2_SB(b, h) + boff + n * 2048); \
        else { _Pragma("unroll") for (int k = 0; k < 2; ++k) dst[n][k] = *(const LAS bf16x8*)(lds + G2_SB(b, h) + boff + n * 2048 + k * 1024); } } } while (0)
#define G2_MMA(ai, bj, At, Bt) do { __builtin_amdgcn_s_setprio(1); _Pragma("unroll") for (int m = 0; m < 4; ++m) _Pragma("unroll") for (int n = 0; n < 2; ++n) { \
        if constexpr (FP8) acc[ai][bj][m][n] = mfma_fp8(Bt##8[n], At##8[m], acc[ai][bj][m][n]); \
        else { _Pragma("unroll") for (int k = 0; k < 2; ++k) acc[ai][bj][m][n] = __builtin_amdgcn_mfma_f32_16x16x32_bf16(Bt[n][k], At[m][k], acc[ai][bj][m][n], 0, 0, 0); } } \
        __builtin_amdgcn_s_setprio(0); } while (0)
#define G2_MMAP(ai, b, h) do { if constexpr (!FP8) { G2_MMA(ai, 0, At, B0); G2_MMA(ai, 1, At, B1); } else { __builtin_amdgcn_s_setprio(1); \
        _Pragma("unroll") for (int m = 0; m < 2; ++m) _Pragma("unroll") for (int n = 0; n < 2; ++n) { acc[ai][0][m][n] = mfma_fp8(B08[n], At8[m], acc[ai][0][m][n]); acc[ai][1][m][n] = mfma_fp8(B18[n], At8[m], acc[ai][1][m][n]); } \
        At8[0] = ld_frag8(lds + G2_SA(b, h) + aoff + 2 * 2048); At8[1] = ld_frag8(lds + G2_SA(b, h) + aoff + 3 * 2048); \
        _Pragma("unroll") for (int m = 0; m < 2; ++m) _Pragma("unroll") for (int n = 0; n < 2; ++n) { acc[ai][0][m + 2][n] = mfma_fp8(B08[n], At8[m], acc[ai][0][m + 2][n]); acc[ai][1][m + 2][n] = mfma_fp8(B18[n], At8[m], acc[ai][1][m + 2][n]); } \
        __builtin_amdgcn_s_setprio(0); } } while (0)
#define G2_WAIT_V(n) asm volatile("s_waitcnt vmcnt(" #n ")" ::: "memory")
#define G2_WAIT_L(n) asm volatile("s_waitcnt lgkmcnt(" #n ")" ::: "memory")
#define G2_BAR __builtin_amdgcn_s_barrier()
#define G2_SCHED __builtin_amdgcn_sched_barrier(0)
#define G2_SCHED8 do { if constexpr (FP8) __builtin_amdgcn_sched_barrier(0); } while (0)
    Unit cur, nxt; int ui = 0;
    if (!S.next(0, cur)) return;
    f32x4 acc[2][2][4][2];
#pragma unroll
    for (int a = 0; a < 2; ++a)
#pragma unroll
        for (int b = 0; b < 2; ++b)
#pragma unroll
            for (int m = 0; m < 4; ++m)
#pragma unroll
                for (int n = 0; n < 2; ++n) acc[a][b][m][n] = (f32x4){0.f, 0.f, 0.f, 0.f};
    bf16x8 At[4][2], B0[2][2], B1[2][2]; i32x8 At8[2], B08[2], B18[2];
    unsigned aoC[2][2], aoN[2][2];
    S.a_off(cur, aoC);
    const char* cB = S.b_base(cur);
    G2_STAGE_B(G2_SB(0, 0), cB); G2_STAGE_B(G2_SB(0, 1), cB + hstepB); G2_STAGE_A(G2_SA(0, 0), aoC[0], 0); G2_STAGE_A(G2_SA(0, 1), aoC[1], 0);
    if (wr == 1) G2_BAR;
    G2_WAIT_V(2); G2_BAR;
    G2_STAGE_B(G2_SB(1, 0), cB + 128); G2_STAGE_A(G2_SA(1, 0), aoC[0], 128); G2_STAGE_B(G2_SB(1, 1), cB + hstepB + 128);
    G2_WAIT_V(6); G2_BAR;
    for (;;) {
        const bool has_next = S.next(ui + 1, nxt);
        const char* nB = cB;
        if constexpr (!Sched::CHEAP_AOFF) {
#pragma unroll
            for (int h = 0; h < 2; ++h)
#pragma unroll
                for (int i = 0; i < 2; ++i) aoN[h][i] = aoC[h][i];
            if (has_next) S.a_off(nxt, aoN);
        }
        if (has_next) nB = S.b_base(nxt);
#pragma unroll 1
        for (int t = 0; t < nt; t += 2) {
            const bool last = (t == nt - 2);
            const unsigned k1 = (unsigned)(t + 1) * 128u, k2 = last ? 0u : (unsigned)(t + 2) * 128u, k3 = k2 + 128u;
            unsigned a2o[2][2];
#pragma unroll
            for (int h = 0; h < 2; ++h)
#pragma unroll
                for (int i = 0; i < 2; ++i) a2o[h][i] = (!Sched::CHEAP_AOFF && last) ? aoN[h][i] : aoC[h][i];
            if constexpr (Sched::CHEAP_AOFF) { if (last && has_next) S.a_off(nxt, a2o); }
            const char* b2 = last ? nB : cB + (size_t)(t + 2) * 128; const char* b3 = b2 + 128;
            G2_LDB(B0, 0, 0); G2_LDB(B1, 0, 1); G2_SCHED; G2_LDA(At, 0, 0); G2_STAGE_A(G2_SA(1, 1), aoC[1], k1);
            G2_WAIT_V(8); G2_WAIT_L(0); G2_BAR; G2_MMAP(0, 0, 0); G2_BAR; G2_SCHED;
            G2_LDA(At, 0, 1); G2_STAGE_B(G2_SB(0, 0), b2); G2_STAGE_B(G2_SB(0, 1), b2 + hstepB); G2_STAGE_A(G2_SA(0, 0), a2o[0], k2);
            G2_WAIT_V(8); G2_WAIT_L(0); G2_BAR; G2_MMAP(1, 0, 1); G2_BAR; G2_SCHED;
            G2_LDB(B0, 1, 0); G2_LDB(B1, 1, 1); G2_SCHED; G2_LDA(At, 1, 0); G2_STAGE_A(G2_SA(0, 1), a2o[1], k2);
            G2_WAIT_V(8); G2_WAIT_L(0); G2_BAR; G2_MMAP(0, 1, 0); G2_BAR; G2_SCHED;
            G2_LDA(At, 1, 1); G2_STAGE_B(G2_SB(1, 0), b3); G2_STAGE_B(G2_SB(1, 1), b3 + hstepB); G2_STAGE_A(G2_SA(1, 0), a2o[0], k3);
            G2_WAIT_V(8); G2_WAIT_L(0); G2_BAR; G2_MMAP(1, 1, 1); G2_BAR; G2_SCHED;
        }
        if (wr == 0) G2_BAR;
        { int lane_e = (int)(threadIdx.x & 63); asm volatile("" : "+v"(lane_e));
          E(acc, cur, wr, wc, lane_e & 15, lane_e >> 4); }
        if (!has_next) break;
#pragma unroll
        for (int a = 0; a < 2; ++a)
#pragma unroll
            for (int b = 0; b < 2; ++b)
#pragma unroll
                for (int m = 0; m < 4; ++m)
#pragma unroll
                    for (int n = 0; n < 2; ++n) acc[a][b][m][n] = (f32x4){0.f, 0.f, 0.f, 0.f};
        cur = nxt; cB = nB; ++ui;
        if constexpr (Sched::CHEAP_AOFF) S.a_off(cur, aoC);
        else {
#pragma unroll
            for (int h = 0; h < 2; ++h)
#pragma unroll
                for (int i = 0; i < 2; ++i) aoC[h][i] = aoN[h][i];
        }
        if (wr == 1) G2_BAR;
    }
    G2_WAIT_V(0);
    G2_BAR;
#undef G2_SA
#undef G2_SB
#undef G2_STAGE_A
#undef G2_STAGE_B
#undef G2_LDA
#undef G2_LDB
#undef G2_MMA
#undef G2_MMAP
#undef G2_WAIT_V
#undef G2_WAIT_L
#undef G2_BAR
#undef G2_SCHED
#undef G2_SCHED8
}
struct DenseSched {
    static constexpr bool CHEAP_AOFF = false;
    int G, c, nM, nN, K; const char* Bt;
    __device__ __forceinline__ bool next(int i, Unit& u) const { return static_next(i, G, c, nM, nN, u); }
    __device__ __forceinline__ void a_off(const Unit& u, unsigned (&ao)[2][2]) const {
        int Rs[2], Cs[2];
#pragma unroll
        for (int i = 0; i < 2; ++i) stage_rc((int)threadIdx.x * 16 + i * 8192, Rs[i], Cs[i]);
#pragma unroll
        for (int h = 0; h < 2; ++h)
#pragma unroll
            for (int i = 0; i < 2; ++i) ao[h][i] = ((unsigned)(u.pm * 256 + h * 128 + Rs[i]) * (unsigned)K + (unsigned)Cs[i]) * 2u;
    }
    __device__ __forceinline__ const char* b_base(const Unit& u) const { return Bt + (size_t)u.pn * 256 * K * 2; }
};
}

__device__ __forceinline__ unsigned opaque_tid() { unsigned t = threadIdx.x; asm volatile("" : "+v"(t)); return t; }
template <class RM>
__device__ __forceinline__ void transpose_item(const float* __restrict__ W, int N, bf16_t* __restrict__ WT, int ldwt, int k0, int n0, RM rowmap, LAS float* scr, int lane) {
#pragma unroll 16
    for (int i = 0; i < 64; ++i) scr[i * 65 + lane] = __builtin_nontemporal_load(&W[(size_t)(k0 + i) * N + n0 + lane]);
    __builtin_amdgcn_wave_barrier();
    const int c = lane & 7;
#pragma unroll
    for (int j = 0; j < 8; ++j) {
        const int n = (lane >> 3) + 8 * j;
        const LAS float* s = scr + (8 * c) * 65 + n;
        u32x4 o; o.x = pk_bf16(s[0], s[65]); o.y = pk_bf16(s[2 * 65], s[3 * 65]); o.z = pk_bf16(s[4 * 65], s[5 * 65]); o.w = pk_bf16(s[6 * 65], s[7 * 65]);
        *(u32x4*)(WT + (size_t)rowmap(n0 + n) * ldwt + k0 + 8 * c) = o;
    }
    __builtin_amdgcn_wave_barrier();
}
struct RmId { __device__ __forceinline__ int operator()(int n) const { return n; } };
struct RmMoeIn { __device__ __forceinline__ int operator()(int n) const { const int half = n >> 10, j = n & 1023; return (j >> 7) * 256 + half * 128 + (j & 127); } };
struct RmGate { int gate; __device__ __forceinline__ int operator()(int j) const { return (j >> 5) * 64 + gate * 32 + (j & 31); } };

template <class RM>
__device__ __forceinline__ void transpose_matrix(const float* W, int K, int N, bf16_t* WT, int ldwt, RM rm, LAS float* scr, int gw, int NGW, int lane, int first_wave) {
    const int nkb = K / 64, nnb = N / 64;
    int it = gw - first_wave; if (it < 0) it += NGW;
    for (; it < nkb * nnb; it += NGW) transpose_item(W, N, WT, ldwt, (it / nnb) * 64, (it % nnb) * 64, rm, scr, lane);
}

constexpr int CONV_ITEMS = 12288, TAIL_QUOTA = 24;
__device__ __forceinline__ void conv_decode(const Params& P, int layer, int r, const float*& src, int& N, unsigned char*& dst, float& scale) {
    unsigned char* base = P.ws + (layer ? WS_MW1 : WS_MWIN);
    if (r < 8192) {
        const int e = r >> 8, rr = r & 255, kb = rr >> 5, nb = rr & 31;
        N = 2048; scale = FP8_SWIN;
        src = P.in[I_M_WIN] + ((size_t)layer * 32 + e) * 1024 * 2048 + (size_t)(kb * 128) * 2048 + nb * 64;
        dst = base + (size_t)e * 2048 * 1024 + (size_t)RmMoeIn()(nb * 64) * 1024 + kb * 128;
    } else {
        const int r2 = r - 8192, e = r2 >> 7, rr = r2 & 127, kb = rr >> 4, nb = rr & 15;
        N = 1024; scale = FP8_SWOUT;
        src = P.in[I_M_WOUT] + ((size_t)layer * 32 + e) * 1024 * 1024 + (size_t)(kb * 128) * 1024 + nb * 64;
        dst = base + (size_t)32 * 2048 * 1024 + (size_t)e * 1024 * 1024 + (size_t)(nb * 64) * 1024 + kb * 128;
    }
}
__device__ __forceinline__ void convert_stream(const Params& P, int layer, int first, int step, int end, LAS float* scr, int lane) {
    if (first >= end) return;
    const float* src; int N; unsigned char* dst; float scale;
    conv_decode(P, layer, first, src, N, dst, scale);
    const int lr = lane >> 4, lc = (lane & 15) * 4, c = lane & 7;
    f32x4 v[16];
#define CONV_LOAD(SRC) do { _Pragma("unroll") for (int i = 0; i < 16; ++i) v[i] = __builtin_nontemporal_load((const f32x4*)((SRC) + (size_t)(4 * i + lr) * N + lc)); } while (0)
#define CONV_TO_LDS() do { _Pragma("unroll") for (int i = 0; i < 16; ++i) { LAS float* w = scr + (4 * i + lr) * 65 + lc; w[0] = v[i][0]; w[1] = v[i][1]; w[2] = v[i][2]; w[3] = v[i][3]; } } while (0)
#define CONV_PACK(O, SC) do { const int n_ = (lane >> 3) + 8 * j; const LAS float* sp = scr + (8 * c) * 65 + n_; \
        (O).x = pk_fp8x4((f32x4){sp[0], sp[65], sp[2 * 65], sp[3 * 65]} * (SC)); (O).y = pk_fp8x4((f32x4){sp[4 * 65], sp[5 * 65], sp[6 * 65], sp[7 * 65]} * (SC)); } while (0)
    CONV_LOAD(src);
#pragma unroll 1
    for (int r = first; r < end; r += step) {
        u32x2 o0[8];
        CONV_TO_LDS();
        CONV_LOAD(src + (size_t)64 * N);
        __builtin_amdgcn_wave_barrier();
#pragma unroll
        for (int j = 0; j < 8; ++j) CONV_PACK(o0[j], scale);
        __builtin_amdgcn_wave_barrier();
        CONV_TO_LDS();
        unsigned char* dcur = dst; const float scur = scale;
        if (r + step < end) { conv_decode(P, layer, r + step, src, N, dst, scale); CONV_LOAD(src); }
        __builtin_amdgcn_wave_barrier();
#pragma unroll
        for (int j = 0; j < 8; ++j) {
            u32x2 o1; CONV_PACK(o1, scur);
            unsigned char* q = dcur + (size_t)((lane >> 3) + 8 * j) * 1024 + 8 * c;
            __builtin_nontemporal_store(o0[j], (u32x2*)q); __builtin_nontemporal_store(o1, (u32x2*)(q + 64));
        }
        __builtin_amdgcn_wave_barrier();
    }
#undef CONV_LOAD
#undef CONV_TO_LDS
#undef CONV_PACK
}
__device__ __forceinline__ void convert_range_wg(const Params& P, int layer, int first, int count, lds_t* lds) {
    const int lane = threadIdx.x & 63, wave = threadIdx.x >> 6;
    LAS float* scr = (LAS float*)(lds + wave * 16640);
    const int end = (first + count < CONV_ITEMS) ? first + count : CONV_ITEMS;
    convert_stream(P, layer, first + wave, 8, end, scr, lane);
}
__device__ __forceinline__ void convert_moe_weights(const Params& P, int layer, int first, lds_t* lds, int skip_wgs = 0) {
    if ((int)blockIdx.x < skip_wgs) return;
    const int lane = threadIdx.x & 63, wave = threadIdx.x >> 6, gw = ((int)blockIdx.x - skip_wgs) * 8 + wave, NGW = ((int)gridDim.x - skip_wgs) * 8;
    LAS float* scr = (LAS float*)(lds + wave * 16640);
    convert_stream(P, layer, first + gw, NGW, CONV_ITEMS, scr, lane);
}
__device__ __forceinline__ int tail_idle(int nunits, int G) { const int r = nunits % G; return r ? G - r : 0; }
__device__ __forceinline__ int tail_done_up(int nM, int G) { const int d = tail_idle(nM * 8, G) * TAIL_QUOTA; return d < CONV_ITEMS ? d : CONV_ITEMS; }
__device__ __forceinline__ int tail_done_all(int nM, int G) { const int d = tail_done_up(nM, G) + tail_idle(nM * 4, G) * TAIL_QUOTA; return d < CONV_ITEMS ? d : CONV_ITEMS; }

__device__ __forceinline__ void s5_precompute(const Params& P, int g, lds_t* lds) {
    const int tid = threadIdx.x;
    LAS float* Bbr = (LAS float*)lds;
    LAS float* Bbi = Bbr + 1024;
    LAS float* Cr = Bbi + 1024;
    LAS float* Ci = Cr + 1024;
    LAS float* ApR = Ci + 1024;
    LAS float* ApI = ApR + 33 * 64;
    LAS float* KJ = ApI + 33 * 64;
    const float* lre = P.in[I_S5_LRE] + g * 64; const float* lim = P.in[I_S5_LIM] + g * 64;
    const float step = expf(P.in[I_S5_STEP][g]);
    for (int idx = tid; idx < 1024; idx += NTHREADS) {
        const int p = idx >> 4;
        const float lr = fminf(lre[p], -1e-4f), li = lim[p];
        const float mag = expf(lr * step); float sn, cs; sincosf(li * step, &sn, &cs);
        const float ar = mag * cs, ai = mag * sn, inv = 1.0f / (lr * lr + li * li);
        const float zr = ((ar - 1.0f) * lr + ai * li) * inv, zi = (ai * lr - (ar - 1.0f) * li) * inv;
        const float br = P.in[I_S5_BRE][g * 1024 + idx], bi = P.in[I_S5_BIM][g * 1024 + idx];
        Bbr[idx] = zr * br - zi * bi; Bbi[idx] = zr * bi + zi * br;
        Cr[idx] = P.in[I_S5_CRE][g * 1024 + idx]; Ci[idx] = P.in[I_S5_CIM][g * 1024 + idx];
    }
    for (int idx = tid; idx < 33 * 64; idx += NTHREADS) {
        const int j = idx >> 6, p = idx & 63;
        const float lr = fminf(lre[p], -1e-4f), li = lim[p];
        const float mag = fexp((float)j * lr * step); float sn, cs; fsincos((float)j * li * step, sn, cs);
        ApR[idx] = mag * cs; ApI[idx] = mag * sn;
    }
    __syncthreads();
    {
        const int h = (tid >> 4) & 15, h2 = tid & 15, jh = tid >> 8;
        float gr[64], gi[64];
#pragma unroll
        for (int p = 0; p < 64; ++p) { const float cr = Cr[h * 64 + p], ci = Ci[h * 64 + p], br = Bbr[p * 16 + h2], bi = Bbi[p * 16 + h2]; gr[p] = cr * br - ci * bi; gi[p] = cr * bi + ci * br; }
        for (int j = jh * 16; j < jh * 16 + 16; ++j) {
            float s0 = 0.f, s1 = 0.f;
#pragma unroll
            for (int p = 0; p < 64; p += 2) { s0 += gr[p] * ApR[j * 64 + p] - gi[p] * ApI[j * 64 + p]; s1 += gr[p + 1] * ApR[j * 64 + p + 1] - gi[p + 1] * ApI[j * 64 + p + 1]; }
            float sres = s0 + s1;
            if (j == 0 && h == h2) sres += P.in[I_S5_D][g * 16 + h];
            KJ[(j * 16 + h) * 16 + h2] = sres;
        }
    }
    __syncthreads();
    bf16_t* Tm = (bf16_t*)(P.ws + WS_S5TM) + (size_t)g * 512 * S5K;
    for (int pi = tid; pi < 512 * (S5K / 8); pi += NTHREADS) {
        const int row = pi / (S5K / 8), c8 = (pi % (S5K / 8)) * 8, t = row >> 4, h = row & 15;
        float v[8];
#pragma unroll
        for (int e = 0; e < 8; ++e) {
            const int col = c8 + e;
            if (col < 512) { const int s = col >> 4, h2 = col & 15; v[e] = (s <= t) ? KJ[((t - s) * 16 + h) * 16 + h2] : 0.f; }
            else { const int p = (col - 512) & 63, im = (col - 512) >> 6;
                const float cr = Cr[h * 64 + p], ci = Ci[h * 64 + p], ar = ApR[(t + 1) * 64 + p], ai = ApI[(t + 1) * 64 + p];
                v[e] = im ? -(cr * ai + ci * ar) : (cr * ar - ci * ai); }
        }
        *(u32x4*)(Tm + (size_t)row * S5K + c8) = pack8(v);
    }
    bf16_t* Wst = (bf16_t*)(P.ws + WS_S5WST) + (size_t)g * 128 * 512;
    for (int pi = tid; pi < 128 * 64; pi += NTHREADS) {
        const int row = pi >> 6, c8 = (pi & 63) * 8, p = row & 63, im = row >> 6;
        float v[8];
#pragma unroll
        for (int e = 0; e < 8; ++e) {
            const int col = c8 + e, s = col >> 4, h2 = col & 15;
            const float ar = ApR[(S5TC - 1 - s) * 64 + p], ai = ApI[(S5TC - 1 - s) * 64 + p], br = Bbr[p * 16 + h2], bi = Bbi[p * 16 + h2];
            v[e] = im ? (ar * bi + ai * br) : (ar * br - ai * bi);
        }
        *(u32x4*)(Wst + (size_t)row * 512 + c8) = pack8(v);
    }
    __syncthreads();
}

__device__ __forceinline__ void phase0(const Params& P, lds_t* lds) {
    const int tid = threadIdx.x, lane = tid & 63, wave = tid >> 6, gw = blockIdx.x * 8 + wave, NGW = gridDim.x * 8;
    const size_t gtid = (size_t)blockIdx.x * NTHREADS + tid, GT = (size_t)gridDim.x * NTHREADS;
    unsigned char* ws = P.ws;
    for (int g = blockIdx.x; g < 32; g += gridDim.x) s5_precompute(P, g, lds);
    {
        const f32x4* x4 = (const f32x4*)P.in[I_X]; u32x4* xb = (u32x4*)(ws + WS_XB);
        for (size_t i0 = gtid; i0 < (size_t)T * D / 8; i0 += 4 * GT) {
            f32x4 a[4], b[4];
#pragma unroll
            for (int j = 0; j < 4; ++j) { const size_t i = i0 + j * GT; a[j] = __builtin_nontemporal_load(&x4[2 * i]); b[j] = __builtin_nontemporal_load(&x4[2 * i + 1]); }
#pragma unroll
            for (int j = 0; j < 4; ++j) { u32x4 o; o.x = pk_bf16(a[j].x, a[j].y); o.y = pk_bf16(a[j].z, a[j].w); o.z = pk_bf16(b[j].x, b[j].y); o.w = pk_bf16(b[j].z, b[j].w); __builtin_nontemporal_store(o, &xb[i0 + j * GT]); }
        }
    }
    {
        float* Wc = (float*)(ws + WS_WC);
        for (int idx = gw; idx < 8192; idx += NGW) {
            const int which = idx >> 12, i = (idx >> 3) & 511, gg = idx & 7, h = i >> 7, ii = i & 127;
            const float* wif = P.in[I_CD_WIF];
            float sacc = 0.f;
#pragma unroll
            for (int jj = 0; jj < 2; ++jj) {
                const int j = lane + 64 * jj;
                if (which == 0) sacc += P.in[I_CD_WQ][(size_t)(h * 128 + ii) * 128 + j] * wif[(h * 128 + j) * 8 + gg] + 0.08838834764831845f * P.in[I_CD_WK][(size_t)(h * 128 + ii) * 128 + j] * wif[(512 + h * 128 + j) * 8 + gg];
                else sacc += P.in[I_CD_WV][(size_t)(h * 128 + ii) * 128 + j] * wif[(1024 + h * 128 + j) * 8 + gg];
            }
            sacc = wave_sum(sacc);
            if (lane == 0) Wc[idx] = sacc;
        }
    }
    LAS float* scr = (LAS float*)(lds + wave * 16640);
    transpose_matrix(P.in[I_AB_WIN], 1024, 1536, (bf16_t*)(ws + WS_WABIN), 1024, RmId(), scr, gw, NGW, lane, 256);
    transpose_matrix(P.in[I_AB_GLUW], 512, 512, (bf16_t*)(ws + WS_WGLU), 512, RmId(), scr, gw, NGW, lane, 256 + 384);
    transpose_matrix(P.in[I_AB_WOUT], 1024, 1024, (bf16_t*)(ws + WS_WABOUT), 1024, RmId(), scr, gw, NGW, lane, 256 + 448);
    transpose_matrix(P.in[I_CD_WIN], 1024, 2560, (bf16_t*)(ws + WS_WCDIN), 1024, RmId(), scr, gw, NGW, lane, 256 + 704);
    transpose_matrix(P.in[I_CD_WOUT], 1024, 1024, (bf16_t*)(ws + WS_WCDOUT), 1024, RmId(), scr, gw, NGW, lane, 256 + 1344);
    { int it = gw - (256 + 1600); if (it < 0) it += NGW;
      for (; it < 16; it += NGW) {
        const int gate = it >> 3, h = it & 7;
        transpose_item(P.in[gate ? I_AB_GIW : I_AB_GRW] + h * 4096, 64, (bf16_t*)(ws + WS_WG) + h * 8192, 64, 0, 0, RmGate{gate}, scr, lane);
      } }
    { int it = gw - (256 + 1616); if (it < 0) it += NGW;
      for (; it < 48; it += NGW) {
        const int which = it >> 4, h = (it >> 2) & 3, kb = (it >> 1) & 1, nb = it & 1;
        transpose_item(P.in[I_CD_WQ + which] + h * 16384, 128, (bf16_t*)(ws + WS_WQKV) + (which * 4 + h) * 16384, 128, kb * 64, nb * 64, RmId(), scr, lane);
      } }
    convert_moe_weights(P, 0, 0, lds, (int)gridDim.x > 64 ? 32 : 0);
}

__device__ __forceinline__ void store_bf16x4(bf16_t* p, f32x4 v) { u32x2 o; o.x = pk_bf16(v[0], v[1]); o.y = pk_bf16(v[2], v[3]); *(u32x2*)p = o; }
__device__ __forceinline__ void store_pair_bf16(bf16_t* prow, int fq, f32x4 y0, f32x4 y1) {
    const auto r = __builtin_amdgcn_permlane16_swap(pk_bf16(y0[0], y0[1]), pk_bf16(y1[0], y1[1]), false, false);
    const auto q = __builtin_amdgcn_permlane16_swap(pk_bf16(y0[2], y0[3]), pk_bf16(y1[2], y1[3]), false, false);
    u32x4 o; o.x = r[0]; o.y = q[0]; o.z = r[1]; o.w = q[1];
    *(u32x4*)(prow + (fq & 1) * 16 + (fq >> 1) * 8) = o;
}

__device__ __forceinline__ void ph_conv0(const Params& P) {
    const bf16_t* proj = (const bf16_t*)(P.ws + WS_PROJ); bf16_t* xc = (bf16_t*)(P.ws + WS_XC);
    const int lane = threadIdx.x & 63, gw = blockIdx.x * 8 + (threadIdx.x >> 6), NGW = gridDim.x * 8, c8 = lane * 8;
    float w[4][8], bias[8];
#pragma unroll
    for (int e = 0; e < 8; ++e) { bias[e] = P.in[I_AB_CONVB][c8 + e];
#pragma unroll
        for (int k = 0; k < 4; ++k) w[k][e] = P.in[I_AB_CONVW][k * 512 + c8 + e]; }
    for (int run = gw; run < T / 16; run += NGW) {
        const int tok0 = run * 16, p0 = tok0 & (SEQ - 1);
        u32x4 r[19];
#pragma unroll
        for (int i = 0; i < 19; ++i) { r[i] = (u32x4){0u, 0u, 0u, 0u}; if (p0 + i - 3 >= 0) r[i] = *(const u32x4*)(proj + (size_t)(tok0 + i - 3) * 1536 + c8); }
#pragma unroll
        for (int t = 0; t < 16; ++t) {
            float a[8];
#pragma unroll
            for (int e = 0; e < 8; ++e) a[e] = bias[e];
#pragma unroll
            for (int k = 0; k < 4; ++k) { float xv[8]; unpack8(r[t + k], xv);
#pragma unroll
                for (int e = 0; e < 8; ++e) a[e] += w[k][e] * xv[e]; }
            *(u32x4*)(xc + (size_t)(tok0 + t) * 512 + c8) = pack8(a);
        }
    }
}

__device__ __forceinline__ void ph_gates0(const Params& P, lds_t* lds) {
    const bf16_t* xc = (const bf16_t*)(P.ws + WS_XC); const bf16_t* Wg = (const bf16_t*)(P.ws + WS_WG);
    unsigned* lau = (unsigned*)(P.ws + WS_AF);
    const float* br = P.in[I_AB_GRB]; const float* bi = P.in[I_AB_GIB]; const float* lam = P.in[I_AB_LAMBDA];
    const int b0 = (int)blockIdx.x, G = (int)gridDim.x;
    {
        e1_stream<true>(lds, wg_tiles(1024), [](int) { return 1; },
            [=](int j, int, int r, int kp) { const int tile = b0 + j * G, h = tile & 7, rt = tile >> 3; return *(const u32x4*)(xc + (size_t)(rt * 256 + r) * 512 + h * 64 + kp * 8); },
            [=](int j, int, int n, int kp) { const int h = (b0 + j * G) & 7; return *(const u32x4*)(Wg + (size_t)h * 8192 + n * 64 + kp * 8); },
            [=](int j, f32x4 (&acc)[4][4], int wr, int wc, int fr, int fq) {
                const int tile = b0 + j * G, h = tile & 7, rt = tile >> 3;
#pragma unroll
                for (int n = 0; n < 2; ++n) {
                    const int ch = h * 64 + wc * 32 + n * 16 + fq * 4;
                    float sp[4], brv[4], biv[4];
#pragma unroll
                    for (int c = 0; c < 4; ++c) { const float l = -lam[ch + c]; sp[c] = fmaxf(l, 0.f) + flog(1.0f + fexp(-fabsf(l))); brv[c] = br[ch + c]; biv[c] = bi[ch + c]; }
#pragma unroll
                    for (int m = 0; m < 4; ++m) {
                        const size_t row = (size_t)(rt * 256 + wr * 64 + m * 16 + fr);
                        const u32x2 xr = *(const u32x2*)(xc + row * 512 + ch);
                        const float xv[4] = {__uint_as_float(xr.x << 16), __uint_as_float(xr.x & 0xffff0000u), __uint_as_float(xr.y << 16), __uint_as_float(xr.y & 0xffff0000u)};
                        f32x4 a4, u4;
#pragma unroll
                        for (int c = 0; c < 4; ++c) {
                            const float r = fsigmoid(acc[m][n][c] + brv[c]), ig = fsigmoid(acc[m][n + 2][c] + biv[c]);
                            const float la = -8.0f * r * sp[c], x2 = 2.0f * la;
                            const float om = (x2 > -0.01f) ? -x2 * (1.0f + 0.5f * x2 * (1.0f + x2 * (1.0f / 3.0f))) : 1.0f - fexp(x2);
                            a4[c] = la; u4[c] = sqrtf(om) * ig * xv[c];
                        }
                        { u32x4 o; o.x = pk_bf16(a4[0], u4[0]); o.y = pk_bf16(a4[1], u4[1]); o.z = pk_bf16(a4[2], u4[2]); o.w = pk_bf16(a4[3], u4[3]); *(u32x4*)(lau + row * 512 + ch) = o; }
                    }
                }
            });
    }
}

__device__ __forceinline__ void ph_lru_scan(const Params& P, lds_t* lds) {
    const unsigned* lau = (const unsigned*)(P.ws + WS_AF);
    const bf16_t* proj = (const bf16_t*)(P.ws + WS_PROJ); bf16_t* cat = (bf16_t*)(P.ws + WS_CAT);
    LAS float* lA = (LAS float*)lds; LAS float* lH = lA + 2048;
    const int tid = threadIdx.x, seg = tid >> 2, c4 = (tid & 3) * 4;
    for (int it0 = blockIdx.x; it0 < 256; it0 += gridDim.x) {
        const int item = (((it0 >> 5) * 8 + (it0 & 7)) * 4 + ((it0 >> 3) & 3));
        const int b = item >> 5, ch = (item & 31) * 16 + c4;
        const size_t base = (size_t)b * SEQ + seg * 32;
        float H[4] = {0.f, 0.f, 0.f, 0.f}, sla[4] = {0.f, 0.f, 0.f, 0.f};
        {
            u32x4 r[32];
#pragma unroll
            for (int j = 0; j < 32; ++j) r[j] = *(const u32x4*)(lau + (base + j) * 512 + ch);
#pragma unroll
            for (int j = 0; j < 32; ++j)
#pragma unroll
                for (int e = 0; e < 4; ++e) { const float la = __uint_as_float(r[j][e] << 16), u = __uint_as_float(r[j][e] & 0xffff0000u); H[e] = fexp(la) * H[e] + u; sla[e] += la; }
        }
        *(LAS f32x4*)(lA + seg * 16 + c4) = (f32x4){fexp(sla[0]), fexp(sla[1]), fexp(sla[2]), fexp(sla[3])};
        *(LAS f32x4*)(lH + seg * 16 + c4) = (f32x4){H[0], H[1], H[2], H[3]};
        __syncthreads();
        f32x4 carry = {0.f, 0.f, 0.f, 0.f};
#pragma unroll 8
        for (int s2 = 0; s2 < seg; ++s2) carry = *(const LAS f32x4*)(lA + s2 * 16 + c4) * carry + *(const LAS f32x4*)(lH + s2 * 16 + c4);
#pragma unroll
        for (int e = 0; e < 4; ++e) H[e] = carry[e];
#pragma unroll 1
        for (int i0 = 0; i0 < 32; i0 += 16) {
            u32x4 r[16]; u32x2 ga[16];
#pragma unroll
            for (int j = 0; j < 16; ++j) { r[j] = *(const u32x4*)(lau + (base + i0 + j) * 512 + ch); ga[j] = *(const u32x2*)(proj + (base + i0 + j) * 1536 + 512 + ch); }
#pragma unroll
            for (int j = 0; j < 16; ++j) {
                const float gv[4] = {__uint_as_float(ga[j].x << 16), __uint_as_float(ga[j].x & 0xffff0000u), __uint_as_float(ga[j].y << 16), __uint_as_float(ga[j].y & 0xffff0000u)};
                f32x4 o;
#pragma unroll
                for (int e = 0; e < 4; ++e) { const float la = __uint_as_float(r[j][e] << 16), u = __uint_as_float(r[j][e] & 0xffff0000u); H[e] = fexp(la) * H[e] + u; o[e] = H[e] * gelu_tanh(gv[e]); }
                store_bf16x4(cat + (base + i0 + j) * 1024 + ch, o);
            }
        }
        __syncthreads();
    }
}

__device__ __forceinline__ void ph_s5_state(const Params& P, lds_t* lds) {
    const bf16_t* proj = (const bf16_t*)(P.ws + WS_PROJ); const bf16_t* Wst = (const bf16_t*)(P.ws + WS_S5WST); float* S = (float*)(P.ws + WS_S5S);
    const int b0 = xcd_group_id(2), G = (int)gridDim.x;
    {
        e1_stream<true>(lds, wg_tiles(128), [](int) { return 8; },
            [=](int j, int, int r, int kp) { const int tile = b0 + j * G, g = tile & 31, rt = tile >> 5; return *(const u32x4*)(proj + (size_t)((rt * 256 + r) * 32 + (kp >> 1)) * 1536 + 1024 + g * 16 + (kp & 1) * 8); },
            [=](int j, int, int n, int kp) { const int g = (b0 + j * G) & 31; return *(const u32x4*)(Wst + (size_t)g * 65536 + n * 512 + kp * 8); },
            [=](int j, f32x4 (&acc)[4][4], int wr, int wc, int fr, int fq) {
                const int tile = b0 + j * G, g = tile & 31, rt = tile >> 5;
#pragma unroll
                for (int m = 0; m < 4; ++m)
#pragma unroll
                    for (int n = 0; n < 4; ++n) *(f32x4*)(S + ((size_t)(rt * 256 + wr * 64 + m * 16 + fr) * 32 + g) * 128 + wc * 64 + n * 16 + fq * 4) = acc[m][n];
            });
    }
}

__device__ __forceinline__ void ph_s5_carry(const Params& P) {
    const float* S = (const float*)(P.ws + WS_S5S); bf16_t* X = (bf16_t*)(P.ws + WS_S5X);
    if (threadIdx.x >= 64) return;
    const int p = threadIdx.x;
    for (int it = blockIdx.x; it < 256; it += gridDim.x) {
        const int b = it >> 5, g = it & 31;
        const float lr = fminf(P.in[I_S5_LRE][g * 64 + p], -1e-4f), li = P.in[I_S5_LIM][g * 64 + p], step = expf(P.in[I_S5_STEP][g]);
        const float mag = expf((float)S5TC * lr * step); float sn, cs; sincosf((float)S5TC * li * step, &sn, &cs);
        const float cr = mag * cs, ci = mag * sn;
        float xr = 0.f, xi = 0.f;
        for (int c0 = 0; c0 < 128; c0 += 16) {
            float sr[16], si[16];
#pragma unroll
            for (int j = 0; j < 16; ++j) { const size_t o = ((size_t)(b * 128 + c0 + j) * 32 + g) * 128; sr[j] = S[o + p]; si[j] = S[o + 64 + p]; }
#pragma unroll
            for (int j = 0; j < 16; ++j) {
                const size_t o = ((size_t)(b * 128 + c0 + j) * 32 + g) * 128;
                X[o + p] = (bf16_t)(pk_bf16(xr, 0.f) & 0xffffu); X[o + 64 + p] = (bf16_t)(pk_bf16(xi, 0.f) & 0xffffu);
                const float nr = cr * xr - ci * xi + sr[j], ni = cr * xi + ci * xr + si[j];
                xr = nr; xi = ni;
            }
        }
    }
}

__device__ __forceinline__ void ph_s5_out(const Params& P, lds_t* lds) {
    const bf16_t* proj = (const bf16_t*)(P.ws + WS_PROJ); const bf16_t* Tm = (const bf16_t*)(P.ws + WS_S5TM); const bf16_t* X = (const bf16_t*)(P.ws + WS_S5X);
    bf16_t* sb = (bf16_t*)(P.ws + WS_SB);
    const int b0 = xcd_group_id(4), G = (int)gridDim.x;
#define S5O_DECODE(J) const int tile = b0 + (J) * G, ct = (tile < 256) ? (tile & 3) : 3 - (tile & 3), g = (tile >> 2) & 31, rt = tile >> 7, nkl = 2 * ct + 2; (void)g; (void)rt;
    {
        e1_stream<true>(lds, wg_tiles(512), [=](int j) { S5O_DECODE(j) return nkl + 2; },
            [=](int j, int, int r, int kp0) {
                S5O_DECODE(j)
                const int kp = kp0 < nkl * 8 ? kp0 : kp0 - nkl * 8 + 64;
                if (kp < 64) return *(const u32x4*)(proj + (size_t)((rt * 256 + r) * 32 + (kp >> 1)) * 1536 + 1024 + g * 16 + (kp & 1) * 8);
                return *(const u32x4*)(X + ((size_t)(rt * 256 + r) * 32 + g) * 128 + (kp - 64) * 8); },
            [=](int j, int, int n, int kp0) { S5O_DECODE(j) const int kp = kp0 < nkl * 8 ? kp0 : kp0 - nkl * 8 + 64; return *(const u32x4*)(Tm + (size_t)g * 512 * S5K + (size_t)(ct * 128 + n) * S5K + kp * 8); },
            [=](int j, f32x4 (&acc)[4][4], int wr, int wc, int fr, int fq) {
                S5O_DECODE(j)
#pragma unroll
                for (int m = 0; m < 4; ++m)
#pragma unroll
                    for (int n = 0; n < 4; ++n) {
                        const int col = ct * 128 + wc * 64 + n * 16 + fq * 4, t = col >> 4, h0 = col & 15;
                        const size_t tok = (size_t)(rt * 256 + wr * 64 + m * 16 + fr) * 32 + t;
                        f32x4 y = acc[m][n];
#pragma unroll
                        for (int c = 0; c < 4; ++c) y[c] = gelu_tanh(y[c]);
                        store_bf16x4(sb + tok * 512 + g * 16 + h0, y);
                    }
            });
    }
}

#undef S5O_DECODE
__device__ __forceinline__ void ph_glu(const Params& P, lds_t* lds) {
    const bf16_t* sb = (const bf16_t*)(P.ws + WS_SB); const bf16_t* Wt = (const bf16_t*)(P.ws + WS_WGLU); bf16_t* cat = (bf16_t*)(P.ws + WS_CAT);
    const float* gb = P.in[I_AB_GLUB];
    const int b0 = xcd_group_id(2), G = (int)gridDim.x;
    {
        e1_stream<true>(lds, wg_tiles(512), [](int) { return 8; },
            [=](int j, int, int r, int kp) { const int rt = (b0 + j * G) >> 2; return *(const u32x4*)(sb + (size_t)(rt * 256 + r) * 512 + kp * 8); },
            [=](int j, int, int n, int kp) { const int ct = (b0 + j * G) & 3; return *(const u32x4*)(Wt + (size_t)(ct * 128 + n) * 512 + kp * 8); },
            [=](int j, f32x4 (&acc)[4][4], int wr, int wc, int fr, int fq) {
                const int tile = b0 + j * G, rt = tile >> 2, ct = tile & 3;
#pragma unroll
                for (int np = 0; np < 2; ++np) {
                    const int col = ct * 128 + wc * 64 + np * 32 + fq * 4;
                    const f32x4 bv[2] = {*(const f32x4*)(gb + col), *(const f32x4*)(gb + col + 16)};
#pragma unroll
                    for (int m = 0; m < 4; ++m) {
                        const size_t row = (size_t)(rt * 256 + wr * 64 + m * 16 + fr);
                        f32x4 y[2];
#pragma unroll
                        for (int q = 0; q < 2; ++q) {
                            const u32x2 sr = *(const u32x2*)(sb + row * 512 + col + q * 16);
                            const float sv[4] = {__uint_as_float(sr.x << 16), __uint_as_float(sr.x & 0xffff0000u), __uint_as_float(sr.y << 16), __uint_as_float(sr.y & 0xffff0000u)};
#pragma unroll
                            for (int c = 0; c < 4; ++c) y[q][c] = sv[c] * fsigmoid(acc[m][2 * np + q][c] + bv[q][c]);
                        }
                        store_pair_bf16(cat + row * 1024 + 512 + ct * 128 + wc * 64 + np * 32, fq, y[0], y[1]);
                    }
                }
            });
    }
}

__device__ __forceinline__ void ph_ln_router(const Params& P, lds_t* lds, int layer) {
    const unsigned tx_ = opaque_tid();
    const bf16_t* mixb = (const bf16_t*)(P.ws + WS_ZF); bf16_t* xb = (bf16_t*)(P.ws + WS_XB); unsigned* xb8 = (unsigned*)(P.ws + WS_X1F);
    const float* lg = P.in[I_LNM_G] + layer * 1024; const float* lb = P.in[I_LNM_B] + layer * 1024;
    const float* rw = P.in[I_R_W] + (size_t)layer * 1024 * 32; const float* rbias = P.in[I_R_B] + layer * 32;
    int* gcount = (int*)(P.ws + WS_CTL) + 64 * layer;
    int* dest = (int*)(P.ws + WS_ROUTE); int* etok = (int*)(P.ws + WS_ELIST); float* egate = (float*)(P.ws + WS_ELIST + 4 * MiB);
    constexpr int XP = 2064;
    lds_t* Xh = lds; lds_t* Xl = lds + 16 * XP;
    LAS float* part = (LAS float*)(lds + 32 * XP);
    LAS int* hist = (LAS int*)(lds + 32 * XP + 16384); LAS int* basev = hist + 32; LAS int* pinfo = basev + 32;
    const int tid = tx_, lane = tid & 63, wave = tid >> 6, fr = lane & 15, fq = lane >> 4;
    bf16x8 wh[4][2], wl[4][2];
#pragma unroll
    for (int ks = 0; ks < 4; ++ks)
#pragma unroll
        for (int nt = 0; nt < 2; ++nt) {
            unsigned ph[4], pl[4];
#pragma unroll
            for (int j2 = 0; j2 < 4; ++j2) {
                const int k = wave * 128 + ks * 32 + fq * 8 + 2 * j2;
                const float w0 = rw[(size_t)k * 32 + nt * 16 + fr], w1 = rw[(size_t)(k + 1) * 32 + nt * 16 + fr];
                ph[j2] = pk_bf16(w0, w1);
                pl[j2] = pk_bf16(w0 - __uint_as_float(ph[j2] << 16), w1 - __uint_as_float(ph[j2] & 0xffff0000u));
            }
            const u32x4 uh = {ph[0], ph[1], ph[2], ph[3]}, ul = {pl[0], pl[1], pl[2], pl[3]};
            wh[ks][nt] = __builtin_bit_cast(bf16x8, uh); wl[ks][nt] = __builtin_bit_cast(bf16x8, ul);
        }
    const float myrb = rbias[lane & 31];
    u32x4 rx[2][2], rm[2][2];
#define LNR_LOAD(IT) do { _Pragma("unroll") for (int rr = 0; rr < 2; ++rr) _Pragma("unroll") for (int j = 0; j < 2; ++j) { \
        const size_t o_ = ((size_t)(IT) * 16 + wave * 2 + rr) * 1024 + j * 512 + lane * 8; rx[rr][j] = *(const u32x4*)(xb + o_); rm[rr][j] = *(const u32x4*)(mixb + o_); } } while (0)
    if ((int)blockIdx.x < T / 16) LNR_LOAD(blockIdx.x);
    if (tid < 32) hist[tid] = 0;
    int li = 0;
    for (int it = blockIdx.x; it < T / 16; it += gridDim.x, ++li) {
        float y[2][2][8];
#pragma unroll
        for (int rr = 0; rr < 2; ++rr)
#pragma unroll
            for (int j = 0; j < 2; ++j) {
                float xa[8], ma[8]; unpack8(rx[rr][j], xa); unpack8(rm[rr][j], ma);
#pragma unroll
                for (int e = 0; e < 8; ++e) y[rr][j][e] = xa[e] * ALPHA + ma[e];
            }
#pragma unroll
        for (int rr = 0; rr < 2; ++rr) {
            const int rl = wave * 2 + rr; const size_t row = (size_t)it * 16 + rl;
            float s = 0.f;
#pragma unroll
            for (int j = 0; j < 2; ++j) s += ((y[rr][j][0] + y[rr][j][1]) + (y[rr][j][2] + y[rr][j][3])) + ((y[rr][j][4] + y[rr][j][5]) + (y[rr][j][6] + y[rr][j][7]));
            const float mean = wave_sum(s) * (1.0f / 1024.0f); float s2 = 0.f;
#pragma unroll
            for (int j = 0; j < 2; ++j)
#pragma unroll
                for (int e = 0; e < 8; ++e) { y[rr][j][e] -= mean; s2 += y[rr][j][e] * y[rr][j][e]; }
            const float rstd = rsqrtf(wave_sum(s2) * (1.0f / 1024.0f) + LN_EPS);
#pragma unroll
            for (int j = 0; j < 2; ++j) {
                const int c0 = j * 512 + lane * 8;
                const f32x4 g0 = *(const f32x4*)(lg + c0), g1 = *(const f32x4*)(lg + c0 + 4), b0 = *(const f32x4*)(lb + c0), b1 = *(const f32x4*)(lb + c0 + 4);
                float v[8], hf[8], lo8[8];
#pragma unroll
                for (int e = 0; e < 4; ++e) { v[e] = y[rr][j][e] * rstd * g0[e] + b0[e]; v[4 + e] = y[rr][j][4 + e] * rstd * g1[e] + b1[e]; }
                const u32x4 hi = pack8(v); unpack8(hi, hf);
#pragma unroll
                for (int e = 0; e < 8; ++e) lo8[e] = v[e] - hf[e];
                const u32x4 lo = pack8(lo8);
                __builtin_nontemporal_store(hi, (u32x4*)(xb + row * 1024 + c0));
                { u32x2 q8; q8.x = pk_fp8x4((f32x4){v[0], v[1], v[2], v[3]} * FP8_SX); q8.y = pk_fp8x4((f32x4){v[4], v[5], v[6], v[7]} * FP8_SX); *(u32x2*)((unsigned char*)xb8 + row * 1024 + c0) = q8; }
                *(LAS u32x4*)(Xh + rl * XP + c0 * 2) = hi;
                *(LAS u32x4*)(Xl + rl * XP + c0 * 2) = lo;
            }
        }
        __syncthreads();
        { const int nit = it + (int)gridDim.x; if (nit < T / 16) LNR_LOAD(nit); }
        f32x4 acc[2] = {(f32x4){0.f, 0.f, 0.f, 0.f}, (f32x4){0.f, 0.f, 0.f, 0.f}};
#pragma unroll
        for (int ks = 0; ks < 4; ++ks) {
            const int ko = (wave * 128 + ks * 32 + fq * 8) * 2;
            const bf16x8 ah = *(LAS bf16x8*)(Xh + fr * XP + ko), al = *(LAS bf16x8*)(Xl + fr * XP + ko);
#pragma unroll
            for (int nt = 0; nt < 2; ++nt) { acc[nt] = MFMA16(ah, wh[ks][nt], acc[nt]); acc[nt] = MFMA16(ah, wl[ks][nt], acc[nt]); acc[nt] = MFMA16(al, wh[ks][nt], acc[nt]); }
        }
#pragma unroll
        for (int nt = 0; nt < 2; ++nt)
#pragma unroll
            for (int r = 0; r < 4; ++r) part[(wave * 16 + fq * 4 + r) * 32 + nt * 16 + fr] = acc[nt][r];
        __syncthreads();
        {
            const int rl = wave * 2 + (lane >> 5), my = lane & 31;
            float val = myrb;
#pragma unroll
            for (int w2 = 0; w2 < 8; ++w2) val += part[(w2 * 16 + rl) * 32 + my];
            float topv[4]; int topi[4];
#pragma unroll
            for (int k = 0; k < 4; ++k) {
                float bv = val; int bi = my;
#pragma unroll
                for (int off = 16; off >= 1; off >>= 1) { const float ov = __shfl_xor(bv, off); const int oi = __shfl_xor(bi, off); if (ov > bv || (ov == bv && oi < bi)) { bv = ov; bi = oi; } }
                topv[k] = bv; topi[k] = bi; if (my == bi) val = -INFINITY;
            }
            if (my == 0) {
                const float e1 = expf(topv[1] - topv[0]), e2 = expf(topv[2] - topv[0]), e3 = expf(topv[3] - topv[0]);
                const float inv = 1.0f / (1.0f + e1 + e2 + e3);
                const float gt[4] = {inv, e1 * inv, e2 * inv, e3 * inv};
#pragma unroll
                for (int k = 0; k < 4; ++k) { const int lr = __hip_atomic_fetch_add(&hist[topi[k]], 1, __ATOMIC_RELAXED, __HIP_MEMORY_SCOPE_WORKGROUP); const int pq = ((li * 16 + rl) * 4 + k) * 3; pinfo[pq + 0] = topi[k]; pinfo[pq + 1] = lr; pinfo[pq + 2] = __float_as_int(gt[k]); }
            }
        }
    }
    __syncthreads();
    if (tid < 32) { const int c = hist[tid]; basev[tid] = c ? atomicAdd(gcount + tid, c) : 0; }
    __syncthreads();
    for (int q = tid; q < li * 64; q += NTHREADS) {
        const int e = pinfo[q * 3 + 0]; const size_t pi = (size_t)(blockIdx.x + (q >> 6) * gridDim.x) * 64 + (q & 63);
        const int rank = basev[e] + pinfo[q * 3 + 1];
        dest[pi] = e | (rank << 5); etok[e * 32768 + rank] = (int)(pi >> 2); egate[e * 32768 + rank] = __int_as_float(pinfo[q * 3 + 2]);
    }
}

__device__ __forceinline__ void moe_pstart(const Params& P, lds_t* lds, int layer) {
    LAS int* ps = (LAS int*)(lds + PS_OFF);
    const int* gcount = (const int*)(P.ws + WS_CTL) + 64 * layer;
    if (threadIdx.x < 64) {
        const int lane = (int)threadIdx.x, c = (lane < 32) ? gcount[lane] : 0, padded = ((c + 255) >> 8) << 8;
        int incl = padded;
#pragma unroll
        for (int off = 1; off < 32; off <<= 1) { const int t = __shfl_up(incl, off); if (lane >= off) incl += t; }
        if (lane < 32) { ps[lane] = incl - padded; ps[40 + lane] = c; }
        if (lane == 31) ps[32] = incl;
    }
    __syncthreads();
}

struct EpiInproj {
    bf16_t* proj; int N; const int* pos;
    __device__ __forceinline__ void operator()(f32x4 (&acc)[2][2][4][2], const g2::Unit& u, int wr, int wc, int fr, int fq) const {
#pragma unroll
        for (int bj = 0; bj < 2; ++bj) {
            const int ct = 2 * u.pn + bj;
            if (pos != nullptr && ct >= 8 && ct < 16 && wc == 0) {
                float invf[4];
#pragma unroll
                for (int c = 0; c < 4; ++c) invf[c] = exp2f(-(float)(fq * 4 + c) * (18.931568569324174f / 16.0f));
#pragma unroll
                for (int ai = 0; ai < 2; ++ai)
#pragma unroll
                    for (int m = 0; m < 4; ++m) {
                        const float pf = (float)pos[u.pm * 256 + ai * 128 + wr * 64 + m * 16 + fr];
#pragma unroll
                        for (int c = 0; c < 4; ++c) {
                            float sn, cs; fsincos(pf * invf[c], sn, cs);
                            const float a = acc[ai][bj][m][0][c], b = acc[ai][bj][m][1][c];
                            acc[ai][bj][m][0][c] = a * cs - b * sn; acc[ai][bj][m][1][c] = b * cs + a * sn;
                        }
                    }
            }
            const float sc = (pos != nullptr && ct >= 8 && ct < 12) ? 0.08838834764831845f : 1.0f;
#pragma unroll
            for (int ai = 0; ai < 2; ++ai)
#pragma unroll
                for (int m = 0; m < 4; ++m)
                    store_pair_bf16(proj + (size_t)(u.pm * 256 + ai * 128 + wr * 64 + m * 16 + fr) * N + ct * 128 + wc * 32, fq, acc[ai][bj][m][0] * sc, acc[ai][bj][m][1] * sc);
        }
    }
};
__device__ __forceinline__ void ph_inproj2(const Params& P, lds_t* lds, const bf16_t* Wt, int N, const int* pos) {
    g2::DenseSched S{(int)gridDim.x, (int)blockIdx.x, T / 256, N / 256, 1024, (const char*)Wt};
    EpiInproj E{(bf16_t*)(P.ws + WS_PROJ), N, pos};
    g2::gemm_phase<false>(lds, (const char*)(P.ws + WS_XB), 16, 2048u, S, E);
}
struct EpiOutproj {
    bf16_t* mixb;
    __device__ __forceinline__ void operator()(f32x4 (&acc)[2][2][4][2], const g2::Unit& u, int wr, int wc, int fr, int fq) const {
#pragma unroll
        for (int ai = 0; ai < 2; ++ai)
#pragma unroll
            for (int m = 0; m < 4; ++m)
#pragma unroll
                for (int bj = 0; bj < 2; ++bj) {
                    const size_t o = (size_t)(u.pm * 256 + ai * 128 + wr * 64 + m * 16 + fr) * 1024 + u.pn * 256 + bj * 128 + wc * 32;
                    store_pair_bf16(mixb + o, fq, acc[ai][bj][m][0], acc[ai][bj][m][1]);
                }
    }
};
__device__ __forceinline__ void ph_outproj2(const Params& P, lds_t* lds, const bf16_t* Wt) {
    g2::DenseSched S{(int)gridDim.x, (int)blockIdx.x, T / 256, 4, 1024, (const char*)Wt};
    EpiOutproj E{(bf16_t*)(P.ws + WS_ZF)};
    g2::gemm_phase<false>(lds, (const char*)(P.ws + WS_CAT), 16, 2048u, S, E);
}
template <class RT> struct MoeSchedT {
    static constexpr bool CHEAP_AOFF = false;
    int G, c, nM, nN; const char* W; size_t wstride; const LAS RT* rt16; LAS int* ps; unsigned apitch, bpitch;
    __device__ __forceinline__ bool next(int i, g2::Unit& u) const { return g2::static_next(i, G, c, nM, nN, u); }
    __device__ __forceinline__ int expert(int pm) const {
        const int lane = (int)(threadIdx.x & 63); const bool below = (lane < 32) && (ps[lane + 1] <= pm * 256);
        return (int)__popcll(__ballot(below)); }
    __device__ __forceinline__ void a_off(const g2::Unit& u, unsigned (&ao)[2][2]) const {
        int Rs[2], Cs[2];
#pragma unroll
        for (int i = 0; i < 2; ++i) g2::stage_rc((int)threadIdx.x * 16 + i * 8192, Rs[i], Cs[i]);
#pragma unroll
        for (int h = 0; h < 2; ++h)
#pragma unroll
            for (int i = 0; i < 2; ++i) {
                const unsigned row = (unsigned)rt16[u.idx * 256 + h * 128 + Rs[i]];
                ao[h][i] = row * apitch + (unsigned)Cs[i] * 2u;
            }
    }
    __device__ __forceinline__ const char* b_base(const g2::Unit& u) const { return W + (size_t)((const LAS int*)((lds_t*)ps - 128))[u.idx] * wstride + (size_t)u.pn * 256 * bpitch; }
};
struct EpiMoeUp {
    unsigned* hact8; const LAS float* tb;
    __device__ __forceinline__ void operator()(f32x4 (&acc)[2][2][4][2], const g2::Unit& u, int wr, int wc, int fr, int fq) const {
        constexpr float us = 1.0f / (FP8_SX * FP8_SWIN);
        const int jl = wc * 32 + fq * 4;
        unsigned wv0[2][4];
#pragma unroll
        for (int n = 0; n < 2; ++n) {
            __builtin_amdgcn_sched_barrier(0);
            const f32x4 bg = *(const LAS f32x4*)(tb + u.idx * 256 + jl + n * 16), bl8 = (*(const LAS f32x4*)(tb + u.idx * 256 + 128 + jl + n * 16) + 1.0f) * FP8_SH;
#pragma unroll
            for (int ai = 0; ai < 2; ++ai)
#pragma unroll
                for (int m = 0; m < 4; ++m) {
                    f32x4 gv = acc[ai][0][m][n] * us + bg, l8 = acc[ai][1][m][n] * (us * FP8_SH) + bl8;
#pragma unroll
                    for (int c = 0; c < 4; ++c) { gv[c] = fminf(gv[c], 7.0f); l8[c] = fminf(fmaxf(l8[c], -6.0f * FP8_SH), 8.0f * FP8_SH); }
                    f32x4 tt = gv * (-1.702f * 1.4426950408889634f);
#pragma unroll
                    for (int c = 0; c < 4; ++c) tt[c] = __builtin_amdgcn_exp2f(tt[c]);
                    tt = tt + 1.0f;
#pragma unroll
                    for (int c = 0; c < 4; ++c) tt[c] = __builtin_amdgcn_rcpf(tt[c]);
                    const f32x4 ys = gv * tt * l8;
                    unsigned w = 0;
                    w = __builtin_amdgcn_cvt_pk_fp8_f32(ys[0], ys[1], w, false); w = __builtin_amdgcn_cvt_pk_fp8_f32(ys[2], ys[3], w, true);
                    if (n == 0) wv0[ai][m] = w;
                    else {
                        const auto r = __builtin_amdgcn_permlane16_swap(wv0[ai][m], w, false, false);
                        u32x2 o; o.x = r[0]; o.y = r[1];
                        *(u32x2*)((unsigned char*)hact8 + (unsigned)((u.pm * 256 + ai * 128 + wr * 64 + m * 16 + fr) * 1024 + u.pn * 128 + wc * 32 + (fq & 1) * 16 + (fq >> 1) * 8)) = o;
                    }
                }
        }
    }
};
__device__ __forceinline__ void ph_moe_up2(const Params& P, lds_t* lds, int layer) {
    moe_pstart(P, lds, layer);
    LAS int* ps = (LAS int*)(lds + PS_OFF);
    const int* etok = (const int*)(P.ws + WS_ELIST);
    const float* b_in = P.in[I_M_BIN] + (size_t)layer * 32 * 2048;
    const int nM = ps[32] >> 8, G = (int)gridDim.x, c = (int)blockIdx.x;
    LAS float* tb = (LAS float*)(lds + MTAB_OFF);
    LAS unsigned short* rt16 = (LAS unsigned short*)(lds + MTAB_OFF + 17 * 1024);
    MoeSchedT<unsigned short> S{G, c, nM, 8, (const char*)(P.ws + (layer ? WS_MW1 : WS_MWIN)), (size_t)2048 * 1024, rt16, ps, 1024u, 1024u};
    {
        unsigned ld[17]; bool ok[17];
#pragma unroll
        for (int i = 0; i < 17; ++i) {
            g2::Unit u; ok[i] = S.next(i, u); ld[i] = 0u;
            if (ok[i]) { const int e = S.expert(u.pm); if (threadIdx.x == 0) ((LAS int*)(lds + UEXP_OFF))[i] = e;
                if (threadIdx.x < 256) { const int t = threadIdx.x; ld[i] = __float_as_uint(b_in[e * 2048 + (t >> 7) * 1024 + u.pn * 128 + (t & 127)]); }
                else { const int t = threadIdx.x - 256, rank = u.pm * 256 - ps[e] + t; ld[i] = (rank < ps[40 + e]) ? (unsigned)etok[e * 32768 + rank] : 0u; } }
        }
#pragma unroll
        for (int i = 0; i < 17; ++i) if (ok[i]) { if (threadIdx.x < 256) tb[i * 256 + threadIdx.x] = __uint_as_float(ld[i]); else rt16[i * 256 + threadIdx.x - 256] = (unsigned short)ld[i]; }
    }
    __syncthreads();
    EpiMoeUp E{(unsigned*)(P.ws + WS_HACT), tb};
    g2::gemm_phase<true>(lds, (const char*)(P.ws + WS_X1F), 8, 1024u, S, E);
    if (layer == 0) { const int r = (nM * 8) % G; if (r != 0 && c >= r) convert_range_wg(P, 1, (c - r) * TAIL_QUOTA, TAIL_QUOTA, lds); }
}
struct EpiMoeDown {
    unsigned char* yb8; const LAS float* tb;
    __device__ __forceinline__ void operator()(f32x4 (&acc)[2][2][4][2], const g2::Unit& u, int wr, int wc, int fr, int fq) const {
        const int cs = (fq & 1) * 16 + (fq >> 1) * 8;
#pragma unroll
        for (int bj = 0; bj < 2; ++bj) {
            unsigned w0[2][4];
#pragma unroll
            for (int n = 0; n < 2; ++n) {
                __builtin_amdgcn_sched_barrier(0);
                const f32x4 bv = *(const LAS f32x4*)(tb + u.idx * 512 + bj * 128 + wc * 32 + fq * 4 + n * 16);
#pragma unroll
                for (int ai = 0; ai < 2; ++ai)
#pragma unroll
                    for (int m = 0; m < 4; ++m) {
                        const int rl = ai * 128 + wr * 64 + m * 16 + fr; const float gt = tb[u.idx * 512 + 256 + rl] * FP8_SY;
                        const unsigned w = pk_fp8x4((acc[ai][bj][m][n] * (1.0f / (FP8_SH * FP8_SWOUT)) + bv) * gt);
                        if (n == 0) w0[ai][m] = w;
                        else {
                            const auto r = __builtin_amdgcn_permlane16_swap(w0[ai][m], w, false, false);
                            u32x2 o; o.x = r[0]; o.y = r[1];
                            *(u32x2*)(yb8 + (unsigned)((u.pm * 256 + rl) * 1024 + u.pn * 256 + bj * 128 + wc * 32 + cs)) = o;
                        }
                    }
            }
        }
    }
};
__device__ __forceinline__ void ph_moe_down2(const Params& P, lds_t* lds, int layer) {
    moe_pstart(P, lds, layer);
    LAS int* ps = (LAS int*)(lds + PS_OFF);
    const float* egate = (const float*)(P.ws + WS_ELIST + 4 * MiB);
    const float* b_out = P.in[I_M_BOUT] + (size_t)layer * 32 * 1024;
    const int nM = ps[32] >> 8, G = (int)gridDim.x, c = (int)blockIdx.x;
    LAS float* tb = (LAS float*)(lds + MTAB_OFF);
    LAS unsigned* rt32 = (LAS unsigned*)(lds + MTAB_OFF + 9 * 2048);
    MoeSchedT<unsigned> S{G, c, nM, 4, (const char*)(P.ws + (layer ? WS_MW1 : WS_MWIN) + (size_t)32 * 2048 * 1024), (size_t)1024 * 1024, rt32, ps, 1024u, 1024u};
    {
        float ld[9]; bool ok[9]; int pmv[9];
#pragma unroll
        for (int i = 0; i < 9; ++i) {
            g2::Unit u; ok[i] = S.next(i, u); ld[i] = 0.f; pmv[i] = 0;
            if (ok[i]) { const int e = S.expert(u.pm); if (threadIdx.x == 0) ((LAS int*)(lds + UEXP_OFF))[i] = e; pmv[i] = u.pm;
                const int t = threadIdx.x; if (t < 256) ld[i] = b_out[e * 1024 + u.pn * 256 + t]; else { const int rank = u.pm * 256 - ps[e] + (t - 256); ld[i] = (rank < ps[40 + e]) ? egate[e * 32768 + rank] : 0.f; } }
        }
#pragma unroll
        for (int i = 0; i < 9; ++i) if (ok[i]) { const int t = threadIdx.x; tb[i * 512 + t] = ld[i]; if (t < 256) rt32[i * 256 + t] = (unsigned)(pmv[i] * 256 + t); }
    }
    __syncthreads();
    EpiMoeDown E{P.ws + WS_YB, tb};
    g2::gemm_phase<true>(lds, (const char*)(P.ws + WS_HACT), 8, 1024u, S, E);
    if (layer == 0) { const int r = (nM * 4) % G; if (r != 0 && c >= r) convert_range_wg(P, 1, tail_done_up(nM, G) + (c - r) * TAIL_QUOTA, TAIL_QUOTA, lds); }
}

__device__ __forceinline__ void ph_combine_ln(const Params& P, lds_t* lds, int layer, float* outf  ) {
    moe_pstart(P, lds, layer);
    const LAS int* ps = (const LAS int*)(lds + PS_OFF);
    const unsigned char* yb = P.ws + WS_YB; bf16_t* xb = (bf16_t*)(P.ws + WS_XB);
    const int* dest = (const int*)(P.ws + WS_ROUTE);
    const float* lg = P.in[I_LNF_G] + layer * 1024; const float* lb = P.in[I_LNF_B] + layer * 1024;
    const unsigned tx_ = opaque_tid();
    const int lane = tx_ & 63, gw = blockIdx.x * 8 + (tx_ >> 6), NGW = gridDim.x * 8;
    LAS float* tr = (LAS float*)(lds + (tx_ >> 6) * 2048);
    u32x4 rx[2][2]; u32x2 yr[2][2][4];
    int4 dnext[2];
#define CMB_LOAD(ROW0, D) do { _Pragma("unroll") for (int rr = 0; rr < 2; ++rr) { const int row_ = (ROW0) + rr; const int4 d = (D)[rr]; \
        const int dd[4] = {ps[d.x & 31] + (d.x >> 5), ps[d.y & 31] + (d.y >> 5), ps[d.z & 31] + (d.z >> 5), ps[d.w & 31] + (d.w >> 5)}; \
        _Pragma("unroll") for (int j = 0; j < 2; ++j) { rx[rr][j] = *(const u32x4*)(xb + (size_t)row_ * 1024 + j * 512 + lane * 8); \
            _Pragma("unroll") for (int k = 0; k < 4; ++k) yr[rr][j][k] = __builtin_nontemporal_load((const u32x2*)(yb + (size_t)dd[k] * 1024 + j * 512 + lane * 8)); } } } while (0)
    if (gw * 2 < T) {
#pragma unroll
        for (int rr = 0; rr < 2; ++rr) dnext[rr] = *(const int4*)(dest + (gw * 2 + rr) * 4);
        CMB_LOAD(gw * 2, dnext);
#pragma unroll
        for (int rr = 0; rr < 2; ++rr) { const int nr = gw * 2 + NGW * 2 + rr; dnext[rr] = (nr < T) ? *(const int4*)(dest + nr * 4) : (int4){0, 0, 0, 0}; }
    }
    for (int row0 = gw * 2; row0 < T; row0 += NGW * 2) {
        float v[2][2][8];
#pragma unroll
        for (int rr = 0; rr < 2; ++rr)
#pragma unroll
            for (int j = 0; j < 2; ++j) {
                unpack8(rx[rr][j], v[rr][j]);
#pragma unroll
                for (int e = 0; e < 8; ++e) v[rr][j][e] *= ALPHA;
#pragma unroll
                for (int k = 0; k < 4; ++k) {
                    const f32x2 t0 = __builtin_amdgcn_cvt_pk_f32_fp8(yr[rr][j][k].x, false), t1 = __builtin_amdgcn_cvt_pk_f32_fp8(yr[rr][j][k].x, true);
                    const f32x2 t2 = __builtin_amdgcn_cvt_pk_f32_fp8(yr[rr][j][k].y, false), t3 = __builtin_amdgcn_cvt_pk_f32_fp8(yr[rr][j][k].y, true);
                    const float t8[8] = {t0[0], t0[1], t1[0], t1[1], t2[0], t2[1], t3[0], t3[1]};
#pragma unroll
                    for (int e = 0; e < 8; ++e) v[rr][j][e] += t8[e] * (1.0f / FP8_SY);
                }
            }
        { const int nrow0 = row0 + NGW * 2;
          if (nrow0 < T) {
              CMB_LOAD(nrow0, dnext);
#pragma unroll
              for (int rr = 0; rr < 2; ++rr) { const int nr = nrow0 + NGW * 2 + rr; if (nr < T) dnext[rr] = *(const int4*)(dest + nr * 4); }
          } }
#pragma unroll
        for (int rr = 0; rr < 2; ++rr) {
            const int row = row0 + rr; float s = 0.f;
#pragma unroll
            for (int j = 0; j < 2; ++j) s += ((v[rr][j][0] + v[rr][j][1]) + (v[rr][j][2] + v[rr][j][3])) + ((v[rr][j][4] + v[rr][j][5]) + (v[rr][j][6] + v[rr][j][7]));
            const float mean = wave_sum(s) * (1.0f / 1024.0f); float s2 = 0.f;
#pragma unroll
            for (int j = 0; j < 2; ++j)
#pragma unroll
                for (int e = 0; e < 8; ++e) { v[rr][j][e] -= mean; s2 += v[rr][j][e] * v[rr][j][e]; }
            const float rstd = rsqrtf(wave_sum(s2) * (1.0f / 1024.0f) + LN_EPS);
#pragma unroll
            for (int j = 0; j < 2; ++j) {
                const int c0 = j * 512 + lane * 8;
                const f32x4 g0 = *(const f32x4*)(lg + c0), g1 = *(const f32x4*)(lg + c0 + 4), b0 = *(const f32x4*)(lb + c0), b1 = *(const f32x4*)(lb + c0 + 4);
                float o[8];
#pragma unroll
                for (int e = 0; e < 4; ++e) { o[e] = v[rr][j][e] * rstd * g0[e] + b0[e]; o[4 + e] = v[rr][j][4 + e] * rstd * g1[e] + b1[e]; }
                if (outf) {
                    *(LAS f32x4*)(tr + lane * 8) = (f32x4){o[0], o[1], o[2], o[3]}; *(LAS f32x4*)(tr + lane * 8 + 4) = (f32x4){o[4], o[5], o[6], o[7]};
                    __builtin_amdgcn_wave_barrier();
                    const f32x4 q0 = *(const LAS f32x4*)(tr + lane * 4), q1 = *(const LAS f32x4*)(tr + 256 + lane * 4);
                    __builtin_amdgcn_wave_barrier();
                    __builtin_nontemporal_store(q0, (f32x4*)(outf + (size_t)row * 1024 + j * 512 + lane * 4)); __builtin_nontemporal_store(q1, (f32x4*)(outf + (size_t)row * 1024 + j * 512 + 256 + lane * 4));
                } else __builtin_nontemporal_store(pack8(o), (u32x4*)(xb + (size_t)row * 1024 + c0));
            }
        }
    }
}

__device__ __forceinline__ void ph_conv1(const Params& P, lds_t* lds) {
    const bf16_t* proj = (const bf16_t*)(P.ws + WS_PROJ); bf16_t* xconv = (bf16_t*)(P.ws + WS_XCONV); float* gates = (float*)(P.ws + WS_GATES);
    LAS float* Wc = (LAS float*)lds;
    const float* Wcg = (const float*)(P.ws + WS_WC);
    for (int i = threadIdx.x; i < 8192; i += NTHREADS) {
        const int which = i >> 12, ch = (i >> 3) & 511, gg = i & 7;
        Wc[which * 4096 + (((ch & 7) * 2 + (gg >> 2)) * 64 + (ch >> 3)) * 4 + (gg & 3)] = Wcg[i];
    }
    __syncthreads();
    const int lane = threadIdx.x & 63, gw = blockIdx.x * 8 + (threadIdx.x >> 6), NGW = gridDim.x * 8, c8 = lane * 8;
    float w[4][8], bias[8];
#pragma unroll
    for (int e = 0; e < 8; ++e) { bias[e] = P.in[I_CD_CONVB][c8 + e];
#pragma unroll
        for (int k = 0; k < 4; ++k) w[k][e] = P.in[I_CD_CONVW][k * 512 + c8 + e]; }
    const float bif = P.in[I_CD_BIF][lane & 7];
    for (int run = gw; run < T / 8; run += NGW) {
        const int tok0 = run * 8, p0 = tok0 & (SEQ - 1);
        u32x4 r[11];
#pragma unroll
        for (int i = 0; i < 11; ++i) { r[i] = (u32x4){0u, 0u, 0u, 0u}; if (p0 + i - 3 >= 0) r[i] = *(const u32x4*)(proj + (size_t)(tok0 + i - 3) * 2560 + c8); }
#pragma unroll
        for (int t = 0; t < 8; ++t) {
            int woff = lane * 4; asm volatile("" : "+v"(woff));
            const int tok = tok0 + t;
            float a[8], xraw[8];
#pragma unroll
            for (int e = 0; e < 8; ++e) a[e] = bias[e];
#pragma unroll
            for (int k = 0; k < 4; ++k) { float xv[8]; unpack8(r[t + k], xv);
#pragma unroll
                for (int e = 0; e < 8; ++e) { a[e] += w[k][e] * xv[e]; if (k == 3) xraw[e] = xv[e]; } }
#pragma unroll
            for (int e = 0; e < 8; ++e) a[e] = a[e] * fsigmoid(a[e]);
            const u32x4 packed = pack8(a);
            *(u32x4*)(xconv + (size_t)tok * 512 + c8) = packed;
            float ar[8]; unpack8(packed, ar);
            float gs[8];
#pragma unroll
            for (int gg = 0; gg < 8; ++gg) gs[gg] = 0.f;
#pragma unroll
            for (int e = 0; e < 8; ++e) {
                const f32x4 w1a = *(LAS f32x4*)(Wc + woff + (e * 2) * 256), w1b = *(LAS f32x4*)(Wc + woff + (e * 2 + 1) * 256);
                const f32x4 w2a = *(LAS f32x4*)(Wc + 4096 + woff + (e * 2) * 256), w2b = *(LAS f32x4*)(Wc + 4096 + woff + (e * 2 + 1) * 256);
#pragma unroll
                for (int gg = 0; gg < 4; ++gg) { gs[gg] += ar[e] * w1a[gg] + xraw[e] * w2a[gg]; gs[gg + 4] += ar[e] * w1b[gg] + xraw[e] * w2b[gg]; }
            }
            float mine = 0.f;
#pragma unroll
            for (int gg = 0; gg < 8; ++gg) { const float tsum = wave_sum(gs[gg]); if ((lane & 7) == gg) mine = tsum; }
            if (lane < 8) gates[(size_t)tok * 8 + lane] = mine + bif;
        }
    }
}

__device__ __forceinline__ void ph_qkv(const Params& P, lds_t* lds) {
    const bf16_t* xconv = (const bf16_t*)(P.ws + WS_XCONV); const bf16_t* proj = (const bf16_t*)(P.ws + WS_PROJ); const bf16_t* Wt = (const bf16_t*)(P.ws + WS_WQKV);
    bf16_t* qb = (bf16_t*)(P.ws + WS_QB); static_assert(WS_KB == WS_QB + 32 * MiB && WS_VB == WS_QB + 64 * MiB, "q/k/v spacing");
    const int b0 = (int)blockIdx.x, G = (int)gridDim.x;
#define QKV_DECODE(J) const int tile = b0 + (J) * G, which = tile % 3, rt = (tile / 3) & 127, h = tile / 384; (void)rt;
    e1_stream<true>(lds, wg_tiles(1536), [](int) { return 2; },
        [=](int j, int, int r, int kp) { QKV_DECODE(j) const bf16_t* A = which < 2 ? xconv : proj; const int lda = which < 2 ? 512 : 2560; return *(const u32x4*)(A + (size_t)(rt * 256 + r) * lda + h * 128 + kp * 8); },
        [=](int j, int, int n, int kp) { QKV_DECODE(j) return *(const u32x4*)(Wt + (size_t)(which * 4 + h) * 16384 + n * 128 + kp * 8); },
        [=](int j, f32x4 (&acc)[4][4], int wr, int wc, int fr, int fq) {
            QKV_DECODE(j)
            bf16_t* out = (bf16_t*)((unsigned char*)qb + (size_t)which * (32 * MiB));
            const float sc = which == 1 ? 0.08838834764831845f : 1.0f;
#pragma unroll
            for (int m = 0; m < 4; ++m)
#pragma unroll
                for (int np = 0; np < 2; ++np)
                    store_pair_bf16(out + (size_t)(rt * 256 + wr * 64 + m * 16 + fr) * 512 + h * 128 + wc * 64 + np * 32, fq, acc[m][2 * np] * sc, acc[m][2 * np + 1] * sc);
        });
#undef QKV_DECODE
}

constexpr int TP = 272;
__device__ __forceinline__ void ph_m1(const Params& P, lds_t* lds) {
    const bf16_t* kb = (const bf16_t*)(P.ws + WS_KB); const bf16_t* vb = (const bf16_t*)(P.ws + WS_VB); const float* gates = (const float*)(P.ws + WS_GATES);
    bf16_t* kvc = (bf16_t*)(P.ws + WS_KVC); float* nchunk = (float*)(P.ws + WS_MISC); float* scal = nchunk + 2 * 2048 * 128;
    lds_t* Kt = lds; lds_t* Vt = lds + 64 * TP; LAS float* wv = (LAS float*)(lds + 128 * TP);
    const int tid = threadIdx.x, lane = tid & 63, w = tid >> 6, fr = lane & 15, fq = lane >> 4, q = (lane & 15) >> 2, p4 = lane & 3;
    int item = blockIdx.x; if (item >= 2048) return;
    u32x4 rk[2], rv[2]; float pf_f, pf_i;
#define M1_LOAD(IT) do { const int bh_ = (IT) >> 6, n_ = (IT) & 63, b_ = bh_ >> 2, h_ = bh_ & 3; const size_t t0_ = (size_t)b_ * SEQ + n_ * 64; \
        _Pragma("unroll") for (int i_ = 0; i_ < 2; ++i_) { const int p_ = tid + i_ * NTHREADS; const size_t o_ = (t0_ + (p_ >> 4)) * 512 + h_ * 128 + (p_ & 15) * 8; rk[i_] = *(const u32x4*)(kb + o_); rv[i_] = *(const u32x4*)(vb + o_); } \
        pf_f = gates[(t0_ + lane) * 8 + 4 + h_]; pf_i = gates[(t0_ + lane) * 8 + h_]; } while (0)
    M1_LOAD(item);
    for (;;) {
#pragma unroll
        for (int i = 0; i < 2; ++i) { const int p = tid + i * NTHREADS; *(LAS u32x4*)(Kt + (p >> 4) * TP + (p & 15) * 16) = rk[i]; *(LAS u32x4*)(Vt + (p >> 4) * TP + (p & 15) * 16) = rv[i]; }
        if (w == 0) {
            float cum = logsigmoidf(pf_f);
#pragma unroll
            for (int off = 1; off < 64; off <<= 1) { const float t = __shfl_up(cum, off); if (lane >= off) cum += t; }
            const float cf = __shfl(cum, 63), te = cf - cum + pf_i, m = wave_max(te);
            wv[lane] = expf(te - m);
            if (lane == 0) { scal[item] = cf; scal[2048 + item] = m; }
        }
        __syncthreads();
        const int nitem = item + gridDim.x; const bool has_next = nitem < 2048;
        if (has_next) M1_LOAD(nitem);
        bf16x8 af[2]; float nsum = 0.f;
#pragma unroll
        for (int ks = 0; ks < 2; ++ks) {
            unsigned pk[4];
#pragma unroll
            for (int t = 0; t < 2; ++t) {
                const int s0 = 32 * ks + 8 * fq + 4 * t;
                const bf16x4 r = tr_read(Kt + (s0 + q) * TP + (16 * w + 4 * p4) * 2);
                const f32x4 ww = *(LAS f32x4*)(wv + s0);
                float x[4];
#pragma unroll
                for (int e = 0; e < 4; ++e) { x[e] = bf2f((unsigned short)r[e]) * ww[e]; nsum += x[e]; }
                pk[2 * t] = pk_bf16(x[0], x[1]); pk[2 * t + 1] = pk_bf16(x[2], x[3]);
            }
            u32x4 u = {pk[0], pk[1], pk[2], pk[3]}; af[ks] = __builtin_bit_cast(bf16x8, u);
        }
        nsum += __shfl_xor(nsum, 16); nsum += __shfl_xor(nsum, 32);
        if (fq == 0) nchunk[(size_t)item * 128 + 16 * w + fr] = nsum;
#pragma unroll
        for (int c = 0; c < 8; ++c) {
            f32x4 acc = {0.f, 0.f, 0.f, 0.f};
#pragma unroll
            for (int ks = 0; ks < 2; ++ks) {
                const int s0 = 32 * ks + 8 * fq;
                const bf16x8 bfv = cat44(tr_read(Vt + (s0 + q) * TP + (16 * c + 4 * p4) * 2), tr_read(Vt + (s0 + 4 + q) * TP + (16 * c + 4 * p4) * 2));
                acc = MFMA16(af[ks], bfv, acc);
            }
            store_bf16x4(kvc + ((size_t)item * 128 + c * 16 + fr) * 128 + 16 * w + fq * 4, acc);
        }
        __syncthreads();
        if (!has_next) break;
        item = nitem;
    }
#undef M1_LOAD
}

__device__ __forceinline__ void ph_m2(const Params& P) {
    const bf16_t* kvc = (const bf16_t*)(P.ws + WS_KVC); bf16_t* cprev = (bf16_t*)(P.ws + WS_CPREV);
    const float* nchunk = (const float*)(P.ws + WS_MISC); float* nprev = (float*)(P.ws + WS_MISC) + 2048 * 128; float* scal = (float*)(P.ws + WS_MISC) + 2 * 2048 * 128;
    const int tid = threadIdx.x;
    for (int it = blockIdx.x; it < 256; it += gridDim.x) {
        const int bh = it >> 3, sl = it & 7, idx = sl * 2048 + tid * 4;
        const bool donv = (sl == 0 && tid < 128);
        f32x4 C = {0.f, 0.f, 0.f, 0.f}; float nv = 0.f, m = -INFINITY;
        for (int n0 = 0; n0 < 64; n0 += 4) {
            f32x4 kv[4]; float nc[4], fc[4], mc[4];
#pragma unroll
            for (int j = 0; j < 4; ++j) {
                const int item = bh * 64 + n0 + j;
                { const u32x2 kq = *(const u32x2*)(kvc + (size_t)item * 16384 + idx); kv[j] = (f32x4){__uint_as_float(kq.x << 16), __uint_as_float(kq.x & 0xffff0000u), __uint_as_float(kq.y << 16), __uint_as_float(kq.y & 0xffff0000u)}; }
                nc[j] = donv ? nchunk[(size_t)item * 128 + tid] : 0.f;
                fc[j] = scal[item]; mc[j] = scal[2048 + item];
            }
#pragma unroll
            for (int j = 0; j < 4; ++j) {
                const int item = bh * 64 + n0 + j;
                store_bf16x4(cprev + (size_t)item * 16384 + idx, C);
                if (donv) nprev[(size_t)item * 128 + tid] = nv;
                if (sl == 0 && tid == 0) scal[4096 + item] = m;
                const float mn = fmaxf(fc[j] + m, mc[j]), so = expf(fc[j] + m - mn), sn = expf(mc[j] - mn);
                C = C * so + kv[j] * sn; nv = so * nv + sn * nc[j]; m = mn;
            }
        }
    }
}

__device__ __forceinline__ void ph_m3(const Params& P, lds_t* lds) {
    const bf16_t* qb = (const bf16_t*)(P.ws + WS_QB); const bf16_t* kb = (const bf16_t*)(P.ws + WS_KB); const bf16_t* vb = (const bf16_t*)(P.ws + WS_VB);
    const bf16_t* cprev = (const bf16_t*)(P.ws + WS_CPREV); const float* gates = (const float*)(P.ws + WS_GATES);
    const float* nprev = (const float*)(P.ws + WS_MISC) + 2048 * 128; const float* scal = (const float*)(P.ws + WS_MISC) + 2 * 2048 * 128;
    const bf16_t* proj = (const bf16_t*)(P.ws + WS_PROJ); bf16_t* cat = (bf16_t*)(P.ws + WS_CAT);
    lds_t* Qt = lds; lds_t* Kt = lds + 64 * TP; lds_t* Vt = lds + 128 * TP; lds_t* Ct = lds + 192 * TP;
    LAS float* cumf = (LAS float*)(lds + 320 * TP); LAS float* gv = cumf + 64; LAS float* msv = gv + 64; LAS float* npv = msv + 64; LAS float* ex = npv + 128;
    const int tid = threadIdx.x, lane = tid & 63, w = tid >> 6, fr = lane & 15, fq = lane >> 4, q = (lane & 15) >> 2, p4 = lane & 3;
    const int rt = w & 3, vh = w >> 2;
    int item = blockIdx.x; if (item >= 2048) return;
    u32x4 rq[2], rk[2], rv[2], rc[4]; float pf_f, pf_i, pf_n, pf_mp;
#define M3_LOAD(IT) do { const int bh_ = (IT) >> 6, n_ = (IT) & 63, b_ = bh_ >> 2, h_ = bh_ & 3; const size_t t0_ = (size_t)b_ * SEQ + n_ * 64; \
        _Pragma("unroll") for (int i_ = 0; i_ < 2; ++i_) { const int p_ = tid + i_ * NTHREADS; const size_t o_ = (t0_ + (p_ >> 4)) * 512 + h_ * 128 + (p_ & 15) * 8; rq[i_] = *(const u32x4*)(qb + o_); rk[i_] = *(const u32x4*)(kb + o_); rv[i_] = *(const u32x4*)(vb + o_); } \
        _Pragma("unroll") for (int i_ = 0; i_ < 4; ++i_) { const int p_ = tid + i_ * NTHREADS; rc[i_] = *(const u32x4*)(cprev + (size_t)(IT) * 16384 + (p_ >> 4) * 128 + (p_ & 15) * 8); } \
        pf_f = gates[(t0_ + lane) * 8 + 4 + h_]; pf_i = gates[(t0_ + lane) * 8 + h_]; pf_n = nprev[(size_t)(IT) * 128 + (tid & 127)]; pf_mp = scal[4096 + (IT)]; } while (0)
    M3_LOAD(item);
    for (;;) {
        const int bh = item >> 6, n = item & 63, b = bh >> 2, h = bh & 3; const size_t tok0 = (size_t)b * SEQ + n * 64;
#pragma unroll
        for (int i = 0; i < 2; ++i) { const int p = tid + i * NTHREADS; const int o = (p >> 4) * TP + (p & 15) * 16; *(LAS u32x4*)(Qt + o) = rq[i]; *(LAS u32x4*)(Kt + o) = rk[i]; *(LAS u32x4*)(Vt + o) = rv[i]; }
#pragma unroll
        for (int i = 0; i < 4; ++i) { const int p = tid + i * NTHREADS; *(LAS u32x4*)(Ct + (p >> 4) * TP + (p & 15) * 16) = rc[i]; }
        if (tid < 128) npv[tid] = pf_n;
        const float mp = pf_mp;
        if (w == 0) {
            float cum = logsigmoidf(pf_f);
#pragma unroll
            for (int off = 1; off < 64; off <<= 1) { const float t = __shfl_up(cum, off); if (lane >= off) cum += t; }
            const float gg = pf_i - cum; float pm = gg;
#pragma unroll
            for (int off = 1; off < 64; off <<= 1) { const float t = __shfl_up(pm, off); if (lane >= off) pm = fmaxf(pm, t); }
            cumf[lane] = cum; gv[lane] = gg; msv[lane] = cum + fmaxf(pm, mp);
        }
        __syncthreads();
        const int nitem = item + gridDim.x; const bool has_next = nitem < 2048;
        if (has_next) M3_LOAD(nitem);
        u32x2 opv[4];
#pragma unroll
        for (int c = 0; c < 4; ++c) opv[c] = *(const u32x2*)(proj + (tok0 + rt * 16 + fr) * 2560 + 512 + h * 128 + vh * 64 + c * 16 + fq * 4);
        bf16x8 qf[4];
#pragma unroll
        for (int ks = 0; ks < 4; ++ks) qf[ks] = *(LAS bf16x8*)(Qt + (rt * 16 + fr) * TP + ks * 64 + fq * 16);
        const int s = rt * 16 + fr; const float cs = cumf[s], mss = msv[s];
        float sp[4][4]; float rowsum = 0.f;
#pragma unroll
        for (int jt = 0; jt < 4; ++jt) {
            f32x4 st = {0.f, 0.f, 0.f, 0.f};
            if (jt <= rt) {
#pragma unroll
                for (int ks = 0; ks < 4; ++ks) st = MFMA16(*(LAS bf16x8*)(Kt + (jt * 16 + fr) * TP + ks * 64 + fq * 16), qf[ks], st);
            }
            const f32x4 g4 = *(LAS f32x4*)(gv + jt * 16 + fq * 4);
#pragma unroll
            for (int r = 0; r < 4; ++r) { const int j = jt * 16 + fq * 4 + r; const float wgt = (j <= s) ? fexp(cs + g4[r] - mss) : 0.f; sp[jt][r] = st[r] * wgt; rowsum += sp[jt][r]; }
        }
        rowsum += __shfl_xor(rowsum, 16); rowsum += __shfl_xor(rowsum, 32);
        float qn = 0.f;
#pragma unroll
        for (int ks = 0; ks < 4; ++ks) {
            const f32x4 n0 = *(LAS f32x4*)(npv + ks * 32 + fq * 8), n1 = *(LAS f32x4*)(npv + ks * 32 + fq * 8 + 4);
#pragma unroll
            for (int e = 0; e < 4; ++e) { qn += bf2f((unsigned short)qf[ks][e]) * n0[e]; qn += bf2f((unsigned short)qf[ks][4 + e]) * n1[e]; }
        }
        qn += __shfl_xor(qn, 16); qn += __shfl_xor(qn, 32);
        const float inter = expf(cs + mp - mss), den = rowsum + inter * qn, inv = 1.0f / fmaxf(fabsf(den), expf(-mss));
        bf16x8 pa[2];
#pragma unroll
        for (int kk = 0; kk < 2; ++kk) { u32x4 u = {pk_bf16(sp[2 * kk][0], sp[2 * kk][1]), pk_bf16(sp[2 * kk][2], sp[2 * kk][3]), pk_bf16(sp[2 * kk + 1][0], sp[2 * kk + 1][1]), pk_bf16(sp[2 * kk + 1][2], sp[2 * kk + 1][3])}; pa[kk] = __builtin_bit_cast(bf16x8, u); }
        f32x4 yo[4];
#pragma unroll
        for (int c = 0; c < 4; ++c) {
            const int vcol = vh * 64 + c * 16;
            f32x4 acc = {0.f, 0.f, 0.f, 0.f};
#pragma unroll
            for (int ks = 0; ks < 4; ++ks) acc = MFMA16(*(LAS bf16x8*)(Ct + (vcol + fr) * TP + ks * 64 + fq * 16), qf[ks], acc);
            acc = acc * inter;
#pragma unroll
            for (int kk = 0; kk < 2; ++kk) {
                const bf16x8 vbf = cat44(tr_read(Vt + (32 * kk + 4 * fq + q) * TP + (vcol + 4 * p4) * 2), tr_read(Vt + (32 * kk + 16 + 4 * fq + q) * TP + (vcol + 4 * p4) * 2));
                acc = MFMA16(vbf, pa[kk], acc);
            }
            const float og[4] = {__uint_as_float(opv[c].x << 16), __uint_as_float(opv[c].x & 0xffff0000u), __uint_as_float(opv[c].y << 16), __uint_as_float(opv[c].y & 0xffff0000u)};
#pragma unroll
            for (int r = 0; r < 4; ++r) yo[c][r] = fsigmoid(og[r]) * acc[r] * inv;
        }
        {
            bf16_t* orow = cat + (tok0 + rt * 16 + fr) * 1024 + h * 128 + vh * 64;
            store_pair_bf16(orow, fq, yo[0], yo[1]); store_pair_bf16(orow + 32, fq, yo[2], yo[3]);
        }
        __syncthreads();
        if (!has_next) break;
        item = nitem;
    }
#undef M3_LOAD
}

__device__ __forceinline__ void ph_attn(const Params& P, lds_t* lds) {
    const bf16_t* proj = (const bf16_t*)(P.ws + WS_PROJ); bf16_t* atto = (bf16_t*)(P.ws + WS_ATTO); float* lse = (float*)(P.ws + WS_LSE);
    lds_t* Kt = lds; lds_t* Vt = lds + 256 * TP; LAS float* ex = (LAS float*)(lds + 512 * TP);
    const int tid = threadIdx.x, lane = tid & 63, w = tid >> 6, fr = lane & 15, fq = lane >> 4, q = (lane & 15) >> 2, p4 = lane & 3;
    const int per = (3072 + (int)gridDim.x - 1) / (int)gridDim.x;
    int item = (int)blockIdx.x * per; const int iend = (item + per < 3072) ? item + per : 3072;
    if (item >= iend) return;
    u32x4 rg[16]; bf16x8 qf[4], qn[4];
#define AT_DECODE(IT) const int g = (IT) >> 10, rem = (IT) & 1023, dsh = 2 * g, dil = 1 << dsh, nbsh = 5 - dsh, nb = rem & ((1 << nbsh) - 1), chain = rem >> nbsh, \
        h = chain & 3, br = chain >> 2, r = br & (dil - 1), b = br >> dsh; const size_t tokb = (size_t)b * SEQ + r;
#define AT_LOAD(IT, CHAINED, QF) do { AT_DECODE(IT) \
        _Pragma("unroll") for (int it8 = 0; it8 < 8; ++it8) { const int p = tid + it8 * NTHREADS, kr = p >> 4, pc = p & 15; const int i = nb * 128 + kr - 128; \
            rg[it8] = (u32x4){0u, 0u, 0u, 0u}; rg[8 + it8] = (u32x4){0u, 0u, 0u, 0u}; \
            if (i >= 0 && !((CHAINED) && it8 < 4)) { const bf16_t* src = proj + (tokb + (size_t)i * dil) * 2560 + h * 128 + pc * 8; rg[it8] = *(const u32x4*)(src + 1536); rg[8 + it8] = *(const u32x4*)(src + 2048); } } \
        const size_t tq_ = tokb + (size_t)(nb * 128 + w * 16 + fr) * dil; \
        _Pragma("unroll") for (int ks = 0; ks < 4; ++ks) QF[ks] = __builtin_bit_cast(bf16x8, *(const u32x4*)(proj + tq_ * 2560 + 1024 + h * 128 + ks * 32 + fq * 8)); } while (0)
    bool chained = false; int flip = 0;
    AT_LOAD(item, false, qf);
    for (;;) {
        if (!chained) {
            flip = 0;
#pragma unroll
            for (int it8 = 0; it8 < 8; ++it8) { const int p = tid + it8 * NTHREADS, kr = p >> 4, pc = p & 15; *(LAS u32x4*)(Kt + kr * TP + pc * 16) = rg[it8]; *(LAS u32x4*)(Vt + kr * TP + pc * 16) = rg[8 + it8]; }
        } else {
            flip ^= 1;
#pragma unroll
            for (int it8 = 4; it8 < 8; ++it8) { const int p = tid + it8 * NTHREADS, kr = (p >> 4) & 127, pc = p & 15; const int pr = ((1 ^ flip) << 7) + kr;
                *(LAS u32x4*)(Kt + pr * TP + pc * 16) = rg[it8]; *(LAS u32x4*)(Vt + pr * TP + pc * 16) = rg[8 + it8]; }
        }
        __syncthreads();
        const int nitem = item + 1; const bool has_next = nitem < iend;
        bool chained_next = false;
        if (has_next) { const int g2 = nitem >> 10, nbm = (1 << (5 - 2 * g2)) - 1; chained_next = (g2 == (item >> 10)) && ((nitem & 1023 & nbm) != 0); }
        if (has_next) { if (chained_next) AT_LOAD(nitem, true, qn); else AT_LOAD(nitem, false, qn); }
        AT_DECODE(item)
        const int qi = w * 16 + fr;
        const size_t tokq = tokb + (size_t)(nb * 128 + qi) * dil;
        float pv[9][4]; float mx = -INFINITY;
#pragma unroll
        for (int jj = 0; jj < 9; ++jj) {
            const int tw = w + jj, pt = ((((tw >> 3) ^ flip) & 1) << 3) + (tw & 7);
            f32x4 st = {0.f, 0.f, 0.f, 0.f};
#pragma unroll
            for (int ks = 0; ks < 4; ++ks) st = MFMA16(*(LAS bf16x8*)(Kt + (pt * 16 + fr) * TP + ks * 64 + fq * 16), qf[ks], st);
#pragma unroll
            for (int rr = 0; rr < 4; ++rr) {
                const int kj = tw * 16 + fq * 4 + rr;
                const bool valid = (kj >= qi) && (kj <= qi + 128) && (nb > 0 || kj >= 128);
                pv[jj][rr] = valid ? st[rr] : -INFINITY; mx = fmaxf(mx, pv[jj][rr]);
            }
        }
        mx = fmaxf(mx, __shfl_xor(mx, 16)); mx = fmaxf(mx, __shfl_xor(mx, 32));
        float l = 0.f;
#pragma unroll
        for (int jj = 0; jj < 9; ++jj)
#pragma unroll
            for (int rr = 0; rr < 4; ++rr) { pv[jj][rr] = fexp(pv[jj][rr] - mx); l += pv[jj][rr]; }
        l += __shfl_xor(l, 16); l += __shfl_xor(l, 32);
        if (fq == 0) lse[((size_t)g * T + tokq) * 4 + h] = mx + logf(l);
        const float inv = 1.0f / l;
        f32x4 acc[8];
#pragma unroll
        for (int c = 0; c < 8; ++c) acc[c] = (f32x4){0.f, 0.f, 0.f, 0.f};
#pragma unroll
        for (int kk = 0; kk < 5; ++kk) {
            const int ja = 2 * kk, jb = (2 * kk + 1 < 9) ? 2 * kk + 1 : 2 * kk;
            const int twa = w + ja, twb = w + jb;
            const int pa_t = ((((twa >> 3) ^ flip) & 1) << 3) + (twa & 7), pb_t = ((((twb >> 3) ^ flip) & 1) << 3) + (twb & 7);
            u32x4 u; u.x = pk_bf16(pv[ja][0], pv[ja][1]); u.y = pk_bf16(pv[ja][2], pv[ja][3]);
            if (2 * kk + 1 < 9) { u.z = pk_bf16(pv[jb][0], pv[jb][1]); u.w = pk_bf16(pv[jb][2], pv[jb][3]); } else { u.z = 0u; u.w = 0u; }
            const bf16x8 pa = __builtin_bit_cast(bf16x8, u);
#pragma unroll
            for (int c = 0; c < 8; ++c) {
                const bf16x8 vbf = cat44(tr_read(Vt + (pa_t * 16 + 4 * fq + q) * TP + (c * 16 + 4 * p4) * 2), tr_read(Vt + (pb_t * 16 + 4 * fq + q) * TP + (c * 16 + 4 * p4) * 2));
                acc[c] = MFMA16(vbf, pa, acc[c]);
            }
        }
        {
            bf16_t* orow = atto + ((size_t)g * T + tokq) * 512 + h * 128;
#pragma unroll
            for (int c = 0; c < 8; c += 2) store_pair_bf16(orow + c * 16, fq, acc[c] * inv, acc[c + 1] * inv);
        }
        __syncthreads();
        if (!has_next) break;
        item = nitem; chained = chained_next;
#pragma unroll
        for (int ks = 0; ks < 4; ++ks) qf[ks] = qn[ks];
    }
#undef AT_LOAD
#undef AT_DECODE
}

__device__ __forceinline__ void ph_attn_combine(const Params& P) {
    const bf16_t* atto = (const bf16_t*)(P.ws + WS_ATTO); const float* lse = (const float*)(P.ws + WS_LSE); bf16_t* cat = (bf16_t*)(P.ws + WS_CAT);
    const size_t gtid = (size_t)blockIdx.x * NTHREADS + threadIdx.x, GT = (size_t)gridDim.x * NTHREADS;
    for (size_t i0 = gtid; i0 < (size_t)T * 128; i0 += 4 * GT) {
        float l[4][3]; u32x2 o[4][3];
#pragma unroll
        for (int j = 0; j < 4; ++j) {
            const size_t i = i0 + j * GT, tok = i >> 7; const int c4 = (int)(i & 127) * 4, h = c4 >> 7;
#pragma unroll
            for (int g = 0; g < 3; ++g) { l[j][g] = lse[((size_t)g * T + tok) * 4 + h]; o[j][g] = *(const u32x2*)(atto + ((size_t)g * T + tok) * 512 + c4); }
        }
#pragma unroll
        for (int j = 0; j < 4; ++j) {
            const size_t i = i0 + j * GT, tok = i >> 7; const int c4 = (int)(i & 127) * 4;
            const float mx = fmaxf(l[j][0], fmaxf(l[j][1], l[j][2])), e0 = expf(l[j][0] - mx), e1 = expf(l[j][1] - mx), e2 = expf(l[j][2] - mx), inv = 1.0f / (e0 + e1 + e2);
            f32x4 of[3];
#pragma unroll
            for (int g = 0; g < 3; ++g) of[g] = (f32x4){__uint_as_float(o[j][g].x << 16), __uint_as_float(o[j][g].x & 0xffff0000u), __uint_as_float(o[j][g].y << 16), __uint_as_float(o[j][g].y & 0xffff0000u)};
            store_bf16x4(cat + tok * 1024 + 512 + c4, (of[0] * e0 + of[1] * e1 + of[2] * e2) * inv);
        }
    }
}

constexpr int NPHASES = 33;
__device__ __forceinline__ void grid_barrier_cg(cg::grid_group& grid) {
    asm volatile("s_waitcnt vmcnt(0)" ::: "memory");
    grid.sync();
    __builtin_amdgcn_fence(__ATOMIC_ACQUIRE, "agent");
    asm volatile("s_waitcnt vmcnt(0)" ::: "memory");
}
#define XB_TMO      128
#define XB_XCNT(j)  (256  + 64 * (j))
#define XB_XSUB(j)  (1280 + 64 * (j))
#define XB_XGEN(j)  (2304 + 64 * (j))
#define XB_TOP      3328
#define XB_TOPGEN   3392
#define XCD_BAR_WORDS 3456
#define XB_SPIN_CAP (1u << 22)
__device__ __forceinline__ unsigned xb_ld(unsigned* p)              { return __hip_atomic_load(p, __ATOMIC_RELAXED, __HIP_MEMORY_SCOPE_AGENT); }
__device__ __forceinline__ unsigned xb_add(unsigned* p, unsigned v) { return __hip_atomic_fetch_add(p, v, __ATOMIC_RELAXED, __HIP_MEMORY_SCOPE_AGENT); }
__device__ __forceinline__ unsigned xb_xcc_id() { return (unsigned)__builtin_amdgcn_s_getreg((3 << 11) | 20) & 0xFu; }
#define XB_SPIN(cond, bar) do { unsigned _sp = 0; while (cond) { __builtin_amdgcn_s_sleep(1); \
    if ((++_sp & 255u) == 0u) { if (xb_ld(&(bar)[XB_TMO])) break; if (_sp > XB_SPIN_CAP) { atomicAdd(&(bar)[XB_TMO], 1u); break; } } } } while (0)
struct XcdBarrier { unsigned* bar; unsigned x; volatile LAS unsigned* st; };
__device__ __forceinline__ XcdBarrier xcd_barrier_post(unsigned* bar, volatile LAS unsigned* st) {
    XcdBarrier b; b.bar = bar; b.x = xb_xcc_id(); b.st = st;
    if (threadIdx.x == 0) (void)xb_add(&bar[XB_XCNT(b.x)], 1u);
    return b;
}
__device__ __forceinline__ void xcd_barrier_complete(unsigned* bar, unsigned x, unsigned& nloc, unsigned& nx) {
    const unsigned G = gridDim.x * gridDim.y * gridDim.z;
    unsigned sum, cnt, mine, sp = 0u;
    for (;;) {
        sum = 0u; cnt = 0u; mine = 0u;
#pragma unroll
        for (unsigned j = 0; j < 16; ++j) { const unsigned c = xb_ld(&bar[XB_XCNT(j)]); sum += c; cnt += (c > 0u) ? 1u : 0u; mine = (j == x) ? c : mine; }
        if (sum == G) break;
        __builtin_amdgcn_s_sleep(1);
        if ((++sp & 255u) == 0u) { if (xb_ld(&bar[XB_TMO])) break; if (sp > XB_SPIN_CAP) { atomicAdd(&bar[XB_TMO], 1u); break; } }
    }
    nloc = mine > 0u ? mine : 1u; nx = cnt > 0u ? cnt : 1u;
}
__device__ __forceinline__ void xcd_barrier(const XcdBarrier& b) {
    asm volatile("s_waitcnt vmcnt(0)" ::: "memory");
    __syncthreads();
    if (threadIdx.x == 0) {
        unsigned* bar = b.bar;
        __builtin_amdgcn_s_waitcnt(0);
        unsigned nloc = b.st[0], nx = b.st[1];
        if (nloc == 0u) { xcd_barrier_complete(bar, b.x, nloc, nx); b.st[0] = nloc; b.st[1] = nx; }
        const unsigned old = xb_add(&bar[XB_XSUB(b.x)], 1u);
        const unsigned gen = old / nloc;
        if (old + 1u == (gen + 1u) * nloc) {
            __builtin_amdgcn_fence(__ATOMIC_RELEASE, "agent");
            asm volatile("s_waitcnt vmcnt(0)" ::: "memory");
            const unsigned og = xb_add(&bar[XB_TOP], 1u);
            const unsigned tg = og / nx;
            if (og + 1u == (tg + 1u) * nx) xb_add(&bar[XB_TOPGEN], 1u);
            else XB_SPIN(xb_ld(&bar[XB_TOPGEN]) == tg, bar);
            __builtin_amdgcn_fence(__ATOMIC_ACQUIRE, "agent");
            xb_add(&bar[XB_XGEN(b.x)], 1u);
            asm volatile("s_waitcnt vmcnt(0)" ::: "memory");
        } else {
            XB_SPIN(xb_ld(&bar[XB_XGEN(b.x)]) == gen, bar);
            __builtin_amdgcn_fence(__ATOMIC_ACQUIRE, "agent");
            asm volatile("s_waitcnt vmcnt(0)" ::: "memory");
        }
    }
    __syncthreads();
}
typedef __attribute__((address_space(4))) const Params* KP4;
__device__ __forceinline__ const Params& phase_params() { KP4 kp = (KP4)__builtin_amdgcn_kernarg_segment_ptr(); asm volatile("" : "+s"(kp)); return *(const Params*)kp; }
__global__ void __launch_bounds__(NTHREADS) fwd_megakernel(Params Pk) {
    extern __shared__ __attribute__((aligned(16))) unsigned char lds_raw[];
    lds_t* lds = (lds_t*)lds_raw;
    cg::grid_group grid = cg::this_grid();
    const int ph_lo = Pk.ph_lo, ph_hi = Pk.ph_hi;
    unsigned* barw = (unsigned*)(Pk.ws + WS_CTL) + 4096;
    volatile LAS unsigned* bst = (volatile LAS unsigned*)(lds + LDS_BYTES - 64);
    if (threadIdx.x == 0) { bst[0] = 0u; bst[1] = 0u; }
    if (ph_hi < 0) grid_barrier_cg(grid);
    (void)xcd_barrier_post(barw, bst);
#define SEAM(k) do { XcdBarrier xb_; xb_.bar = (unsigned*)(P.ws + WS_CTL) + 4096; xb_.x = xb_xcc_id(); xb_.st = bst; xcd_barrier(xb_); } while (0)
#define PHASE(k, ...) if (ph_lo <= (k) && (k) < ph_hi) { const Params& P = phase_params(); unsigned char* ws = P.ws; (void)ws; __VA_ARGS__; if ((k) + 1 < ph_hi) SEAM(k); }
    PHASE(0, phase0(P, lds))
    PHASE(1, ph_inproj2(P, lds, (const bf16_t*)(ws + WS_WABIN), 1536, nullptr))
    PHASE(2, ph_conv0(P); ph_s5_state(P, lds))
    PHASE(3, ph_gates0(P, lds); ph_s5_carry(P))
    PHASE(4, ph_s5_out(P, lds))
    PHASE(5, ph_glu(P, lds); ph_lru_scan(P, lds))
    PHASE(6, ph_outproj2(P, lds, (const bf16_t*)(ws + WS_WABOUT)))
    PHASE(7, ph_ln_router(P, lds, 0))
    PHASE(8, ph_moe_up2(P, lds, 0))
    PHASE(9, ph_moe_down2(P, lds, 0))
    PHASE(10, ph_combine_ln(P, lds, 0, nullptr))
    PHASE(11, ph_inproj2(P, lds, (const bf16_t*)(ws + WS_WCDIN), 2560, (const int*)P.in[I_POS]); moe_pstart(P, lds, 0); convert_moe_weights(P, 1, tail_done_all(((LAS int*)(lds + PS_OFF))[32] >> 8, (int)gridDim.x), lds))
    PHASE(12, ph_conv1(P, lds))
    PHASE(13, ph_qkv(P, lds))
    PHASE(14, ph_m1(P, lds); ph_attn(P, lds))
    PHASE(15, ph_m2(P); ph_attn_combine(P))
    PHASE(16, ph_m3(P, lds))
    PHASE(17, ph_outproj2(P, lds, (const bf16_t*)(ws + WS_WCDOUT)))
    PHASE(18, ph_ln_router(P, lds, 1))
    PHASE(19, ph_moe_up2(P, lds, 1))
    PHASE(20, ph_moe_down2(P, lds, 1))
    PHASE(21, ph_combine_ln(P, lds, 1, P.out))
#undef PHASE
}

extern "C" void kernel_launch(void* const* d_in, const int* in_sizes, int n_in, void* d_out, int out_size, void* d_ws, size_t ws_size, hipStream_t stream) {
    static int grid_blocks = 0;
    if (grid_blocks == 0) {
        if (n_in != N_IN || out_size != T * D || ws_size < WS_END) { fprintf(stderr, "kernel_launch: unexpected shapes (n_in %d out %d ws %zu need %zu)\n", n_in, out_size, ws_size, (size_t)WS_END); grid_blocks = -1; return; }
        int dev = 0, cus = 0, per_cu = 0;
        (void)hipGetDevice(&dev);
        (void)hipDeviceGetAttribute(&cus, hipDeviceAttributeMultiprocessorCount, dev);
        if (hipFuncSetAttribute((const void*)fwd_megakernel, hipFuncAttributeMaxDynamicSharedMemorySize, LDS_BYTES) != hipSuccess) { fprintf(stderr, "kernel_launch: hipFuncSetAttribute failed\n"); grid_blocks = -1; return; }
        (void)hipOccupancyMaxActiveBlocksPerMultiprocessor(&per_cu, (const void*)fwd_megakernel, NTHREADS, LDS_BYTES);
        if (per_cu < 1) { fprintf(stderr, "kernel_launch: occupancy query returned %d\n", per_cu); grid_blocks = -1; return; }
        grid_blocks = cus * per_cu;
        if (grid_blocks != 256) { fprintf(stderr, "kernel_launch: built for a 256-workgroup resident grid (256 CUs x 1), got %d x %d; nothing launched\n", cus, per_cu); grid_blocks = -1; return; }
    }
    if (grid_blocks < 0) return;
    (void)hipMemsetAsync((unsigned char*)d_ws + WS_CTL, 0, 65536, stream);
    Params p{};
    for (int i = 0; i < N_IN; ++i) p.in[i] = (const float*)d_in[i];
    p.out = (float*)d_out; p.ws = (unsigned char*)d_ws;
    p.ph_lo = 0; p.ph_hi = 22;
    void* args[] = {&p};
    hipError_t e = hipLaunchCooperativeKernel((const void*)fwd_megakernel, dim3(grid_blocks), dim3(NTHREADS), args, LDS_BYTES, stream);
    if (e != hipSuccess) fprintf(stderr, "cooperative launch failed: %s (grid %d)\n", hipGetErrorString(e), grid_blocks);
}
```
